# Optimizing an MI355X kernel written in HIP

```python
import math
import jax, jax.numpy as jnp
from jax import lax
import numpy as np

D_MODEL = 2048
BATCH = 2
SEQ = 8192
DEPTH = 4

HEAD_DIM = 64
Q_CHUNK = 128
A_CONFIGS = ((128, 1), (512, 4), (2048, 16))
N_A_GROUPS = len(A_CONFIGS)
A_HEADS_PER_GROUP = 4
A_HEADS = N_A_GROUPS * A_HEADS_PER_GROUP
A_BLOCK = 128
B_HEADS = 8
MOBA_BLOCK = 256
MOBA_TOPK = 3
C_KV_HEADS = 3
C_GROUP = 4
C_HEADS = C_KV_HEADS * C_GROUP
CMP_STRIDE = 16
CMP_LEN = 2 * CMP_STRIDE
CMP_HIDDEN = 128
SLC_BLOCK = 64
SLC_TOPN = 16
WIN = 512
FORCE_SCORE = 1e9
N_HEADS = A_HEADS + B_HEADS + C_HEADS
MIX_WIDTH = N_HEADS * HEAD_DIM
A_WIDTH = 3 * A_HEADS * HEAD_DIM
B_WIDTH = 3 * B_HEADS * HEAD_DIM
C_Q_WIDTH = C_HEADS * HEAD_DIM
C_KV_WIDTH = 6 * C_KV_HEADS * HEAD_DIM
C_GATE_WIDTH = 3 * C_HEADS
IN_WIDTH = A_WIDTH + B_WIDTH + C_Q_WIDTH + C_KV_WIDTH + C_GATE_WIDTH
D_FF = 5632
CONV_WIDTH = 3
N_BUCKETS = 32
T5_MAX_DIST = 2048
EPS = 1e-6
NEG = -1e30
Q_SCALE = HEAD_DIM ** -0.5

kernel_name = "hybrid_dilated_moba_nsa_convffn"


def rmsnorm(x, g):
    x32 = x.astype(jnp.float32)
    y = x32 * lax.rsqrt(jnp.mean(x32 * x32, axis=-1, keepdims=True) + EPS)
    return (y * g.astype(jnp.float32)).astype(x.dtype)


def t5_bucket(dist):
    n = jnp.maximum(dist, 0)
    max_exact = N_BUCKETS // 2
    nf = jnp.maximum(n, 1).astype(jnp.float32)
    large = max_exact + (jnp.log(nf / max_exact) / math.log(T5_MAX_DIST / max_exact)
                         * (N_BUCKETS - max_exact)).astype(jnp.int32)
    large = jnp.minimum(large, N_BUCKETS - 1)
    return jnp.where(n < max_exact, n, large)


def masked_softmax(s, mask):
    s32 = jnp.where(mask, s.astype(jnp.float32), NEG)
    m = jnp.max(s32, axis=-1, keepdims=True)
    e = jnp.where(mask, jnp.exp(s32 - m), 0.0)
    den = jnp.sum(e, axis=-1, keepdims=True)
    p = e / jnp.maximum(den, 1e-30)
    lse = m[..., 0] + jnp.log(jnp.maximum(den[..., 0], 1e-30))
    return p, lse


def dilated_group(q, k, v, window, dilation, tbl):
    B, S, H, dh = q.shape
    L = S // dilation
    nq = -(-L // A_BLOCK)
    Lp = nq * A_BLOCK
    nback = window // dilation

    def to_class(t):
        t = t.reshape(B, L, dilation, H, dh).transpose(0, 2, 3, 1, 4)
        return jnp.pad(t, ((0, 0), (0, 0), (0, 0), (0, Lp - L), (0, 0)))

    def band(t):
        tp = jnp.pad(t, ((0, 0), (0, 0), (0, 0), (A_BLOCK, 0), (0, 0)))
        prev = tp[:, :, :, :Lp].reshape(B, dilation, H, nq, A_BLOCK, dh)
        cur = t.reshape(B, dilation, H, nq, A_BLOCK, dh)
        return jnp.concatenate([prev, cur], axis=4)

    qb = to_class(q).reshape(B, dilation, H, nq, A_BLOCK, dh)
    kb = band(to_class(k))
    vb = band(to_class(v))
    a = jnp.arange(A_BLOCK)[:, None]
    bk = jnp.arange(2 * A_BLOCK)[None, :]
    rel = a + A_BLOCK - bk
    key_idx = jnp.arange(nq)[:, None, None] * A_BLOCK - A_BLOCK + bk[None]
    mask = (rel >= 0)[None] & (rel <= nback)[None] & (key_idx >= 0)
    bias = tbl[:, t5_bucket(rel * dilation)]
    s = jnp.einsum('bdhnqe,bdhnke->bdhnqk', qb, kb) + bias[:, None]
    p, lse = masked_softmax(s, mask)
    o = jnp.einsum('bdhnqk,bdhnke->bdhnqe', p.astype(v.dtype), vb)
    o = o.reshape(B, dilation, H, Lp, dh)[:, :, :, :L].transpose(0, 3, 1, 2, 4).reshape(B, S, H, dh)
    lse = lse.reshape(B, dilation, H, Lp)[:, :, :, :L].transpose(0, 3, 1, 2).reshape(B, S, H)
    return o, lse


def dilated_mixer(pA, tbl_a):
    B, S = pA.shape[:2]
    outs, lses = [], []
    for g, (w, d) in enumerate(A_CONFIGS):
        o, lse = dilated_group(pA[:, :, g, 0] * Q_SCALE, pA[:, :, g, 1], pA[:, :, g, 2], w, d,
                               tbl_a[g * A_HEADS_PER_GROUP:(g + 1) * A_HEADS_PER_GROUP])
        outs.append(o)
        lses.append(lse)
    alpha = jax.nn.softmax(jnp.stack(lses, axis=2), axis=2)
    o = jnp.stack(outs, axis=2) * alpha[..., None].astype(outs[0].dtype)
    return o.reshape(B, S, A_HEADS * HEAD_DIM)


def moba_mixer(q, k, v, tbl):
    B, S, H, dh = q.shape
    q, k, v = (t.transpose(0, 2, 1, 3) for t in (q, k, v))
    nb = -(-S // MOBA_BLOCK)
    Sp = nb * MOBA_BLOCK
    kp = jnp.pad(k, ((0, 0), (0, 0), (0, Sp - S), (0, 0)))
    vp = jnp.pad(v, ((0, 0), (0, 0), (0, Sp - S), (0, 0)))
    kb = kp.reshape(B, H, nb, MOBA_BLOCK, dh)
    vb = vp.reshape(B, H, nb, MOBA_BLOCK, dh)
    kmean = jnp.mean(kb.astype(jnp.float32), axis=3).astype(k.dtype)
    topk = min(MOBA_TOPK, nb)
    ar_b = jnp.arange(B)[:, None, None, None]
    ar_h = jnp.arange(H)[None, :, None, None]
    blk_off = jnp.arange(MOBA_BLOCK)

    def chunk(c):
        start = c * Q_CHUNK
        t = start + jnp.arange(Q_CHUNK)
        ob = start // MOBA_BLOCK
        qc = lax.dynamic_slice_in_dim(q, start, Q_CHUNK, axis=2)
        gate = jnp.einsum('bhqe,bhne->bhqn', qc, kmean).astype(jnp.float32)
        past = jnp.arange(nb) < ob
        gate = jnp.where(past, gate, NEG)
        _, idx = lax.top_k(gate, topk)
        sel_ok = idx < ob
        ks = kb[ar_b, ar_h, idx].reshape(B, H, Q_CHUNK, topk * MOBA_BLOCK, dh)
        vs = vb[ar_b, ar_h, idx].reshape(B, H, Q_CHUNK, topk * MOBA_BLOCK, dh)
        pos_s = (idx[..., None] * MOBA_BLOCK + blk_off).reshape(B, H, Q_CHUNK, topk * MOBA_BLOCK)
        mask_s = jnp.repeat(sel_ok, MOBA_BLOCK, axis=-1)
        ko = lax.dynamic_slice_in_dim(kp, ob * MOBA_BLOCK, MOBA_BLOCK, axis=2)
        vo = lax.dynamic_slice_in_dim(vp, ob * MOBA_BLOCK, MOBA_BLOCK, axis=2)
        pos_o = ob * MOBA_BLOCK + blk_off
        mask_o = jnp.broadcast_to(pos_o[None, :] <= t[:, None], (B, H, Q_CHUNK, MOBA_BLOCK))
        s_s = (jnp.einsum('bhqe,bhqke->bhqk', qc, ks)
               + tbl[ar_h, t5_bucket(t[None, None, :, None] - pos_s)])
        s_o = (jnp.einsum('bhqe,bhke->bhqk', qc, ko)
               + tbl[:, t5_bucket(t[:, None] - pos_o[None, :])][None])
        p, _ = masked_softmax(jnp.concatenate([s_s, s_o], -1), jnp.concatenate([mask_s, mask_o], -1))
        p = p.astype(v.dtype)
        n_sel = topk * MOBA_BLOCK
        return (jnp.einsum('bhqk,bhqke->bhqe', p[..., :n_sel], vs)
                + jnp.einsum('bhqk,bhke->bhqe', p[..., n_sel:], vo))

    outs = lax.map(chunk, jnp.arange(S // Q_CHUNK))
    return outs.transpose(1, 0, 3, 2, 4).reshape(B, S, H * dh)


def nsa_mixer(q, kvC, gates, cmp_w1, cmp_w2, cmp_pe, tbl):
    B, S, _, dh = q.shape
    KV, G = C_KV_HEADS, C_GROUP
    q = q.reshape(B, S, KV, G, dh).transpose(0, 2, 3, 1, 4)
    k_cmp, v_cmp, k_slc, v_slc, k_win, v_win = (kvC[:, :, i].transpose(0, 2, 1, 3) for i in range(6))
    gates = gates.reshape(B, S, KV, G, 3).transpose(0, 2, 3, 1, 4)
    n_cmp = S // CMP_STRIDE - 1
    n_slc = S // SLC_BLOCK
    n_sel = min(SLC_TOPN, n_slc)

    def compress(t, w1, w2, pe):
        sub = t.reshape(B, KV, S // CMP_STRIDE, CMP_STRIDE, dh)
        blocks = jnp.concatenate([sub[:, :, :-1], sub[:, :, 1:]], axis=3) + pe
        return jax.nn.gelu(blocks.reshape(B, KV, n_cmp, CMP_LEN * dh) @ w1) @ w2

    kc = compress(k_cmp, cmp_w1[0], cmp_w2[0], cmp_pe[0])
    vc = compress(v_cmp, cmp_w1[1], cmp_w2[1], cmp_pe[1])
    cmp_end = jnp.arange(n_cmp) * CMP_STRIDE + CMP_LEN - 1
    ci = jnp.arange(n_cmp)[:, None] * CMP_STRIDE
    sj = jnp.arange(n_slc)[None, :] * SLC_BLOCK
    overlap = ((ci < sj + SLC_BLOCK) & (ci + CMP_LEN > sj)).astype(jnp.float32)
    ksb = k_slc.reshape(B, KV, n_slc, SLC_BLOCK, dh)
    vsb = v_slc.reshape(B, KV, n_slc, SLC_BLOCK, dh)
    kwp = jnp.pad(k_win, ((0, 0), (0, 0), (WIN, 0), (0, 0)))
    vwp = jnp.pad(v_win, ((0, 0), (0, 0), (WIN, 0), (0, 0)))
    tbl_kgn = tbl.reshape(KV, G, N_BUCKETS)
    tbl_kng = tbl_kgn.transpose(0, 2, 1)
    ar_b = jnp.arange(B)[:, None, None, None]
    ar_kv = jnp.arange(KV)[None, :, None, None]
    slc_off = jnp.arange(SLC_BLOCK)
    jj = jnp.arange(n_slc)[None, :]

    def chunk(c):
        start = c * Q_CHUNK
        t = start + jnp.arange(Q_CHUNK)
        qc = lax.dynamic_slice_in_dim(q, start, Q_CHUNK, axis=3)
        s_c = jnp.einsum('bkgqe,bkne->bkgqn', qc, kc)
        p_c, _ = masked_softmax(s_c, cmp_end[None, :] <= t[:, None])
        o_c = jnp.einsum('bkgqn,bkne->bkgqe', p_c.astype(v_cmp.dtype), vc)
        imp = jnp.einsum('bkgqn,nj->bkqj', p_c, overlap)
        own = (t // SLC_BLOCK)[:, None]
        valid = jj <= own
        forced = (jj == 0) | (jj == own) | (jj == own - 1)
        score = jnp.where(valid, jnp.where(forced, FORCE_SCORE, imp), -1.0)
        _, idx = lax.top_k(score, n_sel)
        ks = ksb[ar_b, ar_kv, idx].reshape(B, KV, Q_CHUNK, n_sel * SLC_BLOCK, dh)
        vs = vsb[ar_b, ar_kv, idx].reshape(B, KV, Q_CHUNK, n_sel * SLC_BLOCK, dh)
        pos = (idx[..., None] * SLC_BLOCK + slc_off).reshape(B, KV, Q_CHUNK, n_sel * SLC_BLOCK)
        dist = t[None, None, :, None] - pos
        bias_s = tbl_kng[ar_kv, t5_bucket(dist)].transpose(0, 1, 4, 2, 3)
        s_s = jnp.einsum('bkgqe,bkqse->bkgqs', qc, ks) + bias_s
        p_s, _ = masked_softmax(s_s, (dist >= 0)[:, :, None])
        o_s = jnp.einsum('bkgqs,bkqse->bkgqe', p_s.astype(v_slc.dtype), vs)
        kw = lax.dynamic_slice_in_dim(kwp, start, Q_CHUNK + WIN, axis=2)
        vw = lax.dynamic_slice_in_dim(vwp, start, Q_CHUNK + WIN, axis=2)
        pos_w = start - WIN + jnp.arange(Q_CHUNK + WIN)
        dist_w = t[:, None] - pos_w[None, :]
        mask_w = (dist_w >= 0) & (dist_w < WIN) & (pos_w[None, :] >= 0)
        s_w = jnp.einsum('bkgqe,bkse->bkgqs', qc, kw) + tbl_kgn[:, :, t5_bucket(dist_w)]
        p_w, _ = masked_softmax(s_w, mask_w)
        o_w = jnp.einsum('bkgqs,bkse->bkgqe', p_w.astype(v_win.dtype), vw)
        g = lax.dynamic_slice_in_dim(gates, start, Q_CHUNK, axis=3).astype(o_c.dtype)
        return g[..., 0:1] * o_c + g[..., 1:2] * o_s + g[..., 2:3] * o_w

    outs = lax.map(chunk, jnp.arange(S // Q_CHUNK))
    return outs.transpose(1, 0, 4, 2, 3, 5).reshape(B, S, C_HEADS * dh)


def conv_ffn(h, w_up, conv_w, conv_b, w_down):
    S = h.shape[1]
    u = h @ w_up
    up = jnp.pad(u, ((0, 0), (CONV_WIDTH - 1, 0), (0, 0)))
    acc = conv_b
    for j in range(CONV_WIDTH):
        acc = acc + conv_w[j] * up[:, CONV_WIDTH - 1 - j:CONV_WIDTH - 1 - j + S]
    a, g = jnp.split(acc, 2, axis=-1)
    return (jax.nn.silu(g) * a) @ w_down


def setup_inputs(seed: int = 0) -> dict:
    key = jax.random.key(seed)
    ks = jax.random.split(key, 14)
    nrm = jax.random.normal
    f32 = jnp.float32
    return {
        "x": nrm(ks[0], (BATCH, SEQ, D_MODEL), f32),
        "rel_table": 0.5 * nrm(ks[1], (N_HEADS, N_BUCKETS), f32),
        "w_in": nrm(ks[2], (DEPTH, D_MODEL, IN_WIDTH), f32) * D_MODEL ** -0.5,
        "w_out": nrm(ks[3], (DEPTH, MIX_WIDTH, D_MODEL), f32) * MIX_WIDTH ** -0.5,
        "cmp_w1": nrm(ks[4], (DEPTH, 2, CMP_LEN * HEAD_DIM, CMP_HIDDEN), f32) * (CMP_LEN * HEAD_DIM) ** -0.5,
        "cmp_w2": nrm(ks[5], (DEPTH, 2, CMP_HIDDEN, HEAD_DIM), f32) * CMP_HIDDEN ** -0.5,
        "cmp_pe": 0.5 * nrm(ks[6], (DEPTH, 2, CMP_LEN, HEAD_DIM), f32),
        "norm_attn": 1.0 + 0.05 * nrm(ks[7], (DEPTH, D_MODEL), f32),
        "norm_mlp": 1.0 + 0.05 * nrm(ks[8], (DEPTH, D_MODEL), f32),
        "w_up": nrm(ks[9], (DEPTH, D_MODEL, 2 * D_FF), f32) * D_MODEL ** -0.5,
        "conv_w": nrm(ks[10], (DEPTH, CONV_WIDTH, 2 * D_FF), f32) * CONV_WIDTH ** -0.5,
        "conv_b": 0.02 * nrm(ks[11], (DEPTH, 2 * D_FF), f32),
        "w_down": nrm(ks[12], (DEPTH, D_FF, D_MODEL), f32) * D_FF ** -0.5,
        "norm_final": 1.0 + 0.05 * nrm(ks[13], (D_MODEL,), f32),
    }


def reference(x, rel_table, w_in, w_out, cmp_w1, cmp_w2, cmp_pe, norm_attn, norm_mlp,
              w_up, conv_w, conv_b, w_down, norm_final):
    B, S, _ = x.shape
    tbl_a = rel_table[:A_HEADS]
    tbl_b = rel_table[A_HEADS:A_HEADS + B_HEADS]
    tbl_c = rel_table[A_HEADS + B_HEADS:]
    for l in range(DEPTH):
        h = rmsnorm(x, norm_attn[l])
        proj = h @ w_in[l]
        pA = proj[..., :A_WIDTH].reshape(B, S, N_A_GROUPS, 3, A_HEADS_PER_GROUP, HEAD_DIM)
        pB = proj[..., A_WIDTH:A_WIDTH + B_WIDTH].reshape(B, S, 3, B_HEADS, HEAD_DIM)
        pC = proj[..., A_WIDTH + B_WIDTH:]
        o_a = dilated_mixer(pA, tbl_a)
        o_b = moba_mixer(pB[:, :, 0] * Q_SCALE, pB[:, :, 1], pB[:, :, 2], tbl_b)
        q_c = pC[..., :C_Q_WIDTH].reshape(B, S, C_HEADS, HEAD_DIM) * Q_SCALE
        kv_c = pC[..., C_Q_WIDTH:C_Q_WIDTH + C_KV_WIDTH].reshape(B, S, 6, C_KV_HEADS, HEAD_DIM)
        g_c = jax.nn.sigmoid(pC[..., C_Q_WIDTH + C_KV_WIDTH:].reshape(B, S, C_HEADS, 3))
        o_c = nsa_mixer(q_c, kv_c, g_c, cmp_w1[l], cmp_w2[l], cmp_pe[l], tbl_c)
        x = x + jnp.concatenate([o_a, o_b, o_c], axis=-1) @ w_out[l]
        h = rmsnorm(x, norm_mlp[l])
        x = x + conv_ffn(h, w_up[l], conv_w[l], conv_b[l], w_down[l])
    return rmsnorm(x, norm_final)
```

```cpp
#include <hip/hip_runtime.h>
#include <hip/hip_cooperative_groups.h>
#include <cstdio>
#include <cstdint>
namespace cg = cooperative_groups;
namespace pg8 {
#define PG8_LAS __attribute__((address_space(3)))
typedef unsigned short bf16_t;
typedef short bf16x8 __attribute__((ext_vector_type(8)));
typedef float f32x4 __attribute__((ext_vector_type(4)));
typedef unsigned u32x4 __attribute__((ext_vector_type(4)));
constexpr int BM = 256, BK = 64, HALF = 128, HTB = HALF * BK * 2  , STAGE_BYTES = 8 * HTB, NXCD = 8, WGM = 8;

__host__ __device__ __forceinline__ int lds_byte(int r, int c) { const int st = (r >> 4) * 2 + (c >> 5), rr = r & 15, cc = c & 31, ob = rr * 64 + cc * 2; return st * 1024 + (ob ^ (((ob >> 9) & 1) << 5)); }
__host__ __device__ __forceinline__ void stage_rc(int b, int& R, int& C) { const int st = b / 1024, sb = b % 1024, swz = sb ^ (((sb >> 9) & 1) << 5); R = (st >> 1) * 16 + swz / 64; C = (st & 1) * 32 + (swz % 64) / 2; }
__host__ __device__ __forceinline__ int perm32(int rho) { const int n = rho >> 4, i = rho & 15; return 8 * (i >> 2) + 4 * n + (i & 3); }

struct Unit { int pm, pn; };
struct Gemm { const bf16_t* A; const bf16_t* Bt; int M, N, K; };

struct StaticOrder {
    int nM, nN, nwg, G, c;
    __host__ __device__ void init(int M, int N, int G_, int c_) { nM = M / BM; nN = N / BM; nwg = nM * nN; G = G_; c = c_; }
    __host__ __device__ bool next(int i, Unit& u) const {
        const long L = (long)i * G + c; if (L >= nwg) return false;
        int wgid = (int)L; { const int q = nwg / NXCD, r = nwg % NXCD, xcd = wgid % NXCD, off = wgid / NXCD; wgid = (xcd < r ? xcd * (q + 1) : r * (q + 1) + (xcd - r) * q) + off; }
        const int nig = WGM * nN, gid = wgid / nig, fm = gid * WGM, gsz = (nM - fm) < WGM ? (nM - fm) : WGM;
        u.pm = fm + ((wgid % nig) % gsz); u.pn = (wgid % nig) / gsz; return true;
    }
    __device__ __forceinline__ void a_ready(const Unit&) const {}
    __device__ __forceinline__ void done(const Unit&) const {}
};
typedef float f32x2 __attribute__((ext_vector_type(2)));
typedef __bf16 bf16x2_pk __attribute__((ext_vector_type(2)));
__device__ __forceinline__ unsigned cvt_pk_bf16(float lo, float hi) { f32x2 v = {lo, hi}; bf16x2_pk b = __builtin_convertvector(v, bf16x2_pk); return __builtin_bit_cast(unsigned, b); }
__device__ __forceinline__ float row_rstd(const float* ssp, int row) {
    const f32x4* p = (const f32x4*)(ssp + (size_t)row * 32); float s = 0.f;
#pragma unroll
    for (int i = 0; i < 8; ++i) { const f32x4 v = p[i]; s += (v[0] + v[1]) + (v[2] + v[3]); }
    return 1.0f / sqrtf(s * (1.0f / 2048.0f) + 1e-6f);
}
struct EpiScaleBf16 {
    static constexpr bool PERM = true, AFTER_DRAIN = false;
    bf16_t* O; int ldc; const float* ssp;
    __device__ __forceinline__ void operator()(const f32x4 (&acc)[2][2][4][2], const Unit& u, int wr, int wc, int fr, int fq) const {
        const int row0 = u.pm * BM + wr * 64 + fr; const int col0 = u.pn * BM + wc * 32 + 8 * fq;
#pragma unroll
        for (int ai = 0; ai < 2; ++ai)
#pragma unroll
            for (int m = 0; m < 4; ++m) { const int row = row0 + ai * HALF + m * 16; const float rs = row_rstd(ssp, row); bf16_t* rowp = O + (size_t)row * ldc + col0;
#pragma unroll
                for (int bj = 0; bj < 2; ++bj) { const f32x4 v0 = acc[ai][bj][m][0] * rs, v1 = acc[ai][bj][m][1] * rs; u32x4 w;
                    w.x = cvt_pk_bf16(v0[0], v0[1]); w.y = cvt_pk_bf16(v0[2], v0[3]); w.z = cvt_pk_bf16(v1[0], v1[1]); w.w = cvt_pk_bf16(v1[2], v1[3]);
                    *(u32x4*)(rowp + bj * HALF) = w; }
                asm volatile("" ::: "memory"); }
    }
};
struct EpiResid {
    static constexpr bool PERM = false, AFTER_DRAIN = false;
    const float* base; float* X; bf16_t* XB; float* ssp;
    __device__ __forceinline__ void operator()(const f32x4 (&acc)[2][2][4][2], const Unit& u, int wr, int wc, int fr, int fq) const {
        typedef unsigned u32x2v __attribute__((ext_vector_type(2)));
        const int row0 = u.pm * BM + wr * 64 + fr; const int col0 = u.pn * BM + wc * 32 + 4 * fq;
#pragma unroll
        for (int ai = 0; ai < 2; ++ai)
#pragma unroll
            for (int m = 0; m < 4; ++m) { const int row = row0 + ai * HALF + m * 16; const size_t off = (size_t)row * 2048 + col0; float ss = 0.f;
#pragma unroll
                for (int bj = 0; bj < 2; ++bj)
#pragma unroll
                    for (int n = 0; n < 2; ++n) { const size_t o2 = off + bj * HALF + n * 16; const f32x4 v = *(const f32x4*)(base + o2) + acc[ai][bj][m][n];
                        *(f32x4*)(X + o2) = v; u32x2v w; w.x = cvt_pk_bf16(v[0], v[1]); w.y = cvt_pk_bf16(v[2], v[3]); *(u32x2v*)(XB + o2) = w;
                        ss += (v[0] * v[0] + v[1] * v[1]) + (v[2] * v[2] + v[3] * v[3]); }
                ss += __shfl_xor(ss, 16); ss += __shfl_xor(ss, 32);
                if (fq == 0) ssp[(size_t)row * 32 + u.pn * 4 + wc] = ss;
                asm volatile("" ::: "memory"); }
    }
};
template <class Epi, class Sched, bool ALIGN_EPI = false, bool SP2 = false>
__device__ __forceinline__ void gemm_phase(PG8_LAS unsigned char* lds, const Gemm g, const Sched& S, const Epi& E) {
    int tid_ = threadIdx.x; asm volatile("" : "+v"(tid_)); const int tid = tid_, wid = __builtin_amdgcn_readfirstlane(tid >> 6), lane = tid & 63, wr = wid >> 2, wc = wid & 3, fr = lane & 15, fq = lane >> 4;
    const int K = g.K, nt = K / BK;
    unsigned voffA[2], voffB[2];
#pragma unroll
    for (int i = 0; i < 2; ++i) { int R, C; stage_rc(tid * 16 + i * 8192, R, C); const int Rb = Epi::PERM ? ((R & ~31) + perm32(R & 31)) : R;
        voffA[i] = (unsigned)(R * K + C) * 2u; voffB[i] = (unsigned)(Rb * K + C) * 2u; }
    const size_t kstep = (size_t)(BK * 2);
    const size_t hstep = (size_t)HALF * K * 2;
    const size_t tstep = 2 * hstep;
    const unsigned ldsw = (unsigned)wid * 1024u;
    const int aoff = lds_byte(wr * 64 + fr, fq * 8), boff = lds_byte(wc * 32 + fr, fq * 8);
#define PG8_SA(b, h) (((b) * 2 + (h)) * HTB)
#define PG8_SB(b, h) ((4 + (b) * 2 + (h)) * HTB)
#define PG8_STAGE(bufoff, gbase, voff) do { _Pragma("unroll") for (int _i = 0; _i < 2; ++_i) \
        __builtin_amdgcn_global_load_lds((const unsigned*)((const char*)(gbase) + (voff)[_i]), (PG8_LAS unsigned*)(lds + (bufoff) + ldsw + _i * 8192), 16, 0, 0); } while (0)
#define PG8_LDA(dst, b, h) do { _Pragma("unroll") for (int m = 0; m < 4; ++m) _Pragma("unroll") for (int k = 0; k < 2; ++k) dst[m][k] = *(const PG8_LAS bf16x8*)(lds + PG8_SA(b, h) + aoff + m * 2048 + k * 1024); } while (0)
#define PG8_LDB(dst, b, h) do { _Pragma("unroll") for (int n = 0; n < 2; ++n) _Pragma("unroll") for (int k = 0; k < 2; ++k) dst[n][k] = *(const PG8_LAS bf16x8*)(lds + PG8_SB(b, h) + boff + n * 2048 + k * 1024); } while (0)
#define PG8_MMA(ai, bj, At, Bt) do { __builtin_amdgcn_s_setprio(1); _Pragma("unroll") for (int m = 0; m < 4; ++m) _Pragma("unroll") for (int n = 0; n < 2; ++n) _Pragma("unroll") for (int k = 0; k < 2; ++k) \
        acc[ai][bj][m][n] = __builtin_amdgcn_mfma_f32_16x16x32_bf16(Bt[n][k], At[m][k], acc[ai][bj][m][n], 0, 0, 0); __builtin_amdgcn_s_setprio(0); } while (0)
#define PG8_WAIT_V(n) asm volatile("s_waitcnt vmcnt(" #n ")" ::: "memory")
#define PG8_WAIT_L(n) asm volatile("s_waitcnt lgkmcnt(" #n ")" ::: "memory")
#define PG8_BAR __builtin_amdgcn_s_barrier()
#define PG8_SCHED __builtin_amdgcn_sched_barrier(0)
    Unit cur, nxt; int ui = 0;
    if (!S.next(0, cur)) return;
    f32x4 acc[2][2][4][2];
#pragma unroll
    for (int a = 0; a < 2; ++a)
#pragma unroll
        for (int b = 0; b < 2; ++b)
#pragma unroll
            for (int m = 0; m < 4; ++m)
#pragma unroll
                for (int n = 0; n < 2; ++n) acc[a][b][m][n] = (f32x4){0.f, 0.f, 0.f, 0.f};
    bf16x8 At[4][2], B0[2][2], B1[2][2];
    const char* cA = (const char*)g.A + (size_t)cur.pm * tstep; const char* cB = (const char*)g.Bt + (size_t)cur.pn * tstep;
    S.a_ready(cur);
    if constexpr (SP2) {
        PG8_STAGE(PG8_SB(0, 0), cB, voffB); PG8_STAGE(PG8_SB(0, 1), cB + hstep, voffB); PG8_STAGE(PG8_SA(0, 0), cA, voffA); PG8_STAGE(PG8_SA(0, 1), cA + hstep, voffA);
        if (wr == 1) PG8_BAR;
        PG8_WAIT_V(2); PG8_BAR;
        PG8_STAGE(PG8_SB(1, 0), cB + kstep, voffB); PG8_STAGE(PG8_SA(1, 0), cA + kstep, voffA); PG8_STAGE(PG8_SB(1, 1), cB + hstep + kstep, voffB);
        PG8_WAIT_V(6); PG8_BAR;
    } else {
        PG8_STAGE(PG8_SB(0, 0), cB, voffB); PG8_STAGE(PG8_SA(0, 0), cA, voffA); PG8_STAGE(PG8_SB(0, 1), cB + hstep, voffB); PG8_STAGE(PG8_SA(0, 1), cA + hstep, voffA);
        if (wr == 1) PG8_BAR;
        PG8_WAIT_V(4); PG8_BAR;
        PG8_STAGE(PG8_SB(1, 0), cB + kstep, voffB); PG8_STAGE(PG8_SA(1, 0), cA + kstep, voffA); PG8_STAGE(PG8_SB(1, 1), cB + hstep + kstep, voffB);
        PG8_WAIT_V(6); PG8_BAR;
    }
    for (;;) {
        const bool has_next = S.next(ui + 1, nxt);
        const char* nA = has_next ? (const char*)g.A + (size_t)nxt.pm * tstep : cA; const char* nB = has_next ? (const char*)g.Bt + (size_t)nxt.pn * tstep : cB;
        for (int t = 0; t < nt; t += 2) {
            const bool last = (t == nt - 2);
            const char* a1 = cA + (size_t)(t + 1) * kstep;
            const char* a2 = last ? nA : cA + (size_t)(t + 2) * kstep; const char* b2 = last ? nB : cB + (size_t)(t + 2) * kstep;
            const char* a3 = a2 + kstep; const char* b3 = b2 + kstep;
            if (last && has_next) S.a_ready(nxt);
            if constexpr (SP2) {
            PG8_LDB(B0, 0, 0); PG8_LDB(B1, 0, 1); PG8_SCHED; PG8_LDA(At, 0, 0); PG8_STAGE(PG8_SA(1, 1), a1 + hstep, voffA);
            PG8_WAIT_V(8); PG8_WAIT_L(0); PG8_BAR; PG8_MMA(0, 0, At, B0); PG8_MMA(0, 1, At, B1); PG8_BAR; PG8_SCHED;
            PG8_LDA(At, 0, 1); PG8_STAGE(PG8_SB(0, 0), b2, voffB); PG8_STAGE(PG8_SB(0, 1), b2 + hstep, voffB); PG8_STAGE(PG8_SA(0, 0), a2, voffA);
            PG8_WAIT_V(8); PG8_WAIT_L(0); PG8_BAR; PG8_MMA(1, 0, At, B0); PG8_MMA(1, 1, At, B1); PG8_BAR; PG8_SCHED;
            PG8_LDB(B0, 1, 0); PG8_LDB(B1, 1, 1); PG8_SCHED; PG8_LDA(At, 1, 0); PG8_STAGE(PG8_SA(0, 1), a2 + hstep, voffA);
            PG8_WAIT_V(8); PG8_WAIT_L(0); PG8_BAR; PG8_MMA(0, 0, At, B0); PG8_MMA(0, 1, At, B1); PG8_BAR; PG8_SCHED;
            PG8_LDA(At, 1, 1); PG8_STAGE(PG8_SB(1, 0), b3, voffB); PG8_STAGE(PG8_SB(1, 1), b3 + hstep, voffB); PG8_STAGE(PG8_SA(1, 0), a3, voffA);
            PG8_WAIT_V(8); PG8_WAIT_L(0); PG8_BAR; PG8_MMA(1, 0, At, B0); PG8_MMA(1, 1, At, B1); PG8_BAR; PG8_SCHED;
            } else {
            PG8_LDB(B0, 0, 0); PG8_SCHED; PG8_LDA(At, 0, 0); PG8_STAGE(PG8_SA(1, 1), a1 + hstep, voffA);
            PG8_WAIT_L(8); PG8_BAR; PG8_WAIT_L(0); PG8_MMA(0, 0, At, B0); PG8_BAR; PG8_SCHED;
            PG8_LDB(B1, 0, 1); PG8_STAGE(PG8_SB(0, 0), b2, voffB);
            PG8_BAR; PG8_WAIT_L(0); PG8_MMA(0, 1, At, B1); PG8_BAR;
            PG8_LDA(At, 0, 1); PG8_STAGE(PG8_SA(0, 0), a2, voffA);
            PG8_BAR; PG8_WAIT_L(0); PG8_MMA(1, 0, At, B0); PG8_BAR; PG8_SCHED;
            PG8_STAGE(PG8_SB(0, 1), b2 + hstep, voffB);
            PG8_WAIT_V(6); PG8_BAR; PG8_MMA(1, 1, At, B1); PG8_BAR;
            PG8_LDB(B0, 1, 0); PG8_SCHED; PG8_LDA(At, 1, 0); PG8_STAGE(PG8_SA(0, 1), a2 + hstep, voffA);
            PG8_WAIT_L(8); PG8_BAR; PG8_WAIT_L(0); PG8_MMA(0, 0, At, B0); PG8_BAR; PG8_SCHED;
            PG8_LDB(B1, 1, 1); PG8_STAGE(PG8_SB(1, 0), b3, voffB);
            PG8_BAR; PG8_WAIT_L(0); PG8_MMA(0, 1, At, B1); PG8_BAR;
            PG8_LDA(At, 1, 1); PG8_STAGE(PG8_SA(1, 0), a3, voffA);
            PG8_BAR; PG8_WAIT_L(0); PG8_MMA(1, 0, At, B0); PG8_BAR; PG8_SCHED;
            PG8_STAGE(PG8_SB(1, 1), b3 + hstep, voffB);
            PG8_WAIT_V(6); PG8_BAR; PG8_MMA(1, 1, At, B1); PG8_BAR;
            }
        }
        if constexpr (ALIGN_EPI) { if (wr == 0) PG8_BAR; }
        if constexpr (!Epi::AFTER_DRAIN) { E(acc, cur, wr, wc, fr, fq); S.done(cur); }
        if (!has_next) break;
#pragma unroll
        for (int a = 0; a < 2; ++a)
#pragma unroll
            for (int b = 0; b < 2; ++b)
#pragma unroll
                for (int m = 0; m < 4; ++m)
#pragma unroll
                    for (int n = 0; n < 2; ++n) acc[a][b][m][n] = (f32x4){0.f, 0.f, 0.f, 0.f};
        cur = nxt; cA = nA; cB = nB; ++ui;
        if constexpr (ALIGN_EPI) { if (wr == 1) PG8_BAR; }
    }
    PG8_WAIT_V(0);
    if constexpr (!ALIGN_EPI) { if (wr == 0) PG8_BAR; }
    PG8_BAR;
    if constexpr (Epi::AFTER_DRAIN) { E.fused(acc, cur, wr, wc, fr, fq, lds, wid, lane); S.done(cur); }
#undef PG8_SA
#undef PG8_SB
#undef PG8_STAGE
#undef PG8_LDA
#undef PG8_LDB
#undef PG8_MMA
#undef PG8_WAIT_V
#undef PG8_WAIT_L
#undef PG8_BAR
#undef PG8_SCHED
}
}

#define GAS __attribute__((address_space(1)))
#define LAS __attribute__((address_space(3)))
typedef unsigned short bf16_t;
typedef short bf16x8 __attribute__((ext_vector_type(8)));
typedef float f32x4 __attribute__((ext_vector_type(4)));
typedef unsigned u32x4 __attribute__((ext_vector_type(4)));
typedef unsigned u32x2 __attribute__((ext_vector_type(2)));
typedef short s16x4 __attribute__((ext_vector_type(4)));

constexpr int BATCH = 2, SEQ = 8192, DM = 2048, DEPTH = 4, MROWS = BATCH * SEQ;
constexpr int INW = 5796, INP = 5888, DFF = 5632, UPW = 2 * DFF;
constexpr int A_OFF = 0, B_OFF = 2304, CQ_OFF = 3840, CKV_OFF = 4608, CG_OFF = 5760;
constexpr int LUTN = 1536;
constexpr float LOG2E = 1.4426950408889634f, LN2 = 0.6931471805599453f;
constexpr int NTHREADS = 512, NWAVES = 8;

constexpr size_t al256(size_t x) { return (x + 255) & ~(size_t)255; }
constexpr size_t WS_CTL = 0, CTL_BYTES = 1u << 20;
constexpr size_t SZ_WIN = (size_t)INP * DM * 2, SZ_WOUT = (size_t)DM * DM * 2, SZ_WUP = (size_t)UPW * DM * 2, SZ_WDN = (size_t)DM * DFF * 2;
constexpr size_t WS_WIN = CTL_BYTES;
constexpr size_t WS_WOUT = WS_WIN + DEPTH * SZ_WIN;
constexpr size_t WS_WUP = WS_WOUT + DEPTH * SZ_WOUT;
constexpr size_t WS_WDN = WS_WUP + DEPTH * SZ_WUP;
constexpr size_t WS_W1T = WS_WDN + DEPTH * SZ_WDN;
constexpr size_t WS_W2T = WS_W1T + (size_t)DEPTH * 2 * 128 * 2048 * 2;
constexpr size_t WS_CPE = WS_W2T + (size_t)DEPTH * 2 * 64 * 128 * 2;
constexpr size_t WS_GLUT = al256(WS_CPE + (size_t)DEPTH * 2 * 128 * 4);
constexpr size_t WS_X = al256(WS_GLUT + (size_t)32 * LUTN * 4);
constexpr size_t WS_XB = WS_X + (size_t)MROWS * DM * 4;
constexpr size_t WS_SSP = WS_XB + (size_t)MROWS * DM * 2;
constexpr size_t WS_R1 = WS_SSP + (size_t)MROWS * 32 * 4;
constexpr size_t WS_PROJ = WS_R1;
constexpr size_t WS_O = WS_R1 + (size_t)MROWS * INP * 2;
constexpr size_t WS_U = WS_R1;
constexpr size_t SZ_R1 = (size_t)MROWS * UPW * 2;
static_assert((size_t)MROWS * INP * 2 + (size_t)MROWS * DM * 2 <= SZ_R1, "overlay");
constexpr size_t WS_ACT = WS_R1 + SZ_R1;
constexpr size_t WS_TOT = WS_ACT + (size_t)MROWS * DFF * 2;
constexpr size_t WS_LSE = WS_TOT + (size_t)MROWS * 768 * 4;
constexpr size_t WS_KC = WS_LSE + (size_t)MROWS * 12 * 4;
constexpr size_t WS_VC = WS_KC + (size_t)BATCH * 3 * 512 * 64 * 2;
constexpr size_t WS_KMEAN = WS_VC + (size_t)BATCH * 3 * 512 * 64 * 2;
constexpr size_t WS_END = WS_KMEAN + (size_t)BATCH * 8 * 32 * 64 * 4;

constexpr int KP = 160;
constexpr int TILE_B = 64 * KP;
constexpr int L_K0 = 0, L_V0 = TILE_B, L_K1 = 2 * TILE_B, L_V1 = 3 * TILE_B;
constexpr int L_LUT = 4 * TILE_B;
constexpr int L_IMP = L_LUT + 4 * LUTN * 4;
constexpr int L_SEL = L_IMP + 65536;
constexpr int L_TL = L_SEL + 2048;
constexpr int L_MISC = L_TL + 2048;
constexpr int L_WUN = L_MISC + 64;
constexpr int LDS_BYTES = 147456;
static_assert(L_MISC + 256 <= LDS_BYTES, "lds map");

struct Params {
    const float* x; const float* rel; const float* w_in; const float* w_out; const float* cmp_w1; const float* cmp_w2; const float* cmp_pe;
    const float* norm_attn; const float* norm_mlp; const float* w_up; const float* conv_w; const float* conv_b; const float* w_down; const float* norm_final;
    float* out; unsigned char* ws;
};

typedef float f32x2_t __attribute__((ext_vector_type(2))); typedef __bf16 bf16x2_t __attribute__((ext_vector_type(2)));
__device__ __forceinline__ unsigned cvtpk(float lo, float hi) { f32x2_t v = {lo, hi}; bf16x2_t b = __builtin_convertvector(v, bf16x2_t); return __builtin_bit_cast(unsigned, b); }
__device__ __forceinline__ float bf2f(unsigned short b) { return __uint_as_float(((unsigned)b) << 16); }
__device__ __forceinline__ float bflo(unsigned w) { return __uint_as_float(w << 16); }
__device__ __forceinline__ float bfhi(unsigned w) { return __uint_as_float(w & 0xffff0000u); }
__device__ __forceinline__ float fexp2(float x) { return __builtin_amdgcn_exp2f(x); }
__device__ __forceinline__ void lds_wait() { asm volatile("s_waitcnt lgkmcnt(0)" ::: "memory"); }
__device__ __forceinline__ s16x4 tr_read(const LAS unsigned char* p) { return __builtin_bit_cast(s16x4, __builtin_amdgcn_ds_read_tr16_b64_v4i16((LAS s16x4*)p)); }
__device__ __forceinline__ f32x4 mfma16(bf16x8 a, bf16x8 b, f32x4 c) { return __builtin_amdgcn_mfma_f32_16x16x32_bf16(a, b, c, 0, 0, 0); }

__device__ __forceinline__ int t5_bucket(int n) {
    if (n < 16) return n < 0 ? 0 : n;
    int b = 16;
    b += n >= 22; b += n >= 30; b += n >= 40; b += n >= 54; b += n >= 73; b += n >= 99; b += n >= 134; b += n >= 182;
    b += n >= 246; b += n >= 332; b += n >= 450; b += n >= 609; b += n >= 825; b += n >= 1117; b += n >= 1513;
    return b;
}
__device__ __forceinline__ bool is_qcol(int n) { return (n < 2304) ? ((n % 768) < 256) : ((n < 2816) || (n >= 3840 && n < 4608)); }

template <int MODE>
__device__ __forceinline__ void p0_item(const float* W, int K, int Nsrc, bf16_t* WT, const float* kscale, LAS float* scr, int kb, int nb, int lane) {
    const int k0 = 64 * kb, n0 = 32 * nb;
    const int nd = n0 + (lane & 31);
    int sc = nd; float cs = 1.f; bool ok = true;
    if (MODE == 0) { ok = nd < INW; if (is_qcol(nd)) cs = 0.125f; }
    if (MODE == 2) { const int pn = nd >> 8, r = nd & 255; sc = (r >= 128 ? DFF : 0) + 128 * pn + (r & 127); }
#pragma unroll 8
    for (int i = 0; i < 32; ++i) { const int kk = 2 * i + (lane >> 5); float v = 0.f;
        if (ok) { v = W[(size_t)(k0 + kk) * Nsrc + sc] * cs; if (MODE != 1) v *= kscale[k0 + kk]; }
        scr[kk * 33 + (lane & 31)] = v; }
    lds_wait();
    const int c = lane & 7;
#pragma unroll
    for (int j = 0; j < 4; ++j) { const int n = (lane >> 3) + 8 * j; const LAS float* s = scr + (8 * c) * 33 + n;
        u32x4 o; o.x = cvtpk(s[0 * 33], s[1 * 33]); o.y = cvtpk(s[2 * 33], s[3 * 33]); o.z = cvtpk(s[4 * 33], s[5 * 33]); o.w = cvtpk(s[6 * 33], s[7 * 33]);
        *(u32x4*)(WT + (size_t)(n0 + n) * K + k0 + 8 * c) = o; }
    lds_wait();
}

__device__ __forceinline__ void p0_prologue(const Params& P, LAS unsigned char* lds, int tid, int lane, int wave) {
    unsigned char* ws = P.ws;
    LAS float* scr = (LAS float*)(lds + wave * 16384);
    const int G = gridDim.x, gw = blockIdx.x * NWAVES + wave, NGW = G * NWAVES;
    constexpr int I_IN = 32 * (INP / 32), I_OUT = 32 * 64, I_UP = 32 * (UPW / 32), I_DN = (DFF / 64) * 64, I_W1 = 2 * 32 * 4, I_W2 = 2 * 2 * 2;
    constexpr int I_LAYER = I_IN + I_OUT + I_UP + I_DN + I_W1 + I_W2;
    for (int it = gw; it < DEPTH * I_LAYER; it += NGW) {
        const int l = it / I_LAYER; int r = it % I_LAYER;
        if (r < I_IN) { p0_item<0>(P.w_in + (size_t)l * DM * INW, DM, INW, (bf16_t*)(ws + WS_WIN + l * SZ_WIN), P.norm_attn + l * DM, scr, r / (INP / 32), r % (INP / 32), lane); continue; } r -= I_IN;
        if (r < I_OUT) { p0_item<1>(P.w_out + (size_t)l * DM * DM, DM, DM, (bf16_t*)(ws + WS_WOUT + l * SZ_WOUT), nullptr, scr, r / 64, r % 64, lane); continue; } r -= I_OUT;
        if (r < I_UP) { p0_item<2>(P.w_up + (size_t)l * DM * UPW, DM, UPW, (bf16_t*)(ws + WS_WUP + l * SZ_WUP), P.norm_mlp + l * DM, scr, r / (UPW / 32), r % (UPW / 32), lane); continue; } r -= I_UP;
        if (r < I_DN) { p0_item<1>(P.w_down + (size_t)l * DFF * DM, DFF, DM, (bf16_t*)(ws + WS_WDN + l * SZ_WDN), nullptr, scr, r / 64, r % 64, lane); continue; } r -= I_DN;
        if (r < I_W1) { const int i = r / 128, rr = r % 128; p0_item<1>(P.cmp_w1 + (size_t)(l * 2 + i) * 2048 * 128, 2048, 128, (bf16_t*)(ws + WS_W1T) + (size_t)(l * 2 + i) * 128 * 2048, nullptr, scr, rr / 4, rr % 4, lane); continue; } r -= I_W1;
        { const int i = r / 4, rr = r % 4; p0_item<1>(P.cmp_w2 + (size_t)(l * 2 + i) * 128 * 64, 128, 64, (bf16_t*)(ws + WS_W2T) + (size_t)(l * 2 + i) * 64 * 128, nullptr, scr, rr / 2, rr % 2, lane); }
    }
    for (int m = gw; m < MROWS; m += NGW) {
        const f32x4* xr = (const f32x4*)(P.x + (size_t)m * DM) + lane; float s = 0.f;
        u32x2* ob = (u32x2*)((bf16_t*)(ws + WS_XB) + (size_t)m * DM) + lane;
#pragma unroll
        for (int j = 0; j < 8; ++j) { const f32x4 v = xr[64 * j]; s += (v[0] * v[0] + v[1] * v[1]) + (v[2] * v[2] + v[3] * v[3]); u32x2 w; w.x = cvtpk(v[0], v[1]); w.y = cvtpk(v[2], v[3]); ob[64 * j] = w; }
#pragma unroll
        for (int o = 1; o < 64; o <<= 1) s += __shfl_xor(s, o);
        if (lane < 32) ((float*)(ws + WS_SSP))[(size_t)m * 32 + lane] = (lane == 0) ? s : 0.f;
    }
    for (int i = blockIdx.x * NTHREADS + tid; i < 32 * LUTN; i += G * NTHREADS) { const int h = i / LUTN, n = i % LUTN; ((float*)(ws + WS_GLUT))[i] = P.rel[h * 32 + t5_bucket(n)] * LOG2E; }
    if (blockIdx.x < DEPTH * 2) {
        __syncthreads();
        const int li = blockIdx.x, kp = tid >> 7, hid = tid & 127; const float* pe = P.cmp_pe + (size_t)li * 2048; const float* w1 = P.cmp_w1 + (size_t)li * 2048 * 128;
        float s = 0.f;
#pragma unroll 8
        for (int k = kp * 512; k < kp * 512 + 512; ++k) s += pe[k] * w1[(size_t)k * 128 + hid];
        LAS float* red = (LAS float*)lds; red[tid] = s; __syncthreads();
        if (tid < 128) ((float*)(ws + WS_CPE))[li * 128 + tid] = (red[tid] + red[tid + 128]) + (red[tid + 256] + red[tid + 384]);
        __syncthreads();
    }
}

struct Src { const bf16_t* kb; const bf16_t* vb; int stride; int dil; int roff; };

template <int QG, int MODE>
__device__ __forceinline__ void flash_run(LAS unsigned char* lds, const Src S, const int ntiles, const bf16x8 (&qf)[QG][2], f32x4 (&o)[QG][4], float (&m)[QG], float (&l)[QG],
                                          const int qc, const int qcw_min, const int qcw_max, const int maxrel, const LAS unsigned* selp, const LAS unsigned* wunp,
                                          const float (&invl)[QG], LAS float* impw, const bool imp_acc, const int lutslot, const int lane, const int tid) {
    const LAS int* tl = (const LAS int*)(lds + L_TL);
    const LAS float* lut = (const LAS float*)(lds + L_LUT) + lutslot * LUTN;
    const int srow = tid >> 3, sch = tid & 7;
    const int g = lane >> 4, i16 = lane & 15;
    u32x4 kreg = {0, 0, 0, 0}, vreg = {0, 0, 0, 0};
    float carryB = 0.f;
#define FL_ISSUE(i) do { int c_ = tl[2 * (i)] + srow; c_ = c_ < 0 ? 0 : c_; const size_t off_ = (size_t)(c_ * S.dil + S.roff) * S.stride + sch * 8; \
        kreg = *(const u32x4*)(S.kb + off_); if (!(MODE & 2)) vreg = *(const u32x4*)(S.vb + off_); } while (0)
#define FL_COMMIT(b) do { *(LAS u32x4*)(lds + ((b) ? L_K1 : L_K0) + srow * KP + sch * 16) = kreg; if (!(MODE & 2)) *(LAS u32x4*)(lds + ((b) ? L_V1 : L_V0) + srow * KP + sch * 16) = vreg; } while (0)
    __syncthreads();
    if (ntiles > 0) { FL_ISSUE(0); FL_COMMIT(0); }
    __syncthreads();
    for (int i = 0; i < ntiles; ++i) {
        if (i + 1 < ntiles) FL_ISSUE(i + 1);
        const int k0 = tl[2 * i], tag = tl[2 * i + 1];
        bool skip = (k0 > qcw_max) || (maxrel != 0x7fffffff && k0 + 63 < qcw_min - maxrel);
        if (tag >= 0) { const unsigned w = wunp[tag >> 5]; if (!((w >> (tag & 31)) & 1u)) skip = true; }
        if (MODE & 4) skip = false;
        if (!skip) {
            const LAS unsigned char* Ks = lds + ((i & 1) ? L_K1 : L_K0);
            const LAS unsigned char* Vs = lds + ((i & 1) ? L_V1 : L_V0);
            bool allowed = true;
            if (tag >= 0) { const unsigned w = selp[tag >> 5]; allowed = ((w >> (tag & 31)) & 1u) != 0u; }
            bf16x8 kf[4][2];
#pragma unroll
            for (int kt = 0; kt < 4; ++kt)
#pragma unroll
                for (int ks = 0; ks < 2; ++ks) kf[kt][ks] = *(const LAS bf16x8*)(Ks + (16 * kt + i16) * KP + ks * 64 + g * 16);
            float impA[4] = {0.f, 0.f, 0.f, 0.f}, impB[4] = {0.f, 0.f, 0.f, 0.f};
#pragma unroll
            for (int qg = 0; qg < QG; ++qg) {
                f32x4 s[4];
#pragma unroll
                for (int kt = 0; kt < 4; ++kt) { s[kt] = (f32x4){0.f, 0.f, 0.f, 0.f};
#pragma unroll
                    for (int ks = 0; ks < 2; ++ks) s[kt] = mfma16(kf[kt][ks], qf[qg][ks], s[kt]); }
                float mx = -1e30f;
#pragma unroll
                for (int kt = 0; kt < 4; ++kt)
#pragma unroll
                    for (int r = 0; r < 4; ++r) { const int kc = k0 + 16 * kt + 4 * g + r; const int rel = qc - kc;
                        const bool ok = allowed && ((unsigned)rel <= (unsigned)maxrel) && (kc >= 0);
                        float sc = s[kt][r] * LOG2E;
                        if (MODE & 1) { unsigned di = (unsigned)(rel * S.dil); di = di < (unsigned)(LUTN - 1) ? di : (unsigned)(LUTN - 1); sc += lut[qg * LUTN + di]; }
                        sc = ok ? sc : -1e30f; s[kt][r] = sc; mx = fmaxf(mx, sc); }
                mx = fmaxf(mx, __shfl_xor(mx, 16)); mx = fmaxf(mx, __shfl_xor(mx, 32));
                const float mnew = fmaxf(m[qg], mx); const float alpha = fexp2(m[qg] - mnew); m[qg] = mnew;
                float rs = 0.f;
#pragma unroll
                for (int kt = 0; kt < 4; ++kt)
#pragma unroll
                    for (int r = 0; r < 4; ++r) { const float p = (s[kt][r] > -5e29f) ? fexp2(s[kt][r] - mnew) : 0.f; s[kt][r] = p; rs += p; }
                rs += __shfl_xor(rs, 16); rs += __shfl_xor(rs, 32);
                l[qg] = l[qg] * alpha + rs;
                if (MODE & 4) {
#pragma unroll
                    for (int kt = 0; kt < 4; ++kt) { impA[kt] += ((s[kt][0] + s[kt][1]) + (s[kt][2] + s[kt][3])) * invl[qg]; impB[kt] += s[kt][3] * invl[qg]; }
                }
                if (!(MODE & 2)) {
#pragma unroll
                    for (int dt = 0; dt < 4; ++dt) o[qg][dt] = o[qg][dt] * alpha;
                    bf16x8 pf[2];
#pragma unroll
                    for (int s2 = 0; s2 < 2; ++s2) { u32x4 w; w.x = cvtpk(s[2 * s2][0], s[2 * s2][1]); w.y = cvtpk(s[2 * s2][2], s[2 * s2][3]); w.z = cvtpk(s[2 * s2 + 1][0], s[2 * s2 + 1][1]); w.w = cvtpk(s[2 * s2 + 1][2], s[2 * s2 + 1][3]);
                        pf[s2] = __builtin_bit_cast(bf16x8, w); }
#pragma unroll
                    for (int dt = 0; dt < 4; ++dt)
#pragma unroll
                        for (int s2 = 0; s2 < 2; ++s2) { const LAS unsigned char* vp = Vs + (32 * s2 + 4 * g + (i16 >> 2)) * KP + (16 * dt + 4 * (i16 & 3)) * 2;
                            const s16x4 lo = tr_read(vp), hi = tr_read(vp + 16 * KP);
                            const bf16x8 vf = {lo[0], lo[1], lo[2], lo[3], hi[0], hi[1], hi[2], hi[3]};
                            o[qg][dt] = mfma16(vf, pf[s2], o[qg][dt]); }
                }
                if (QG > 1) asm volatile("" ::: "memory");
            }
            if (MODE & 4) {
                const int srcl = (lane + 48) & 63;
#pragma unroll
                for (int kt = 0; kt < 4; ++kt) { const float pb = (kt == 0) ? carryB : impB[kt == 0 ? 0 : kt - 1];
                    const float x0 = __shfl(pb, srcl), x1 = __shfl(impB[kt], srcl); const float add = (g == 0) ? x0 : x1;
                    const int J = 4 * ((k0 >> 4) + kt) + g; const float prevv = imp_acc ? impw[i16 * 128 + J] : 0.f; impw[i16 * 128 + J] = prevv + impA[kt] + add; }
                carryB = impB[3];
            }
        }
        if (i + 1 < ntiles) FL_COMMIT((i + 1) & 1);
        __syncthreads();
    }
#undef FL_ISSUE
#undef FL_COMMIT
}

template <int QG> __device__ __forceinline__ void flash_init(f32x4 (&o)[QG][4], float (&m)[QG], float (&l)[QG]) {
#pragma unroll
    for (int q = 0; q < QG; ++q) { m[q] = -1e30f; l[q] = 0.f;
#pragma unroll
        for (int d = 0; d < 4; ++d) o[q][d] = (f32x4){0.f, 0.f, 0.f, 0.f}; }
}
__device__ __forceinline__ void load_lut(LAS unsigned char* lds, const float* glut, int head, int slot, int tid) {
    LAS float* lut = (LAS float*)(lds + L_LUT) + slot * LUTN; const float* src = glut + (size_t)head * LUTN;
    for (int i = tid; i < LUTN; i += NTHREADS) lut[i] = src[i];
}
__device__ __forceinline__ int next_unit(unsigned* ctr, LAS unsigned char* lds, int tid) {
    LAS int* slot = (LAS int*)(lds + L_MISC);
    __syncthreads();
    if (tid == 0) *slot = (int)atomicAdd(ctr, 1u);
    __syncthreads();
    return *slot;
}

__device__ __forceinline__ void unit_mixA(const Params& P, LAS unsigned char* lds, int uid, int tid, int lane, int wave) {
    unsigned char* ws = P.ws; const bf16_t* proj = (const bf16_t*)(ws + WS_PROJ);
    const int b = uid / 768; int rem = uid % 768; const int gi = rem / 256; rem %= 256; const int hs = rem / 64, idx = rem % 64;
    const int d = gi == 0 ? 1 : (gi == 1 ? 4 : 16); const int rc = idx % d, nb = idx / d;
    const int g = lane >> 4, i16 = lane & 15;
    load_lut(lds, (const float*)(ws + WS_GLUT), gi * 4 + hs, 0, tid);
    const int ntiles = nb == 0 ? 2 : 4;
    if (tid < 4) { LAS int* tl = (LAS int*)(lds + L_TL); const int i = tid + (nb == 0 ? 2 : 0); if (i < 4) { tl[2 * tid] = nb * 128 - 128 + 64 * i; tl[2 * tid + 1] = -1; } }
    const int qi = nb * 128 + 16 * wave + i16; const int tok = qi * d + rc; const size_t row = (size_t)b * SEQ + tok;
    const int colq = A_OFF + gi * 768 + hs * 64;
    bf16x8 qf[1][2];
#pragma unroll
    for (int ks = 0; ks < 2; ++ks) qf[0][ks] = *(const bf16x8*)(proj + row * INP + colq + ks * 32 + g * 8);
    f32x4 o[1][4]; float m[1], l[1]; flash_init<1>(o, m, l);
    const float il[1] = {0.f};
    Src S{proj + (size_t)b * SEQ * INP + colq + 256, proj + (size_t)b * SEQ * INP + colq + 512, INP, d, rc};
    flash_run<1, 1>(lds, S, ntiles, qf, o, m, l, qi, nb * 128 + 16 * wave, nb * 128 + 16 * wave + 15, 128, nullptr, nullptr, il, nullptr, false, 0, lane, tid);
    const float inv = l[0] > 0.f ? 1.f / l[0] : 0.f;
    bf16_t* O = (bf16_t*)(ws + WS_O) + row * 2048 + gi * 256 + hs * 64;
#pragma unroll
    for (int dt = 0; dt < 4; ++dt) { u32x2 w; w.x = cvtpk(o[0][dt][0] * inv, o[0][dt][1] * inv); w.y = cvtpk(o[0][dt][2] * inv, o[0][dt][3] * inv); *(u32x2*)(O + 16 * dt + 4 * g) = w; }
    if (g == 0) ((float*)(ws + WS_LSE))[row * 12 + gi * 4 + hs] = (m[0] + __log2f(fmaxf(l[0], 1e-30f))) * LN2;
}

__device__ __forceinline__ void unit_moba(const Params& P, LAS unsigned char* lds, int b, int h, int c, int tid, int lane, int wave) {
    unsigned char* ws = P.ws; const bf16_t* proj = (const bf16_t*)(ws + WS_PROJ);
    const int g = lane >> 4, i16 = lane & 15;
    const int t0 = c * 128, ob = t0 >> 8;
    load_lut(lds, (const float*)(ws + WS_GLUT), 12 + h, 0, tid);
    LAS float* km = (LAS float*)(lds + L_IMP);
    { const float* src = (const float*)(ws + WS_KMEAN) + (size_t)(b * 8 + h) * 2048; for (int i = tid; i < 2048; i += NTHREADS) km[i] = src[i]; }
    LAS unsigned* misc = (LAS unsigned*)(lds + L_MISC);
    if (tid == 0) misc[1] = 0u;
    __syncthreads();
    const int tok = t0 + 16 * wave + i16; const size_t row = (size_t)b * SEQ + tok;
    const int colq = B_OFF + h * 64;
    bf16x8 qf[1][2];
#pragma unroll
    for (int ks = 0; ks < 2; ++ks) qf[0][ks] = *(const bf16x8*)(proj + row * INP + colq + ks * 32 + g * 8);
    unsigned sel = 0u;
    if (ob > 0) {
        float gt[8];
#pragma unroll
        for (int k = 0; k < 8; ++k) gt[k] = 0.f;
#pragma unroll 1
        for (int dc = 0; dc < 8; ++dc) { const u32x4 qw = *(const u32x4*)(proj + row * INP + colq + dc * 8);
            const float q0 = bflo(qw.x), q1 = bfhi(qw.x), q2 = bflo(qw.y), q3 = bfhi(qw.y), q4 = bflo(qw.z), q5 = bfhi(qw.z), q6 = bflo(qw.w), q7 = bfhi(qw.w);
#pragma unroll
            for (int k = 0; k < 8; ++k) { const LAS f32x4* kr = (const LAS f32x4*)(km + (8 * g + k) * 64 + dc * 8); const f32x4 a = kr[0], bq = kr[1];
                gt[k] += (q0 * a[0] + q1 * a[1]) + (q2 * a[2] + q3 * a[3]) + (q4 * bq[0] + q5 * bq[1]) + (q6 * bq[2] + q7 * bq[3]); } }
#pragma unroll
        for (int k = 0; k < 8; ++k) if (8 * g + k >= ob) gt[k] = -INFINITY;
#pragma unroll
        for (int it = 0; it < 3; ++it) {
            float best = -INFINITY; int bi = 99;
#pragma unroll
            for (int k = 0; k < 8; ++k) if (gt[k] > best) { best = gt[k]; bi = 8 * g + k; }
#pragma unroll
            for (int off = 16; off <= 32; off <<= 1) { const float ob_ = __shfl_xor(best, off); const int oi = __shfl_xor(bi, off); if (ob_ > best || (ob_ == best && oi < bi)) { best = ob_; bi = oi; } }
            if (bi < 32) { sel |= 1u << bi;
#pragma unroll
                for (int k = 0; k < 8; ++k) if (8 * g + k == bi) gt[k] = -INFINITY; }
        }
    }
    unsigned wu = sel;
#pragma unroll
    for (int off = 1; off < 16; off <<= 1) wu |= (unsigned)__shfl_xor((int)wu, off);
    wu = (unsigned)__builtin_amdgcn_readfirstlane((int)wu);
    LAS unsigned* selS = (LAS unsigned*)(lds + L_SEL); LAS unsigned* wunS = (LAS unsigned*)(lds + L_WUN) + wave * 4;
    if (g == 0) selS[(16 * wave + i16) * 4] = sel;
    if (lane == 0) wunS[0] = wu;
    __syncthreads();
    unsigned um = 0u;
#pragma unroll
    for (int w8 = 0; w8 < 8; ++w8) um |= ((const LAS unsigned*)(lds + L_WUN))[w8 * 4];
    if (tid == 0) { LAS int* tl = (LAS int*)(lds + L_TL); int n = 0;
        for (int blk = 0; blk < ob; ++blk) if ((um >> blk) & 1u) for (int s4 = 0; s4 < 4; ++s4) { tl[2 * n] = blk * 256 + 64 * s4; tl[2 * n + 1] = blk; ++n; }
        for (int k0 = ob * 256; k0 < t0 + 128; k0 += 64) { tl[2 * n] = k0; tl[2 * n + 1] = -1; ++n; }
        misc[2] = (unsigned)n; }
    __syncthreads();
    const int ntiles = (int)misc[2];
    f32x4 o[1][4]; float m[1], l[1]; flash_init<1>(o, m, l);
    const float il[1] = {0.f};
    Src S{proj + (size_t)b * SEQ * INP + colq + 512, proj + (size_t)b * SEQ * INP + colq + 1024, INP, 1, 0};
    flash_run<1, 1>(lds, S, ntiles, qf, o, m, l, tok, t0 + 16 * wave, t0 + 16 * wave + 15, 0x7fffffff, selS + (16 * wave + i16) * 4, wunS, il, nullptr, false, 0, lane, tid);
    const float inv = l[0] > 0.f ? 1.f / l[0] : 0.f;
    bf16_t* O = (bf16_t*)(ws + WS_O) + row * 2048 + 768 + h * 64;
#pragma unroll
    for (int dt = 0; dt < 4; ++dt) { u32x2 w; w.x = cvtpk(o[0][dt][0] * inv, o[0][dt][1] * inv); w.y = cvtpk(o[0][dt][2] * inv, o[0][dt][3] * inv); *(u32x2*)(O + 16 * dt + 4 * g) = w; }
}

__device__ __forceinline__ float sigmoidf_(float x) { return 1.f / (1.f + __expf(-x)); }
__device__ __forceinline__ void unit_nsa(const Params& P, LAS unsigned char* lds, int b, int kv, int c, int tid, int lane, int wave) {
    unsigned char* ws = P.ws; const bf16_t* proj = (const bf16_t*)(ws + WS_PROJ);
    const int g = lane >> 4, i16 = lane & 15;
    const int t0 = c * 128;
    const int tok = t0 + 16 * wave + i16; const size_t row = (size_t)b * SEQ + tok;
    for (int q = 0; q < 4; ++q) load_lut(lds, (const float*)(ws + WS_GLUT), 20 + kv * 4 + q, q, tid);
    LAS int* tl = (LAS int*)(lds + L_TL);
    LAS unsigned* misc = (LAS unsigned*)(lds + L_MISC);
    LAS unsigned* selS = (LAS unsigned*)(lds + L_SEL);
    LAS float* impw = (LAS float*)(lds + L_IMP) + wave * 2048;
    const int ntc = ((t0 + 96) >> 4) / 64 + 1;
    if (tid < ntc) { tl[2 * tid] = 64 * tid; tl[2 * tid + 1] = -1; }
    if (tid < 4) misc[4 + tid] = 0u;
    LAS unsigned* wunS = (LAS unsigned*)(lds + L_WUN) + wave * 4;
    float* tot = (float*)(ws + WS_TOT) + row * 768 + (kv * 4) * 64;
    const bf16_t* gatep = proj + row * INP + CG_OFF + (kv * 4) * 3;
    const int qcc = (tok - 31) >> 4;
    const int qcw0 = (t0 + 16 * wave - 31) >> 4, qcw1 = (t0 + 16 * wave + 15 - 31) >> 4;
#pragma unroll 1
    for (int hp = 0; hp < 2; ++hp) {
        bf16x8 qf[2][2];
#pragma unroll
        for (int q = 0; q < 2; ++q)
#pragma unroll
            for (int ks = 0; ks < 2; ++ks) qf[q][ks] = *(const bf16x8*)(proj + row * INP + CQ_OFF + (kv * 4 + hp * 2 + q) * 64 + ks * 32 + g * 8);
        f32x4 o[2][4]; float m[2], l[2]; flash_init<2>(o, m, l);
        float il[2] = {0.f, 0.f};
#ifdef NSA_CMP_FAKEKV
        Src S{proj + (size_t)b * SEQ * INP + CKV_OFF + 4 * 192 + kv * 64, proj + (size_t)b * SEQ * INP + CKV_OFF + 5 * 192 + kv * 64, INP, 1, 0};
#else
        Src S{(const bf16_t*)(ws + WS_KC) + (size_t)(b * 3 + kv) * 512 * 64, (const bf16_t*)(ws + WS_VC) + (size_t)(b * 3 + kv) * 512 * 64, 64, 1, 0};
#endif
#ifdef NSA_CMP_SINGLE
        flash_run<2, 0>(lds, S, ntc, qf, o, m, l, qcc, qcw0, qcw1, 0x7fffffff, nullptr, nullptr, il, nullptr, false, 0, lane, tid);
#pragma unroll
        for (int q = 0; q < 2; ++q) il[q] = l[q] > 0.f ? 1.f / l[q] : 0.f;
        (void)impw;
#elif !defined(NSA_NO_CMP)
        flash_run<2, 2>(lds, S, ntc, qf, o, m, l, qcc, qcw0, qcw1, 0x7fffffff, nullptr, nullptr, il, nullptr, false, 0, lane, tid);
#pragma unroll
        for (int q = 0; q < 2; ++q) { il[q] = l[q] > 0.f ? 1.f / l[q] : 0.f; l[q] = 0.f; }
        flash_run<2, 4>(lds, S, ntc, qf, o, m, l, qcc, qcw0, qcw1, 0x7fffffff, nullptr, nullptr, il, impw, hp != 0, 0, lane, tid);
#else
        (void)S; (void)impw;
#endif
#pragma unroll
        for (int q = 0; q < 2; ++q) { const float gt = sigmoidf_(bf2f(gatep[(hp * 2 + q) * 3 + 0])); const float sc = il[q] * gt;
#pragma unroll
            for (int dt = 0; dt < 4; ++dt) *(f32x4*)(tot + (hp * 2 + q) * 64 + 16 * dt + 4 * g) = o[q][dt] * sc; }
    }
#ifndef NSA_NO_TOPK
    lds_wait();
    unsigned wun0 = 0u, wun1 = 0u, wun2 = 0u, wun3 = 0u;
#pragma unroll 1
    for (int q = 0; q < 16; ++q) {
        const int t = t0 + 16 * wave + q, own = t >> 6;
        const int ncand = own - 2 > 0 ? own - 2 : 0; const int nforced = own >= 2 ? 3 : own + 1; const int K = 16 - nforced;
        const int j0 = lane, j1 = lane + 64;
        const bool c0 = (j0 >= 1) && (j0 <= own - 2), c1 = (j1 <= own - 2);
        const unsigned k0 = c0 ? (__float_as_uint(impw[q * 128 + j0]) + 1u) : 0u, k1 = c1 ? (__float_as_uint(impw[q * 128 + j1]) + 1u) : 0u;
        bool s0 = c0, s1 = c1;
        if (ncand > K) {
            unsigned T = 0u;
            for (int bit = 31; bit >= 0; --bit) { const unsigned Tn = T | (1u << bit);
                const int cnt = __popcll(__ballot(k0 >= Tn)) + __popcll(__ballot(k1 >= Tn)); if (cnt >= K) T = Tn; }
            const bool g0 = k0 > T, g1 = k1 > T; const int ng = __popcll(__ballot(g0)) + __popcll(__ballot(g1)); const int need = K - ng;
            const unsigned long long e0 = __ballot(k0 == T), e1 = __ballot(k1 == T); const unsigned long long lt = (1ull << lane) - 1ull;
            const int r0 = __popcll(e0 & lt), r1 = __popcll(e0) + __popcll(e1 & lt);
            s0 = g0 || (k0 == T && r0 < need); s1 = g1 || (k1 == T && r1 < need);
        }
        s0 = s0 || (j0 == 0) || (j0 == own) || (j0 == own - 1); s1 = s1 || (j1 == own) || (j1 == own - 1);
        const unsigned long long m0 = __ballot(s0), m1 = __ballot(s1);
        const unsigned w0 = (unsigned)m0, w1 = (unsigned)(m0 >> 32), w2 = (unsigned)m1, w3 = (unsigned)(m1 >> 32);
        if (lane == 0) { selS[(16 * wave + q) * 4 + 0] = w0; selS[(16 * wave + q) * 4 + 1] = w1; selS[(16 * wave + q) * 4 + 2] = w2; selS[(16 * wave + q) * 4 + 3] = w3; }
        wun0 |= w0; wun1 |= w1; wun2 |= w2; wun3 |= w3;
    }
    if (lane == 0) { wunS[0] = wun0; wunS[1] = wun1; wunS[2] = wun2; wunS[3] = wun3; }
    __syncthreads();
    if (tid < 4) { unsigned u_ = 0u; for (int w8 = 0; w8 < 8; ++w8) u_ |= ((const LAS unsigned*)(lds + L_WUN))[w8 * 4 + tid]; misc[4 + tid] = u_; }
    __syncthreads();
    const LAS unsigned* selp = selS + (16 * wave + i16) * 4;
    const int ownmax = (t0 + 127) >> 6;
    if (tid == 0) { int n = 0; for (int j = 0; j <= ownmax; ++j) if ((misc[4 + (j >> 5)] >> (j & 31)) & 1u) { tl[2 * n] = 64 * j; tl[2 * n + 1] = j; ++n; } misc[2] = (unsigned)n; }
    __syncthreads();
    const int nts = (int)misc[2];
#else
    const int ownmax = (t0 + 127) >> 6; const int nts = 0; const LAS unsigned* selp = nullptr; (void)selS; (void)wunS;
#endif
    const int kfirst = t0 - 512 > 0 ? t0 - 512 : 0; const int ntw = (t0 + 128 - kfirst) / 64;
#pragma unroll 1
    for (int hp = 0; hp < 2; ++hp) {
        bf16x8 qf[2][2];
#pragma unroll
        for (int q = 0; q < 2; ++q)
#pragma unroll
            for (int ks = 0; ks < 2; ++ks) qf[q][ks] = *(const bf16x8*)(proj + row * INP + CQ_OFF + (kv * 4 + hp * 2 + q) * 64 + ks * 32 + g * 8);
        f32x4 o[2][4]; float m[2], l[2];
        const float il[2] = {0.f, 0.f};
        __syncthreads();
        if (tid == 0) { int n = 0; for (int j = 0; j <= ownmax; ++j) if ((misc[4 + (j >> 5)] >> (j & 31)) & 1u) { tl[2 * n] = 64 * j; tl[2 * n + 1] = j; ++n; } }
#ifndef NSA_NO_SLC
        { flash_init<2>(o, m, l);
          Src S{proj + (size_t)b * SEQ * INP + CKV_OFF + 2 * 192 + kv * 64, proj + (size_t)b * SEQ * INP + CKV_OFF + 3 * 192 + kv * 64, INP, 1, 0};
          flash_run<2, 1>(lds, S, nts, qf, o, m, l, tok, t0 + 16 * wave, t0 + 16 * wave + 15, 0x7fffffff, selp, wunS, il, nullptr, false, hp * 2, lane, tid);
#pragma unroll
          for (int q = 0; q < 2; ++q) { const float gt = sigmoidf_(bf2f(gatep[(hp * 2 + q) * 3 + 1])); const float sc = (l[q] > 0.f ? 1.f / l[q] : 0.f) * gt;
#pragma unroll
              for (int dt = 0; dt < 4; ++dt) { float* tp = tot + (hp * 2 + q) * 64 + 16 * dt + 4 * g; *(f32x4*)tp = *(const f32x4*)tp + o[q][dt] * sc; } }
        }
#endif
        if (tid < ntw) { tl[2 * tid] = kfirst + 64 * tid; tl[2 * tid + 1] = -1; }
        { flash_init<2>(o, m, l);
          Src S{proj + (size_t)b * SEQ * INP + CKV_OFF + 4 * 192 + kv * 64, proj + (size_t)b * SEQ * INP + CKV_OFF + 5 * 192 + kv * 64, INP, 1, 0};
#ifndef NSA_NO_WIN
          flash_run<2, 1>(lds, S, ntw, qf, o, m, l, tok, t0 + 16 * wave, t0 + 16 * wave + 15, 511, nullptr, nullptr, il, nullptr, false, hp * 2, lane, tid);
#else
          (void)S;
#endif
          bf16_t* O = (bf16_t*)(ws + WS_O) + row * 2048 + 1280 + (kv * 4) * 64;
#pragma unroll
          for (int q = 0; q < 2; ++q) { const float gt = sigmoidf_(bf2f(gatep[(hp * 2 + q) * 3 + 2])); const float sc = (l[q] > 0.f ? 1.f / l[q] : 0.f) * gt;
#pragma unroll
              for (int dt = 0; dt < 4; ++dt) { const f32x4 v = *(const f32x4*)(tot + (hp * 2 + q) * 64 + 16 * dt + 4 * g) + o[q][dt] * sc;
                  u32x2 w; w.x = cvtpk(v[0], v[1]); w.y = cvtpk(v[2], v[3]); *(u32x2*)(O + (hp * 2 + q) * 64 + 16 * dt + 4 * g) = w; } }
        }
    }
}

__device__ __forceinline__ float gelu_tanh(float x) { const float u = 0.7978845608028654f * (x + 0.044715f * x * x * x); const float e = __expf(2.f * u); const float th = 1.f - 2.f / (1.f + e); return 0.5f * x * (1.f + th); }
__device__ __forceinline__ void item_compress(const Params& P, int layer, int it, int lane) {
    unsigned char* ws = P.ws; const bf16_t* proj = (const bf16_t*)(ws + WS_PROJ);
    const int nt = it & 31; int r = it >> 5; const int which = r & 1; r >>= 1; const int kv = r % 3, b = r / 3;
    const int g = lane >> 4, i16 = lane & 15;
    int n = 16 * nt + i16; const int nld = n > 510 ? 510 : n;
    const bf16_t* w1t = (const bf16_t*)(ws + WS_W1T) + (size_t)(layer * 2 + which) * 128 * 2048;
    const bf16_t* w2t = (const bf16_t*)(ws + WS_W2T) + (size_t)(layer * 2 + which) * 64 * 128;
    const float* cpe = (const float*)(ws + WS_CPE) + (layer * 2 + which) * 128;
    const bf16_t* src = proj + ((size_t)b * SEQ + 16 * nld) * INP + CKV_OFF + which * 192 + kv * 64 + 8 * g;
    f32x4 acc[8];
#pragma unroll
    for (int h = 0; h < 8; ++h) acc[h] = (f32x4){0.f, 0.f, 0.f, 0.f};
    for (int ks = 0; ks < 64; ++ks) {
        const bf16x8 bfrag = *(const bf16x8*)(src + (size_t)(ks >> 1) * INP + (ks & 1) * 32);
#pragma unroll
        for (int h = 0; h < 8; ++h) { const bf16x8 af = *(const bf16x8*)(w1t + (size_t)(16 * h + i16) * 2048 + 32 * ks + 8 * g); acc[h] = mfma16(af, bfrag, acc[h]); }
    }
    bf16x8 pf[4];
#pragma unroll
    for (int s = 0; s < 4; ++s) { float hv[8];
#pragma unroll
        for (int r2 = 0; r2 < 4; ++r2) { hv[r2] = gelu_tanh(acc[2 * s][r2] + cpe[32 * s + 4 * g + r2]); hv[4 + r2] = gelu_tanh(acc[2 * s + 1][r2] + cpe[32 * s + 16 + 4 * g + r2]); }
        u32x4 w; w.x = cvtpk(hv[0], hv[1]); w.y = cvtpk(hv[2], hv[3]); w.z = cvtpk(hv[4], hv[5]); w.w = cvtpk(hv[6], hv[7]); pf[s] = __builtin_bit_cast(bf16x8, w); }
    bf16_t* dst = (bf16_t*)(ws + (which ? WS_VC : WS_KC)) + ((size_t)(b * 3 + kv) * 512 + n) * 64;
#pragma unroll
    for (int et = 0; et < 4; ++et) { f32x4 oc = {0.f, 0.f, 0.f, 0.f};
#pragma unroll
        for (int s = 0; s < 4; ++s) { const bf16_t* wp = w2t + (size_t)(16 * et + i16) * 128 + 32 * s + 4 * g; const u32x2 lo = *(const u32x2*)wp, hi = *(const u32x2*)(wp + 16);
            u32x4 w; w.x = lo.x; w.y = lo.y; w.z = hi.x; w.w = hi.y; oc = mfma16(__builtin_bit_cast(bf16x8, w), pf[s], oc); }
#ifdef PROBE_CLAMP
#pragma unroll
        for (int r2 = 0; r2 < 4; ++r2) oc[r2] = fminf(fmaxf(oc[r2], -100.f), 100.f);
#endif
        u32x2 w; w.x = cvtpk(oc[0], oc[1]); w.y = cvtpk(oc[2], oc[3]); *(u32x2*)(dst + 16 * et + 4 * g) = w; }
}
__device__ __forceinline__ void item_kmean(const Params& P, int it, int lane) {
    unsigned char* ws = P.ws; const bf16_t* proj = (const bf16_t*)(ws + WS_PROJ);
    const int blk = it & 31, h = (it >> 5) & 7, b = it >> 8;
    const bf16_t* src = proj + ((size_t)b * SEQ + blk * 256) * INP + B_OFF + 512 + h * 64 + lane;
    float s = 0.f;
#pragma unroll 8
    for (int r = 0; r < 256; ++r) s += bf2f(src[(size_t)r * INP]);
    ((float*)(ws + WS_KMEAN))[(size_t)it * 64 + lane] = s * (1.f / 256.f);
}
__device__ __forceinline__ void item_combineA(const Params& P, int row, int lane) {
    unsigned char* ws = P.ws; const float* lse = (const float*)(ws + WS_LSE) + (size_t)row * 12; bf16_t* O = (bf16_t*)(ws + WS_O) + (size_t)row * 2048;
#pragma unroll
    for (int k = 0; k < 3; ++k) { const int chunk = lane + 64 * k; const int col = 4 * chunk; const int gi = col >> 8, hs = (col >> 6) & 3;
        const float a0 = lse[hs], a1 = lse[4 + hs], a2 = lse[8 + hs]; const float mx = fmaxf(a0, fmaxf(a1, a2));
        const float e0 = __expf(a0 - mx), e1 = __expf(a1 - mx), e2 = __expf(a2 - mx); const float al = (gi == 0 ? e0 : (gi == 1 ? e1 : e2)) / (e0 + e1 + e2);
        const u32x2 w = *(const u32x2*)(O + col); u32x2 r; r.x = cvtpk(bflo(w.x) * al, bfhi(w.x) * al); r.y = cvtpk(bflo(w.y) * al, bfhi(w.y) * al); *(u32x2*)(O + col) = r; }
}

__device__ __forceinline__ void phase_conv(const Params& P, int layer, int tid) {
    unsigned char* ws = P.ws; const bf16_t* U = (const bf16_t*)(ws + WS_U); bf16_t* ACT = (bf16_t*)(ws + WS_ACT);
    const float* cw = P.conv_w + (size_t)layer * 3 * UPW; const float* cb = P.conv_b + (size_t)layer * UPW;
    constexpr int NCH = DFF / 8, TB = 16, NTB = MROWS / TB;
    for (int it = blockIdx.x * NTHREADS + tid; it < NCH * NTB; it += gridDim.x * NTHREADS) {
        const int ch = it % NCH, tb = it / NCH; const int c = ch * 8; const int ua = 256 * (c >> 7) + (c & 127);
        float wa[3][8], wg[3][8], ba[8], bg[8];
#pragma unroll
        for (int j = 0; j < 3; ++j)
#pragma unroll
            for (int e = 0; e < 8; ++e) { wa[j][e] = cw[(size_t)j * UPW + c + e]; wg[j][e] = cw[(size_t)j * UPW + DFF + c + e]; }
#pragma unroll
        for (int e = 0; e < 8; ++e) { ba[e] = cb[c + e]; bg[e] = cb[DFF + c + e]; }
        const int row0 = tb * TB; const bool first = (row0 % SEQ) == 0;
        float a1[8], a2[8], g1[8], g2[8];
        {
            u32x4 pa1 = {0, 0, 0, 0}, pa2 = {0, 0, 0, 0}, pg1 = {0, 0, 0, 0}, pg2 = {0, 0, 0, 0};
            if (!first) { pa1 = *(const u32x4*)(U + (size_t)(row0 - 1) * UPW + ua); pa2 = *(const u32x4*)(U + (size_t)(row0 - 2) * UPW + ua);
                          pg1 = *(const u32x4*)(U + (size_t)(row0 - 1) * UPW + ua + 128); pg2 = *(const u32x4*)(U + (size_t)(row0 - 2) * UPW + ua + 128); }
#pragma unroll
            for (int e = 0; e < 4; ++e) { a1[2 * e] = bflo(pa1[e]); a1[2 * e + 1] = bfhi(pa1[e]); a2[2 * e] = bflo(pa2[e]); a2[2 * e + 1] = bfhi(pa2[e]);
                                          g1[2 * e] = bflo(pg1[e]); g1[2 * e + 1] = bfhi(pg1[e]); g2[2 * e] = bflo(pg2[e]); g2[2 * e + 1] = bfhi(pg2[e]); }
        }
#pragma unroll 4
        for (int t = 0; t < TB; ++t) {
            const u32x4 pa = *(const u32x4*)(U + (size_t)(row0 + t) * UPW + ua), pg = *(const u32x4*)(U + (size_t)(row0 + t) * UPW + ua + 128);
            float a0[8], g0[8], r[8];
#pragma unroll
            for (int e = 0; e < 4; ++e) { a0[2 * e] = bflo(pa[e]); a0[2 * e + 1] = bfhi(pa[e]); g0[2 * e] = bflo(pg[e]); g0[2 * e + 1] = bfhi(pg[e]); }
#pragma unroll
            for (int e = 0; e < 8; ++e) { const float ya = ba[e] + wa[0][e] * a0[e] + wa[1][e] * a1[e] + wa[2][e] * a2[e]; const float yg = bg[e] + wg[0][e] * g0[e] + wg[1][e] * g1[e] + wg[2][e] * g2[e];
                r[e] = ya * yg / (1.f + __expf(-yg)); a2[e] = a1[e]; a1[e] = a0[e]; g2[e] = g1[e]; g1[e] = g0[e]; }
            u32x4 w; w.x = cvtpk(r[0], r[1]); w.y = cvtpk(r[2], r[3]); w.z = cvtpk(r[4], r[5]); w.w = cvtpk(r[6], r[7]);
            *(u32x4*)(ACT + (size_t)(row0 + t) * DFF + c) = w;
        }
    }
}

#define XB_TMO      128
#define XB_XCNT(j)  (256  + 64 * (j))
#define XB_XSUB(j)  (1280 + 64 * (j))
#define XB_XGEN(j)  (2304 + 64 * (j))
#define XB_TOP      3328
#define XB_TOPGEN   3392
#define XCD_BAR_WORDS 3456
#define XB_SPIN_CAP (1u << 27)

__device__ __forceinline__ unsigned xb_ld(unsigned* p)              { return __hip_atomic_load(p, __ATOMIC_RELAXED, __HIP_MEMORY_SCOPE_AGENT); }
__device__ __forceinline__ unsigned xb_add(unsigned* p, unsigned v) { return __hip_atomic_fetch_add(p, v, __ATOMIC_RELAXED, __HIP_MEMORY_SCOPE_AGENT); }
__device__ __forceinline__ unsigned xb_xcc_id() { return (unsigned)__builtin_amdgcn_s_getreg((3 << 11) | 20) & 0xFu; }
#define XB_SPIN(cond, bar) do { unsigned _sp = 0; while (cond) { __builtin_amdgcn_s_sleep(1); \
    if ((++_sp & 255u) == 0u) { if (xb_ld(&(bar)[XB_TMO])) break; if (_sp > XB_SPIN_CAP) { atomicAdd(&(bar)[XB_TMO], 1u); break; } } } } while (0)

struct XcdBarrier {
    unsigned* bar; unsigned x;
    volatile LAS unsigned* st;
};

__device__ __forceinline__ XcdBarrier xcd_barrier_post(unsigned* bar, volatile LAS unsigned* st) {
    XcdBarrier b; b.bar = bar; b.x = xb_xcc_id(); b.st = st;
    if (threadIdx.x == 0) (void)xb_add(&bar[XB_XCNT(b.x)], 1u);
    return b;
}
__device__ __forceinline__ void xcd_barrier_complete(unsigned* bar, unsigned x, unsigned& nloc, unsigned& nx) {
    const unsigned G = gridDim.x * gridDim.y * gridDim.z;
    unsigned sum, cnt, mine, sp = 0u;
    for (;;) {
        sum = 0u; cnt = 0u; mine = 0u;
#pragma unroll
        for (unsigned j = 0; j < 16; ++j) { const unsigned c = xb_ld(&bar[XB_XCNT(j)]); sum += c; cnt += (c > 0u) ? 1u : 0u; mine = (j == x) ? c : mine; }
        if (sum == G) break;
        __builtin_amdgcn_s_sleep(1);
        if ((++sp & 255u) == 0u) { if (xb_ld(&bar[XB_TMO])) break; if (sp > XB_SPIN_CAP) { atomicAdd(&bar[XB_TMO], 1u); break; } }
    }
    nloc = mine > 0u ? mine : 1u; nx = cnt > 0u ? cnt : 1u;
}

__device__ __forceinline__ void xcd_barrier(const XcdBarrier& b) {
    asm volatile("s_waitcnt vmcnt(0)" ::: "memory");
    __syncthreads();
    if (threadIdx.x == 0) {
        unsigned* bar = b.bar;
        __builtin_amdgcn_s_waitcnt(0);
        unsigned nloc = b.st[0], nx = b.st[1];
        if (nloc == 0u) { xcd_barrier_complete(bar, b.x, nloc, nx); b.st[0] = nloc; b.st[1] = nx; }
        const unsigned old = xb_add(&bar[XB_XSUB(b.x)], 1u);
        const unsigned gen = old / nloc;
        if (old + 1u == (gen + 1u) * nloc) {
            __builtin_amdgcn_fence(__ATOMIC_RELEASE, "agent");
            asm volatile("s_waitcnt vmcnt(0)" ::: "memory");
            const unsigned og = xb_add(&bar[XB_TOP], 1u);
            const unsigned tg = og / nx;
            if (og + 1u == (tg + 1u) * nx) xb_add(&bar[XB_TOPGEN], 1u);
            else XB_SPIN(xb_ld(&bar[XB_TOPGEN]) == tg, bar);
            __builtin_amdgcn_fence(__ATOMIC_ACQUIRE, "agent");
            xb_add(&bar[XB_XGEN(b.x)], 1u);
            asm volatile("s_waitcnt vmcnt(0)" ::: "memory");
        } else {
            XB_SPIN(xb_ld(&bar[XB_XGEN(b.x)]) == gen, bar);
            __builtin_amdgcn_fence(__ATOMIC_ACQUIRE, "agent");
            asm volatile("s_waitcnt vmcnt(0)" ::: "memory");
        }
    }
    __syncthreads();
}

__global__ void __launch_bounds__(NTHREADS) fwd_megakernel(Params P) {
    extern __shared__ __attribute__((aligned(16))) unsigned char lds_raw[];
    LAS unsigned char* lds = (LAS unsigned char*)lds_raw;
    int tid0 = threadIdx.x;
    unsigned char* ws0 = P.ws;
    volatile LAS unsigned* bst = (volatile LAS unsigned*)(lds + LDS_BYTES - 64);
    if (threadIdx.x < 2) bst[threadIdx.x] = 0u;
    __syncthreads();
    (void)xcd_barrier_post((unsigned*)(P.ws + WS_CTL) + 4096, bst);
#define GRID_BAR() do { XcdBarrier b_; b_.bar = (unsigned*)(ws0 + WS_CTL) + 4096; b_.x = xb_xcc_id(); b_.st = (volatile LAS unsigned*)(lds + LDS_BYTES - 64); xcd_barrier(b_); } while (0)
    { const int tid = tid0, lane = tid & 63, wave = __builtin_amdgcn_readfirstlane(tid >> 6);

#ifndef SKIP_P0
    p0_prologue(P, lds, tid, lane, wave);
#endif
    }
    GRID_BAR();

#pragma unroll 1
    for (int layer = 0; layer < DEPTH; ++layer) {
        asm volatile("" : "+v"(tid0), "+s"(ws0));
        const int tid = tid0, lane = tid & 63, wave = __builtin_amdgcn_readfirstlane(tid >> 6);
        const int G = gridDim.x, gw = blockIdx.x * NWAVES + wave, NGW = G * NWAVES;
        unsigned char* ws = ws0;
        unsigned* ctl = (unsigned*)(ws + WS_CTL);
        const float* xbase = layer == 0 ? P.x : (const float*)(ws + WS_X);
#ifdef PROBE_ZERO_O
        for (size_t i = (size_t)blockIdx.x * NTHREADS + tid; i < (size_t)MROWS * 2048 / 8; i += (size_t)G * NTHREADS) ((u32x4*)(ws + WS_O))[i] = (u32x4){0u, 0u, 0u, 0u};
#endif
        { pg8::Gemm gm{(const pg8::bf16_t*)(ws + WS_XB), (const pg8::bf16_t*)(ws + WS_WIN + layer * SZ_WIN), MROWS, INP, DM};
          pg8::StaticOrder S; S.init(MROWS, INP, G, (int)blockIdx.x);
          pg8::EpiScaleBf16 E{(pg8::bf16_t*)(ws + WS_PROJ), INP, (const float*)(ws + WS_SSP)};
          pg8::gemm_phase<pg8::EpiScaleBf16, pg8::StaticOrder, true, true>(lds, gm, S, E); }
        GRID_BAR();
#ifndef SKIP_CMP
        for (int it = gw; it < 384 + 512; it += NGW) { if (it < 384) item_compress(P, layer, it, lane); else item_kmean(P, it - 384, lane); }
#endif
#ifndef SKIP_MIXA
        for (;;) { const int u = next_unit(ctl + 64 * (layer * 2 + 0), lds, tid); if (u >= 1536) break; unit_mixA(P, lds, u, tid, lane, wave); }
#endif
        GRID_BAR();
        for (int r = gw; r < MROWS; r += NGW) item_combineA(P, r, lane);
        for (;;) { const int u = next_unit(ctl + 64 * (layer * 2 + 1), lds, tid); if (u >= 384 + 1024) break;
            if (u < 384) {
#ifndef SKIP_NSA
                unit_nsa(P, lds, (u % 6) / 3, (u % 6) % 3, 63 - u / 6, tid, lane, wave);
#endif
            } else { const int v = u - 384;
#ifndef SKIP_MOBA
                unit_moba(P, lds, (v % 16) / 8, (v % 16) % 8, 63 - v / 16, tid, lane, wave);
#endif
            } }
        GRID_BAR();
        { pg8::Gemm gm{(const pg8::bf16_t*)(ws + WS_O), (const pg8::bf16_t*)(ws + WS_WOUT + layer * SZ_WOUT), MROWS, DM, DM};
          pg8::StaticOrder S; S.init(MROWS, DM, G, (int)blockIdx.x);
          pg8::EpiResid E{xbase, (float*)(ws + WS_X), (pg8::bf16_t*)(ws + WS_XB), (float*)(ws + WS_SSP)};
          pg8::gemm_phase<pg8::EpiResid, pg8::StaticOrder, true, true>(lds, gm, S, E); }
        GRID_BAR();
        { pg8::Gemm gm{(const pg8::bf16_t*)(ws + WS_XB), (const pg8::bf16_t*)(ws + WS_WUP + layer * SZ_WUP), MROWS, UPW, DM};
          pg8::StaticOrder S; S.init(MROWS, UPW, G, (int)blockIdx.x);
          pg8::EpiScaleBf16 E{(pg8::bf16_t*)(ws + WS_U), UPW, (const float*)(ws + WS_SSP)};
          pg8::gemm_phase<pg8::EpiScaleBf16, pg8::StaticOrder, true, true>(lds, gm, S, E); }
        GRID_BAR();
#ifndef SKIP_CONV
        phase_conv(P, layer, tid);
#endif
        GRID_BAR();
        { pg8::Gemm gm{(const pg8::bf16_t*)(ws + WS_ACT), (const pg8::bf16_t*)(ws + WS_WDN + layer * SZ_WDN), MROWS, DM, DFF};
          pg8::StaticOrder S; S.init(MROWS, DM, G, (int)blockIdx.x);
          pg8::EpiResid E{(const float*)(ws + WS_X), (float*)(ws + WS_X), (pg8::bf16_t*)(ws + WS_XB), (float*)(ws + WS_SSP)};
          pg8::gemm_phase<pg8::EpiResid, pg8::StaticOrder, true, true>(lds, gm, S, E); }
        GRID_BAR();
    }
    const int tid = tid0, lane = tid & 63, wave = __builtin_amdgcn_readfirstlane(tid >> 6);
    const int G = gridDim.x, gw = blockIdx.x * NWAVES + wave, NGW = G * NWAVES;
    unsigned char* ws = ws0; (void)tid; (void)G;
    for (int mrow = gw; mrow < MROWS; mrow += NGW) {
        const f32x4* xr = (const f32x4*)((const float*)(ws + WS_X) + (size_t)mrow * DM) + lane; const f32x4* gr = (const f32x4*)P.norm_final + lane;
        f32x4 v[8]; float s = 0.f;
#pragma unroll
        for (int j = 0; j < 8; ++j) { v[j] = xr[64 * j]; s += (v[j][0] * v[j][0] + v[j][1] * v[j][1]) + (v[j][2] * v[j][2] + v[j][3] * v[j][3]); }
#pragma unroll
        for (int o = 1; o < 64; o <<= 1) s += __shfl_xor(s, o);
        const float rs = 1.0f / sqrtf(s * (1.0f / DM) + 1e-6f);
        f32x4* orow = (f32x4*)(P.out + (size_t)mrow * DM) + lane;
#pragma unroll
        for (int j = 0; j < 8; ++j) orow[64 * j] = v[j] * rs * gr[64 * j];
    }
}

extern "C" void kernel_launch(void* const* d_in, const int* in_sizes, int n_in, void* d_out, int out_size, void* d_ws, size_t ws_size, hipStream_t stream) {
    static int grid = 0;
    if (grid == 0) {
        if (n_in != 14 || ws_size < WS_END) { fprintf(stderr, "kernel_launch: unexpected n_in %d or workspace %zu < %zu\n", n_in, ws_size, (size_t)WS_END); grid = -1; return; }
        int dev = 0, cus = 0, per_cu = 0;
        hipGetDevice(&dev); hipDeviceGetAttribute(&cus, hipDeviceAttributeMultiprocessorCount, dev);
        if (hipFuncSetAttribute((const void*)fwd_megakernel, hipFuncAttributeMaxDynamicSharedMemorySize, LDS_BYTES) != hipSuccess) { fprintf(stderr, "kernel_launch: hipFuncSetAttribute failed\n"); grid = -1; return; }
        if (hipOccupancyMaxActiveBlocksPerMultiprocessor(&per_cu, (const void*)fwd_megakernel, NTHREADS, LDS_BYTES) != hipSuccess || per_cu < 1) { fprintf(stderr, "kernel_launch: occupancy query says %d\n", per_cu); per_cu = 1; }
        (void)hipGetLastError();
        grid = cus * 1;
    }
    if (grid < 0) return;
    hipMemsetAsync((char*)d_ws + WS_CTL, 0, CTL_BYTES, stream);
    Params p{};
    p.x = (const float*)d_in[0]; p.rel = (const float*)d_in[1]; p.w_in = (const float*)d_in[2]; p.w_out = (const float*)d_in[3]; p.cmp_w1 = (const float*)d_in[4]; p.cmp_w2 = (const float*)d_in[5];
    p.cmp_pe = (const float*)d_in[6]; p.norm_attn = (const float*)d_in[7]; p.norm_mlp = (const float*)d_in[8]; p.w_up = (const float*)d_in[9]; p.conv_w = (const float*)d_in[10]; p.conv_b = (const float*)d_in[11];
    p.w_down = (const float*)d_in[12]; p.norm_final = (const float*)d_in[13]; p.out = (float*)d_out; p.ws = (unsigned char*)d_ws;
    void* args[] = {&p};
    hipError_t e = hipLaunchCooperativeKernel((const void*)fwd_megakernel, dim3(grid), dim3(NTHREADS), args, LDS_BYTES, stream);
    if (e != hipSuccess) fprintf(stderr, "kernel_launch: cooperative launch failed: %s (grid %d)\n", hipGetErrorString(e), grid);
}
```

```cpp
#include <hip/hip_runtime.h>
#include <hip/hip_cooperative_groups.h>
#include <cstdio>
#include <cstdint>
namespace cg = cooperative_groups;
namespace pg8 {
#define PG8_LAS __attribute__((address_space(3)))
typedef unsigned short bf16_t;
typedef short bf16x8 __attribute__((ext_vector_type(8)));
typedef float f32x4 __attribute__((ext_vector_type(4)));
typedef unsigned u32x4 __attribute__((ext_vector_type(4)));
constexpr int BM = 256, BK = 64, HALF = 128, HTB = HALF * BK * 2  , STAGE_BYTES = 8 * HTB, NXCD = 8, WGM = 8;

__host__ __device__ __forceinline__ int lds_byte(int r, int c) { const int st = (r >> 4) * 2 + (c >> 5), rr = r & 15, cc = c & 31, ob = rr * 64 + cc * 2; return st * 1024 + (ob ^ (((ob >> 9) & 1) << 5)); }
__host__ __device__ __forceinline__ void stage_rc(int b, int& R, int& C) { const int st = b / 1024, sb = b % 1024, swz = sb ^ (((sb >> 9) & 1) << 5); R = (st >> 1) * 16 + swz / 64; C = (st & 1) * 32 + (swz % 64) / 2; }
__host__ __device__ __forceinline__ int perm32(int rho) { const int n = rho >> 4, i = rho & 15; return 8 * (i >> 2) + 4 * n + (i & 3); }

struct Unit { int pm, pn; };
struct Gemm { const bf16_t* A; const bf16_t* Bt; int M, N, K; };

struct StaticOrder {
    int nM, nN, nwg, G, c;
    __host__ __device__ void init(int M, int N, int G_, int c_) { nM = M / BM; nN = N / BM; nwg = nM * nN; G = G_; c = c_; }
    __host__ __device__ bool next(int i, Unit& u) const {
        const long L = (long)i * G + c; if (L >= nwg) return false;
        int wgid = (int)L; { const int q = nwg / NXCD, r = nwg % NXCD, xcd = wgid % NXCD, off = wgid / NXCD; wgid = (xcd < r ? xcd * (q + 1) : r * (q + 1) + (xcd - r) * q) + off; }
        const int nig = WGM * nN, gid = wgid / nig, fm = gid * WGM, gsz = (nM - fm) < WGM ? (nM - fm) : WGM;
        u.pm = fm + ((wgid % nig) % gsz); u.pn = (wgid % nig) / gsz; return true;
    }
    __device__ __forceinline__ void a_ready(const Unit&) const {}
    __device__ __forceinline__ void done(const Unit&) const {}
};
typedef float f32x2 __attribute__((ext_vector_type(2)));
typedef __bf16 bf16x2_pk __attribute__((ext_vector_type(2)));
__device__ __forceinline__ unsigned cvt_pk_bf16(float lo, float hi) { f32x2 v = {lo, hi}; bf16x2_pk b = __builtin_convertvector(v, bf16x2_pk); return __builtin_bit_cast(unsigned, b); }
__device__ __forceinline__ float row_rstd(const float* ssp, int row) {
    const f32x4* p = (const f32x4*)(ssp + (size_t)row * 32); float s = 0.f;
#pragma unroll
    for (int i = 0; i < 8; ++i) { const f32x4 v = p[i]; s += (v[0] + v[1]) + (v[2] + v[3]); }
    return 1.0f / sqrtf(s * (1.0f / 2048.0f) + 1e-6f);
}
struct EpiScaleBf16 {
    static constexpr bool PERM = true, AFTER_DRAIN = false;
    bf16_t* O; int ldc; const float* ssp;
    __device__ __forceinline__ void operator()(const f32x4 (&acc)[2][2][4][2], const Unit& u, int wr, int wc, int fr, int fq) const {
        const int lane = fq * 16 + fr;
        const int rbase = u.pm * BM + wr * 64;
        f32x4 t[2][8];
#pragma unroll
        for (int j = 0; j < 2; ++j) { const int q = 2 * lane + j; const int row = rbase + (q >> 6) * HALF + (q & 63);
            const f32x4* p = (const f32x4*)(ssp + (size_t)row * 32);
#pragma unroll
            for (int i = 0; i < 8; ++i) t[j][i] = p[i]; }
        __builtin_amdgcn_sched_barrier(0);
        float rsv[2];
#pragma unroll
        for (int j = 0; j < 2; ++j) { float sm = 0.f;
#pragma unroll
            for (int i = 0; i < 8; ++i) sm += (t[j][i][0] + t[j][i][1]) + (t[j][i][2] + t[j][i][3]);
            rsv[j] = 1.0f / sqrtf(sm * (1.0f / 2048.0f) + 1e-6f); }
        const int row0 = rbase + fr; const int col0 = u.pn * BM + wc * 32 + 8 * fq;
#pragma unroll
        for (int ai = 0; ai < 2; ++ai)
#pragma unroll
            for (int m = 0; m < 4; ++m) { const int q = ai * 64 + m * 16 + fr; const float v0 = __shfl(rsv[0], q >> 1), v1 = __shfl(rsv[1], q >> 1); const float rs = (q & 1) ? v1 : v0;
                bf16_t* rowp = O + (size_t)(row0 + ai * HALF + m * 16) * ldc + col0;
#pragma unroll
                for (int bj = 0; bj < 2; ++bj) { const f32x4 v0_ = acc[ai][bj][m][0] * rs, v1_ = acc[ai][bj][m][1] * rs; u32x4 w;
                    w.x = cvt_pk_bf16(v0_[0], v0_[1]); w.y = cvt_pk_bf16(v0_[2], v0_[3]); w.z = cvt_pk_bf16(v1_[0], v1_[1]); w.w = cvt_pk_bf16(v1_[2], v1_[3]);
                    *(u32x4*)(rowp + bj * HALF) = w; } }
    }
};
struct EpiResid {
    static constexpr bool PERM = false, AFTER_DRAIN = false;
    const float* base; float* X; bf16_t* XB; float* ssp;
    __device__ __forceinline__ void operator()(const f32x4 (&acc)[2][2][4][2], const Unit& u, int wr, int wc, int fr, int fq) const {
        typedef unsigned u32x2v __attribute__((ext_vector_type(2)));
        const int row0 = u.pm * BM + wr * 64 + fr; const int col0 = u.pn * BM + wc * 32 + 4 * fq;
#pragma unroll
        for (int ai = 0; ai < 2; ++ai)
#pragma unroll
            for (int m = 0; m < 4; ++m) { const int row = row0 + ai * HALF + m * 16; const size_t off = (size_t)row * 2048 + col0; float ss = 0.f;
#pragma unroll
                for (int bj = 0; bj < 2; ++bj)
#pragma unroll
                    for (int n = 0; n < 2; ++n) { const size_t o2 = off + bj * HALF + n * 16; const f32x4 v = *(const f32x4*)(base + o2) + acc[ai][bj][m][n];
                        *(f32x4*)(X + o2) = v; u32x2v w; w.x = cvt_pk_bf16(v[0], v[1]); w.y = cvt_pk_bf16(v[2], v[3]); *(u32x2v*)(XB + o2) = w;
                        ss += (v[0] * v[0] + v[1] * v[1]) + (v[2] * v[2] + v[3] * v[3]); }
                ss += __shfl_xor(ss, 16); ss += __shfl_xor(ss, 32);
                if (fq == 0) ssp[(size_t)row * 32 + u.pn * 4 + wc] = ss;
                asm volatile("" ::: "memory"); }
    }
};
template <class Epi, class Sched, bool ALIGN_EPI = false, bool SP2 = false>
__device__ __forceinline__ void gemm_phase(PG8_LAS unsigned char* lds, const Gemm g, const Sched& S, const Epi& E, const int wid_in) {
    int lane_; asm volatile("v_mbcnt_lo_u32_b32 %0, -1, 0\n\tv_mbcnt_hi_u32_b32 %0, -1, %0" : "=v"(lane_)); const int wid = wid_in, lane = lane_, tid = wid * 64 + lane, wr = wid >> 2, wc = wid & 3, fr = lane & 15, fq = lane >> 4;
    const int K = g.K, nt = K / BK;
    unsigned voffA[2], voffB[2];
#pragma unroll
    for (int i = 0; i < 2; ++i) { int R, C; stage_rc(tid * 16 + i * 8192, R, C); const int Rb = Epi::PERM ? ((R & ~31) + perm32(R & 31)) : R;
        voffA[i] = (unsigned)(R * K + C) * 2u; voffB[i] = (unsigned)(Rb * K + C) * 2u; }
    const size_t kstep = (size_t)(BK * 2);
    const size_t hstep = (size_t)HALF * K * 2;
    const size_t tstep = 2 * hstep;
    const unsigned ldsw = (unsigned)wid * 1024u;
    const int aoff = lds_byte(wr * 64 + fr, fq * 8), boff = lds_byte(wc * 32 + fr, fq * 8);
#define PG8_SA(b, h) (((b) * 2 + (h)) * HTB)
#define PG8_SB(b, h) ((4 + (b) * 2 + (h)) * HTB)
#define PG8_STAGE(bufoff, gbase, voff) do { _Pragma("unroll") for (int _i = 0; _i < 2; ++_i) \
        __builtin_amdgcn_global_load_lds((const unsigned*)((const char*)(gbase) + (voff)[_i]), (PG8_LAS unsigned*)(lds + (bufoff) + ldsw + _i * 8192), 16, 0, 0); } while (0)
#define PG8_LDA(dst, b, h) do { _Pragma("unroll") for (int m = 0; m < 4; ++m) _Pragma("unroll") for (int k = 0; k < 2; ++k) dst[m][k] = *(const PG8_LAS bf16x8*)(lds + PG8_SA(b, h) + aoff + m * 2048 + k * 1024); } while (0)
#define PG8_LDB(dst, b, h) do { _Pragma("unroll") for (int n = 0; n < 2; ++n) _Pragma("unroll") for (int k = 0; k < 2; ++k) dst[n][k] = *(const PG8_LAS bf16x8*)(lds + PG8_SB(b, h) + boff + n * 2048 + k * 1024); } while (0)
#define PG8_MMA(ai, bj, At, Bt) do { __builtin_amdgcn_s_setprio(1); _Pragma("unroll") for (int m = 0; m < 4; ++m) _Pragma("unroll") for (int n = 0; n < 2; ++n) _Pragma("unroll") for (int k = 0; k < 2; ++k) \
        acc[ai][bj][m][n] = __builtin_amdgcn_mfma_f32_16x16x32_bf16(Bt[n][k], At[m][k], acc[ai][bj][m][n], 0, 0, 0); __builtin_amdgcn_s_setprio(0); } while (0)
#define PG8_WAIT_V(n) asm volatile("s_waitcnt vmcnt(" #n ")" ::: "memory")
#define PG8_WAIT_L(n) asm volatile("s_waitcnt lgkmcnt(" #n ")" ::: "memory")
#define PG8_BAR __builtin_amdgcn_s_barrier()
#define PG8_SCHED __builtin_amdgcn_sched_barrier(0)
    Unit cur, nxt; int ui = 0;
    if (!S.next(0, cur)) return;
    f32x4 acc[2][2][4][2];
#pragma unroll
    for (int a = 0; a < 2; ++a)
#pragma unroll
        for (int b = 0; b < 2; ++b)
#pragma unroll
            for (int m = 0; m < 4; ++m)
#pragma unroll
                for (int n = 0; n < 2; ++n) acc[a][b][m][n] = (f32x4){0.f, 0.f, 0.f, 0.f};
    bf16x8 At[4][2], B0[2][2], B1[2][2];
    const char* cA = (const char*)g.A + (size_t)cur.pm * tstep; const char* cB = (const char*)g.Bt + (size_t)cur.pn * tstep;
    S.a_ready(cur);
    if constexpr (SP2) {
        PG8_STAGE(PG8_SB(0, 0), cB, voffB); PG8_STAGE(PG8_SB(0, 1), cB + hstep, voffB); PG8_STAGE(PG8_SA(0, 0), cA, voffA); PG8_STAGE(PG8_SA(0, 1), cA + hstep, voffA);
        if (wr == 1) PG8_BAR;
        PG8_WAIT_V(2); PG8_BAR;
        PG8_STAGE(PG8_SB(1, 0), cB + kstep, voffB); PG8_STAGE(PG8_SA(1, 0), cA + kstep, voffA); PG8_STAGE(PG8_SB(1, 1), cB + hstep + kstep, voffB);
        PG8_WAIT_V(6); PG8_BAR;
    } else {
        PG8_STAGE(PG8_SB(0, 0), cB, voffB); PG8_STAGE(PG8_SA(0, 0), cA, voffA); PG8_STAGE(PG8_SB(0, 1), cB + hstep, voffB); PG8_STAGE(PG8_SA(0, 1), cA + hstep, voffA);
        if (wr == 1) PG8_BAR;
        PG8_WAIT_V(4); PG8_BAR;
        PG8_STAGE(PG8_SB(1, 0), cB + kstep, voffB); PG8_STAGE(PG8_SA(1, 0), cA + kstep, voffA); PG8_STAGE(PG8_SB(1, 1), cB + hstep + kstep, voffB);
        PG8_WAIT_V(6); PG8_BAR;
    }
    for (;;) {
        const bool has_next = S.next(ui + 1, nxt);
        const char* nA = has_next ? (const char*)g.A + (size_t)nxt.pm * tstep : cA; const char* nB = has_next ? (const char*)g.Bt + (size_t)nxt.pn * tstep : cB;
        for (int t = 0; t < nt; t += 2) {
            const bool last = (t == nt - 2);
            const char* a1 = cA + (size_t)(t + 1) * kstep;
            const char* a2 = last ? nA : cA + (size_t)(t + 2) * kstep; const char* b2 = last ? nB : cB + (size_t)(t + 2) * kstep;
            const char* a3 = a2 + kstep; const char* b3 = b2 + kstep;
            if (last && has_next) S.a_ready(nxt);
            if constexpr (SP2) {
            PG8_LDB(B0, 0, 0); PG8_LDB(B1, 0, 1); PG8_SCHED; PG8_LDA(At, 0, 0); PG8_STAGE(PG8_SA(1, 1), a1 + hstep, voffA);
            PG8_WAIT_V(8); PG8_WAIT_L(0); PG8_BAR; PG8_MMA(0, 0, At, B0); PG8_MMA(0, 1, At, B1); PG8_BAR; PG8_SCHED;
            PG8_LDA(At, 0, 1); PG8_STAGE(PG8_SB(0, 0), b2, voffB); PG8_STAGE(PG8_SB(0, 1), b2 + hstep, voffB); PG8_STAGE(PG8_SA(0, 0), a2, voffA);
            PG8_WAIT_V(8); PG8_WAIT_L(0); PG8_BAR; PG8_MMA(1, 0, At, B0); PG8_MMA(1, 1, At, B1); PG8_BAR; PG8_SCHED;
            PG8_LDB(B0, 1, 0); PG8_LDB(B1, 1, 1); PG8_SCHED; PG8_LDA(At, 1, 0); PG8_STAGE(PG8_SA(0, 1), a2 + hstep, voffA);
            PG8_WAIT_V(8); PG8_WAIT_L(0); PG8_BAR; PG8_MMA(0, 0, At, B0); PG8_MMA(0, 1, At, B1); PG8_BAR; PG8_SCHED;
            PG8_LDA(At, 1, 1); PG8_STAGE(PG8_SB(1, 0), b3, voffB); PG8_STAGE(PG8_SB(1, 1), b3 + hstep, voffB); PG8_STAGE(PG8_SA(1, 0), a3, voffA);
            PG8_WAIT_V(8); PG8_WAIT_L(0); PG8_BAR; PG8_MMA(1, 0, At, B0); PG8_MMA(1, 1, At, B1); PG8_BAR; PG8_SCHED;
            } else {
            PG8_LDB(B0, 0, 0); PG8_SCHED; PG8_LDA(At, 0, 0); PG8_STAGE(PG8_SA(1, 1), a1 + hstep, voffA);
            PG8_WAIT_L(8); PG8_BAR; PG8_WAIT_L(0); PG8_MMA(0, 0, At, B0); PG8_BAR; PG8_SCHED;
            PG8_LDB(B1, 0, 1); PG8_STAGE(PG8_SB(0, 0), b2, voffB);
            PG8_BAR; PG8_WAIT_L(0); PG8_MMA(0, 1, At, B1); PG8_BAR;
            PG8_LDA(At, 0, 1); PG8_STAGE(PG8_SA(0, 0), a2, voffA);
            PG8_BAR; PG8_WAIT_L(0); PG8_MMA(1, 0, At, B0); PG8_BAR; PG8_SCHED;
            PG8_STAGE(PG8_SB(0, 1), b2 + hstep, voffB);
            PG8_WAIT_V(6); PG8_BAR; PG8_MMA(1, 1, At, B1); PG8_BAR;
            PG8_LDB(B0, 1, 0); PG8_SCHED; PG8_LDA(At, 1, 0); PG8_STAGE(PG8_SA(0, 1), a2 + hstep, voffA);
            PG8_WAIT_L(8); PG8_BAR; PG8_WAIT_L(0); PG8_MMA(0, 0, At, B0); PG8_BAR; PG8_SCHED;
            PG8_LDB(B1, 1, 1); PG8_STAGE(PG8_SB(1, 0), b3, voffB);
            PG8_BAR; PG8_WAIT_L(0); PG8_MMA(0, 1, At, B1); PG8_BAR;
            PG8_LDA(At, 1, 1); PG8_STAGE(PG8_SA(1, 0), a3, voffA);
            PG8_BAR; PG8_WAIT_L(0); PG8_MMA(1, 0, At, B0); PG8_BAR; PG8_SCHED;
            PG8_STAGE(PG8_SB(1, 1), b3 + hstep, voffB);
            PG8_WAIT_V(6); PG8_BAR; PG8_MMA(1, 1, At, B1); PG8_BAR;
            }
        }
        if constexpr (ALIGN_EPI) { if (wr == 0) PG8_BAR; }
        if constexpr (!Epi::AFTER_DRAIN) { E(acc, cur, wr, wc, fr, fq); S.done(cur); }
        if (!has_next) break;
#pragma unroll
        for (int a = 0; a < 2; ++a)
#pragma unroll
            for (int b = 0; b < 2; ++b)
#pragma unroll
                for (int m = 0; m < 4; ++m)
#pragma unroll
                    for (int n = 0; n < 2; ++n) acc[a][b][m][n] = (f32x4){0.f, 0.f, 0.f, 0.f};
        cur = nxt; cA = nA; cB = nB; ++ui;
        if constexpr (ALIGN_EPI) { if (wr == 1) PG8_BAR; }
    }
    PG8_WAIT_V(0);
    if constexpr (!ALIGN_EPI) { if (wr == 0) PG8_BAR; }
    PG8_BAR;
    if constexpr (Epi::AFTER_DRAIN) { E.fused(acc, cur, wr, wc, fr, fq, lds, wid, lane); S.done(cur); }
#undef PG8_SA
#undef PG8_SB
#undef PG8_STAGE
#undef PG8_LDA
#undef PG8_LDB
#undef PG8_MMA
#undef PG8_WAIT_V
#undef PG8_WAIT_L
#undef PG8_BAR
#undef PG8_SCHED
}
}

#define GAS __attribute__((address_space(1)))
#define LAS __attribute__((address_space(3)))
typedef unsigned short bf16_t;
typedef short bf16x8 __attribute__((ext_vector_type(8)));
typedef float f32x4 __attribute__((ext_vector_type(4)));
typedef unsigned u32x4 __attribute__((ext_vector_type(4)));
typedef unsigned u32x2 __attribute__((ext_vector_type(2)));
typedef short s16x4 __attribute__((ext_vector_type(4)));

constexpr int BATCH = 2, SEQ = 8192, DM = 2048, DEPTH = 4, MROWS = BATCH * SEQ;
constexpr int INW = 5796, INP = 5888, DFF = 5632, UPW = 2 * DFF;
constexpr int A_OFF = 0, B_OFF = 2304, CQ_OFF = 3840, CKV_OFF = 4608, CG_OFF = 5760;
constexpr int LUTN = 1536;
constexpr float LOG2E = 1.4426950408889634f, LN2 = 0.6931471805599453f;
constexpr int NTHREADS = 512, NWAVES = 8;

constexpr size_t al256(size_t x) { return (x + 255) & ~(size_t)255; }
constexpr size_t WS_CTL = 0, CTL_BYTES = 1u << 20;
constexpr size_t SZ_WIN = (size_t)INP * DM * 2, SZ_WOUT = (size_t)DM * DM * 2, SZ_WUP = (size_t)UPW * DM * 2, SZ_WDN = (size_t)DM * DFF * 2;
constexpr size_t WS_WIN = CTL_BYTES;
constexpr size_t WS_WOUT = WS_WIN + DEPTH * SZ_WIN;
constexpr size_t WS_WUP = WS_WOUT + DEPTH * SZ_WOUT;
constexpr size_t WS_WDN = WS_WUP + DEPTH * SZ_WUP;
constexpr size_t WS_W1T = WS_WDN + DEPTH * SZ_WDN;
constexpr size_t WS_W2T = WS_W1T + (size_t)DEPTH * 2 * 128 * 2048 * 2;
constexpr size_t WS_CPE = WS_W2T + (size_t)DEPTH * 2 * 64 * 128 * 2;
constexpr size_t WS_GLUT = al256(WS_CPE + (size_t)DEPTH * 2 * 128 * 4);
constexpr size_t WS_X = al256(WS_GLUT + (size_t)32 * LUTN * 4);
constexpr size_t WS_XB = WS_X + (size_t)MROWS * DM * 4;
constexpr size_t WS_SSP = WS_XB + (size_t)MROWS * DM * 2;
constexpr size_t WS_R1 = WS_SSP + (size_t)MROWS * 32 * 4;
constexpr size_t WS_PROJ = WS_R1;
constexpr size_t WS_O = WS_R1 + (size_t)MROWS * INP * 2;
constexpr size_t WS_U = WS_R1;
constexpr size_t SZ_R1 = (size_t)MROWS * UPW * 2;
static_assert((size_t)MROWS * INP * 2 + (size_t)MROWS * DM * 2 <= SZ_R1, "overlay");
constexpr size_t WS_ACT = WS_R1 + SZ_R1;
constexpr size_t WS_TOT = WS_ACT + (size_t)MROWS * DFF * 2;
constexpr size_t WS_LSE = WS_TOT + (size_t)MROWS * 768 * 4;
constexpr size_t WS_KC = WS_LSE + (size_t)MROWS * 12 * 4;
constexpr size_t WS_VC = WS_KC + (size_t)BATCH * 3 * 512 * 64 * 2;
constexpr size_t WS_KMEAN = WS_VC + (size_t)BATCH * 3 * 512 * 64 * 2;
constexpr size_t WS_END = WS_KMEAN + (size_t)BATCH * 8 * 32 * 64 * 4;

constexpr int KP = 160;
constexpr int TILE_B = 64 * KP;
constexpr int L_K0 = 0, L_V0 = TILE_B, L_K1 = 2 * TILE_B, L_V1 = 3 * TILE_B;
constexpr int L_LUT = 4 * TILE_B;
constexpr int L_IMP = L_LUT + 4 * LUTN * 4;
constexpr int L_SEL = L_IMP + 65536;
constexpr int L_TL = L_SEL + 2048;
constexpr int L_MISC = L_TL + 2048;
constexpr int L_WUN = L_MISC + 64;
constexpr int LDS_BYTES = 147456;
static_assert(L_MISC + 256 <= LDS_BYTES, "lds map");

struct Params {
    const float* x; const float* rel; const float* w_in; const float* w_out; const float* cmp_w1; const float* cmp_w2; const float* cmp_pe;
    const float* norm_attn; const float* norm_mlp; const float* w_up; const float* conv_w; const float* conv_b; const float* w_down; const float* norm_final;
    float* out; unsigned char* ws;
};

typedef float f32x2_t __attribute__((ext_vector_type(2))); typedef __bf16 bf16x2_t __attribute__((ext_vector_type(2)));
__device__ __forceinline__ unsigned cvtpk(float lo, float hi) { f32x2_t v = {lo, hi}; bf16x2_t b = __builtin_convertvector(v, bf16x2_t); return __builtin_bit_cast(unsigned, b); }
__device__ __forceinline__ float bf2f(unsigned short b) { return __uint_as_float(((unsigned)b) << 16); }
__device__ __forceinline__ float bflo(unsigned w) { return __uint_as_float(w << 16); }
__device__ __forceinline__ float bfhi(unsigned w) { return __uint_as_float(w & 0xffff0000u); }
__device__ __forceinline__ float fexp2(float x) { return __builtin_amdgcn_exp2f(x); }
__device__ __forceinline__ int lane_id_opaque() { int l_; asm volatile("v_mbcnt_lo_u32_b32 %0, -1, 0\n\tv_mbcnt_hi_u32_b32 %0, -1, %0" : "=v"(l_)); return l_; }
#define LDS_BARRIER() do { asm volatile("s_waitcnt lgkmcnt(0)" ::: "memory"); __builtin_amdgcn_s_barrier(); asm volatile("" ::: "memory"); } while (0)
__device__ __forceinline__ void lds_wait() { asm volatile("s_waitcnt lgkmcnt(0)" ::: "memory"); }
__device__ __forceinline__ s16x4 tr_read(const LAS unsigned char* p) { return __builtin_bit_cast(s16x4, __builtin_amdgcn_ds_read_tr16_b64_v4i16((LAS s16x4*)p)); }
__device__ __forceinline__ f32x4 mfma16(bf16x8 a, bf16x8 b, f32x4 c) { return __builtin_amdgcn_mfma_f32_16x16x32_bf16(a, b, c, 0, 0, 0); }

__device__ __forceinline__ int t5_bucket(int n) {
    if (n < 16) return n < 0 ? 0 : n;
    int b = 16;
    b += n >= 22; b += n >= 30; b += n >= 40; b += n >= 54; b += n >= 73; b += n >= 99; b += n >= 134; b += n >= 182;
    b += n >= 246; b += n >= 332; b += n >= 450; b += n >= 609; b += n >= 825; b += n >= 1117; b += n >= 1513;
    return b;
}
__device__ __forceinline__ bool is_qcol(int n) { return (n < 2304) ? ((n % 768) < 256) : ((n < 2816) || (n >= 3840 && n < 4608)); }

template <int MODE>
__device__ __forceinline__ void p0_item(const float* W, int K, int Nsrc, bf16_t* WT, const float* kscale, LAS float* scr, int kb, int nb, int lane) {
    const int k0 = 64 * kb, n0 = 32 * nb;
    const int nd = n0 + (lane & 31);
    int sc = nd; float cs = 1.f; bool ok = true;
    if (MODE == 0) { ok = nd < INW; if (is_qcol(nd)) cs = 0.125f; }
    if (MODE == 2) { const int pn = nd >> 8, r = nd & 255; sc = (r >= 128 ? DFF : 0) + 128 * pn + (r & 127); }
#pragma unroll 8
    for (int i = 0; i < 32; ++i) { const int kk = 2 * i + (lane >> 5); float v = 0.f;
        if (ok) { v = W[(size_t)(k0 + kk) * Nsrc + sc] * cs; if (MODE != 1) v *= kscale[k0 + kk]; }
        scr[kk * 33 + (lane & 31)] = v; }
    lds_wait();
    const int c = lane & 7;
#pragma unroll
    for (int j = 0; j < 4; ++j) { const int n = (lane >> 3) + 8 * j; const LAS float* s = scr + (8 * c) * 33 + n;
        u32x4 o; o.x = cvtpk(s[0 * 33], s[1 * 33]); o.y = cvtpk(s[2 * 33], s[3 * 33]); o.z = cvtpk(s[4 * 33], s[5 * 33]); o.w = cvtpk(s[6 * 33], s[7 * 33]);
        *(u32x4*)(WT + (size_t)(n0 + n) * K + k0 + 8 * c) = o; }
    lds_wait();
}

__device__ __forceinline__ void p0_prologue(const Params& P, LAS unsigned char* lds, int tid, int lane, int wave) {
    unsigned char* ws = P.ws;
    LAS float* scr = (LAS float*)(lds + wave * 16384);
    const int G = gridDim.x, gw = blockIdx.x * NWAVES + wave, NGW = G * NWAVES;
    constexpr int I_IN = 32 * (INP / 32), I_OUT = 32 * 64, I_UP = 32 * (UPW / 32), I_DN = (DFF / 64) * 64, I_W1 = 2 * 32 * 4, I_W2 = 2 * 2 * 2;
    constexpr int I_LAYER = I_IN + I_OUT + I_UP + I_DN + I_W1 + I_W2;
    for (int it = gw; it < DEPTH * I_LAYER; it += NGW) {
        const int l = it / I_LAYER; int r = it % I_LAYER;
        if (r < I_IN) { p0_item<0>(P.w_in + (size_t)l * DM * INW, DM, INW, (bf16_t*)(ws + WS_WIN + l * SZ_WIN), P.norm_attn + l * DM, scr, r / (INP / 32), r % (INP / 32), lane); continue; } r -= I_IN;
        if (r < I_OUT) { p0_item<1>(P.w_out + (size_t)l * DM * DM, DM, DM, (bf16_t*)(ws + WS_WOUT + l * SZ_WOUT), nullptr, scr, r / 64, r % 64, lane); continue; } r -= I_OUT;
        if (r < I_UP) { p0_item<2>(P.w_up + (size_t)l * DM * UPW, DM, UPW, (bf16_t*)(ws + WS_WUP + l * SZ_WUP), P.norm_mlp + l * DM, scr, r / (UPW / 32), r % (UPW / 32), lane); continue; } r -= I_UP;
        if (r < I_DN) { p0_item<1>(P.w_down + (size_t)l * DFF * DM, DFF, DM, (bf16_t*)(ws + WS_WDN + l * SZ_WDN), nullptr, scr, r / 64, r % 64, lane); continue; } r -= I_DN;
        if (r < I_W1) { const int i = r / 128, rr = r % 128; p0_item<1>(P.cmp_w1 + (size_t)(l * 2 + i) * 2048 * 128, 2048, 128, (bf16_t*)(ws + WS_W1T) + (size_t)(l * 2 + i) * 128 * 2048, nullptr, scr, rr / 4, rr % 4, lane); continue; } r -= I_W1;
        { const int i = r / 4, rr = r % 4; p0_item<1>(P.cmp_w2 + (size_t)(l * 2 + i) * 128 * 64, 128, 64, (bf16_t*)(ws + WS_W2T) + (size_t)(l * 2 + i) * 64 * 128, nullptr, scr, rr / 2, rr % 2, lane); }
    }
    for (int m = gw; m < MROWS; m += NGW) {
        const f32x4* xr = (const f32x4*)(P.x + (size_t)m * DM) + lane; float s = 0.f;
        u32x2* ob = (u32x2*)((bf16_t*)(ws + WS_XB) + (size_t)m * DM) + lane;
#pragma unroll
        for (int j = 0; j < 8; ++j) { const f32x4 v = xr[64 * j]; s += (v[0] * v[0] + v[1] * v[1]) + (v[2] * v[2] + v[3] * v[3]); u32x2 w; w.x = cvtpk(v[0], v[1]); w.y = cvtpk(v[2], v[3]); ob[64 * j] = w; }
#pragma unroll
        for (int o = 1; o < 64; o <<= 1) s += __shfl_xor(s, o);
        if (lane < 32) ((float*)(ws + WS_SSP))[(size_t)m * 32 + lane] = (lane == 0) ? s : 0.f;
    }
    for (int i = blockIdx.x * NTHREADS + tid; i < 32 * LUTN; i += G * NTHREADS) { const int h = i / LUTN, n = i % LUTN; ((float*)(ws + WS_GLUT))[i] = P.rel[h * 32 + t5_bucket(n)] * LOG2E; }
    if (blockIdx.x < DEPTH * 2) {
        __syncthreads();
        const int li = blockIdx.x, kp = tid >> 7, hid = tid & 127; const float* pe = P.cmp_pe + (size_t)li * 2048; const float* w1 = P.cmp_w1 + (size_t)li * 2048 * 128;
        float s = 0.f;
#pragma unroll 8
        for (int k = kp * 512; k < kp * 512 + 512; ++k) s += pe[k] * w1[(size_t)k * 128 + hid];
        LAS float* red = (LAS float*)lds; red[tid] = s; __syncthreads();
        if (tid < 128) ((float*)(ws + WS_CPE))[li * 128 + tid] = (red[tid] + red[tid + 128]) + (red[tid + 256] + red[tid + 384]);
        __syncthreads();
    }
}

struct Src { const bf16_t* kb; const bf16_t* vb; int stride; int dil; int roff; };

template <int QG, int MODE>
__device__ __forceinline__ void flash_tile(LAS unsigned char* lds, const int buf, const int k0, const int tag, const int dil, const bf16x8 (&qf)[QG][2], f32x4 (&o)[QG][4], float (&m)[QG], float (&l)[QG],
                                           const int qc, const int qcw_min, const int qcw_max, const int maxrel, const LAS unsigned* selp, const LAS unsigned* wunp,
                                           const float (&invl)[QG], LAS float* impw, const bool imp_acc, const LAS float* lut, float& carryB, const int lane) {
    const int g = lane >> 4, i16 = lane & 15;
    bool skip = (k0 > qcw_max) || (maxrel != 0x7fffffff && k0 + 63 < qcw_min - maxrel);
    if (tag >= 0) { const unsigned w = wunp[tag >> 5]; if (!((w >> (tag & 31)) & 1u)) skip = true; }
    if (MODE & 4) skip = false;
    if (!skip) {
        const LAS unsigned char* Ks = lds + (buf ? L_K1 : L_K0);
        const LAS unsigned char* Vs = lds + (buf ? L_V1 : L_V0);
        bool allowed = true;
        if (tag >= 0) { const unsigned w = selp[tag >> 5]; allowed = ((w >> (tag & 31)) & 1u) != 0u; }
        float impA[4] = {0.f, 0.f, 0.f, 0.f}, impB[4] = {0.f, 0.f, 0.f, 0.f};
        const int dl_ = qcw_min - (k0 + 63), dh_ = qcw_max - k0;
        bool uni = (k0 >= 0) && (dl_ >= 0) && (maxrel == 0x7fffffff || dh_ <= maxrel);
        if (MODE & 1) uni = uni && (t5_bucket(dl_ * dil) == t5_bucket(dh_ * dil));
        const unsigned uni_di = (unsigned)(dl_ * dil) < (unsigned)(LUTN - 1) ? (unsigned)(dl_ * dil) : (unsigned)(LUTN - 1);
#pragma unroll
        for (int qg = 0; qg < QG; ++qg) {
            bf16x8 kf[4][2];
#pragma unroll
            for (int kt = 0; kt < 4; ++kt)
#pragma unroll
                for (int ks = 0; ks < 2; ++ks) kf[kt][ks] = *(const LAS bf16x8*)(Ks + (16 * kt + i16) * KP + ks * 64 + g * 16);
            __builtin_amdgcn_sched_barrier(0);
            f32x4 s[4];
#pragma unroll
            for (int kt = 0; kt < 4; ++kt) { s[kt] = (f32x4){0.f, 0.f, 0.f, 0.f};
#pragma unroll
                for (int ks = 0; ks < 2; ++ks) s[kt] = mfma16(kf[kt][ks], qf[qg][ks], s[kt]); }
            bf16x8 vfr[4][2];
            if (!(MODE & 2)) {
#pragma unroll
                for (int dt = 0; dt < 4; ++dt)
#pragma unroll
                    for (int s2 = 0; s2 < 2; ++s2) { const LAS unsigned char* vp = Vs + (32 * s2 + 4 * g + (i16 >> 2)) * KP + (16 * dt + 4 * (i16 & 3)) * 2;
                        const s16x4 lo = tr_read(vp), hi = tr_read(vp + 16 * KP);
                        vfr[dt][s2] = (bf16x8){lo[0], lo[1], lo[2], lo[3], hi[0], hi[1], hi[2], hi[3]}; }
            }
            __builtin_amdgcn_sched_barrier(0);
            float mx = -INFINITY;
            if (uni) {
                float lb = 0.f;
                if (MODE & 1) lb = lut[qg * LUTN + uni_di];
                const float lanebias = allowed ? lb : -INFINITY;
#pragma unroll
                for (int kt = 0; kt < 4; ++kt)
#pragma unroll
                    for (int r = 0; r < 4; ++r) { const float sc = __builtin_fmaf(s[kt][r], LOG2E, lanebias); s[kt][r] = sc; mx = fmaxf(mx, sc); }
            } else {
                float bv[4][4];
#pragma unroll
                for (int kt = 0; kt < 4; ++kt)
#pragma unroll
                    for (int r = 0; r < 4; ++r) { bv[kt][r] = 0.f;
                        if (MODE & 1) { const int rel = qc - (k0 + 16 * kt + 4 * g + r); unsigned di = (unsigned)(rel * dil); di = di < (unsigned)(LUTN - 1) ? di : (unsigned)(LUTN - 1); bv[kt][r] = lut[qg * LUTN + di]; } }
                if (MODE & 1) __builtin_amdgcn_sched_barrier(0);
#pragma unroll
                for (int kt = 0; kt < 4; ++kt)
#pragma unroll
                    for (int r = 0; r < 4; ++r) { const int kc = k0 + 16 * kt + 4 * g + r; const int rel = qc - kc;
                        const bool ok = allowed && ((unsigned)rel <= (unsigned)maxrel) && (kc >= 0);
                        float sc = __builtin_fmaf(s[kt][r], LOG2E, bv[kt][r]);
                        sc = ok ? sc : -INFINITY; s[kt][r] = sc; mx = fmaxf(mx, sc); }
            }
            mx = fmaxf(mx, __shfl_xor(mx, 16)); mx = fmaxf(mx, __shfl_xor(mx, 32));
            const float mnew = fmaxf(m[qg], mx); const float alpha = fexp2(m[qg] - mnew); m[qg] = mnew;
            float rs = 0.f;
#pragma unroll
            for (int kt = 0; kt < 4; ++kt)
#pragma unroll
                for (int r = 0; r < 4; ++r) { const float p = fexp2(s[kt][r] - mnew); s[kt][r] = p; rs += p; }
            rs += __shfl_xor(rs, 16); rs += __shfl_xor(rs, 32);
            l[qg] = l[qg] * alpha + rs;
            if (MODE & 4) {
#pragma unroll
                for (int kt = 0; kt < 4; ++kt) { impA[kt] += ((s[kt][0] + s[kt][1]) + (s[kt][2] + s[kt][3])) * invl[qg]; impB[kt] += s[kt][3] * invl[qg]; }
            }
            if (!(MODE & 2)) {
#pragma unroll
                for (int dt = 0; dt < 4; ++dt) o[qg][dt] = o[qg][dt] * alpha;
                bf16x8 pf[2];
#pragma unroll
                for (int s2 = 0; s2 < 2; ++s2) { u32x4 w; w.x = cvtpk(s[2 * s2][0], s[2 * s2][1]); w.y = cvtpk(s[2 * s2][2], s[2 * s2][3]); w.z = cvtpk(s[2 * s2 + 1][0], s[2 * s2 + 1][1]); w.w = cvtpk(s[2 * s2 + 1][2], s[2 * s2 + 1][3]);
                    pf[s2] = __builtin_bit_cast(bf16x8, w); }
#pragma unroll
                for (int dt = 0; dt < 4; ++dt)
#pragma unroll
                    for (int s2 = 0; s2 < 2; ++s2) o[qg][dt] = mfma16(vfr[dt][s2], pf[s2], o[qg][dt]);
            }
            if (QG > 1) asm volatile("" ::: "memory");
        }
        if (MODE & 4) {
            const int srcl = (lane + 48) & 63;
#pragma unroll
            for (int kt = 0; kt < 4; ++kt) { const float pb = (kt == 0) ? carryB : impB[kt == 0 ? 0 : kt - 1];
                const float x0 = __shfl(pb, srcl), x1 = __shfl(impB[kt], srcl); const float add = (g == 0) ? x0 : x1;
                const int J = 4 * ((k0 >> 4) + kt) + g; const float prevv = imp_acc ? impw[i16 * 128 + J] : 0.f; impw[i16 * 128 + J] = prevv + impA[kt] + add; }
            carryB = impB[3];
        }
    }
}

template <int QG, int MODE>
__device__ __forceinline__ void flash_run(LAS unsigned char* lds, const Src S, const int ntiles, const bf16x8 (&qf)[QG][2], f32x4 (&o)[QG][4], float (&m)[QG], float (&l)[QG],
                                          const int qc, const int qcw_min, const int qcw_max, const int maxrel, const LAS unsigned* selp, const LAS unsigned* wunp,
                                          const float (&invl)[QG], LAS float* impw, const bool imp_acc, const int lutslot, const int lane, const int tid) {
    const LAS int* tl = (const LAS int*)(lds + L_TL);
    const LAS float* lut = (const LAS float*)(lds + L_LUT) + lutslot * LUTN;
    const int srow = tid >> 3, sch = tid & 7;
    u32x4 kr0 = {0, 0, 0, 0}, vr0 = {0, 0, 0, 0}, kr1 = {0, 0, 0, 0}, vr1 = {0, 0, 0, 0};
    float carryB = 0.f;
#define FL_ISSUE(i, KR, VR) do { int c_ = tl[2 * (i)] + srow; c_ = c_ < 0 ? 0 : c_; const size_t off_ = (size_t)(c_ * S.dil + S.roff) * S.stride + sch * 8; \
        KR = *(const u32x4*)(S.kb + off_); if (!(MODE & 2)) VR = *(const u32x4*)(S.vb + off_); } while (0)
#define FL_COMMIT(b, KR, VR) do { *(LAS u32x4*)(lds + ((b) ? L_K1 : L_K0) + srow * KP + sch * 16) = KR; if (!(MODE & 2)) *(LAS u32x4*)(lds + ((b) ? L_V1 : L_V0) + srow * KP + sch * 16) = VR; } while (0)
#define FL_TILE(i, b) flash_tile<QG, MODE>(lds, b, tl[2 * (i)], tl[2 * (i) + 1], S.dil, qf, o, m, l, qc, qcw_min, qcw_max, maxrel, selp, wunp, invl, impw, imp_acc, lut, carryB, lane)
    LDS_BARRIER();
    if (ntiles > 0) { FL_ISSUE(0, kr0, vr0); if (ntiles > 1) FL_ISSUE(1, kr1, vr1); FL_COMMIT(0, kr0, vr0); }
    LDS_BARRIER();
    for (int i = 0; i < ntiles; i += 2) {
        if (i + 2 < ntiles) FL_ISSUE(i + 2, kr0, vr0);
        FL_TILE(i, 0);
        if (i + 1 < ntiles) FL_COMMIT(1, kr1, vr1);
        LDS_BARRIER();
        if (i + 1 >= ntiles) break;
        if (i + 3 < ntiles) FL_ISSUE(i + 3, kr1, vr1);
        FL_TILE(i + 1, 1);
        if (i + 2 < ntiles) FL_COMMIT(0, kr0, vr0);
        LDS_BARRIER();
    }
#undef FL_ISSUE
#undef FL_COMMIT
#undef FL_TILE
}

template <int QG> __device__ __forceinline__ void flash_init(f32x4 (&o)[QG][4], float (&m)[QG], float (&l)[QG]) {
#pragma unroll
    for (int q = 0; q < QG; ++q) { m[q] = -1e30f; l[q] = 0.f;
#pragma unroll
        for (int d = 0; d < 4; ++d) o[q][d] = (f32x4){0.f, 0.f, 0.f, 0.f}; }
}
__device__ __forceinline__ void load_lut(LAS unsigned char* lds, const float* glut, int head, int slot, int tid) {
    LAS float* lut = (LAS float*)(lds + L_LUT) + slot * LUTN; const float* src = glut + (size_t)head * LUTN;
    for (int i = tid; i < LUTN; i += NTHREADS) lut[i] = src[i];
}
__device__ __forceinline__ int next_unit(unsigned* ctr, LAS unsigned char* lds, int tid) {
    LAS int* slot = (LAS int*)(lds + L_MISC);
    __syncthreads();
    if (tid == 0) *slot = (int)atomicAdd(ctr, 1u);
    __syncthreads();
    return *slot;
}

__device__ __forceinline__ void unit_mixA(const Params& P, LAS unsigned char* lds, int uid, int tid, int lane, int wave) {
    unsigned char* ws = P.ws; const bf16_t* proj = (const bf16_t*)(ws + WS_PROJ);
    const int b = uid / 768; int rem = uid % 768; const int gi = rem / 256; rem %= 256; const int hs = rem / 64, idx = rem % 64;
    const int d = gi == 0 ? 1 : (gi == 1 ? 4 : 16); const int rc = idx % d, nb = idx / d;
    const int g = lane >> 4, i16 = lane & 15;
    load_lut(lds, (const float*)(ws + WS_GLUT), gi * 4 + hs, 0, tid);
    const int ntiles = nb == 0 ? 2 : 4;
    if (tid < 4) { LAS int* tl = (LAS int*)(lds + L_TL); const int i = tid + (nb == 0 ? 2 : 0); if (i < 4) { tl[2 * tid] = nb * 128 - 128 + 64 * i; tl[2 * tid + 1] = -1; } }
    const int qi = nb * 128 + 16 * wave + i16; const int tok = qi * d + rc; const size_t row = (size_t)b * SEQ + tok;
    const int colq = A_OFF + gi * 768 + hs * 64;
    bf16x8 qf[1][2];
#pragma unroll
    for (int ks = 0; ks < 2; ++ks) qf[0][ks] = *(const bf16x8*)(proj + row * INP + colq + ks * 32 + g * 8);
    f32x4 o[1][4]; float m[1], l[1]; flash_init<1>(o, m, l);
    const float il[1] = {0.f};
    Src S{proj + (size_t)b * SEQ * INP + colq + 256, proj + (size_t)b * SEQ * INP + colq + 512, INP, d, rc};
    flash_run<1, 1>(lds, S, ntiles, qf, o, m, l, qi, nb * 128 + 16 * wave, nb * 128 + 16 * wave + 15, 128, nullptr, nullptr, il, nullptr, false, 0, lane, tid);
    const float inv = l[0] > 0.f ? 1.f / l[0] : 0.f;
    bf16_t* O = (bf16_t*)(ws + WS_O) + row * 2048 + gi * 256 + hs * 64;
#pragma unroll
    for (int dt = 0; dt < 4; ++dt) { u32x2 w; w.x = cvtpk(o[0][dt][0] * inv, o[0][dt][1] * inv); w.y = cvtpk(o[0][dt][2] * inv, o[0][dt][3] * inv); *(u32x2*)(O + 16 * dt + 4 * g) = w; }
    if (g == 0) ((float*)(ws + WS_LSE))[row * 12 + gi * 4 + hs] = (m[0] + __log2f(fmaxf(l[0], 1e-30f))) * LN2;
}

__device__ __forceinline__ void unit_moba(const Params& P, LAS unsigned char* lds, int b, int h, int c, int tid, int lane, int wave) {
    unsigned char* ws = P.ws; const bf16_t* proj = (const bf16_t*)(ws + WS_PROJ);
    const int g = lane >> 4, i16 = lane & 15;
    const int t0 = c * 128, ob = t0 >> 8;
    load_lut(lds, (const float*)(ws + WS_GLUT), 12 + h, 0, tid);
    LAS float* km = (LAS float*)(lds + L_IMP);
    { const float* src = (const float*)(ws + WS_KMEAN) + (size_t)(b * 8 + h) * 2048; for (int i = tid; i < 2048; i += NTHREADS) km[i] = src[i]; }
    LAS unsigned* misc = (LAS unsigned*)(lds + L_MISC);
    if (tid == 0) misc[1] = 0u;
    __syncthreads();
    const int tok = t0 + 16 * wave + i16; const size_t row = (size_t)b * SEQ + tok;
    const int colq = B_OFF + h * 64;
    bf16x8 qf[1][2];
#pragma unroll
    for (int ks = 0; ks < 2; ++ks) qf[0][ks] = *(const bf16x8*)(proj + row * INP + colq + ks * 32 + g * 8);
    unsigned sel = 0u;
    if (ob > 0) {
        float gt[8];
#pragma unroll
        for (int k = 0; k < 8; ++k) gt[k] = 0.f;
#pragma unroll 1
        for (int dc = 0; dc < 8; ++dc) { const u32x4 qw = *(const u32x4*)(proj + row * INP + colq + dc * 8);
            const float q0 = bflo(qw.x), q1 = bfhi(qw.x), q2 = bflo(qw.y), q3 = bfhi(qw.y), q4 = bflo(qw.z), q5 = bfhi(qw.z), q6 = bflo(qw.w), q7 = bfhi(qw.w);
#pragma unroll
            for (int k = 0; k < 8; ++k) { const LAS f32x4* kr = (const LAS f32x4*)(km + (8 * g + k) * 64 + dc * 8); const f32x4 a = kr[0], bq = kr[1];
                gt[k] += (q0 * a[0] + q1 * a[1]) + (q2 * a[2] + q3 * a[3]) + (q4 * bq[0] + q5 * bq[1]) + (q6 * bq[2] + q7 * bq[3]); } }
#pragma unroll
        for (int k = 0; k < 8; ++k) if (8 * g + k >= ob) gt[k] = -INFINITY;
#pragma unroll
        for (int it = 0; it < 3; ++it) {
            float best = -INFINITY; int bi = 99;
#pragma unroll
            for (int k = 0; k < 8; ++k) if (gt[k] > best) { best = gt[k]; bi = 8 * g + k; }
#pragma unroll
            for (int off = 16; off <= 32; off <<= 1) { const float ob_ = __shfl_xor(best, off); const int oi = __shfl_xor(bi, off); if (ob_ > best || (ob_ == best && oi < bi)) { best = ob_; bi = oi; } }
            if (bi < 32) { sel |= 1u << bi;
#pragma unroll
                for (int k = 0; k < 8; ++k) if (8 * g + k == bi) gt[k] = -INFINITY; }
        }
    }
    unsigned wu = sel;
#pragma unroll
    for (int off = 1; off < 16; off <<= 1) wu |= (unsigned)__shfl_xor((int)wu, off);
    wu = (unsigned)__builtin_amdgcn_readfirstlane((int)wu);
    LAS unsigned* selS = (LAS unsigned*)(lds + L_SEL); LAS unsigned* wunS = (LAS unsigned*)(lds + L_WUN) + wave * 4;
    if (g == 0) selS[(16 * wave + i16) * 4] = sel;
    if (lane == 0) wunS[0] = wu;
    __syncthreads();
    unsigned um = 0u;
#pragma unroll
    for (int w8 = 0; w8 < 8; ++w8) um |= ((const LAS unsigned*)(lds + L_WUN))[w8 * 4];
    if (tid == 0) { LAS int* tl = (LAS int*)(lds + L_TL); int n = 0;
        for (int blk = 0; blk < ob; ++blk) if ((um >> blk) & 1u) for (int s4 = 0; s4 < 4; ++s4) { tl[2 * n] = blk * 256 + 64 * s4; tl[2 * n + 1] = blk; ++n; }
        for (int k0 = ob * 256; k0 < t0 + 128; k0 += 64) { tl[2 * n] = k0; tl[2 * n + 1] = -1; ++n; }
        misc[2] = (unsigned)n; }
    __syncthreads();
    const int ntiles = (int)misc[2];
    f32x4 o[1][4]; float m[1], l[1]; flash_init<1>(o, m, l);
    const float il[1] = {0.f};
    Src S{proj + (size_t)b * SEQ * INP + colq + 512, proj + (size_t)b * SEQ * INP + colq + 1024, INP, 1, 0};
    flash_run<1, 1>(lds, S, ntiles, qf, o, m, l, tok, t0 + 16 * wave, t0 + 16 * wave + 15, 0x7fffffff, selS + (16 * wave + i16) * 4, wunS, il, nullptr, false, 0, lane, tid);
    const float inv = l[0] > 0.f ? 1.f / l[0] : 0.f;
    bf16_t* O = (bf16_t*)(ws + WS_O) + row * 2048 + 768 + h * 64;
#pragma unroll
    for (int dt = 0; dt < 4; ++dt) { u32x2 w; w.x = cvtpk(o[0][dt][0] * inv, o[0][dt][1] * inv); w.y = cvtpk(o[0][dt][2] * inv, o[0][dt][3] * inv); *(u32x2*)(O + 16 * dt + 4 * g) = w; }
}

__device__ __forceinline__ float sigmoidf_(float x) { return 1.f / (1.f + __expf(-x)); }
__device__ __forceinline__ void unit_nsa(const Params& P, LAS unsigned char* lds, int b, int kv, int c, int tid, int lane, int wave) {
    unsigned char* ws = P.ws; const bf16_t* proj = (const bf16_t*)(ws + WS_PROJ);
    const int g = lane >> 4, i16 = lane & 15;
    const int t0 = c * 128;
    const int tok = t0 + 16 * wave + i16; const size_t row = (size_t)b * SEQ + tok;
    for (int q = 0; q < 4; ++q) load_lut(lds, (const float*)(ws + WS_GLUT), 20 + kv * 4 + q, q, tid);
    LAS int* tl = (LAS int*)(lds + L_TL);
    LAS unsigned* misc = (LAS unsigned*)(lds + L_MISC);
    LAS unsigned* selS = (LAS unsigned*)(lds + L_SEL);
    LAS float* impw = (LAS float*)(lds + L_IMP) + wave * 2048;
    const int ntc = ((t0 + 96) >> 4) / 64 + 1;
    if (tid < ntc) { tl[2 * tid] = 64 * tid; tl[2 * tid + 1] = -1; }
    if (tid < 4) misc[4 + tid] = 0u;
    LAS unsigned* wunS = (LAS unsigned*)(lds + L_WUN) + wave * 4;
    float* tot = (float*)(ws + WS_TOT) + row * 768 + (kv * 4) * 64;
    const bf16_t* gatep = proj + row * INP + CG_OFF + (kv * 4) * 3;
    const int qcc = (tok - 31) >> 4;
    const int qcw0 = (t0 + 16 * wave - 31) >> 4, qcw1 = (t0 + 16 * wave + 15 - 31) >> 4;
#pragma unroll 1
    for (int hp = 0; hp < 2; ++hp) {
        bf16x8 qf[2][2];
#pragma unroll
        for (int q = 0; q < 2; ++q)
#pragma unroll
            for (int ks = 0; ks < 2; ++ks) qf[q][ks] = *(const bf16x8*)(proj + row * INP + CQ_OFF + (kv * 4 + hp * 2 + q) * 64 + ks * 32 + g * 8);
        f32x4 o[2][4]; float m[2], l[2]; flash_init<2>(o, m, l);
        float il[2] = {0.f, 0.f};
#ifdef NSA_CMP_FAKEKV
        Src S{proj + (size_t)b * SEQ * INP + CKV_OFF + 4 * 192 + kv * 64, proj + (size_t)b * SEQ * INP + CKV_OFF + 5 * 192 + kv * 64, INP, 1, 0};
#else
        Src S{(const bf16_t*)(ws + WS_KC) + (size_t)(b * 3 + kv) * 512 * 64, (const bf16_t*)(ws + WS_VC) + (size_t)(b * 3 + kv) * 512 * 64, 64, 1, 0};
#endif
#ifdef NSA_CMP_SINGLE
        flash_run<2, 0>(lds, S, ntc, qf, o, m, l, qcc, qcw0, qcw1, 0x7fffffff, nullptr, nullptr, il, nullptr, false, 0, lane, tid);
#pragma unroll
        for (int q = 0; q < 2; ++q) il[q] = l[q] > 0.f ? 1.f / l[q] : 0.f;
        (void)impw;
#elif !defined(NSA_NO_CMP)
        flash_run<2, 2>(lds, S, ntc, qf, o, m, l, qcc, qcw0, qcw1, 0x7fffffff, nullptr, nullptr, il, nullptr, false, 0, lane, tid);
#pragma unroll
        for (int q = 0; q < 2; ++q) { il[q] = l[q] > 0.f ? 1.f / l[q] : 0.f; l[q] = 0.f; }
        flash_run<2, 4>(lds, S, ntc, qf, o, m, l, qcc, qcw0, qcw1, 0x7fffffff, nullptr, nullptr, il, impw, hp != 0, 0, lane, tid);
#else
        (void)S; (void)impw;
#endif
#pragma unroll
        for (int q = 0; q < 2; ++q) { const float gt = sigmoidf_(bf2f(gatep[(hp * 2 + q) * 3 + 0])); const float sc = il[q] * gt;
#pragma unroll
            for (int dt = 0; dt < 4; ++dt) *(f32x4*)(tot + (hp * 2 + q) * 64 + 16 * dt + 4 * g) = o[q][dt] * sc; }
    }
#ifndef NSA_NO_TOPK
    lds_wait();
    unsigned wun0 = 0u, wun1 = 0u, wun2 = 0u, wun3 = 0u;
#pragma unroll 1
    for (int q = 0; q < 16; ++q) {
        const int t = t0 + 16 * wave + q, own = t >> 6;
        const int ncand = own - 2 > 0 ? own - 2 : 0; const int nforced = own >= 2 ? 3 : own + 1; const int K = 16 - nforced;
        const int j0 = lane, j1 = lane + 64;
        const bool c0 = (j0 >= 1) && (j0 <= own - 2), c1 = (j1 <= own - 2);
        const unsigned k0 = c0 ? (__float_as_uint(impw[q * 128 + j0]) + 1u) : 0u, k1 = c1 ? (__float_as_uint(impw[q * 128 + j1]) + 1u) : 0u;
        bool s0 = c0, s1 = c1;
        if (ncand > K) {
            unsigned T = 0u;
            for (int bit = 31; bit >= 0; --bit) { const unsigned Tn = T | (1u << bit);
                const int cnt = __popcll(__ballot(k0 >= Tn)) + __popcll(__ballot(k1 >= Tn)); if (cnt >= K) T = Tn; }
            const bool g0 = k0 > T, g1 = k1 > T; const int ng = __popcll(__ballot(g0)) + __popcll(__ballot(g1)); const int need = K - ng;
            const unsigned long long e0 = __ballot(k0 == T), e1 = __ballot(k1 == T); const unsigned long long lt = (1ull << lane) - 1ull;
            const int r0 = __popcll(e0 & lt), r1 = __popcll(e0) + __popcll(e1 & lt);
            s0 = g0 || (k0 == T && r0 < need); s1 = g1 || (k1 == T && r1 < need);
        }
        s0 = s0 || (j0 == 0) || (j0 == own) || (j0 == own - 1); s1 = s1 || (j1 == own) || (j1 == own - 1);
        const unsigned long long m0 = __ballot(s0), m1 = __ballot(s1);
        const unsigned w0 = (unsigned)m0, w1 = (unsigned)(m0 >> 32), w2 = (unsigned)m1, w3 = (unsigned)(m1 >> 32);
        if (lane == 0) { selS[(16 * wave + q) * 4 + 0] = w0; selS[(16 * wave + q) * 4 + 1] = w1; selS[(16 * wave + q) * 4 + 2] = w2; selS[(16 * wave + q) * 4 + 3] = w3; }
        wun0 |= w0; wun1 |= w1; wun2 |= w2; wun3 |= w3;
    }
    if (lane == 0) { wunS[0] = wun0; wunS[1] = wun1; wunS[2] = wun2; wunS[3] = wun3; }
    __syncthreads();
    if (tid < 4) { unsigned u_ = 0u; for (int w8 = 0; w8 < 8; ++w8) u_ |= ((const LAS unsigned*)(lds + L_WUN))[w8 * 4 + tid]; misc[4 + tid] = u_; }
    __syncthreads();
    const LAS unsigned* selp = selS + (16 * wave + i16) * 4;
    const int ownmax = (t0 + 127) >> 6;
    if (tid == 0) { int n = 0; for (int j = 0; j <= ownmax; ++j) if ((misc[4 + (j >> 5)] >> (j & 31)) & 1u) { tl[2 * n] = 64 * j; tl[2 * n + 1] = j; ++n; } misc[2] = (unsigned)n; }
    __syncthreads();
    const int nts = (int)misc[2];
#else
    const int ownmax = (t0 + 127) >> 6; const int nts = 0; const LAS unsigned* selp = nullptr; (void)selS; (void)wunS;
#endif
    const int kfirst = t0 - 512 > 0 ? t0 - 512 : 0; const int ntw = (t0 + 128 - kfirst) / 64;
#pragma unroll 1
    for (int hp = 0; hp < 2; ++hp) {
        bf16x8 qf[2][2];
#pragma unroll
        for (int q = 0; q < 2; ++q)
#pragma unroll
            for (int ks = 0; ks < 2; ++ks) qf[q][ks] = *(const bf16x8*)(proj + row * INP + CQ_OFF + (kv * 4 + hp * 2 + q) * 64 + ks * 32 + g * 8);
        f32x4 o[2][4]; float m[2], l[2];
        const float il[2] = {0.f, 0.f};
        __syncthreads();
        if (tid == 0) { int n = 0; for (int j = 0; j <= ownmax; ++j) if ((misc[4 + (j >> 5)] >> (j & 31)) & 1u) { tl[2 * n] = 64 * j; tl[2 * n + 1] = j; ++n; } }
#ifndef NSA_NO_SLC
        { flash_init<2>(o, m, l);
          Src S{proj + (size_t)b * SEQ * INP + CKV_OFF + 2 * 192 + kv * 64, proj + (size_t)b * SEQ * INP + CKV_OFF + 3 * 192 + kv * 64, INP, 1, 0};
          flash_run<2, 1>(lds, S, nts, qf, o, m, l, tok, t0 + 16 * wave, t0 + 16 * wave + 15, 0x7fffffff, selp, wunS, il, nullptr, false, hp * 2, lane, tid);
#pragma unroll
          for (int q = 0; q < 2; ++q) { const float gt = sigmoidf_(bf2f(gatep[(hp * 2 + q) * 3 + 1])); const float sc = (l[q] > 0.f ? 1.f / l[q] : 0.f) * gt;
#pragma unroll
              for (int dt = 0; dt < 4; ++dt) { float* tp = tot + (hp * 2 + q) * 64 + 16 * dt + 4 * g; *(f32x4*)tp = *(const f32x4*)tp + o[q][dt] * sc; } }
        }
#endif
        if (tid < ntw) { tl[2 * tid] = kfirst + 64 * tid; tl[2 * tid + 1] = -1; }
        { flash_init<2>(o, m, l);
          Src S{proj + (size_t)b * SEQ * INP + CKV_OFF + 4 * 192 + kv * 64, proj + (size_t)b * SEQ * INP + CKV_OFF + 5 * 192 + kv * 64, INP, 1, 0};
#ifndef NSA_NO_WIN
          flash_run<2, 1>(lds, S, ntw, qf, o, m, l, tok, t0 + 16 * wave, t0 + 16 * wave + 15, 511, nullptr, nullptr, il, nullptr, false, hp * 2, lane, tid);
#else
          (void)S;
#endif
          bf16_t* O = (bf16_t*)(ws + WS_O) + row * 2048 + 1280 + (kv * 4) * 64;
#pragma unroll
          for (int q = 0; q < 2; ++q) { const float gt = sigmoidf_(bf2f(gatep[(hp * 2 + q) * 3 + 2])); const float sc = (l[q] > 0.f ? 1.f / l[q] : 0.f) * gt;
#pragma unroll
              for (int dt = 0; dt < 4; ++dt) { const f32x4 v = *(const f32x4*)(tot + (hp * 2 + q) * 64 + 16 * dt + 4 * g) + o[q][dt] * sc;
                  u32x2 w; w.x = cvtpk(v[0], v[1]); w.y = cvtpk(v[2], v[3]); *(u32x2*)(O + (hp * 2 + q) * 64 + 16 * dt + 4 * g) = w; } }
        }
    }
}

__device__ __forceinline__ float gelu_tanh(float x) { const float u = 0.7978845608028654f * (x + 0.044715f * x * x * x); const float e = __expf(2.f * u); const float th = 1.f - 2.f / (1.f + e); return 0.5f * x * (1.f + th); }
__device__ __forceinline__ void item_compress(const Params& P, int layer, int it, int lane) {
    unsigned char* ws = P.ws; const bf16_t* proj = (const bf16_t*)(ws + WS_PROJ);
    const int nt = it & 31; int r = it >> 5; const int which = r & 1; r >>= 1; const int kv = r % 3, b = r / 3;
    const int g = lane >> 4, i16 = lane & 15;
    int n = 16 * nt + i16; const int nld = n > 510 ? 510 : n;
    const bf16_t* w1t = (const bf16_t*)(ws + WS_W1T) + (size_t)(layer * 2 + which) * 128 * 2048;
    const bf16_t* w2t = (const bf16_t*)(ws + WS_W2T) + (size_t)(layer * 2 + which) * 64 * 128;
    const float* cpe = (const float*)(ws + WS_CPE) + (layer * 2 + which) * 128;
    const bf16_t* src = proj + ((size_t)b * SEQ + 16 * nld) * INP + CKV_OFF + which * 192 + kv * 64 + 8 * g;
    f32x4 acc[8];
#pragma unroll
    for (int h = 0; h < 8; ++h) acc[h] = (f32x4){0.f, 0.f, 0.f, 0.f};
    const bf16_t* w1l = w1t + (size_t)i16 * 2048 + 8 * g;
#pragma unroll 1
    for (int ks = 0; ks < 64; ks += 2) {
        bf16x8 bq[2], af[2][8];
#pragma unroll
        for (int u = 0; u < 2; ++u) { bq[u] = *(const bf16x8*)(src + (size_t)(ks >> 1) * INP + u * 32);
#pragma unroll
            for (int h = 0; h < 8; ++h) af[u][h] = *(const bf16x8*)(w1l + (size_t)(16 * h) * 2048 + 32 * (ks + u)); }
        __builtin_amdgcn_sched_barrier(0);
#pragma unroll
        for (int u = 0; u < 2; ++u)
#pragma unroll
            for (int h = 0; h < 8; ++h) acc[h] = mfma16(af[u][h], bq[u], acc[h]);
    }
    bf16x8 pf[4];
#pragma unroll
    for (int s = 0; s < 4; ++s) { float hv[8];
#pragma unroll
        for (int r2 = 0; r2 < 4; ++r2) { hv[r2] = gelu_tanh(acc[2 * s][r2] + cpe[32 * s + 4 * g + r2]); hv[4 + r2] = gelu_tanh(acc[2 * s + 1][r2] + cpe[32 * s + 16 + 4 * g + r2]); }
        u32x4 w; w.x = cvtpk(hv[0], hv[1]); w.y = cvtpk(hv[2], hv[3]); w.z = cvtpk(hv[4], hv[5]); w.w = cvtpk(hv[6], hv[7]); pf[s] = __builtin_bit_cast(bf16x8, w); }
    bf16_t* dst = (bf16_t*)(ws + (which ? WS_VC : WS_KC)) + ((size_t)(b * 3 + kv) * 512 + n) * 64;
#pragma unroll
    for (int et = 0; et < 4; ++et) { f32x4 oc = {0.f, 0.f, 0.f, 0.f};
#pragma unroll
        for (int s = 0; s < 4; ++s) { const bf16_t* wp = w2t + (size_t)(16 * et + i16) * 128 + 32 * s + 4 * g; const u32x2 lo = *(const u32x2*)wp, hi = *(const u32x2*)(wp + 16);
            u32x4 w; w.x = lo.x; w.y = lo.y; w.z = hi.x; w.w = hi.y; oc = mfma16(__builtin_bit_cast(bf16x8, w), pf[s], oc); }
#ifdef PROBE_CLAMP
#pragma unroll
        for (int r2 = 0; r2 < 4; ++r2) oc[r2] = fminf(fmaxf(oc[r2], -100.f), 100.f);
#endif
        u32x2 w; w.x = cvtpk(oc[0], oc[1]); w.y = cvtpk(oc[2], oc[3]); *(u32x2*)(dst + 16 * et + 4 * g) = w; }
}
__device__ __forceinline__ void item_kmean(const Params& P, int it, int lane) {
    unsigned char* ws = P.ws; const bf16_t* proj = (const bf16_t*)(ws + WS_PROJ);
    const int blk = it & 31, h = (it >> 5) & 7, b = it >> 8;
    const bf16_t* src = proj + ((size_t)b * SEQ + blk * 256) * INP + B_OFF + 512 + h * 64 + lane;
    float s = 0.f;
#pragma unroll 8
    for (int r = 0; r < 256; ++r) s += bf2f(src[(size_t)r * INP]);
    ((float*)(ws + WS_KMEAN))[(size_t)it * 64 + lane] = s * (1.f / 256.f);
}
__device__ __forceinline__ void item_combineA(const Params& P, int row, int lane) {
    unsigned char* ws = P.ws; const float* lse = (const float*)(ws + WS_LSE) + (size_t)row * 12; bf16_t* O = (bf16_t*)(ws + WS_O) + (size_t)row * 2048;
#pragma unroll
    for (int k = 0; k < 3; ++k) { const int chunk = lane + 64 * k; const int col = 4 * chunk; const int gi = col >> 8, hs = (col >> 6) & 3;
        const float a0 = lse[hs], a1 = lse[4 + hs], a2 = lse[8 + hs]; const float mx = fmaxf(a0, fmaxf(a1, a2));
        const float e0 = __expf(a0 - mx), e1 = __expf(a1 - mx), e2 = __expf(a2 - mx); const float al = (gi == 0 ? e0 : (gi == 1 ? e1 : e2)) / (e0 + e1 + e2);
        const u32x2 w = *(const u32x2*)(O + col); u32x2 r; r.x = cvtpk(bflo(w.x) * al, bfhi(w.x) * al); r.y = cvtpk(bflo(w.y) * al, bfhi(w.y) * al); *(u32x2*)(O + col) = r; }
}

__device__ __forceinline__ void phase_conv(const Params& P, int layer, int tid) {
    unsigned char* ws = P.ws; const bf16_t* U = (const bf16_t*)(ws + WS_U); bf16_t* ACT = (bf16_t*)(ws + WS_ACT);
    const float* cw = P.conv_w + (size_t)layer * 3 * UPW; const float* cb = P.conv_b + (size_t)layer * UPW;
    constexpr int NCH = DFF / 8, TB = 16, NTB = MROWS / TB;
    for (int it = blockIdx.x * NTHREADS + tid; it < NCH * NTB; it += gridDim.x * NTHREADS) {
        const int ch = it % NCH, tb = it / NCH; const int c = ch * 8; const int ua = 256 * (c >> 7) + (c & 127);
        float wa[3][8], wg[3][8], ba[8], bg[8];
#pragma unroll
        for (int j = 0; j < 3; ++j)
#pragma unroll
            for (int e = 0; e < 8; ++e) { wa[j][e] = cw[(size_t)j * UPW + c + e]; wg[j][e] = cw[(size_t)j * UPW + DFF + c + e]; }
#pragma unroll
        for (int e = 0; e < 8; ++e) { ba[e] = cb[c + e]; bg[e] = cb[DFF + c + e]; }
        const int row0 = tb * TB; const bool first = (row0 % SEQ) == 0;
        float a1[8], a2[8], g1[8], g2[8];
        {
            u32x4 pa1 = {0, 0, 0, 0}, pa2 = {0, 0, 0, 0}, pg1 = {0, 0, 0, 0}, pg2 = {0, 0, 0, 0};
            if (!first) { pa1 = *(const u32x4*)(U + (size_t)(row0 - 1) * UPW + ua); pa2 = *(const u32x4*)(U + (size_t)(row0 - 2) * UPW + ua);
                          pg1 = *(const u32x4*)(U + (size_t)(row0 - 1) * UPW + ua + 128); pg2 = *(const u32x4*)(U + (size_t)(row0 - 2) * UPW + ua + 128); }
#pragma unroll
            for (int e = 0; e < 4; ++e) { a1[2 * e] = bflo(pa1[e]); a1[2 * e + 1] = bfhi(pa1[e]); a2[2 * e] = bflo(pa2[e]); a2[2 * e + 1] = bfhi(pa2[e]);
                                          g1[2 * e] = bflo(pg1[e]); g1[2 * e + 1] = bfhi(pg1[e]); g2[2 * e] = bflo(pg2[e]); g2[2 * e + 1] = bfhi(pg2[e]); }
        }
#pragma unroll 4
        for (int t = 0; t < TB; ++t) {
            const u32x4 pa = *(const u32x4*)(U + (size_t)(row0 + t) * UPW + ua), pg = *(const u32x4*)(U + (size_t)(row0 + t) * UPW + ua + 128);
            float a0[8], g0[8], r[8];
#pragma unroll
            for (int e = 0; e < 4; ++e) { a0[2 * e] = bflo(pa[e]); a0[2 * e + 1] = bfhi(pa[e]); g0[2 * e] = bflo(pg[e]); g0[2 * e + 1] = bfhi(pg[e]); }
#pragma unroll
            for (int e = 0; e < 8; ++e) { const float ya = ba[e] + wa[0][e] * a0[e] + wa[1][e] * a1[e] + wa[2][e] * a2[e]; const float yg = bg[e] + wg[0][e] * g0[e] + wg[1][e] * g1[e] + wg[2][e] * g2[e];
                r[e] = ya * yg / (1.f + __expf(-yg)); a2[e] = a1[e]; a1[e] = a0[e]; g2[e] = g1[e]; g1[e] = g0[e]; }
            u32x4 w; w.x = cvtpk(r[0], r[1]); w.y = cvtpk(r[2], r[3]); w.z = cvtpk(r[4], r[5]); w.w = cvtpk(r[6], r[7]);
            *(u32x4*)(ACT + (size_t)(row0 + t) * DFF + c) = w;
        }
    }
}

#define XB_TMO      128
#define XB_XCNT(j)  (256  + 64 * (j))
#define XB_XSUB(j)  (1280 + 64 * (j))
#define XB_XGEN(j)  (2304 + 64 * (j))
#define XB_TOP      3328
#define XB_TOPGEN   3392
#define XCD_BAR_WORDS 3456
#define XB_SPIN_CAP (1u << 27)

__device__ __forceinline__ unsigned xb_ld(unsigned* p)              { return __hip_atomic_load(p, __ATOMIC_RELAXED, __HIP_MEMORY_SCOPE_AGENT); }
__device__ __forceinline__ unsigned xb_add(unsigned* p, unsigned v) { return __hip_atomic_fetch_add(p, v, __ATOMIC_RELAXED, __HIP_MEMORY_SCOPE_AGENT); }
__device__ __forceinline__ unsigned xb_xcc_id() { return (unsigned)__builtin_amdgcn_s_getreg((3 << 11) | 20) & 0xFu; }
#define XB_SPIN(cond, bar) do { unsigned _sp = 0; while (cond) { __builtin_amdgcn_s_sleep(1); \
    if ((++_sp & 255u) == 0u) { if (xb_ld(&(bar)[XB_TMO])) break; if (_sp > XB_SPIN_CAP) { atomicAdd(&(bar)[XB_TMO], 1u); break; } } } } while (0)

struct XcdBarrier {
    unsigned* bar; unsigned x;
    volatile LAS unsigned* st;
};

__device__ __forceinline__ XcdBarrier xcd_barrier_post(unsigned* bar, volatile LAS unsigned* st) {
    XcdBarrier b; b.bar = bar; b.x = xb_xcc_id(); b.st = st;
    if (threadIdx.x == 0) (void)xb_add(&bar[XB_XCNT(b.x)], 1u);
    return b;
}
__device__ __forceinline__ void xcd_barrier_complete(unsigned* bar, unsigned x, unsigned& nloc, unsigned& nx) {
    const unsigned G = gridDim.x * gridDim.y * gridDim.z;
    unsigned sum, cnt, mine, sp = 0u;
    for (;;) {
        sum = 0u; cnt = 0u; mine = 0u;
#pragma unroll
        for (unsigned j = 0; j < 16; ++j) { const unsigned c = xb_ld(&bar[XB_XCNT(j)]); sum += c; cnt += (c > 0u) ? 1u : 0u; mine = (j == x) ? c : mine; }
        if (sum == G) break;
        __builtin_amdgcn_s_sleep(1);
        if ((++sp & 255u) == 0u) { if (xb_ld(&bar[XB_TMO])) break; if (sp > XB_SPIN_CAP) { atomicAdd(&bar[XB_TMO], 1u); break; } }
    }
    nloc = mine > 0u ? mine : 1u; nx = cnt > 0u ? cnt : 1u;
}

__device__ __forceinline__ void xcd_barrier(const XcdBarrier& b) {
    asm volatile("s_waitcnt vmcnt(0)" ::: "memory");
    __syncthreads();
    if (threadIdx.x == 0) {
        unsigned* bar = b.bar;
        __builtin_amdgcn_s_waitcnt(0);
        unsigned nloc = b.st[0], nx = b.st[1];
        if (nloc == 0u) { xcd_barrier_complete(bar, b.x, nloc, nx); b.st[0] = nloc; b.st[1] = nx; }
        const unsigned old = xb_add(&bar[XB_XSUB(b.x)], 1u);
        const unsigned gen = old / nloc;
        if (old + 1u == (gen + 1u) * nloc) {
            __builtin_amdgcn_fence(__ATOMIC_RELEASE, "agent");
            asm volatile("s_waitcnt vmcnt(0)" ::: "memory");
            const unsigned og = xb_add(&bar[XB_TOP], 1u);
            const unsigned tg = og / nx;
            if (og + 1u == (tg + 1u) * nx) xb_add(&bar[XB_TOPGEN], 1u);
            else XB_SPIN(xb_ld(&bar[XB_TOPGEN]) == tg, bar);
            __builtin_amdgcn_fence(__ATOMIC_ACQUIRE, "agent");
            xb_add(&bar[XB_XGEN(b.x)], 1u);
            asm volatile("s_waitcnt vmcnt(0)" ::: "memory");
        } else {
            XB_SPIN(xb_ld(&bar[XB_XGEN(b.x)]) == gen, bar);
            __builtin_amdgcn_fence(__ATOMIC_ACQUIRE, "agent");
            asm volatile("s_waitcnt vmcnt(0)" ::: "memory");
        }
    }
    __syncthreads();
}

__global__ void __launch_bounds__(NTHREADS) fwd_megakernel(Params P) {
    extern __shared__ __attribute__((aligned(16))) unsigned char lds_raw[];
    LAS unsigned char* lds = (LAS unsigned char*)lds_raw;
    int wave0 = __builtin_amdgcn_readfirstlane((int)threadIdx.x >> 6);
    unsigned char* ws0 = P.ws;
    volatile LAS unsigned* bst = (volatile LAS unsigned*)(lds + LDS_BYTES - 64);
    if (threadIdx.x < 2) bst[threadIdx.x] = 0u;
    __syncthreads();
    (void)xcd_barrier_post((unsigned*)(P.ws + WS_CTL) + 4096, bst);
#define GRID_BAR() do { XcdBarrier b_; b_.bar = (unsigned*)(ws0 + WS_CTL) + 4096; b_.x = xb_xcc_id(); b_.st = (volatile LAS unsigned*)(lds + LDS_BYTES - 64); xcd_barrier(b_); } while (0)
    { const int wave = wave0, lane = lane_id_opaque(), tid = wave * 64 + lane;

#ifndef SKIP_P0
    p0_prologue(P, lds, tid, lane, wave);
#endif
    }
    GRID_BAR();

#pragma unroll 1
    for (int layer = 0; layer < DEPTH; ++layer) {
        asm volatile("" : "+s"(wave0), "+s"(ws0));
        const int wave = wave0, lane = lane_id_opaque(), tid = wave * 64 + lane;
        const int G = gridDim.x, gw = blockIdx.x * NWAVES + wave, NGW = G * NWAVES;
        unsigned char* ws = ws0;
        unsigned* ctl = (unsigned*)(ws + WS_CTL);
        const float* xbase = layer == 0 ? P.x : (const float*)(ws + WS_X);
#ifdef PROBE_ZERO_O
        for (size_t i = (size_t)blockIdx.x * NTHREADS + tid; i < (size_t)MROWS * 2048 / 8; i += (size_t)G * NTHREADS) ((u32x4*)(ws + WS_O))[i] = (u32x4){0u, 0u, 0u, 0u};
#endif
        { pg8::Gemm gm{(const pg8::bf16_t*)(ws + WS_XB), (const pg8::bf16_t*)(ws + WS_WIN + layer * SZ_WIN), MROWS, INP, DM};
          pg8::StaticOrder S; S.init(MROWS, INP, G, (int)blockIdx.x);
          pg8::EpiScaleBf16 E{(pg8::bf16_t*)(ws + WS_PROJ), INP, (const float*)(ws + WS_SSP)};
          pg8::gemm_phase<pg8::EpiScaleBf16, pg8::StaticOrder, true, true>(lds, gm, S, E, wave); }
        GRID_BAR();
#ifndef SKIP_CMP
        for (int it = gw; it < 384 + 512; it += NGW) { if (it < 384) item_compress(P, layer, it, lane); else item_kmean(P, it - 384, lane); }
#endif
#ifndef SKIP_MIXA
#ifdef DUP_P2A
        for (int rep_ = 0; rep_ < 2; ++rep_)
        for (;;) { const int u = next_unit(ctl + 64 * (layer * 2 + 0 + 8 * rep_), lds, tid); if (u >= 1536) break; const int ln_ = lane_id_opaque(); unit_mixA(P, lds, u, wave * 64 + ln_, ln_, wave); }
#else
        for (;;) { const int u = next_unit(ctl + 64 * (layer * 2 + 0), lds, tid); if (u >= 1536) break; const int ln_ = lane_id_opaque(); unit_mixA(P, lds, u, wave * 64 + ln_, ln_, wave); }
#endif
#endif
        GRID_BAR();
        for (int r = gw; r < MROWS; r += NGW) item_combineA(P, r, lane);
#ifdef DUP_P2B
        for (int rep_ = 0; rep_ < 2; ++rep_)
        for (;;) { const int u = next_unit(ctl + 64 * (layer * 2 + 1 + 8 * rep_), lds, tid); if (u >= 384 + 1024) break;
#else
        for (;;) { const int u = next_unit(ctl + 64 * (layer * 2 + 1), lds, tid); if (u >= 384 + 1024) break;
#endif
            if (u < 384) {
#ifndef SKIP_NSA
                { const int ln_ = lane_id_opaque(); unit_nsa(P, lds, (u % 6) / 3, (u % 6) % 3, 63 - u / 6, wave * 64 + ln_, ln_, wave); }
#endif
            } else { const int v = u - 384;
#ifndef SKIP_MOBA
                { const int ln_ = lane_id_opaque(); unit_moba(P, lds, (v % 16) / 8, (v % 16) % 8, 63 - v / 16, wave * 64 + ln_, ln_, wave); }
#endif
            } }
        GRID_BAR();
        { pg8::Gemm gm{(const pg8::bf16_t*)(ws + WS_O), (const pg8::bf16_t*)(ws + WS_WOUT + layer * SZ_WOUT), MROWS, DM, DM};
          pg8::StaticOrder S; S.init(MROWS, DM, G, (int)blockIdx.x);
          pg8::EpiResid E{xbase, (float*)(ws + WS_X), (pg8::bf16_t*)(ws + WS_XB), (float*)(ws + WS_SSP)};
          pg8::gemm_phase<pg8::EpiResid, pg8::StaticOrder, true, true>(lds, gm, S, E, wave); }
        GRID_BAR();
        { pg8::Gemm gm{(const pg8::bf16_t*)(ws + WS_XB), (const pg8::bf16_t*)(ws + WS_WUP + layer * SZ_WUP), MROWS, UPW, DM};
          pg8::StaticOrder S; S.init(MROWS, UPW, G, (int)blockIdx.x);
          pg8::EpiScaleBf16 E{(pg8::bf16_t*)(ws + WS_U), UPW, (const float*)(ws + WS_SSP)};
#ifdef DUP_G3
          pg8::gemm_phase<pg8::EpiScaleBf16, pg8::StaticOrder, true, true>(lds, gm, S, E, wave);
#endif
          pg8::gemm_phase<pg8::EpiScaleBf16, pg8::StaticOrder, true, true>(lds, gm, S, E, wave); }
        GRID_BAR();
#ifndef SKIP_CONV
        phase_conv(P, layer, tid);
#ifdef DUP_CONV
        phase_conv(P, layer, tid);
#endif
#endif
        GRID_BAR();
        { pg8::Gemm gm{(const pg8::bf16_t*)(ws + WS_ACT), (const pg8::bf16_t*)(ws + WS_WDN + layer * SZ_WDN), MROWS, DM, DFF};
          pg8::StaticOrder S; S.init(MROWS, DM, G, (int)blockIdx.x);
          pg8::EpiResid E{(const float*)(ws + WS_X), (float*)(ws + WS_X), (pg8::bf16_t*)(ws + WS_XB), (float*)(ws + WS_SSP)};
          pg8::gemm_phase<pg8::EpiResid, pg8::StaticOrder, true, true>(lds, gm, S, E, wave); }
        GRID_BAR();
    }
    const int wave = wave0, lane = lane_id_opaque();
    const int G = gridDim.x, gw = blockIdx.x * NWAVES + wave, NGW = G * NWAVES;
    unsigned char* ws = ws0; (void)G;
    for (int mrow = gw; mrow < MROWS; mrow += NGW) {
        const f32x4* xr = (const f32x4*)((const float*)(ws + WS_X) + (size_t)mrow * DM) + lane; const f32x4* gr = (const f32x4*)P.norm_final + lane;
        f32x4 v[8]; float s = 0.f;
#pragma unroll
        for (int j = 0; j < 8; ++j) { v[j] = xr[64 * j]; s += (v[j][0] * v[j][0] + v[j][1] * v[j][1]) + (v[j][2] * v[j][2] + v[j][3] * v[j][3]); }
#pragma unroll
        for (int o = 1; o < 64; o <<= 1) s += __shfl_xor(s, o);
        const float rs = 1.0f / sqrtf(s * (1.0f / DM) + 1e-6f);
        f32x4* orow = (f32x4*)(P.out + (size_t)mrow * DM) + lane;
#pragma unroll
        for (int j = 0; j < 8; ++j) orow[64 * j] = v[j] * rs * gr[64 * j];
    }
}

extern "C" void kernel_launch(void* const* d_in, const int* in_sizes, int n_in, void* d_out, int out_size, void* d_ws, size_t ws_size, hipStream_t stream) {
    static int grid = 0;
    if (grid == 0) {
        if (n_in != 14 || ws_size < WS_END) { fprintf(stderr, "kernel_launch: unexpected n_in %d or workspace %zu < %zu\n", n_in, ws_size, (size_t)WS_END); grid = -1; return; }
        int dev = 0, cus = 0, per_cu = 0;
        hipGetDevice(&dev); hipDeviceGetAttribute(&cus, hipDeviceAttributeMultiprocessorCount, dev);
        if (hipFuncSetAttribute((const void*)fwd_megakernel, hipFuncAttributeMaxDynamicSharedMemorySize, LDS_BYTES) != hipSuccess) { fprintf(stderr, "kernel_launch: hipFuncSetAttribute failed\n"); grid = -1; return; }
        if (hipOccupancyMaxActiveBlocksPerMultiprocessor(&per_cu, (const void*)fwd_megakernel, NTHREADS, LDS_BYTES) != hipSuccess || per_cu < 1) { fprintf(stderr, "kernel_launch: occupancy query says %d\n", per_cu); per_cu = 1; }
        (void)hipGetLastError();
        grid = cus * 1;
    }
    if (grid < 0) return;
    hipMemsetAsync((char*)d_ws + WS_CTL, 0, CTL_BYTES, stream);
    Params p{};
    p.x = (const float*)d_in[0]; p.rel = (const float*)d_in[1]; p.w_in = (const float*)d_in[2]; p.w_out = (const float*)d_in[3]; p.cmp_w1 = (const float*)d_in[4]; p.cmp_w2 = (const float*)d_in[5];
    p.cmp_pe = (const float*)d_in[6]; p.norm_attn = (const float*)d_in[7]; p.norm_mlp = (const float*)d_in[8]; p.w_up = (const float*)d_in[9]; p.conv_w = (const float*)d_in[10]; p.conv_b = (const float*)d_in[11];
    p.w_down = (const float*)d_in[12]; p.norm_final = (const float*)d_in[13]; p.out = (float*)d_out; p.ws = (unsigned char*)d_ws;
    void* args[] = {&p};
    hipError_t e = hipLaunchCooperativeKernel((const void*)fwd_megakernel, dim3(grid), dim3(NTHREADS), args, LDS_BYTES, stream);
    if (e != hipSuccess) fprintf(stderr, "kernel_launch: cooperative launch failed: %s (grid %d)\n", hipGetErrorString(e), grid);
}
```

```cpp
#include <hip/hip_runtime.h>
#include <hip/hip_cooperative_groups.h>
#include <cstdio>
#include <cstdint>
namespace cg = cooperative_groups;
namespace pg8 {
#define PG8_LAS __attribute__((address_space(3)))
typedef unsigned short bf16_t;
typedef short bf16x8 __attribute__((ext_vector_type(8)));
typedef float f32x4 __attribute__((ext_vector_type(4)));
typedef unsigned u32x4 __attribute__((ext_vector_type(4)));
constexpr int BM = 256, BK = 64, HALF = 128, HTB = HALF * BK * 2  , STAGE_BYTES = 8 * HTB, NXCD = 8, WGM = 8;

__host__ __device__ __forceinline__ int lds_byte(int r, int c) { const int st = (r >> 4) * 2 + (c >> 5), rr = r & 15, cc = c & 31, ob = rr * 64 + cc * 2; return st * 1024 + (ob ^ (((ob >> 9) & 1) << 5)); }
__host__ __device__ __forceinline__ void stage_rc(int b, int& R, int& C) { const int st = b / 1024, sb = b % 1024, swz = sb ^ (((sb >> 9) & 1) << 5); R = (st >> 1) * 16 + swz / 64; C = (st & 1) * 32 + (swz % 64) / 2; }
__host__ __device__ __forceinline__ int perm32(int rho) { const int n = rho >> 4, i = rho & 15; return 8 * (i >> 2) + 4 * n + (i & 3); }

struct Unit { int pm, pn; };
struct Gemm { const bf16_t* A; const bf16_t* Bt; int M, N, K; };

struct StaticOrder {
    int nM, nN, nwg, G, c;
    __host__ __device__ void init(int M, int N, int G_, int c_) { nM = M / BM; nN = N / BM; nwg = nM * nN; G = G_; c = c_; }
    __host__ __device__ bool next(int i, Unit& u) const {
        const long L = (long)i * G + c; if (L >= nwg) return false;
        int wgid = (int)L; { const int q = nwg / NXCD, r = nwg % NXCD, xcd = wgid % NXCD, off = wgid / NXCD; wgid = (xcd < r ? xcd * (q + 1) : r * (q + 1) + (xcd - r) * q) + off; }
        const int nig = WGM * nN, gid = wgid / nig, fm = gid * WGM, gsz = (nM - fm) < WGM ? (nM - fm) : WGM;
        u.pm = fm + ((wgid % nig) % gsz); u.pn = (wgid % nig) / gsz; return true;
    }
    __device__ __forceinline__ void a_ready(const Unit&) const {}
    __device__ __forceinline__ void done(const Unit&) const {}
};
typedef float f32x2 __attribute__((ext_vector_type(2)));
typedef __bf16 bf16x2_pk __attribute__((ext_vector_type(2)));
__device__ __forceinline__ unsigned cvt_pk_bf16(float lo, float hi) { f32x2 v = {lo, hi}; bf16x2_pk b = __builtin_convertvector(v, bf16x2_pk); return __builtin_bit_cast(unsigned, b); }
__device__ __forceinline__ float row_rstd(const float* ssp, int row) {
    const f32x4* p = (const f32x4*)(ssp + (size_t)row * 32); float s = 0.f;
#pragma unroll
    for (int i = 0; i < 8; ++i) { const f32x4 v = p[i]; s += (v[0] + v[1]) + (v[2] + v[3]); }
    return 1.0f / sqrtf(s * (1.0f / 2048.0f) + 1e-6f);
}
struct EpiScaleBf16 {
    static constexpr bool PERM = true, AFTER_DRAIN = false;
    bf16_t* O; int ldc; const float* ssp;
    __device__ __forceinline__ void operator()(const f32x4 (&acc)[2][2][4][2], const Unit& u, int wr, int wc, int fr, int fq) const {
        const int lane = fq * 16 + fr;
        const int rbase = u.pm * BM + wr * 64;
        f32x4 t[2][8];
#pragma unroll
        for (int j = 0; j < 2; ++j) { const int q = 2 * lane + j; const int row = rbase + (q >> 6) * HALF + (q & 63);
            const f32x4* p = (const f32x4*)(ssp + (size_t)row * 32);
#pragma unroll
            for (int i = 0; i < 8; ++i) t[j][i] = p[i]; }
        __builtin_amdgcn_sched_barrier(0);
        float rsv[2];
#pragma unroll
        for (int j = 0; j < 2; ++j) { float sm = 0.f;
#pragma unroll
            for (int i = 0; i < 8; ++i) sm += (t[j][i][0] + t[j][i][1]) + (t[j][i][2] + t[j][i][3]);
            rsv[j] = 1.0f / sqrtf(sm * (1.0f / 2048.0f) + 1e-6f); }
        const int row0 = rbase + fr; const int col0 = u.pn * BM + wc * 32 + 8 * fq;
#pragma unroll
        for (int ai = 0; ai < 2; ++ai)
#pragma unroll
            for (int m = 0; m < 4; ++m) { const int q = ai * 64 + m * 16 + fr; const float v0 = __shfl(rsv[0], q >> 1), v1 = __shfl(rsv[1], q >> 1); const float rs = (q & 1) ? v1 : v0;
                bf16_t* rowp = O + (size_t)(row0 + ai * HALF + m * 16) * ldc + col0;
#pragma unroll
                for (int bj = 0; bj < 2; ++bj) { const f32x4 v0_ = acc[ai][bj][m][0] * rs, v1_ = acc[ai][bj][m][1] * rs; u32x4 w;
                    w.x = cvt_pk_bf16(v0_[0], v0_[1]); w.y = cvt_pk_bf16(v0_[2], v0_[3]); w.z = cvt_pk_bf16(v1_[0], v1_[1]); w.w = cvt_pk_bf16(v1_[2], v1_[3]);
                    *(u32x4*)(rowp + bj * HALF) = w; } }
    }
};
struct EpiResid {
    static constexpr bool PERM = false, AFTER_DRAIN = false;
    const float* base; float* X; bf16_t* XB; float* ssp;
    __device__ __forceinline__ void operator()(const f32x4 (&acc)[2][2][4][2], const Unit& u, int wr, int wc, int fr, int fq) const {
        typedef unsigned u32x2v __attribute__((ext_vector_type(2)));
        const int row0 = u.pm * BM + wr * 64 + fr; const int col0 = u.pn * BM + wc * 32 + 4 * fq;
#pragma unroll
        for (int ai = 0; ai < 2; ++ai) {
            f32x4 bs[4][2][2];
#pragma unroll
            for (int m = 0; m < 4; ++m)
#pragma unroll
                for (int bj = 0; bj < 2; ++bj)
#pragma unroll
                    for (int n = 0; n < 2; ++n) bs[m][bj][n] = *(const f32x4*)(base + (size_t)(row0 + ai * HALF + m * 16) * 2048 + col0 + bj * HALF + n * 16);
            __builtin_amdgcn_sched_barrier(0);
#pragma unroll
            for (int m = 0; m < 4; ++m) { const int row = row0 + ai * HALF + m * 16; const size_t off = (size_t)row * 2048 + col0; float ss = 0.f;
#pragma unroll
                for (int bj = 0; bj < 2; ++bj)
#pragma unroll
                    for (int n = 0; n < 2; ++n) { const size_t o2 = off + bj * HALF + n * 16; const f32x4 v = bs[m][bj][n] + acc[ai][bj][m][n];
                        *(f32x4*)(X + o2) = v; u32x2v w; w.x = cvt_pk_bf16(v[0], v[1]); w.y = cvt_pk_bf16(v[2], v[3]); *(u32x2v*)(XB + o2) = w;
                        ss += (v[0] * v[0] + v[1] * v[1]) + (v[2] * v[2] + v[3] * v[3]); }
                ss += __shfl_xor(ss, 16); ss += __shfl_xor(ss, 32);
                if (fq == 0) ssp[(size_t)row * 32 + u.pn * 4 + wc] = ss; }
            asm volatile("" ::: "memory");
        }
    }
};
template <class Epi, class Sched, bool ALIGN_EPI = false, bool SP2 = false>
__device__ __forceinline__ void gemm_phase(PG8_LAS unsigned char* lds, const Gemm g, const Sched& S, const Epi& E, const int wid_in) {
    int lane_; asm volatile("v_mbcnt_lo_u32_b32 %0, -1, 0\n\tv_mbcnt_hi_u32_b32 %0, -1, %0" : "=v"(lane_)); const int wid = wid_in, lane = lane_, tid = wid * 64 + lane, wr = wid >> 2, wc = wid & 3, fr = lane & 15, fq = lane >> 4;
    const int K = g.K, nt = K / BK;
    unsigned voffA[2], voffB[2];
#pragma unroll
    for (int i = 0; i < 2; ++i) { int R, C; stage_rc(tid * 16 + i * 8192, R, C); const int Rb = Epi::PERM ? ((R & ~31) + perm32(R & 31)) : R;
        voffA[i] = (unsigned)(R * K + C) * 2u; voffB[i] = (unsigned)(Rb * K + C) * 2u; }
    const size_t kstep = (size_t)(BK * 2);
    const size_t hstep = (size_t)HALF * K * 2;
    const size_t tstep = 2 * hstep;
    const unsigned ldsw = (unsigned)wid * 1024u;
    const int aoff = lds_byte(wr * 64 + fr, fq * 8), boff = lds_byte(wc * 32 + fr, fq * 8);
#define PG8_SA(b, h) (((b) * 2 + (h)) * HTB)
#define PG8_SB(b, h) ((4 + (b) * 2 + (h)) * HTB)
#define PG8_STAGE(bufoff, gbase, voff) do { _Pragma("unroll") for (int _i = 0; _i < 2; ++_i) \
        __builtin_amdgcn_global_load_lds((const unsigned*)((const char*)(gbase) + (voff)[_i]), (PG8_LAS unsigned*)(lds + (bufoff) + ldsw + _i * 8192), 16, 0, 0); } while (0)
#define PG8_LDA(dst, b, h) do { _Pragma("unroll") for (int m = 0; m < 4; ++m) _Pragma("unroll") for (int k = 0; k < 2; ++k) dst[m][k] = *(const PG8_LAS bf16x8*)(lds + PG8_SA(b, h) + aoff + m * 2048 + k * 1024); } while (0)
#define PG8_LDB(dst, b, h) do { _Pragma("unroll") for (int n = 0; n < 2; ++n) _Pragma("unroll") for (int k = 0; k < 2; ++k) dst[n][k] = *(const PG8_LAS bf16x8*)(lds + PG8_SB(b, h) + boff + n * 2048 + k * 1024); } while (0)
#define PG8_MMA(ai, bj, At, Bt) do { __builtin_amdgcn_s_setprio(1); _Pragma("unroll") for (int m = 0; m < 4; ++m) _Pragma("unroll") for (int n = 0; n < 2; ++n) _Pragma("unroll") for (int k = 0; k < 2; ++k) \
        acc[ai][bj][m][n] = __builtin_amdgcn_mfma_f32_16x16x32_bf16(Bt[n][k], At[m][k], acc[ai][bj][m][n], 0, 0, 0); __builtin_amdgcn_s_setprio(0); } while (0)
#define PG8_WAIT_V(n) asm volatile("s_waitcnt vmcnt(" #n ")" ::: "memory")
#define PG8_WAIT_L(n) asm volatile("s_waitcnt lgkmcnt(" #n ")" ::: "memory")
#define PG8_BAR __builtin_amdgcn_s_barrier()
#define PG8_SCHED __builtin_amdgcn_sched_barrier(0)
    Unit cur, nxt; int ui = 0;
    if (!S.next(0, cur)) return;
    f32x4 acc[2][2][4][2];
#pragma unroll
    for (int a = 0; a < 2; ++a)
#pragma unroll
        for (int b = 0; b < 2; ++b)
#pragma unroll
            for (int m = 0; m < 4; ++m)
#pragma unroll
                for (int n = 0; n < 2; ++n) acc[a][b][m][n] = (f32x4){0.f, 0.f, 0.f, 0.f};
    bf16x8 At[4][2], B0[2][2], B1[2][2];
    const char* cA = (const char*)g.A + (size_t)cur.pm * tstep; const char* cB = (const char*)g.Bt + (size_t)cur.pn * tstep;
    S.a_ready(cur);
    if constexpr (SP2) {
        PG8_STAGE(PG8_SB(0, 0), cB, voffB); PG8_STAGE(PG8_SB(0, 1), cB + hstep, voffB); PG8_STAGE(PG8_SA(0, 0), cA, voffA); PG8_STAGE(PG8_SA(0, 1), cA + hstep, voffA);
        if (wr == 1) PG8_BAR;
        PG8_WAIT_V(2); PG8_BAR;
        PG8_STAGE(PG8_SB(1, 0), cB + kstep, voffB); PG8_STAGE(PG8_SA(1, 0), cA + kstep, voffA); PG8_STAGE(PG8_SB(1, 1), cB + hstep + kstep, voffB);
        PG8_WAIT_V(6); PG8_BAR;
    } else {
        PG8_STAGE(PG8_SB(0, 0), cB, voffB); PG8_STAGE(PG8_SA(0, 0), cA, voffA); PG8_STAGE(PG8_SB(0, 1), cB + hstep, voffB); PG8_STAGE(PG8_SA(0, 1), cA + hstep, voffA);
        if (wr == 1) PG8_BAR;
        PG8_WAIT_V(4); PG8_BAR;
        PG8_STAGE(PG8_SB(1, 0), cB + kstep, voffB); PG8_STAGE(PG8_SA(1, 0), cA + kstep, voffA); PG8_STAGE(PG8_SB(1, 1), cB + hstep + kstep, voffB);
        PG8_WAIT_V(6); PG8_BAR;
    }
    for (;;) {
        const bool has_next = S.next(ui + 1, nxt);
        const char* nA = has_next ? (const char*)g.A + (size_t)nxt.pm * tstep : cA; const char* nB = has_next ? (const char*)g.Bt + (size_t)nxt.pn * tstep : cB;
        for (int t = 0; t < nt; t += 2) {
            const bool last = (t == nt - 2);
            const char* a1 = cA + (size_t)(t + 1) * kstep;
            const char* a2 = last ? nA : cA + (size_t)(t + 2) * kstep; const char* b2 = last ? nB : cB + (size_t)(t + 2) * kstep;
            const char* a3 = a2 + kstep; const char* b3 = b2 + kstep;
            if (last && has_next) S.a_ready(nxt);
            if constexpr (SP2) {
            PG8_LDB(B0, 0, 0); PG8_LDB(B1, 0, 1); PG8_SCHED; PG8_LDA(At, 0, 0); PG8_STAGE(PG8_SA(1, 1), a1 + hstep, voffA);
            PG8_WAIT_V(8); PG8_WAIT_L(0); PG8_BAR; PG8_MMA(0, 0, At, B0); PG8_MMA(0, 1, At, B1); PG8_BAR; PG8_SCHED;
            PG8_LDA(At, 0, 1); PG8_STAGE(PG8_SB(0, 0), b2, voffB); PG8_STAGE(PG8_SB(0, 1), b2 + hstep, voffB); PG8_STAGE(PG8_SA(0, 0), a2, voffA);
            PG8_WAIT_V(8); PG8_WAIT_L(0); PG8_BAR; PG8_MMA(1, 0, At, B0); PG8_MMA(1, 1, At, B1); PG8_BAR; PG8_SCHED;
            PG8_LDB(B0, 1, 0); PG8_LDB(B1, 1, 1); PG8_SCHED; PG8_LDA(At, 1, 0); PG8_STAGE(PG8_SA(0, 1), a2 + hstep, voffA);
            PG8_WAIT_V(8); PG8_WAIT_L(0); PG8_BAR; PG8_MMA(0, 0, At, B0); PG8_MMA(0, 1, At, B1); PG8_BAR; PG8_SCHED;
            PG8_LDA(At, 1, 1); PG8_STAGE(PG8_SB(1, 0), b3, voffB); PG8_STAGE(PG8_SB(1, 1), b3 + hstep, voffB); PG8_STAGE(PG8_SA(1, 0), a3, voffA);
            PG8_WAIT_V(8); PG8_WAIT_L(0); PG8_BAR; PG8_MMA(1, 0, At, B0); PG8_MMA(1, 1, At, B1); PG8_BAR; PG8_SCHED;
            } else {
            PG8_LDB(B0, 0, 0); PG8_SCHED; PG8_LDA(At, 0, 0); PG8_STAGE(PG8_SA(1, 1), a1 + hstep, voffA);
            PG8_WAIT_L(8); PG8_BAR; PG8_WAIT_L(0); PG8_MMA(0, 0, At, B0); PG8_BAR; PG8_SCHED;
            PG8_LDB(B1, 0, 1); PG8_STAGE(PG8_SB(0, 0), b2, voffB);
            PG8_BAR; PG8_WAIT_L(0); PG8_MMA(0, 1, At, B1); PG8_BAR;
            PG8_LDA(At, 0, 1); PG8_STAGE(PG8_SA(0, 0), a2, voffA);
            PG8_BAR; PG8_WAIT_L(0); PG8_MMA(1, 0, At, B0); PG8_BAR; PG8_SCHED;
            PG8_STAGE(PG8_SB(0, 1), b2 + hstep, voffB);
            PG8_WAIT_V(6); PG8_BAR; PG8_MMA(1, 1, At, B1); PG8_BAR;
            PG8_LDB(B0, 1, 0); PG8_SCHED; PG8_LDA(At, 1, 0); PG8_STAGE(PG8_SA(0, 1), a2 + hstep, voffA);
            PG8_WAIT_L(8); PG8_BAR; PG8_WAIT_L(0); PG8_MMA(0, 0, At, B0); PG8_BAR; PG8_SCHED;
            PG8_LDB(B1, 1, 1); PG8_STAGE(PG8_SB(1, 0), b3, voffB);
            PG8_BAR; PG8_WAIT_L(0); PG8_MMA(0, 1, At, B1); PG8_BAR;
            PG8_LDA(At, 1, 1); PG8_STAGE(PG8_SA(1, 0), a3, voffA);
            PG8_BAR; PG8_WAIT_L(0); PG8_MMA(1, 0, At, B0); PG8_BAR; PG8_SCHED;
            PG8_STAGE(PG8_SB(1, 1), b3 + hstep, voffB);
            PG8_WAIT_V(6); PG8_BAR; PG8_MMA(1, 1, At, B1); PG8_BAR;
            }
        }
        if constexpr (ALIGN_EPI) { if (wr == 0) PG8_BAR; }
        if constexpr (!Epi::AFTER_DRAIN) { E(acc, cur, wr, wc, fr, fq); S.done(cur); }
        if (!has_next) break;
#pragma unroll
        for (int a = 0; a < 2; ++a)
#pragma unroll
            for (int b = 0; b < 2; ++b)
#pragma unroll
                for (int m = 0; m < 4; ++m)
#pragma unroll
                    for (int n = 0; n < 2; ++n) acc[a][b][m][n] = (f32x4){0.f, 0.f, 0.f, 0.f};
        cur = nxt; cA = nA; cB = nB; ++ui;
        if constexpr (ALIGN_EPI) { if (wr == 1) PG8_BAR; }
    }
    PG8_WAIT_V(0);
    if constexpr (!ALIGN_EPI) { if (wr == 0) PG8_BAR; }
    PG8_BAR;
    if constexpr (Epi::AFTER_DRAIN) { E.fused(acc, cur, wr, wc, fr, fq, lds, wid, lane); S.done(cur); }
#undef PG8_SA
#undef PG8_SB
#undef PG8_STAGE
#undef PG8_LDA
#undef PG8_LDB
#undef PG8_MMA
#undef PG8_WAIT_V
#undef PG8_WAIT_L
#undef PG8_BAR
#undef PG8_SCHED
}
}

#define GAS __attribute__((address_space(1)))
#define LAS __attribute__((address_space(3)))
typedef unsigned short bf16_t;
typedef short bf16x8 __attribute__((ext_vector_type(8)));
typedef float f32x4 __attribute__((ext_vector_type(4)));
typedef unsigned u32x4 __attribute__((ext_vector_type(4)));
typedef unsigned u32x2 __attribute__((ext_vector_type(2)));
typedef short s16x4 __attribute__((ext_vector_type(4)));

constexpr int BATCH = 2, SEQ = 8192, DM = 2048, DEPTH = 4, MROWS = BATCH * SEQ;
constexpr int INW = 5796, INP = 5888, DFF = 5632, UPW = 2 * DFF;
constexpr int A_OFF = 0, B_OFF = 2304, CQ_OFF = 3840, CKV_OFF = 4608, CG_OFF = 5760;
constexpr int LUTN = 1536;
constexpr float LOG2E = 1.4426950408889634f, LN2 = 0.6931471805599453f;
constexpr int NTHREADS = 512, NWAVES = 8;

constexpr size_t al256(size_t x) { return (x + 255) & ~(size_t)255; }
constexpr size_t WS_CTL = 0, CTL_BYTES = 1u << 20;
constexpr size_t SZ_WIN = (size_t)INP * DM * 2, SZ_WOUT = (size_t)DM * DM * 2, SZ_WUP = (size_t)UPW * DM * 2, SZ_WDN = (size_t)DM * DFF * 2;
constexpr size_t WS_WIN = CTL_BYTES;
constexpr size_t WS_WOUT = WS_WIN + DEPTH * SZ_WIN;
constexpr size_t WS_WUP = WS_WOUT + DEPTH * SZ_WOUT;
constexpr size_t WS_WDN = WS_WUP + DEPTH * SZ_WUP;
constexpr size_t WS_W1T = WS_WDN + DEPTH * SZ_WDN;
constexpr size_t WS_W2T = WS_W1T + (size_t)DEPTH * 2 * 128 * 2048 * 2;
constexpr size_t WS_CPE = WS_W2T + (size_t)DEPTH * 2 * 64 * 128 * 2;
constexpr size_t WS_GLUT = al256(WS_CPE + (size_t)DEPTH * 2 * 128 * 4);
constexpr size_t WS_X = al256(WS_GLUT + (size_t)32 * LUTN * 4);
constexpr size_t WS_XB = WS_X + (size_t)MROWS * DM * 4;
constexpr size_t WS_SSP = WS_XB + (size_t)MROWS * DM * 2;
constexpr size_t WS_R1 = WS_SSP + (size_t)MROWS * 32 * 4;
constexpr size_t WS_PROJ = WS_R1;
constexpr size_t WS_O = WS_R1 + (size_t)MROWS * INP * 2;
constexpr size_t WS_U = WS_R1;
constexpr size_t SZ_R1 = (size_t)MROWS * UPW * 2;
static_assert((size_t)MROWS * INP * 2 + (size_t)MROWS * DM * 2 <= SZ_R1, "overlay");
constexpr size_t WS_ACT = WS_R1 + SZ_R1;
constexpr size_t WS_TOT = WS_ACT + (size_t)MROWS * DFF * 2;
constexpr size_t WS_LSE = WS_TOT + (size_t)MROWS * 768 * 4;
constexpr size_t WS_KC = WS_LSE + (size_t)MROWS * 12 * 4;
constexpr size_t WS_VC = WS_KC + (size_t)BATCH * 3 * 512 * 64 * 2;
constexpr size_t WS_KMEAN = WS_VC + (size_t)BATCH * 3 * 512 * 64 * 2;
constexpr size_t WS_END = WS_KMEAN + (size_t)BATCH * 8 * 32 * 64 * 4;

constexpr int KP = 160;
constexpr int TILE_B = 64 * KP;
constexpr int L_K0 = 0, L_V0 = TILE_B, L_K1 = 2 * TILE_B, L_V1 = 3 * TILE_B;
constexpr int L_LUT = 4 * TILE_B;
constexpr int L_IMP = L_LUT + 4 * LUTN * 4;
constexpr int L_SEL = L_IMP + 65536;
constexpr int L_TL = L_SEL + 2048;
constexpr int L_MISC = L_TL + 2048;
constexpr int L_WUN = L_MISC + 64;
constexpr int LDS_BYTES = 147456;
static_assert(L_MISC + 256 <= LDS_BYTES, "lds map");

struct Params {
    const float* x; const float* rel; const float* w_in; const float* w_out; const float* cmp_w1; const float* cmp_w2; const float* cmp_pe;
    const float* norm_attn; const float* norm_mlp; const float* w_up; const float* conv_w; const float* conv_b; const float* w_down; const float* norm_final;
    float* out; unsigned char* ws;
};

typedef float f32x2_t __attribute__((ext_vector_type(2))); typedef __bf16 bf16x2_t __attribute__((ext_vector_type(2)));
__device__ __forceinline__ unsigned cvtpk(float lo, float hi) { f32x2_t v = {lo, hi}; bf16x2_t b = __builtin_convertvector(v, bf16x2_t); return __builtin_bit_cast(unsigned, b); }
__device__ __forceinline__ float bf2f(unsigned short b) { return __uint_as_float(((unsigned)b) << 16); }
__device__ __forceinline__ float bflo(unsigned w) { return __uint_as_float(w << 16); }
__device__ __forceinline__ float bfhi(unsigned w) { return __uint_as_float(w & 0xffff0000u); }
__device__ __forceinline__ float fexp2(float x) { return __builtin_amdgcn_exp2f(x); }
__device__ __forceinline__ int lane_id_opaque() { int l_; asm volatile("v_mbcnt_lo_u32_b32 %0, -1, 0\n\tv_mbcnt_hi_u32_b32 %0, -1, %0" : "=v"(l_)); return l_; }
#define LDS_BARRIER() do { asm volatile("s_waitcnt lgkmcnt(0)" ::: "memory"); __builtin_amdgcn_s_barrier(); asm volatile("" ::: "memory"); } while (0)
__device__ __forceinline__ void lds_wait() { asm volatile("s_waitcnt lgkmcnt(0)" ::: "memory"); }
__device__ __forceinline__ s16x4 tr_read(const LAS unsigned char* p) { return __builtin_bit_cast(s16x4, __builtin_amdgcn_ds_read_tr16_b64_v4i16((LAS s16x4*)p)); }
__device__ __forceinline__ f32x4 mfma16(bf16x8 a, bf16x8 b, f32x4 c) { return __builtin_amdgcn_mfma_f32_16x16x32_bf16(a, b, c, 0, 0, 0); }

__device__ __forceinline__ int t5_bucket(int n) {
    if (n < 16) return n < 0 ? 0 : n;
    int b = 16;
    b += n >= 22; b += n >= 30; b += n >= 40; b += n >= 54; b += n >= 73; b += n >= 99; b += n >= 134; b += n >= 182;
    b += n >= 246; b += n >= 332; b += n >= 450; b += n >= 609; b += n >= 825; b += n >= 1117; b += n >= 1513;
    return b;
}
__device__ __forceinline__ bool is_qcol(int n) { return (n < 2304) ? ((n % 768) < 256) : ((n < 2816) || (n >= 3840 && n < 4608)); }

template <int MODE>
__device__ __forceinline__ void p0_item(const float* W, int K, int Nsrc, bf16_t* WT, const float* kscale, LAS float* scr, int kb, int nb, int lane) {
    const int k0 = 64 * kb, n0 = 32 * nb;
    const int nd = n0 + (lane & 31);
    int sc = nd; float cs = 1.f; bool ok = true;
    if (MODE == 0) { ok = nd < INW; if (is_qcol(nd)) cs = 0.125f; }
    if (MODE == 2) { const int pn = nd >> 8, r = nd & 255; sc = (r >= 128 ? DFF : 0) + 128 * pn + (r & 127); }
    float wv[32], kv_[32];
    const float* wp_ = W + (size_t)(k0 + (lane >> 5)) * Nsrc + (ok ? sc : 0);
#pragma unroll
    for (int i = 0; i < 32; ++i) { wv[i] = wp_[(size_t)(2 * i) * Nsrc]; kv_[i] = (MODE != 1) ? kscale[k0 + 2 * i + (lane >> 5)] : 1.f; }
    __builtin_amdgcn_sched_barrier(0);
#pragma unroll
    for (int i = 0; i < 32; ++i) { const int kk = 2 * i + (lane >> 5); scr[kk * 33 + (lane & 31)] = ok ? wv[i] * cs * kv_[i] : 0.f; }
    lds_wait();
    const int c = lane & 7;
#pragma unroll
    for (int j = 0; j < 4; ++j) { const int n = (lane >> 3) + 8 * j; const LAS float* s = scr + (8 * c) * 33 + n;
        u32x4 o; o.x = cvtpk(s[0 * 33], s[1 * 33]); o.y = cvtpk(s[2 * 33], s[3 * 33]); o.z = cvtpk(s[4 * 33], s[5 * 33]); o.w = cvtpk(s[6 * 33], s[7 * 33]);
        *(u32x4*)(WT + (size_t)(n0 + n) * K + k0 + 8 * c) = o; }
    lds_wait();
}

__device__ __forceinline__ void p0_prologue(const Params& P, LAS unsigned char* lds, int tid, int lane, int wave) {
    unsigned char* ws = P.ws;
    LAS float* scr = (LAS float*)(lds + wave * 16384);
    const int G = gridDim.x, gw = blockIdx.x * NWAVES + wave, NGW = G * NWAVES;
    constexpr int I_IN = 32 * (INP / 32), I_OUT = 32 * 64, I_UP = 32 * (UPW / 32), I_DN = (DFF / 64) * 64, I_W1 = 2 * 32 * 4, I_W2 = 2 * 2 * 2;
    constexpr int I_LAYER = I_IN + I_OUT + I_UP + I_DN + I_W1 + I_W2;
    for (int it = gw; it < DEPTH * I_LAYER; it += NGW) {
        const int l = it / I_LAYER; int r = it % I_LAYER;
        if (r < I_IN) { p0_item<0>(P.w_in + (size_t)l * DM * INW, DM, INW, (bf16_t*)(ws + WS_WIN + l * SZ_WIN), P.norm_attn + l * DM, scr, r / (INP / 32), r % (INP / 32), lane); continue; } r -= I_IN;
        if (r < I_OUT) { p0_item<1>(P.w_out + (size_t)l * DM * DM, DM, DM, (bf16_t*)(ws + WS_WOUT + l * SZ_WOUT), nullptr, scr, r / 64, r % 64, lane); continue; } r -= I_OUT;
        if (r < I_UP) { p0_item<2>(P.w_up + (size_t)l * DM * UPW, DM, UPW, (bf16_t*)(ws + WS_WUP + l * SZ_WUP), P.norm_mlp + l * DM, scr, r / (UPW / 32), r % (UPW / 32), lane); continue; } r -= I_UP;
        if (r < I_DN) { p0_item<1>(P.w_down + (size_t)l * DFF * DM, DFF, DM, (bf16_t*)(ws + WS_WDN + l * SZ_WDN), nullptr, scr, r / 64, r % 64, lane); continue; } r -= I_DN;
        if (r < I_W1) { const int i = r / 128, rr = r % 128; p0_item<1>(P.cmp_w1 + (size_t)(l * 2 + i) * 2048 * 128, 2048, 128, (bf16_t*)(ws + WS_W1T) + (size_t)(l * 2 + i) * 128 * 2048, nullptr, scr, rr / 4, rr % 4, lane); continue; } r -= I_W1;
        { const int i = r / 4, rr = r % 4; p0_item<1>(P.cmp_w2 + (size_t)(l * 2 + i) * 128 * 64, 128, 64, (bf16_t*)(ws + WS_W2T) + (size_t)(l * 2 + i) * 64 * 128, nullptr, scr, rr / 2, rr % 2, lane); }
    }
    for (int m = gw; m < MROWS; m += NGW) {
        const f32x4* xr = (const f32x4*)(P.x + (size_t)m * DM) + lane; float s = 0.f;
        u32x2* ob = (u32x2*)((bf16_t*)(ws + WS_XB) + (size_t)m * DM) + lane;
#pragma unroll
        for (int j = 0; j < 8; ++j) { const f32x4 v = xr[64 * j]; s += (v[0] * v[0] + v[1] * v[1]) + (v[2] * v[2] + v[3] * v[3]); u32x2 w; w.x = cvtpk(v[0], v[1]); w.y = cvtpk(v[2], v[3]); ob[64 * j] = w; }
#pragma unroll
        for (int o = 1; o < 64; o <<= 1) s += __shfl_xor(s, o);
        if (lane < 32) ((float*)(ws + WS_SSP))[(size_t)m * 32 + lane] = (lane == 0) ? s : 0.f;
    }
    for (int i = blockIdx.x * NTHREADS + tid; i < 32 * LUTN; i += G * NTHREADS) { const int h = i / LUTN, n = i % LUTN; ((float*)(ws + WS_GLUT))[i] = P.rel[h * 32 + t5_bucket(n)] * LOG2E; }
    if (blockIdx.x < DEPTH * 2) {
        __syncthreads();
        const int li = blockIdx.x, kp = tid >> 7, hid = tid & 127; const float* pe = P.cmp_pe + (size_t)li * 2048; const float* w1 = P.cmp_w1 + (size_t)li * 2048 * 128;
        float s = 0.f;
#pragma unroll 8
        for (int k = kp * 512; k < kp * 512 + 512; ++k) s += pe[k] * w1[(size_t)k * 128 + hid];
        LAS float* red = (LAS float*)lds; red[tid] = s; __syncthreads();
        if (tid < 128) ((float*)(ws + WS_CPE))[li * 128 + tid] = (red[tid] + red[tid + 128]) + (red[tid + 256] + red[tid + 384]);
        __syncthreads();
    }
}

struct Src { const bf16_t* kb; const bf16_t* vb; int stride; int dil; int roff; };

template <int QG, int MODE>
__device__ __forceinline__ void flash_tile(LAS unsigned char* lds, const int buf, const int k0, const int tag, const int dil, const bf16x8 (&qf)[QG][2], f32x4 (&o)[QG][4], float (&m)[QG], float (&l)[QG],
                                           const int qc, const int qcw_min, const int qcw_max, const int maxrel, const LAS unsigned* selp, const LAS unsigned* wunp,
                                           const float (&invl)[QG], LAS float* impw, const bool imp_acc, const LAS float* lut, float& carryB, const int lane) {
    const int g = lane >> 4, i16 = lane & 15;
    bool skip = (k0 > qcw_max) || (maxrel != 0x7fffffff && k0 + 63 < qcw_min - maxrel);
    if (tag >= 0) { const unsigned w = (unsigned)__builtin_amdgcn_readfirstlane((int)wunp[tag >> 5]); if (!((w >> (tag & 31)) & 1u)) skip = true; }
    if (MODE & 4) skip = false;
    if (!skip) {
        const LAS unsigned char* Ks = lds + (buf ? L_K1 : L_K0);
        const LAS unsigned char* Vs = lds + (buf ? L_V1 : L_V0);
        bool allowed = true;
        if (tag >= 0) { const unsigned w = selp[tag >> 5]; allowed = ((w >> (tag & 31)) & 1u) != 0u; }
        float impA[4] = {0.f, 0.f, 0.f, 0.f}, impB[4] = {0.f, 0.f, 0.f, 0.f};
        const int dl_ = qcw_min - (k0 + 63), dh_ = qcw_max - k0;
        bool uni = (k0 >= 0) && (dl_ >= 0) && (maxrel == 0x7fffffff || dh_ <= maxrel);
        if (MODE & 1) uni = uni && (dl_ * dil >= 1513);
        const unsigned uni_di = (unsigned)(dl_ * dil) < (unsigned)(LUTN - 1) ? (unsigned)(dl_ * dil) : (unsigned)(LUTN - 1);
#pragma unroll
        for (int qg = 0; qg < QG; ++qg) {
            bf16x8 kf[4][2];
#pragma unroll
            for (int kt = 0; kt < 4; ++kt)
#pragma unroll
                for (int ks = 0; ks < 2; ++ks) kf[kt][ks] = *(const LAS bf16x8*)(Ks + (16 * kt + i16) * KP + ks * 64 + g * 16);
            __builtin_amdgcn_sched_barrier(0);
            f32x4 s[4];
#pragma unroll
            for (int kt = 0; kt < 4; ++kt) { s[kt] = (f32x4){0.f, 0.f, 0.f, 0.f};
#pragma unroll
                for (int ks = 0; ks < 2; ++ks) s[kt] = mfma16(kf[kt][ks], qf[qg][ks], s[kt]); }
            bf16x8 vfr[4][2];
            if (!(MODE & 2)) {
#pragma unroll
                for (int dt = 0; dt < 4; ++dt)
#pragma unroll
                    for (int s2 = 0; s2 < 2; ++s2) { const LAS unsigned char* vp = Vs + (32 * s2 + 4 * g + (i16 >> 2)) * KP + (16 * dt + 4 * (i16 & 3)) * 2;
                        const s16x4 lo = tr_read(vp), hi = tr_read(vp + 16 * KP);
                        vfr[dt][s2] = (bf16x8){lo[0], lo[1], lo[2], lo[3], hi[0], hi[1], hi[2], hi[3]}; }
            }
            __builtin_amdgcn_sched_barrier(0);
            float mx = -INFINITY;
            if (uni) {
                float lb = 0.f;
                if (MODE & 1) lb = lut[qg * LUTN + uni_di];
                const float lanebias = allowed ? lb : -INFINITY;
#pragma unroll
                for (int kt = 0; kt < 4; ++kt)
#pragma unroll
                    for (int r = 0; r < 4; ++r) { const float sc = __builtin_fmaf(s[kt][r], LOG2E, lanebias); s[kt][r] = sc; mx = fmaxf(mx, sc); }
            } else {
                float bv[4][4];
#pragma unroll
                for (int kt = 0; kt < 4; ++kt)
#pragma unroll
                    for (int r = 0; r < 4; ++r) { bv[kt][r] = 0.f;
                        if (MODE & 1) { const int rel = qc - (k0 + 16 * kt + 4 * g + r); unsigned di = (unsigned)(rel * dil); di = di < (unsigned)(LUTN - 1) ? di : (unsigned)(LUTN - 1); bv[kt][r] = lut[qg * LUTN + di]; } }
                if (MODE & 1) __builtin_amdgcn_sched_barrier(0);
#pragma unroll
                for (int kt = 0; kt < 4; ++kt)
#pragma unroll
                    for (int r = 0; r < 4; ++r) { const int kc = k0 + 16 * kt + 4 * g + r; const int rel = qc - kc;
                        const bool ok = allowed && ((unsigned)rel <= (unsigned)maxrel) && (kc >= 0);
                        float sc = __builtin_fmaf(s[kt][r], LOG2E, bv[kt][r]);
                        sc = ok ? sc : -INFINITY; s[kt][r] = sc; mx = fmaxf(mx, sc); }
            }
            mx = fmaxf(mx, __shfl_xor(mx, 16)); mx = fmaxf(mx, __shfl_xor(mx, 32));
            const float mnew = fmaxf(m[qg], mx); const float alpha = fexp2(m[qg] - mnew); m[qg] = mnew;
            float rs = 0.f;
#pragma unroll
            for (int kt = 0; kt < 4; ++kt)
#pragma unroll
                for (int r = 0; r < 4; ++r) { const float p = fexp2(s[kt][r] - mnew); s[kt][r] = p; rs += p; }
            rs += __shfl_xor(rs, 16); rs += __shfl_xor(rs, 32);
            l[qg] = l[qg] * alpha + rs;
            if (MODE & 4) {
#pragma unroll
                for (int kt = 0; kt < 4; ++kt) { impA[kt] += ((s[kt][0] + s[kt][1]) + (s[kt][2] + s[kt][3])) * invl[qg]; impB[kt] += s[kt][3] * invl[qg]; }
            }
            if (!(MODE & 2)) {
#pragma unroll
                for (int dt = 0; dt < 4; ++dt) o[qg][dt] = o[qg][dt] * alpha;
                bf16x8 pf[2];
#pragma unroll
                for (int s2 = 0; s2 < 2; ++s2) { u32x4 w; w.x = cvtpk(s[2 * s2][0], s[2 * s2][1]); w.y = cvtpk(s[2 * s2][2], s[2 * s2][3]); w.z = cvtpk(s[2 * s2 + 1][0], s[2 * s2 + 1][1]); w.w = cvtpk(s[2 * s2 + 1][2], s[2 * s2 + 1][3]);
                    pf[s2] = __builtin_bit_cast(bf16x8, w); }
#pragma unroll
                for (int dt = 0; dt < 4; ++dt)
#pragma unroll
                    for (int s2 = 0; s2 < 2; ++s2) o[qg][dt] = mfma16(vfr[dt][s2], pf[s2], o[qg][dt]);
            }
            if (QG > 1) asm volatile("" ::: "memory");
        }
        if (MODE & 4) {
            const int srcl = (lane + 48) & 63;
#pragma unroll
            for (int kt = 0; kt < 4; ++kt) { const float pb = (kt == 0) ? carryB : impB[kt == 0 ? 0 : kt - 1];
                const float x0 = __shfl(pb, srcl), x1 = __shfl(impB[kt], srcl); const float add = (g == 0) ? x0 : x1;
                const int J = 4 * ((k0 >> 4) + kt) + g; const float prevv = imp_acc ? impw[i16 * 128 + J] : 0.f; impw[i16 * 128 + J] = prevv + impA[kt] + add; }
            carryB = impB[3];
        }
    }
}

template <int QG, int MODE>
__device__ __forceinline__ void flash_run(LAS unsigned char* lds, const Src S, const int ntiles, const bf16x8 (&qf)[QG][2], f32x4 (&o)[QG][4], float (&m)[QG], float (&l)[QG],
                                          const int qc, const int qcw_min, const int qcw_max, const int maxrel, const LAS unsigned* selp, const LAS unsigned* wunp,
                                          const float (&invl)[QG], LAS float* impw, const bool imp_acc, const int lutslot, const int lane, const int tid) {
    const LAS int* tl = (const LAS int*)(lds + L_TL);
    const LAS float* lut = (const LAS float*)(lds + L_LUT) + lutslot * LUTN;
    const int srow = tid >> 3, sch = tid & 7;
    u32x4 kr0 = {0, 0, 0, 0}, vr0 = {0, 0, 0, 0}, kr1 = {0, 0, 0, 0}, vr1 = {0, 0, 0, 0};
    float carryB = 0.f;
#define FL_ISSUE(i, KR, VR) do { int c_ = __builtin_amdgcn_readfirstlane(tl[2 * (i)]) + srow; c_ = c_ < 0 ? 0 : c_; const size_t off_ = (size_t)(c_ * S.dil + S.roff) * S.stride + sch * 8; \
        KR = *(const u32x4*)(S.kb + off_); if (!(MODE & 2)) VR = *(const u32x4*)(S.vb + off_); } while (0)
#define FL_COMMIT(b, KR, VR) do { *(LAS u32x4*)(lds + ((b) ? L_K1 : L_K0) + srow * KP + sch * 16) = KR; if (!(MODE & 2)) *(LAS u32x4*)(lds + ((b) ? L_V1 : L_V0) + srow * KP + sch * 16) = VR; } while (0)
#define FL_TILE(i, b) flash_tile<QG, MODE>(lds, b, __builtin_amdgcn_readfirstlane(tl[2 * (i)]), __builtin_amdgcn_readfirstlane(tl[2 * (i) + 1]), S.dil, qf, o, m, l, qc, qcw_min, qcw_max, maxrel, selp, wunp, invl, impw, imp_acc, lut, carryB, lane)
    LDS_BARRIER();
    if (ntiles > 0) { FL_ISSUE(0, kr0, vr0); if (ntiles > 1) FL_ISSUE(1, kr1, vr1); FL_COMMIT(0, kr0, vr0); }
    LDS_BARRIER();
    for (int i = 0; i < ntiles; i += 2) {
        if (i + 2 < ntiles) FL_ISSUE(i + 2, kr0, vr0);
        FL_TILE(i, 0);
        if (i + 1 < ntiles) FL_COMMIT(1, kr1, vr1);
        LDS_BARRIER();
        if (i + 1 >= ntiles) break;
        if (i + 3 < ntiles) FL_ISSUE(i + 3, kr1, vr1);
        FL_TILE(i + 1, 1);
        if (i + 2 < ntiles) FL_COMMIT(0, kr0, vr0);
        LDS_BARRIER();
    }
#undef FL_ISSUE
#undef FL_COMMIT
#undef FL_TILE
}

template <int QG> __device__ __forceinline__ void flash_init(f32x4 (&o)[QG][4], float (&m)[QG], float (&l)[QG]) {
#pragma unroll
    for (int q = 0; q < QG; ++q) { m[q] = -1e30f; l[q] = 0.f;
#pragma unroll
        for (int d = 0; d < 4; ++d) o[q][d] = (f32x4){0.f, 0.f, 0.f, 0.f}; }
}
template <int NH>
__device__ __forceinline__ void load_lut(LAS unsigned char* lds, const float* glut, int head0, int tid) {
    LAS float* lut = (LAS float*)(lds + L_LUT); const float* src = glut + (size_t)head0 * LUTN;
    float v[NH * 3];
#pragma unroll
    for (int i = 0; i < NH * 3; ++i) v[i] = src[tid + NTHREADS * i];
    __builtin_amdgcn_sched_barrier(0);
#pragma unroll
    for (int i = 0; i < NH * 3; ++i) lut[tid + NTHREADS * i] = v[i];
}
__device__ __forceinline__ int next_unit(unsigned* ctr, LAS unsigned char* lds, int tid) {
    LAS int* slot = (LAS int*)(lds + L_MISC);
    __syncthreads();
    if (tid == 0) *slot = (int)atomicAdd(ctr, 1u);
    __syncthreads();
    return *slot;
}

__device__ __forceinline__ void unit_mixA(const Params& P, LAS unsigned char* lds, int uid, int tid, int lane, int wave) {
    unsigned char* ws = P.ws; const bf16_t* proj = (const bf16_t*)(ws + WS_PROJ);
    const int b = uid / 768; int rem = uid % 768; const int gi = rem / 256; rem %= 256; const int hs = rem / 64, idx = rem % 64;
    const int d = gi == 0 ? 1 : (gi == 1 ? 4 : 16); const int rc = idx % d, nb = idx / d;
    const int g = lane >> 4, i16 = lane & 15;
    load_lut<1>(lds, (const float*)(ws + WS_GLUT), gi * 4 + hs, tid);
    const int ntiles = nb == 0 ? 2 : 4;
    if (tid < 4) { LAS int* tl = (LAS int*)(lds + L_TL); const int i = tid + (nb == 0 ? 2 : 0); if (i < 4) { tl[2 * tid] = nb * 128 - 128 + 64 * i; tl[2 * tid + 1] = -1; } }
    const int qi = nb * 128 + 16 * wave + i16; const int tok = qi * d + rc; const size_t row = (size_t)b * SEQ + tok;
    const int colq = A_OFF + gi * 768 + hs * 64;
    bf16x8 qf[1][2];
#pragma unroll
    for (int ks = 0; ks < 2; ++ks) qf[0][ks] = *(const bf16x8*)(proj + row * INP + colq + ks * 32 + g * 8);
    f32x4 o[1][4]; float m[1], l[1]; flash_init<1>(o, m, l);
    const float il[1] = {0.f};
    Src S{proj + (size_t)b * SEQ * INP + colq + 256, proj + (size_t)b * SEQ * INP + colq + 512, INP, d, rc};
    flash_run<1, 1>(lds, S, ntiles, qf, o, m, l, qi, nb * 128 + 16 * wave, nb * 128 + 16 * wave + 15, 128, nullptr, nullptr, il, nullptr, false, 0, lane, tid);
    const float inv = l[0] > 0.f ? 1.f / l[0] : 0.f;
    bf16_t* O = (bf16_t*)(ws + WS_O) + row * 2048 + gi * 256 + hs * 64;
#pragma unroll
    for (int dt = 0; dt < 4; ++dt) { u32x2 w; w.x = cvtpk(o[0][dt][0] * inv, o[0][dt][1] * inv); w.y = cvtpk(o[0][dt][2] * inv, o[0][dt][3] * inv); *(u32x2*)(O + 16 * dt + 4 * g) = w; }
    if (g == 0) ((float*)(ws + WS_LSE))[row * 12 + gi * 4 + hs] = (m[0] + __log2f(fmaxf(l[0], 1e-30f))) * LN2;
}

__device__ __forceinline__ void unit_moba(const Params& P, LAS unsigned char* lds, int b, int h, int c, int tid, int lane, int wave) {
    unsigned char* ws = P.ws; const bf16_t* proj = (const bf16_t*)(ws + WS_PROJ);
    const int g = lane >> 4, i16 = lane & 15;
    const int t0 = c * 128, ob = t0 >> 8;
    load_lut<1>(lds, (const float*)(ws + WS_GLUT), 12 + h, tid);
    LAS float* km = (LAS float*)(lds + L_IMP);
    { const float* src = (const float*)(ws + WS_KMEAN) + (size_t)(b * 8 + h) * 2048; float kv4[4];
#pragma unroll
      for (int i = 0; i < 4; ++i) kv4[i] = src[tid + NTHREADS * i];
      __builtin_amdgcn_sched_barrier(0);
#pragma unroll
      for (int i = 0; i < 4; ++i) km[tid + NTHREADS * i] = kv4[i]; }
    LAS unsigned* misc = (LAS unsigned*)(lds + L_MISC);
    if (tid == 0) misc[1] = 0u;
    __syncthreads();
    const int tok = t0 + 16 * wave + i16; const size_t row = (size_t)b * SEQ + tok;
    const int colq = B_OFF + h * 64;
    bf16x8 qf[1][2];
#pragma unroll
    for (int ks = 0; ks < 2; ++ks) qf[0][ks] = *(const bf16x8*)(proj + row * INP + colq + ks * 32 + g * 8);
    unsigned sel = 0u;
    if (ob > 0) {
        float gt[8];
#pragma unroll
        for (int k = 0; k < 8; ++k) gt[k] = 0.f;
#pragma unroll 1
        for (int dc = 0; dc < 8; ++dc) { const u32x4 qw = *(const u32x4*)(proj + row * INP + colq + dc * 8);
            const float q0 = bflo(qw.x), q1 = bfhi(qw.x), q2 = bflo(qw.y), q3 = bfhi(qw.y), q4 = bflo(qw.z), q5 = bfhi(qw.z), q6 = bflo(qw.w), q7 = bfhi(qw.w);
#pragma unroll
            for (int k = 0; k < 8; ++k) { const LAS f32x4* kr = (const LAS f32x4*)(km + (8 * g + k) * 64 + dc * 8); const f32x4 a = kr[0], bq = kr[1];
                gt[k] += (q0 * a[0] + q1 * a[1]) + (q2 * a[2] + q3 * a[3]) + (q4 * bq[0] + q5 * bq[1]) + (q6 * bq[2] + q7 * bq[3]); } }
#pragma unroll
        for (int k = 0; k < 8; ++k) if (8 * g + k >= ob) gt[k] = -INFINITY;
#pragma unroll
        for (int it = 0; it < 3; ++it) {
            float best = -INFINITY; int bi = 99;
#pragma unroll
            for (int k = 0; k < 8; ++k) if (gt[k] > best) { best = gt[k]; bi = 8 * g + k; }
#pragma unroll
            for (int off = 16; off <= 32; off <<= 1) { const float ob_ = __shfl_xor(best, off); const int oi = __shfl_xor(bi, off); if (ob_ > best || (ob_ == best && oi < bi)) { best = ob_; bi = oi; } }
            if (bi < 32) { sel |= 1u << bi;
#pragma unroll
                for (int k = 0; k < 8; ++k) if (8 * g + k == bi) gt[k] = -INFINITY; }
        }
    }
    unsigned wu = sel;
#pragma unroll
    for (int off = 1; off < 16; off <<= 1) wu |= (unsigned)__shfl_xor((int)wu, off);
    wu = (unsigned)__builtin_amdgcn_readfirstlane((int)wu);
    LAS unsigned* selS = (LAS unsigned*)(lds + L_SEL); LAS unsigned* wunS = (LAS unsigned*)(lds + L_WUN) + wave * 4;
    if (g == 0) selS[(16 * wave + i16) * 4] = sel;
    if (lane == 0) wunS[0] = wu;
    __syncthreads();
    unsigned um = 0u;
#pragma unroll
    for (int w8 = 0; w8 < 8; ++w8) um |= ((const LAS unsigned*)(lds + L_WUN))[w8 * 4];
    if (tid == 0) { LAS int* tl = (LAS int*)(lds + L_TL); int n = 0;
        for (int blk = 0; blk < ob; ++blk) if ((um >> blk) & 1u) for (int s4 = 0; s4 < 4; ++s4) { tl[2 * n] = blk * 256 + 64 * s4; tl[2 * n + 1] = blk; ++n; }
        for (int k0 = ob * 256; k0 < t0 + 128; k0 += 64) { tl[2 * n] = k0; tl[2 * n + 1] = -1; ++n; }
        misc[2] = (unsigned)n; }
    __syncthreads();
    const int ntiles = (int)misc[2];
    f32x4 o[1][4]; float m[1], l[1]; flash_init<1>(o, m, l);
    const float il[1] = {0.f};
    Src S{proj + (size_t)b * SEQ * INP + colq + 512, proj + (size_t)b * SEQ * INP + colq + 1024, INP, 1, 0};
    flash_run<1, 1>(lds, S, ntiles, qf, o, m, l, tok, t0 + 16 * wave, t0 + 16 * wave + 15, 0x7fffffff, selS + (16 * wave + i16) * 4, wunS, il, nullptr, false, 0, lane, tid);
    const float inv = l[0] > 0.f ? 1.f / l[0] : 0.f;
    bf16_t* O = (bf16_t*)(ws + WS_O) + row * 2048 + 768 + h * 64;
#pragma unroll
    for (int dt = 0; dt < 4; ++dt) { u32x2 w; w.x = cvtpk(o[0][dt][0] * inv, o[0][dt][1] * inv); w.y = cvtpk(o[0][dt][2] * inv, o[0][dt][3] * inv); *(u32x2*)(O + 16 * dt + 4 * g) = w; }
}

__device__ __forceinline__ float sigmoidf_(float x) { return 1.f / (1.f + __expf(-x)); }
__device__ __forceinline__ void unit_nsa(const Params& P, LAS unsigned char* lds, int b, int kv, int c, int tid, int lane, int wave) {
    unsigned char* ws = P.ws; const bf16_t* proj = (const bf16_t*)(ws + WS_PROJ);
    const int g = lane >> 4, i16 = lane & 15;
    const int t0 = c * 128;
    const int tok = t0 + 16 * wave + i16; const size_t row = (size_t)b * SEQ + tok;
    load_lut<4>(lds, (const float*)(ws + WS_GLUT), 20 + kv * 4, tid);
    LAS int* tl = (LAS int*)(lds + L_TL);
    LAS unsigned* misc = (LAS unsigned*)(lds + L_MISC);
    LAS unsigned* selS = (LAS unsigned*)(lds + L_SEL);
    LAS float* impw = (LAS float*)(lds + L_IMP) + wave * 2048;
    const int ntc = ((t0 + 96) >> 4) / 64 + 1;
    if (tid < ntc) { tl[2 * tid] = 64 * tid; tl[2 * tid + 1] = -1; }
    if (tid < 4) misc[4 + tid] = 0u;
    LAS unsigned* wunS = (LAS unsigned*)(lds + L_WUN) + wave * 4;
    float* tot = (float*)(ws + WS_TOT) + row * 768 + (kv * 4) * 64;
    const bf16_t* gatep = proj + row * INP + CG_OFF + (kv * 4) * 3;
    const int qcc = (tok - 31) >> 4;
    const int qcw0 = (t0 + 16 * wave - 31) >> 4, qcw1 = (t0 + 16 * wave + 15 - 31) >> 4;
#pragma unroll 1
    for (int hp = 0; hp < 2; ++hp) {
        bf16x8 qf[2][2];
#pragma unroll
        for (int q = 0; q < 2; ++q)
#pragma unroll
            for (int ks = 0; ks < 2; ++ks) qf[q][ks] = *(const bf16x8*)(proj + row * INP + CQ_OFF + (kv * 4 + hp * 2 + q) * 64 + ks * 32 + g * 8);
        f32x4 o[2][4]; float m[2], l[2]; flash_init<2>(o, m, l);
        float il[2] = {0.f, 0.f};
#ifdef NSA_CMP_FAKEKV
        Src S{proj + (size_t)b * SEQ * INP + CKV_OFF + 4 * 192 + kv * 64, proj + (size_t)b * SEQ * INP + CKV_OFF + 5 * 192 + kv * 64, INP, 1, 0};
#else
        Src S{(const bf16_t*)(ws + WS_KC) + (size_t)(b * 3 + kv) * 512 * 64, (const bf16_t*)(ws + WS_VC) + (size_t)(b * 3 + kv) * 512 * 64, 64, 1, 0};
#endif
#ifdef NSA_CMP_SINGLE
        flash_run<2, 0>(lds, S, ntc, qf, o, m, l, qcc, qcw0, qcw1, 0x7fffffff, nullptr, nullptr, il, nullptr, false, 0, lane, tid);
#pragma unroll
        for (int q = 0; q < 2; ++q) il[q] = l[q] > 0.f ? 1.f / l[q] : 0.f;
        (void)impw;
#elif !defined(NSA_NO_CMP)
        flash_run<2, 2>(lds, S, ntc, qf, o, m, l, qcc, qcw0, qcw1, 0x7fffffff, nullptr, nullptr, il, nullptr, false, 0, lane, tid);
#pragma unroll
        for (int q = 0; q < 2; ++q) { il[q] = l[q] > 0.f ? 1.f / l[q] : 0.f; l[q] = 0.f; }
        flash_run<2, 4>(lds, S, ntc, qf, o, m, l, qcc, qcw0, qcw1, 0x7fffffff, nullptr, nullptr, il, impw, hp != 0, 0, lane, tid);
#else
        (void)S; (void)impw;
#endif
#pragma unroll
        for (int q = 0; q < 2; ++q) { const float gt = sigmoidf_(bf2f(gatep[(hp * 2 + q) * 3 + 0])); const float sc = il[q] * gt;
#pragma unroll
            for (int dt = 0; dt < 4; ++dt) *(f32x4*)(tot + (hp * 2 + q) * 64 + 16 * dt + 4 * g) = o[q][dt] * sc; }
    }
#ifndef NSA_NO_TOPK
    lds_wait();
    unsigned wun0 = 0u, wun1 = 0u, wun2 = 0u, wun3 = 0u;
#pragma unroll 1
    for (int q = 0; q < 16; ++q) {
        const int t = t0 + 16 * wave + q, own = t >> 6;
        const int ncand = own - 2 > 0 ? own - 2 : 0; const int nforced = own >= 2 ? 3 : own + 1; const int K = 16 - nforced;
        const int j0 = lane, j1 = lane + 64;
        const bool c0 = (j0 >= 1) && (j0 <= own - 2), c1 = (j1 <= own - 2);
        const unsigned k0 = c0 ? (__float_as_uint(impw[q * 128 + j0]) + 1u) : 0u, k1 = c1 ? (__float_as_uint(impw[q * 128 + j1]) + 1u) : 0u;
        bool s0 = c0, s1 = c1;
        if (ncand > K) {
            unsigned T = 0u;
            for (int bit = 31; bit >= 0; --bit) { const unsigned Tn = T | (1u << bit);
                const int cnt = __popcll(__ballot(k0 >= Tn)) + __popcll(__ballot(k1 >= Tn)); if (cnt >= K) T = Tn; }
            const bool g0 = k0 > T, g1 = k1 > T; const int ng = __popcll(__ballot(g0)) + __popcll(__ballot(g1)); const int need = K - ng;
            const unsigned long long e0 = __ballot(k0 == T), e1 = __ballot(k1 == T); const unsigned long long lt = (1ull << lane) - 1ull;
            const int r0 = __popcll(e0 & lt), r1 = __popcll(e0) + __popcll(e1 & lt);
            s0 = g0 || (k0 == T && r0 < need); s1 = g1 || (k1 == T && r1 < need);
        }
        s0 = s0 || (j0 == 0) || (j0 == own) || (j0 == own - 1); s1 = s1 || (j1 == own) || (j1 == own - 1);
        const unsigned long long m0 = __ballot(s0), m1 = __ballot(s1);
        const unsigned w0 = (unsigned)m0, w1 = (unsigned)(m0 >> 32), w2 = (unsigned)m1, w3 = (unsigned)(m1 >> 32);
        if (lane == 0) { selS[(16 * wave + q) * 4 + 0] = w0; selS[(16 * wave + q) * 4 + 1] = w1; selS[(16 * wave + q) * 4 + 2] = w2; selS[(16 * wave + q) * 4 + 3] = w3; }
        wun0 |= w0; wun1 |= w1; wun2 |= w2; wun3 |= w3;
    }
    if (lane == 0) { wunS[0] = wun0; wunS[1] = wun1; wunS[2] = wun2; wunS[3] = wun3; }
    __syncthreads();
    if (tid < 4) { unsigned u_ = 0u; for (int w8 = 0; w8 < 8; ++w8) u_ |= ((const LAS unsigned*)(lds + L_WUN))[w8 * 4 + tid]; misc[4 + tid] = u_; }
    __syncthreads();
    const LAS unsigned* selp = selS + (16 * wave + i16) * 4;
    const int ownmax = (t0 + 127) >> 6;
    if (tid == 0) { int n = 0; for (int j = 0; j <= ownmax; ++j) if ((misc[4 + (j >> 5)] >> (j & 31)) & 1u) { tl[2 * n] = 64 * j; tl[2 * n + 1] = j; ++n; } misc[2] = (unsigned)n; }
    __syncthreads();
    const int nts = (int)misc[2];
#else
    const int ownmax = (t0 + 127) >> 6; const int nts = 0; const LAS unsigned* selp = nullptr; (void)selS; (void)wunS;
#endif
    const int kfirst = t0 - 512 > 0 ? t0 - 512 : 0; const int ntw = (t0 + 128 - kfirst) / 64;
#pragma unroll 1
    for (int hp = 0; hp < 2; ++hp) {
        bf16x8 qf[2][2];
#pragma unroll
        for (int q = 0; q < 2; ++q)
#pragma unroll
            for (int ks = 0; ks < 2; ++ks) qf[q][ks] = *(const bf16x8*)(proj + row * INP + CQ_OFF + (kv * 4 + hp * 2 + q) * 64 + ks * 32 + g * 8);
        f32x4 o[2][4]; float m[2], l[2];
        const float il[2] = {0.f, 0.f};
        __syncthreads();
        if (tid == 0) { int n = 0; for (int j = 0; j <= ownmax; ++j) if ((misc[4 + (j >> 5)] >> (j & 31)) & 1u) { tl[2 * n] = 64 * j; tl[2 * n + 1] = j; ++n; } }
#ifndef NSA_NO_SLC
        { flash_init<2>(o, m, l);
          Src S{proj + (size_t)b * SEQ * INP + CKV_OFF + 2 * 192 + kv * 64, proj + (size_t)b * SEQ * INP + CKV_OFF + 3 * 192 + kv * 64, INP, 1, 0};
          flash_run<2, 1>(lds, S, nts, qf, o, m, l, tok, t0 + 16 * wave, t0 + 16 * wave + 15, 0x7fffffff, selp, wunS, il, nullptr, false, hp * 2, lane, tid);
#pragma unroll
          for (int q = 0; q < 2; ++q) { const float gt = sigmoidf_(bf2f(gatep[(hp * 2 + q) * 3 + 1])); const float sc = (l[q] > 0.f ? 1.f / l[q] : 0.f) * gt;
#pragma unroll
              for (int dt = 0; dt < 4; ++dt) { float* tp = tot + (hp * 2 + q) * 64 + 16 * dt + 4 * g; *(f32x4*)tp = *(const f32x4*)tp + o[q][dt] * sc; } }
        }
#endif
        if (tid < ntw) { tl[2 * tid] = kfirst + 64 * tid; tl[2 * tid + 1] = -1; }
        { flash_init<2>(o, m, l);
          Src S{proj + (size_t)b * SEQ * INP + CKV_OFF + 4 * 192 + kv * 64, proj + (size_t)b * SEQ * INP + CKV_OFF + 5 * 192 + kv * 64, INP, 1, 0};
#ifndef NSA_NO_WIN
          flash_run<2, 1>(lds, S, ntw, qf, o, m, l, tok, t0 + 16 * wave, t0 + 16 * wave + 15, 511, nullptr, nullptr, il, nullptr, false, hp * 2, lane, tid);
#else
          (void)S;
#endif
          bf16_t* O = (bf16_t*)(ws + WS_O) + row * 2048 + 1280 + (kv * 4) * 64;
#pragma unroll
          for (int q = 0; q < 2; ++q) { const float gt = sigmoidf_(bf2f(gatep[(hp * 2 + q) * 3 + 2])); const float sc = (l[q] > 0.f ? 1.f / l[q] : 0.f) * gt;
#pragma unroll
              for (int dt = 0; dt < 4; ++dt) { const f32x4 v = *(const f32x4*)(tot + (hp * 2 + q) * 64 + 16 * dt + 4 * g) + o[q][dt] * sc;
                  u32x2 w; w.x = cvtpk(v[0], v[1]); w.y = cvtpk(v[2], v[3]); *(u32x2*)(O + (hp * 2 + q) * 64 + 16 * dt + 4 * g) = w; } }
        }
    }
}

__device__ __forceinline__ float gelu_tanh(float x) { const float u = 0.7978845608028654f * (x + 0.044715f * x * x * x); const float e = __expf(2.f * u); const float th = 1.f - 2.f / (1.f + e); return 0.5f * x * (1.f + th); }
__device__ __forceinline__ void item_compress(const Params& P, int layer, int it, int lane) {
    unsigned char* ws = P.ws; const bf16_t* proj = (const bf16_t*)(ws + WS_PROJ);
    const int nt = it & 31; int r = it >> 5; const int which = r & 1; r >>= 1; const int kv = r % 3, b = r / 3;
    const int g = lane >> 4, i16 = lane & 15;
    int n = 16 * nt + i16; const int nld = n > 510 ? 510 : n;
    const bf16_t* w1t = (const bf16_t*)(ws + WS_W1T) + (size_t)(layer * 2 + which) * 128 * 2048;
    const bf16_t* w2t = (const bf16_t*)(ws + WS_W2T) + (size_t)(layer * 2 + which) * 64 * 128;
    const float* cpe = (const float*)(ws + WS_CPE) + (layer * 2 + which) * 128;
    const bf16_t* src = proj + ((size_t)b * SEQ + 16 * nld) * INP + CKV_OFF + which * 192 + kv * 64 + 8 * g;
    f32x4 acc[8];
#pragma unroll
    for (int h = 0; h < 8; ++h) acc[h] = (f32x4){0.f, 0.f, 0.f, 0.f};
    const bf16_t* w1l = w1t + (size_t)i16 * 2048 + 8 * g;
#pragma unroll 1
    for (int ks = 0; ks < 64; ks += 2) {
        bf16x8 bq[2], af[2][8];
#pragma unroll
        for (int u = 0; u < 2; ++u) { bq[u] = *(const bf16x8*)(src + (size_t)(ks >> 1) * INP + u * 32);
#pragma unroll
            for (int h = 0; h < 8; ++h) af[u][h] = *(const bf16x8*)(w1l + (size_t)(16 * h) * 2048 + 32 * (ks + u)); }
        __builtin_amdgcn_sched_barrier(0);
#pragma unroll
        for (int u = 0; u < 2; ++u)
#pragma unroll
            for (int h = 0; h < 8; ++h) acc[h] = mfma16(af[u][h], bq[u], acc[h]);
    }
    bf16x8 pf[4];
#pragma unroll
    for (int s = 0; s < 4; ++s) { float hv[8];
#pragma unroll
        for (int r2 = 0; r2 < 4; ++r2) { hv[r2] = gelu_tanh(acc[2 * s][r2] + cpe[32 * s + 4 * g + r2]); hv[4 + r2] = gelu_tanh(acc[2 * s + 1][r2] + cpe[32 * s + 16 + 4 * g + r2]); }
        u32x4 w; w.x = cvtpk(hv[0], hv[1]); w.y = cvtpk(hv[2], hv[3]); w.z = cvtpk(hv[4], hv[5]); w.w = cvtpk(hv[6], hv[7]); pf[s] = __builtin_bit_cast(bf16x8, w); }
    bf16_t* dst = (bf16_t*)(ws + (which ? WS_VC : WS_KC)) + ((size_t)(b * 3 + kv) * 512 + n) * 64;
#pragma unroll
    for (int et = 0; et < 4; ++et) { f32x4 oc = {0.f, 0.f, 0.f, 0.f};
#pragma unroll
        for (int s = 0; s < 4; ++s) { const bf16_t* wp = w2t + (size_t)(16 * et + i16) * 128 + 32 * s + 4 * g; const u32x2 lo = *(const u32x2*)wp, hi = *(const u32x2*)(wp + 16);
            u32x4 w; w.x = lo.x; w.y = lo.y; w.z = hi.x; w.w = hi.y; oc = mfma16(__builtin_bit_cast(bf16x8, w), pf[s], oc); }
#ifdef PROBE_CLAMP
#pragma unroll
        for (int r2 = 0; r2 < 4; ++r2) oc[r2] = fminf(fmaxf(oc[r2], -100.f), 100.f);
#endif
        u32x2 w; w.x = cvtpk(oc[0], oc[1]); w.y = cvtpk(oc[2], oc[3]); *(u32x2*)(dst + 16 * et + 4 * g) = w; }
}
__device__ __forceinline__ void item_kmean(const Params& P, int it, int lane) {
    unsigned char* ws = P.ws; const bf16_t* proj = (const bf16_t*)(ws + WS_PROJ);
    const int blk = it & 31, h = (it >> 5) & 7, b = it >> 8;
    const bf16_t* src = proj + ((size_t)b * SEQ + blk * 256) * INP + B_OFF + 512 + h * 64 + lane;
    float s = 0.f;
#pragma unroll 8
    for (int r = 0; r < 256; ++r) s += bf2f(src[(size_t)r * INP]);
    ((float*)(ws + WS_KMEAN))[(size_t)it * 64 + lane] = s * (1.f / 256.f);
}
__device__ __forceinline__ void item_combineA(const Params& P, int row, int lane) {
    unsigned char* ws = P.ws; const float* lse = (const float*)(ws + WS_LSE) + (size_t)row * 12; bf16_t* O = (bf16_t*)(ws + WS_O) + (size_t)row * 2048;
#pragma unroll
    for (int k = 0; k < 3; ++k) { const int chunk = lane + 64 * k; const int col = 4 * chunk; const int gi = col >> 8, hs = (col >> 6) & 3;
        const float a0 = lse[hs], a1 = lse[4 + hs], a2 = lse[8 + hs]; const float mx = fmaxf(a0, fmaxf(a1, a2));
        const float e0 = __expf(a0 - mx), e1 = __expf(a1 - mx), e2 = __expf(a2 - mx); const float al = (gi == 0 ? e0 : (gi == 1 ? e1 : e2)) / (e0 + e1 + e2);
        const u32x2 w = *(const u32x2*)(O + col); u32x2 r; r.x = cvtpk(bflo(w.x) * al, bfhi(w.x) * al); r.y = cvtpk(bflo(w.y) * al, bfhi(w.y) * al); *(u32x2*)(O + col) = r; }
}

__device__ __forceinline__ void phase_conv(const Params& P, int layer, int tid) {
    unsigned char* ws = P.ws; const bf16_t* U = (const bf16_t*)(ws + WS_U); bf16_t* ACT = (bf16_t*)(ws + WS_ACT);
    const float* cw = P.conv_w + (size_t)layer * 3 * UPW; const float* cb = P.conv_b + (size_t)layer * UPW;
    constexpr int NCH = DFF / 8, TB = 8, NTB = MROWS / TB;
    for (int it = blockIdx.x * NTHREADS + tid; it < NCH * NTB; it += gridDim.x * NTHREADS) {
        const int ch = it % NCH, tb = it / NCH; const int c = ch * 8; const int ua = 256 * (c >> 7) + (c & 127);
        const int row0 = tb * TB; const bool first = (row0 % SEQ) == 0;
        u32x4 pa[TB + 2], pg[TB + 2];
#pragma unroll
        for (int t = 0; t < TB + 2; ++t) { const int r = row0 - 2 + t; const size_t off = (size_t)(r < 0 ? 0 : r) * UPW + ua; pa[t] = *(const u32x4*)(U + off); pg[t] = *(const u32x4*)(U + off + 128); }
        f32x4 wa4[3][2], wg4[3][2], ba4[2], bg4[2];
#pragma unroll
        for (int j = 0; j < 3; ++j)
#pragma unroll
            for (int h = 0; h < 2; ++h) { wa4[j][h] = *(const f32x4*)(cw + (size_t)j * UPW + c + 4 * h); wg4[j][h] = *(const f32x4*)(cw + (size_t)j * UPW + DFF + c + 4 * h); }
#pragma unroll
        for (int h = 0; h < 2; ++h) { ba4[h] = *(const f32x4*)(cb + c + 4 * h); bg4[h] = *(const f32x4*)(cb + DFF + c + 4 * h); }
        __builtin_amdgcn_sched_barrier(0);
        if (first) { pa[0] = (u32x4){0, 0, 0, 0}; pa[1] = pa[0]; pg[0] = pa[0]; pg[1] = pa[0]; }
#pragma unroll
        for (int t = 0; t < TB; ++t) {
            float r[8];
#pragma unroll
            for (int e = 0; e < 8; ++e) { const int w_ = e >> 1; const int h = e >> 2, x = e & 3;
                const float a0 = (e & 1) ? bfhi(pa[t + 2][w_]) : bflo(pa[t + 2][w_]), a1 = (e & 1) ? bfhi(pa[t + 1][w_]) : bflo(pa[t + 1][w_]), a2 = (e & 1) ? bfhi(pa[t][w_]) : bflo(pa[t][w_]);
                const float g0 = (e & 1) ? bfhi(pg[t + 2][w_]) : bflo(pg[t + 2][w_]), g1 = (e & 1) ? bfhi(pg[t + 1][w_]) : bflo(pg[t + 1][w_]), g2 = (e & 1) ? bfhi(pg[t][w_]) : bflo(pg[t][w_]);
                const float ya = ba4[h][x] + wa4[0][h][x] * a0 + wa4[1][h][x] * a1 + wa4[2][h][x] * a2;
                const float yg = bg4[h][x] + wg4[0][h][x] * g0 + wg4[1][h][x] * g1 + wg4[2][h][x] * g2;
                r[e] = ya * yg / (1.f + __expf(-yg)); }
            u32x4 w; w.x = cvtpk(r[0], r[1]); w.y = cvtpk(r[2], r[3]); w.z = cvtpk(r[4], r[5]); w.w = cvtpk(r[6], r[7]);
            *(u32x4*)(ACT + (size_t)(row0 + t) * DFF + c) = w;
        }
    }
}

#define XB_TMO      128
#define XB_XCNT(j)  (256  + 64 * (j))
#define XB_XSUB(j)  (1280 + 64 * (j))
#define XB_XGEN(j)  (2304 + 64 * (j))
#define XB_TOP      3328
#define XB_TOPGEN   3392
#define XCD_BAR_WORDS 3456
#define XB_SPIN_CAP (1u << 27)

__device__ __forceinline__ unsigned xb_ld(unsigned* p)              { return __hip_atomic_load(p, __ATOMIC_RELAXED, __HIP_MEMORY_SCOPE_AGENT); }
__device__ __forceinline__ unsigned xb_add(unsigned* p, unsigned v) { return __hip_atomic_fetch_add(p, v, __ATOMIC_RELAXED, __HIP_MEMORY_SCOPE_AGENT); }
__device__ __forceinline__ unsigned xb_xcc_id() { return (unsigned)__builtin_amdgcn_s_getreg((3 << 11) | 20) & 0xFu; }
#define XB_SPIN(cond, bar) do { unsigned _sp = 0; while (cond) { __builtin_amdgcn_s_sleep(1); \
    if ((++_sp & 255u) == 0u) { if (xb_ld(&(bar)[XB_TMO])) break; if (_sp > XB_SPIN_CAP) { atomicAdd(&(bar)[XB_TMO], 1u); break; } } } } while (0)

struct XcdBarrier {
    unsigned* bar; unsigned x;
    volatile LAS unsigned* st;
};

__device__ __forceinline__ XcdBarrier xcd_barrier_post(unsigned* bar, volatile LAS unsigned* st) {
    XcdBarrier b; b.bar = bar; b.x = xb_xcc_id(); b.st = st;
    if (threadIdx.x == 0) (void)xb_add(&bar[XB_XCNT(b.x)], 1u);
    return b;
}
__device__ __forceinline__ void xcd_barrier_complete(unsigned* bar, unsigned x, unsigned& nloc, unsigned& nx) {
    const unsigned G = gridDim.x * gridDim.y * gridDim.z;
    unsigned sum, cnt, mine, sp = 0u;
    for (;;) {
        sum = 0u; cnt = 0u; mine = 0u;
#pragma unroll
        for (unsigned j = 0; j < 16; ++j) { const unsigned c = xb_ld(&bar[XB_XCNT(j)]); sum += c; cnt += (c > 0u) ? 1u : 0u; mine = (j == x) ? c : mine; }
        if (sum == G) break;
        __builtin_amdgcn_s_sleep(1);
        if ((++sp & 255u) == 0u) { if (xb_ld(&bar[XB_TMO])) break; if (sp > XB_SPIN_CAP) { atomicAdd(&bar[XB_TMO], 1u); break; } }
    }
    nloc = mine > 0u ? mine : 1u; nx = cnt > 0u ? cnt : 1u;
}

__device__ __forceinline__ void xcd_barrier(const XcdBarrier& b) {
    asm volatile("s_waitcnt vmcnt(0)" ::: "memory");
    __syncthreads();
    if (threadIdx.x == 0) {
        unsigned* bar = b.bar;
        __builtin_amdgcn_s_waitcnt(0);
        unsigned nloc = b.st[0], nx = b.st[1];
        if (nloc == 0u) { xcd_barrier_complete(bar, b.x, nloc, nx); b.st[0] = nloc; b.st[1] = nx; }
        const unsigned old = xb_add(&bar[XB_XSUB(b.x)], 1u);
        const unsigned gen = old / nloc;
        if (old + 1u == (gen + 1u) * nloc) {
            __builtin_amdgcn_fence(__ATOMIC_RELEASE, "agent");
            asm volatile("s_waitcnt vmcnt(0)" ::: "memory");
            const unsigned og = xb_add(&bar[XB_TOP], 1u);
            const unsigned tg = og / nx;
            if (og + 1u == (tg + 1u) * nx) xb_add(&bar[XB_TOPGEN], 1u);
            else XB_SPIN(xb_ld(&bar[XB_TOPGEN]) == tg, bar);
            __builtin_amdgcn_fence(__ATOMIC_ACQUIRE, "agent");
            xb_add(&bar[XB_XGEN(b.x)], 1u);
            asm volatile("s_waitcnt vmcnt(0)" ::: "memory");
        } else {
            XB_SPIN(xb_ld(&bar[XB_XGEN(b.x)]) == gen, bar);
            __builtin_amdgcn_fence(__ATOMIC_ACQUIRE, "agent");
            asm volatile("s_waitcnt vmcnt(0)" ::: "memory");
        }
    }
    __syncthreads();
}

__global__ void __launch_bounds__(NTHREADS) fwd_megakernel(Params P) {
    extern __shared__ __attribute__((aligned(16))) unsigned char lds_raw[];
    LAS unsigned char* lds = (LAS unsigned char*)lds_raw;
    int wave0 = __builtin_amdgcn_readfirstlane((int)threadIdx.x >> 6);
    unsigned char* ws0 = P.ws;
    volatile LAS unsigned* bst = (volatile LAS unsigned*)(lds + LDS_BYTES - 64);
    if (threadIdx.x < 2) bst[threadIdx.x] = 0u;
    __syncthreads();
    (void)xcd_barrier_post((unsigned*)(P.ws + WS_CTL) + 4096, bst);
#define GRID_BAR() do { XcdBarrier b_; b_.bar = (unsigned*)(ws0 + WS_CTL) + 4096; b_.x = xb_xcc_id(); b_.st = (volatile LAS unsigned*)(lds + LDS_BYTES - 64); xcd_barrier(b_); } while (0)
    { const int wave = wave0, lane = lane_id_opaque(), tid = wave * 64 + lane;

#ifndef SKIP_P0
    p0_prologue(P, lds, tid, lane, wave);
#endif
    }
    GRID_BAR();

#pragma unroll 1
    for (int layer = 0; layer < DEPTH; ++layer) {
        asm volatile("" : "+s"(wave0), "+s"(ws0));
        const int wave = wave0, lane = lane_id_opaque(), tid = wave * 64 + lane;
        const int G = gridDim.x, gw = blockIdx.x * NWAVES + wave, NGW = G * NWAVES;
        unsigned char* ws = ws0;
        unsigned* ctl = (unsigned*)(ws + WS_CTL);
        const float* xbase = layer == 0 ? P.x : (const float*)(ws + WS_X);
#ifdef PROBE_ZERO_O
        for (size_t i = (size_t)blockIdx.x * NTHREADS + tid; i < (size_t)MROWS * 2048 / 8; i += (size_t)G * NTHREADS) ((u32x4*)(ws + WS_O))[i] = (u32x4){0u, 0u, 0u, 0u};
#endif
        { pg8::Gemm gm{(const pg8::bf16_t*)(ws + WS_XB), (const pg8::bf16_t*)(ws + WS_WIN + layer * SZ_WIN), MROWS, INP, DM};
          pg8::StaticOrder S; S.init(MROWS, INP, G, (int)blockIdx.x);
          pg8::EpiScaleBf16 E{(pg8::bf16_t*)(ws + WS_PROJ), INP, (const float*)(ws + WS_SSP)};
          pg8::gemm_phase<pg8::EpiScaleBf16, pg8::StaticOrder, true, true>(lds, gm, S, E, wave); }
        GRID_BAR();
#ifndef SKIP_CMP
        for (int it = gw; it < 384 + 512; it += NGW) { if (it < 384) item_compress(P, layer, it, lane); else item_kmean(P, it - 384, lane); }
#endif
#ifndef SKIP_MIXA
#ifdef DUP_P2A
        for (int rep_ = 0; rep_ < 2; ++rep_)
        for (;;) { const int u = next_unit(ctl + 64 * (layer * 2 + 0 + 8 * rep_), lds, tid); if (u >= 1536) break; const int ln_ = lane_id_opaque(); unit_mixA(P, lds, u, wave * 64 + ln_, ln_, wave); }
#else
        for (;;) { const int u = next_unit(ctl + 64 * (layer * 2 + 0), lds, tid); if (u >= 1536) break; const int ln_ = lane_id_opaque(); unit_mixA(P, lds, u, wave * 64 + ln_, ln_, wave); }
#endif
#endif
        GRID_BAR();
        for (int r = gw; r < MROWS; r += NGW) item_combineA(P, r, lane);
#ifdef DUP_P2B
        for (int rep_ = 0; rep_ < 2; ++rep_)
        for (;;) { const int u = next_unit(ctl + 64 * (layer * 2 + 1 + 8 * rep_), lds, tid); if (u >= 384 + 1024) break;
#else
        for (;;) { const int u = next_unit(ctl + 64 * (layer * 2 + 1), lds, tid); if (u >= 384 + 1024) break;
#endif
            if (u < 384) {
#ifndef SKIP_NSA
                { const int ln_ = lane_id_opaque(); unit_nsa(P, lds, (u % 6) / 3, (u % 6) % 3, 63 - u / 6, wave * 64 + ln_, ln_, wave); }
#endif
            } else { const int v = u - 384;
#ifndef SKIP_MOBA
                { const int ln_ = lane_id_opaque(); unit_moba(P, lds, (v % 16) / 8, (v % 16) % 8, 63 - v / 16, wave * 64 + ln_, ln_, wave); }
#endif
            } }
        GRID_BAR();
        { pg8::Gemm gm{(const pg8::bf16_t*)(ws + WS_O), (const pg8::bf16_t*)(ws + WS_WOUT + layer * SZ_WOUT), MROWS, DM, DM};
          pg8::StaticOrder S; S.init(MROWS, DM, G, (int)blockIdx.x);
          pg8::EpiResid E{xbase, (float*)(ws + WS_X), (pg8::bf16_t*)(ws + WS_XB), (float*)(ws + WS_SSP)};
          pg8::gemm_phase<pg8::EpiResid, pg8::StaticOrder, true, true>(lds, gm, S, E, wave); }
        GRID_BAR();
        { pg8::Gemm gm{(const pg8::bf16_t*)(ws + WS_XB), (const pg8::bf16_t*)(ws + WS_WUP + layer * SZ_WUP), MROWS, UPW, DM};
          pg8::StaticOrder S; S.init(MROWS, UPW, G, (int)blockIdx.x);
          pg8::EpiScaleBf16 E{(pg8::bf16_t*)(ws + WS_U), UPW, (const float*)(ws + WS_SSP)};
#ifdef DUP_G3
          pg8::gemm_phase<pg8::EpiScaleBf16, pg8::StaticOrder, true, true>(lds, gm, S, E, wave);
#endif
          pg8::gemm_phase<pg8::EpiScaleBf16, pg8::StaticOrder, true, true>(lds, gm, S, E, wave); }
        GRID_BAR();
#ifndef SKIP_CONV
        phase_conv(P, layer, tid);
#ifdef DUP_CONV
        phase_conv(P, layer, tid);
#endif
#endif
        GRID_BAR();
        { pg8::Gemm gm{(const pg8::bf16_t*)(ws + WS_ACT), (const pg8::bf16_t*)(ws + WS_WDN + layer * SZ_WDN), MROWS, DM, DFF};
          pg8::StaticOrder S; S.init(MROWS, DM, G, (int)blockIdx.x);
          pg8::EpiResid E{(const float*)(ws + WS_X), (float*)(ws + WS_X), (pg8::bf16_t*)(ws + WS_XB), (float*)(ws + WS_SSP)};
          pg8::gemm_phase<pg8::EpiResid, pg8::StaticOrder, true, true>(lds, gm, S, E, wave); }
        GRID_BAR();
    }
    const int wave = wave0, lane = lane_id_opaque();
    const int G = gridDim.x, gw = blockIdx.x * NWAVES + wave, NGW = G * NWAVES;
    unsigned char* ws = ws0; (void)G;
    for (int mrow = gw; mrow < MROWS; mrow += NGW) {
        const f32x4* xr = (const f32x4*)((const float*)(ws + WS_X) + (size_t)mrow * DM) + lane; const f32x4* gr = (const f32x4*)P.norm_final + lane;
        f32x4 v[8]; float s = 0.f;
#pragma unroll
        for (int j = 0; j < 8; ++j) { v[j] = xr[64 * j]; s += (v[j][0] * v[j][0] + v[j][1] * v[j][1]) + (v[j][2] * v[j][2] + v[j][3] * v[j][3]); }
#pragma unroll
        for (int o = 1; o < 64; o <<= 1) s += __shfl_xor(s, o);
        const float rs = 1.0f / sqrtf(s * (1.0f / DM) + 1e-6f);
        f32x4* orow = (f32x4*)(P.out + (size_t)mrow * DM) + lane;
#pragma unroll
        for (int j = 0; j < 8; ++j) orow[64 * j] = v[j] * rs * gr[64 * j];
    }
}

extern "C" void kernel_launch(void* const* d_in, const int* in_sizes, int n_in, void* d_out, int out_size, void* d_ws, size_t ws_size, hipStream_t stream) {
    static int grid = 0;
    if (grid == 0) {
        if (n_in != 14 || ws_size < WS_END) { fprintf(stderr, "kernel_launch: unexpected n_in %d or workspace %zu < %zu\n", n_in, ws_size, (size_t)WS_END); grid = -1; return; }
        int dev = 0, cus = 0, per_cu = 0;
        hipGetDevice(&dev); hipDeviceGetAttribute(&cus, hipDeviceAttributeMultiprocessorCount, dev);
        if (hipFuncSetAttribute((const void*)fwd_megakernel, hipFuncAttributeMaxDynamicSharedMemorySize, LDS_BYTES) != hipSuccess) { fprintf(stderr, "kernel_launch: hipFuncSetAttribute failed\n"); grid = -1; return; }
        if (hipOccupancyMaxActiveBlocksPerMultiprocessor(&per_cu, (const void*)fwd_megakernel, NTHREADS, LDS_BYTES) != hipSuccess || per_cu < 1) { fprintf(stderr, "kernel_launch: occupancy query says %d\n", per_cu); per_cu = 1; }
        (void)hipGetLastError();
        grid = cus * 1;
    }
    if (grid < 0) return;
    hipMemsetAsync((char*)d_ws + WS_CTL, 0, CTL_BYTES, stream);
    Params p{};
    p.x = (const float*)d_in[0]; p.rel = (const float*)d_in[1]; p.w_in = (const float*)d_in[2]; p.w_out = (const float*)d_in[3]; p.cmp_w1 = (const float*)d_in[4]; p.cmp_w2 = (const float*)d_in[5];
    p.cmp_pe = (const float*)d_in[6]; p.norm_attn = (const float*)d_in[7]; p.norm_mlp = (const float*)d_in[8]; p.w_up = (const float*)d_in[9]; p.conv_w = (const float*)d_in[10]; p.conv_b = (const float*)d_in[11];
    p.w_down = (const float*)d_in[12]; p.norm_final = (const float*)d_in[13]; p.out = (float*)d_out; p.ws = (unsigned char*)d_ws;
    void* args[] = {&p};
    hipError_t e = hipLaunchCooperativeKernel((const void*)fwd_megakernel, dim3(grid), dim3(NTHREADS), args, LDS_BYTES, stream);
    if (e != hipSuccess) fprintf(stderr, "kernel_launch: cooperative launch failed: %s (grid %d)\n", hipGetErrorString(e), grid);
}
```

```cpp
#define NO_TAILFILL
#define FUSE_CONV
#include <hip/hip_runtime.h>
#include <hip/hip_cooperative_groups.h>
#include <cstdio>
#include <cstdint>
namespace cg = cooperative_groups;
namespace pg8 {
#define PG8_LAS __attribute__((address_space(3)))
typedef unsigned short bf16_t;
typedef short bf16x8 __attribute__((ext_vector_type(8)));
typedef float f32x4 __attribute__((ext_vector_type(4)));
typedef unsigned u32x4 __attribute__((ext_vector_type(4)));
constexpr int BM = 256, BK = 64, HALF = 128, HTB = HALF * BK * 2  , STAGE_BYTES = 8 * HTB, NXCD = 8, WGM = 8;

__host__ __device__ __forceinline__ int lds_byte(int r, int c) { const int st = (r >> 4) * 2 + (c >> 5), rr = r & 15, cc = c & 31, ob = rr * 64 + cc * 2; return st * 1024 + (ob ^ (((ob >> 9) & 1) << 5)); }
__host__ __device__ __forceinline__ void stage_rc(int b, int& R, int& C) { const int st = b / 1024, sb = b % 1024, swz = sb ^ (((sb >> 9) & 1) << 5); R = (st >> 1) * 16 + swz / 64; C = (st & 1) * 32 + (swz % 64) / 2; }
__host__ __device__ __forceinline__ int perm32(int rho) { const int n = rho >> 4, i = rho & 15; return 8 * (i >> 2) + 4 * n + (i & 3); }

struct Unit { int pm, pn; };
struct Gemm { const bf16_t* A; const bf16_t* Bt; int M, N, K; };

struct StaticOrder {
    int nM, nN, nwg, G, c;
    __host__ __device__ void init(int M, int N, int G_, int c_) { nM = M / BM; nN = N / BM; nwg = nM * nN; G = G_; c = c_; }
    __host__ __device__ bool next(int i, Unit& u) const {
        const long L = (long)i * G + c; if (L >= nwg) return false;
        int wgid = (int)L; { const int q = nwg / NXCD, r = nwg % NXCD, xcd = wgid % NXCD, off = wgid / NXCD; wgid = (xcd < r ? xcd * (q + 1) : r * (q + 1) + (xcd - r) * q) + off; }
        const int nig = WGM * nN, gid = wgid / nig, fm = gid * WGM, gsz = (nM - fm) < WGM ? (nM - fm) : WGM;
        u.pm = fm + ((wgid % nig) % gsz); u.pn = (wgid % nig) / gsz; return true;
    }
    __device__ __forceinline__ void a_ready(const Unit&) const {}
    __device__ __forceinline__ void done(const Unit&) const {}
};
typedef float f32x2 __attribute__((ext_vector_type(2)));
typedef __bf16 bf16x2_pk __attribute__((ext_vector_type(2)));
__device__ __forceinline__ unsigned cvt_pk_bf16(float lo, float hi) { f32x2 v = {lo, hi}; bf16x2_pk b = __builtin_convertvector(v, bf16x2_pk); return __builtin_bit_cast(unsigned, b); }
__device__ __forceinline__ float row_rstd(const float* ssp, int row) {
    const f32x4* p = (const f32x4*)(ssp + (size_t)row * 32); float s = 0.f;
#pragma unroll
    for (int i = 0; i < 8; ++i) { const f32x4 v = p[i]; s += (v[0] + v[1]) + (v[2] + v[3]); }
    return 1.0f / sqrtf(s * (1.0f / 2048.0f) + 1e-6f);
}
struct EpiScaleBf16 {
    static constexpr bool PERM = true, AFTER_DRAIN = false;
    bf16_t* O; int ldc; const float* ssp;
    __device__ __forceinline__ void operator()(const f32x4 (&acc)[2][2][4][2], const Unit& u, int wr, int wc, int fr, int fq) const {
        const int lane = fq * 16 + fr;
        const int rbase = u.pm * BM + wr * 64;
        f32x4 t[2][8];
#pragma unroll
        for (int j = 0; j < 2; ++j) { const int q = 2 * lane + j; const int row = rbase + (q >> 6) * HALF + (q & 63);
            const f32x4* p = (const f32x4*)(ssp + (size_t)row * 32);
#pragma unroll
            for (int i = 0; i < 8; ++i) t[j][i] = p[i]; }
        __builtin_amdgcn_sched_barrier(0);
        float rsv[2];
#pragma unroll
        for (int j = 0; j < 2; ++j) { float sm = 0.f;
#pragma unroll
            for (int i = 0; i < 8; ++i) sm += (t[j][i][0] + t[j][i][1]) + (t[j][i][2] + t[j][i][3]);
            rsv[j] = 1.0f / sqrtf(sm * (1.0f / 2048.0f) + 1e-6f); }
        const int row0 = rbase + fr; const int col0 = u.pn * BM + wc * 32 + 8 * fq;
#pragma unroll
        for (int ai = 0; ai < 2; ++ai)
#pragma unroll
            for (int m = 0; m < 4; ++m) { const int q = ai * 64 + m * 16 + fr; const float v0 = __shfl(rsv[0], q >> 1), v1 = __shfl(rsv[1], q >> 1); const float rs = (q & 1) ? v1 : v0;
                bf16_t* rowp = O + (size_t)(row0 + ai * HALF + m * 16) * ldc + col0;
#pragma unroll
                for (int bj = 0; bj < 2; ++bj) { const f32x4 v0_ = acc[ai][bj][m][0] * rs, v1_ = acc[ai][bj][m][1] * rs; u32x4 w;
                    w.x = cvt_pk_bf16(v0_[0], v0_[1]); w.y = cvt_pk_bf16(v0_[2], v0_[3]); w.z = cvt_pk_bf16(v1_[0], v1_[1]); w.w = cvt_pk_bf16(v1_[2], v1_[3]);
                    *(u32x4*)(rowp + bj * HALF) = w; } }
    }
};
struct EpiResid {
    static constexpr bool PERM = false, AFTER_DRAIN = false;
    const float* base; float* X; bf16_t* XB; float* ssp;
    __device__ __forceinline__ void operator()(const f32x4 (&acc)[2][2][4][2], const Unit& u, int wr, int wc, int fr, int fq) const {
        typedef unsigned u32x2v __attribute__((ext_vector_type(2)));
        const int row0 = u.pm * BM + wr * 64 + fr; const int col0 = u.pn * BM + wc * 32 + 4 * fq;
#pragma unroll
        for (int ai = 0; ai < 2; ++ai) {
            f32x4 bs[4][2][2];
#pragma unroll
            for (int m = 0; m < 4; ++m)
#pragma unroll
                for (int bj = 0; bj < 2; ++bj)
#pragma unroll
                    for (int n = 0; n < 2; ++n) bs[m][bj][n] = *(const f32x4*)(base + (size_t)(row0 + ai * HALF + m * 16) * 2048 + col0 + bj * HALF + n * 16);
            __builtin_amdgcn_sched_barrier(0);
#pragma unroll
            for (int m = 0; m < 4; ++m) { const int row = row0 + ai * HALF + m * 16; const size_t off = (size_t)row * 2048 + col0; float ss = 0.f;
#pragma unroll
                for (int bj = 0; bj < 2; ++bj)
#pragma unroll
                    for (int n = 0; n < 2; ++n) { const size_t o2 = off + bj * HALF + n * 16; const f32x4 v = bs[m][bj][n] + acc[ai][bj][m][n];
                        *(f32x4*)(X + o2) = v; u32x2v w; w.x = cvt_pk_bf16(v[0], v[1]); w.y = cvt_pk_bf16(v[2], v[3]); *(u32x2v*)(XB + o2) = w;
                        ss += (v[0] * v[0] + v[1] * v[1]) + (v[2] * v[2] + v[3] * v[3]); }
                ss += __shfl_xor(ss, 16); ss += __shfl_xor(ss, 32);
                if (fq == 0) ssp[(size_t)row * 32 + u.pn * 4 + wc] = ss; }
            asm volatile("" ::: "memory");
        }
    }
};

struct EpiConvGate {
    static constexpr bool PERM = true, AFTER_DRAIN = false;
    bf16_t* ACT; bf16_t* UB; const float* ssp; const float* cw; const float* cb; int dff;
    __device__ __forceinline__ void operator()(const f32x4 (&acc)[2][2][4][2], const Unit& u, int wr, int wc, int fr, int fq) const {
        typedef unsigned u32x2v __attribute__((ext_vector_type(2)));
        const int lane = fq * 16 + fr;
        const int rbase = u.pm * BM + wr * 64;
        const int upw = 2 * dff;
        float rsv[2];
        { f32x4 t[2][8];
#pragma unroll
          for (int j = 0; j < 2; ++j) { const int q = 2 * lane + j; const int row = rbase + (q >> 6) * HALF + (q & 63);
              const f32x4* p = (const f32x4*)(ssp + (size_t)row * 32);
#pragma unroll
              for (int i = 0; i < 8; ++i) t[j][i] = p[i]; }
          __builtin_amdgcn_sched_barrier(0);
#pragma unroll
          for (int j = 0; j < 2; ++j) { float sm = 0.f;
#pragma unroll
              for (int i = 0; i < 8; ++i) sm += (t[j][i][0] + t[j][i][1]) + (t[j][i][2] + t[j][i][3]);
              rsv[j] = 1.0f / sqrtf(sm * (1.0f / 2048.0f) + 1e-6f); } }
        const int src1 = fq * 16 + ((fr + 15) & 15), src2 = fq * 16 + ((fr + 14) & 15);
        const int chb = u.pn * HALF + wc * 32 + 8 * fq;
        const int ucb = u.pn * BM + wc * 32 + 8 * fq;
#pragma unroll
        for (int ai = 0; ai < 2; ++ai) {
#pragma unroll
            for (int n = 0; n < 2; ++n) {
                const int ch = chb + 4 * n;
                const f32x4 wa0 = *(const f32x4*)(cw + ch), wa1 = *(const f32x4*)(cw + upw + ch), wa2 = *(const f32x4*)(cw + 2 * upw + ch);
                const f32x4 wg0 = *(const f32x4*)(cw + dff + ch), wg1 = *(const f32x4*)(cw + upw + dff + ch), wg2 = *(const f32x4*)(cw + 2 * upw + dff + ch);
                const f32x4 ba = *(const f32x4*)(cb + ch), bg = *(const f32x4*)(cb + dff + ch);
                f32x4 pa = {0.f, 0.f, 0.f, 0.f}, pg = {0.f, 0.f, 0.f, 0.f};
#pragma unroll
                for (int m = 0; m < 4; ++m) {
                    const int q = ai * 64 + m * 16 + fr; const float rv0 = __shfl(rsv[0], q >> 1), rv1 = __shfl(rsv[1], q >> 1); const float rsm = (q & 1) ? rv1 : rv0;
                    const f32x4 va = acc[ai][0][m][n] * rsm, vg = acc[ai][1][m][n] * rsm;
                    f32x4 a1, a2, g1, g2;
#pragma unroll
                    for (int x = 0; x < 4; ++x) {
                        const float c1 = __shfl(va[x], src1), c2 = __shfl(va[x], src2), e1 = __shfl(vg[x], src1), e2 = __shfl(vg[x], src2);
                        float d1 = 0.f, d2 = 0.f, f1 = 0.f, f2 = 0.f;
                        if (m > 0) { d1 = __shfl(pa[x], src1); d2 = __shfl(pa[x], src2); f1 = __shfl(pg[x], src1); f2 = __shfl(pg[x], src2); }
                        a1[x] = fr >= 1 ? c1 : d1; a2[x] = fr >= 2 ? c2 : d2; g1[x] = fr >= 1 ? e1 : f1; g2[x] = fr >= 2 ? e2 : f2; }
                    const f32x4 ya = ba + wa0 * va + wa1 * a1 + wa2 * a2, yg = bg + wg0 * vg + wg1 * g1 + wg2 * g2;
                    float r4[4];
#pragma unroll
                    for (int x = 0; x < 4; ++x) r4[x] = ya[x] * yg[x] / (1.f + __expf(-yg[x]));
                    const int row = rbase + ai * HALF + m * 16 + fr;
                    if (m > 0 || fr >= 2) { u32x2v w; w.x = cvt_pk_bf16(r4[0], r4[1]); w.y = cvt_pk_bf16(r4[2], r4[3]); *(u32x2v*)(ACT + (size_t)row * dff + ch) = w; }
                    if ((m == 0 && fr < 2) || (m == 3 && fr >= 14)) { const int k = (m == 0) ? fr : fr - 12; bf16_t* ub = UB + ((size_t)(row >> 6) * 4 + k) * upw + ucb + 4 * n;
                        u32x2v w; w.x = cvt_pk_bf16(va[0], va[1]); w.y = cvt_pk_bf16(va[2], va[3]); *(u32x2v*)ub = w;
                        w.x = cvt_pk_bf16(vg[0], vg[1]); w.y = cvt_pk_bf16(vg[2], vg[3]); *(u32x2v*)(ub + HALF) = w; }
                    pa = va; pg = vg;
                }
                asm volatile("" ::: "memory");
            }
        }
    }
};
template <class Epi, class Sched, bool ALIGN_EPI = false, bool SP2 = false>
__device__ __forceinline__ void gemm_phase(PG8_LAS unsigned char* lds, const Gemm g, const Sched& S, const Epi& E, const int wid_in) {
    int lane_; asm volatile("v_mbcnt_lo_u32_b32 %0, -1, 0\n\tv_mbcnt_hi_u32_b32 %0, -1, %0" : "=v"(lane_)); const int wid = wid_in, lane = lane_, tid = wid * 64 + lane, wr = wid >> 2, wc = wid & 3, fr = lane & 15, fq = lane >> 4;
    const int K = g.K, nt = K / BK;
    unsigned voffA[2], voffB[2];
#pragma unroll
    for (int i = 0; i < 2; ++i) { int R, C; stage_rc(tid * 16 + i * 8192, R, C); const int Rb = Epi::PERM ? ((R & ~31) + perm32(R & 31)) : R;
        voffA[i] = (unsigned)(R * K + C) * 2u; voffB[i] = (unsigned)(Rb * K + C) * 2u; }
    const size_t kstep = (size_t)(BK * 2);
    const size_t hstep = (size_t)HALF * K * 2;
    const size_t tstep = 2 * hstep;
    const unsigned ldsw = (unsigned)wid * 1024u;
    const int aoff = lds_byte(wr * 64 + fr, fq * 8), boff = lds_byte(wc * 32 + fr, fq * 8);
#define PG8_SA(b, h) (((b) * 2 + (h)) * HTB)
#define PG8_SB(b, h) ((4 + (b) * 2 + (h)) * HTB)
#define PG8_STAGE(bufoff, gbase, voff) do { _Pragma("unroll") for (int _i = 0; _i < 2; ++_i) \
        __builtin_amdgcn_global_load_lds((const unsigned*)((const char*)(gbase) + (voff)[_i]), (PG8_LAS unsigned*)(lds + (bufoff) + ldsw + _i * 8192), 16, 0, 0); } while (0)
#define PG8_LDA(dst, b, h) do { _Pragma("unroll") for (int m = 0; m < 4; ++m) _Pragma("unroll") for (int k = 0; k < 2; ++k) dst[m][k] = *(const PG8_LAS bf16x8*)(lds + PG8_SA(b, h) + aoff + m * 2048 + k * 1024); } while (0)
#define PG8_LDB(dst, b, h) do { _Pragma("unroll") for (int n = 0; n < 2; ++n) _Pragma("unroll") for (int k = 0; k < 2; ++k) dst[n][k] = *(const PG8_LAS bf16x8*)(lds + PG8_SB(b, h) + boff + n * 2048 + k * 1024); } while (0)
#define PG8_MMA(ai, bj, At, Bt) do { __builtin_amdgcn_s_setprio(1); _Pragma("unroll") for (int m = 0; m < 4; ++m) _Pragma("unroll") for (int n = 0; n < 2; ++n) _Pragma("unroll") for (int k = 0; k < 2; ++k) \
        acc[ai][bj][m][n] = __builtin_amdgcn_mfma_f32_16x16x32_bf16(Bt[n][k], At[m][k], acc[ai][bj][m][n], 0, 0, 0); __builtin_amdgcn_s_setprio(0); } while (0)
#define PG8_WAIT_V(n) asm volatile("s_waitcnt vmcnt(" #n ")" ::: "memory")
#define PG8_WAIT_L(n) asm volatile("s_waitcnt lgkmcnt(" #n ")" ::: "memory")
#define PG8_BAR __builtin_amdgcn_s_barrier()
#define PG8_SCHED __builtin_amdgcn_sched_barrier(0)
    Unit cur, nxt; int ui = 0;
    if (!S.next(0, cur)) return;
    f32x4 acc[2][2][4][2];
#pragma unroll
    for (int a = 0; a < 2; ++a)
#pragma unroll
        for (int b = 0; b < 2; ++b)
#pragma unroll
            for (int m = 0; m < 4; ++m)
#pragma unroll
                for (int n = 0; n < 2; ++n) acc[a][b][m][n] = (f32x4){0.f, 0.f, 0.f, 0.f};
    bf16x8 At[4][2], B0[2][2], B1[2][2];
    const char* cA = (const char*)g.A + (size_t)cur.pm * tstep; const char* cB = (const char*)g.Bt + (size_t)cur.pn * tstep;
    S.a_ready(cur);
    if constexpr (SP2) {
        PG8_STAGE(PG8_SB(0, 0), cB, voffB); PG8_STAGE(PG8_SB(0, 1), cB + hstep, voffB); PG8_STAGE(PG8_SA(0, 0), cA, voffA); PG8_STAGE(PG8_SA(0, 1), cA + hstep, voffA);
        if (wr == 1) PG8_BAR;
        PG8_WAIT_V(2); PG8_BAR;
        PG8_STAGE(PG8_SB(1, 0), cB + kstep, voffB); PG8_STAGE(PG8_SA(1, 0), cA + kstep, voffA); PG8_STAGE(PG8_SB(1, 1), cB + hstep + kstep, voffB);
        PG8_WAIT_V(6); PG8_BAR;
    } else {
        PG8_STAGE(PG8_SB(0, 0), cB, voffB); PG8_STAGE(PG8_SA(0, 0), cA, voffA); PG8_STAGE(PG8_SB(0, 1), cB + hstep, voffB); PG8_STAGE(PG8_SA(0, 1), cA + hstep, voffA);
        if (wr == 1) PG8_BAR;
        PG8_WAIT_V(4); PG8_BAR;
        PG8_STAGE(PG8_SB(1, 0), cB + kstep, voffB); PG8_STAGE(PG8_SA(1, 0), cA + kstep, voffA); PG8_STAGE(PG8_SB(1, 1), cB + hstep + kstep, voffB);
        PG8_WAIT_V(6); PG8_BAR;
    }
    for (;;) {
        const bool has_next = S.next(ui + 1, nxt);
        const char* nA = has_next ? (const char*)g.A + (size_t)nxt.pm * tstep : cA; const char* nB = has_next ? (const char*)g.Bt + (size_t)nxt.pn * tstep : cB;
        for (int t = 0; t < nt; t += 2) {
            const bool last = (t == nt - 2);
            const char* a1 = cA + (size_t)(t + 1) * kstep;
            const char* a2 = last ? nA : cA + (size_t)(t + 2) * kstep; const char* b2 = last ? nB : cB + (size_t)(t + 2) * kstep;
            const char* a3 = a2 + kstep; const char* b3 = b2 + kstep;
            if (last && has_next) S.a_ready(nxt);
            if constexpr (SP2) {
            PG8_LDB(B0, 0, 0); PG8_LDB(B1, 0, 1); PG8_SCHED; PG8_LDA(At, 0, 0); PG8_STAGE(PG8_SA(1, 1), a1 + hstep, voffA);
            PG8_WAIT_V(8); PG8_WAIT_L(0); PG8_BAR; PG8_MMA(0, 0, At, B0); PG8_MMA(0, 1, At, B1); PG8_BAR; PG8_SCHED;
            PG8_LDA(At, 0, 1); PG8_STAGE(PG8_SB(0, 0), b2, voffB); PG8_STAGE(PG8_SB(0, 1), b2 + hstep, voffB); PG8_STAGE(PG8_SA(0, 0), a2, voffA);
            PG8_WAIT_V(8); PG8_WAIT_L(0); PG8_BAR; PG8_MMA(1, 0, At, B0); PG8_MMA(1, 1, At, B1); PG8_BAR; PG8_SCHED;
            PG8_LDB(B0, 1, 0); PG8_LDB(B1, 1, 1); PG8_SCHED; PG8_LDA(At, 1, 0); PG8_STAGE(PG8_SA(0, 1), a2 + hstep, voffA);
            PG8_WAIT_V(8); PG8_WAIT_L(0); PG8_BAR; PG8_MMA(0, 0, At, B0); PG8_MMA(0, 1, At, B1); PG8_BAR; PG8_SCHED;
            PG8_LDA(At, 1, 1); PG8_STAGE(PG8_SB(1, 0), b3, voffB); PG8_STAGE(PG8_SB(1, 1), b3 + hstep, voffB); PG8_STAGE(PG8_SA(1, 0), a3, voffA);
            PG8_WAIT_V(8); PG8_WAIT_L(0); PG8_BAR; PG8_MMA(1, 0, At, B0); PG8_MMA(1, 1, At, B1); PG8_BAR; PG8_SCHED;
            } else {
            PG8_LDB(B0, 0, 0); PG8_SCHED; PG8_LDA(At, 0, 0); PG8_STAGE(PG8_SA(1, 1), a1 + hstep, voffA);
            PG8_WAIT_L(8); PG8_BAR; PG8_WAIT_L(0); PG8_MMA(0, 0, At, B0); PG8_BAR; PG8_SCHED;
            PG8_LDB(B1, 0, 1); PG8_STAGE(PG8_SB(0, 0), b2, voffB);
            PG8_BAR; PG8_WAIT_L(0); PG8_MMA(0, 1, At, B1); PG8_BAR;
            PG8_LDA(At, 0, 1); PG8_STAGE(PG8_SA(0, 0), a2, voffA);
            PG8_BAR; PG8_WAIT_L(0); PG8_MMA(1, 0, At, B0); PG8_BAR; PG8_SCHED;
            PG8_STAGE(PG8_SB(0, 1), b2 + hstep, voffB);
            PG8_WAIT_V(6); PG8_BAR; PG8_MMA(1, 1, At, B1); PG8_BAR;
            PG8_LDB(B0, 1, 0); PG8_SCHED; PG8_LDA(At, 1, 0); PG8_STAGE(PG8_SA(0, 1), a2 + hstep, voffA);
            PG8_WAIT_L(8); PG8_BAR; PG8_WAIT_L(0); PG8_MMA(0, 0, At, B0); PG8_BAR; PG8_SCHED;
            PG8_LDB(B1, 1, 1); PG8_STAGE(PG8_SB(1, 0), b3, voffB);
            PG8_BAR; PG8_WAIT_L(0); PG8_MMA(0, 1, At, B1); PG8_BAR;
            PG8_LDA(At, 1, 1); PG8_STAGE(PG8_SA(1, 0), a3, voffA);
            PG8_BAR; PG8_WAIT_L(0); PG8_MMA(1, 0, At, B0); PG8_BAR; PG8_SCHED;
            PG8_STAGE(PG8_SB(1, 1), b3 + hstep, voffB);
            PG8_WAIT_V(6); PG8_BAR; PG8_MMA(1, 1, At, B1); PG8_BAR;
            }
        }
        if constexpr (ALIGN_EPI) { if (wr == 0) PG8_BAR; }
        if constexpr (!Epi::AFTER_DRAIN) { E(acc, cur, wr, wc, fr, fq); S.done(cur); }
        if (!has_next) break;
#pragma unroll
        for (int a = 0; a < 2; ++a)
#pragma unroll
            for (int b = 0; b < 2; ++b)
#pragma unroll
                for (int m = 0; m < 4; ++m)
#pragma unroll
                    for (int n = 0; n < 2; ++n) acc[a][b][m][n] = (f32x4){0.f, 0.f, 0.f, 0.f};
        cur = nxt; cA = nA; cB = nB; ++ui;
        if constexpr (ALIGN_EPI) { if (wr == 1) PG8_BAR; }
    }
    PG8_WAIT_V(0);
    if constexpr (!ALIGN_EPI) { if (wr == 0) PG8_BAR; }
    PG8_BAR;
    if constexpr (Epi::AFTER_DRAIN) { E.fused(acc, cur, wr, wc, fr, fq, lds, wid, lane); S.done(cur); }
#undef PG8_SA
#undef PG8_SB
#undef PG8_STAGE
#undef PG8_LDA
#undef PG8_LDB
#undef PG8_MMA
#undef PG8_WAIT_V
#undef PG8_WAIT_L
#undef PG8_BAR
#undef PG8_SCHED
}
}

#define GAS __attribute__((address_space(1)))
#define LAS __attribute__((address_space(3)))
typedef unsigned short bf16_t;
typedef short bf16x8 __attribute__((ext_vector_type(8)));
typedef float f32x4 __attribute__((ext_vector_type(4)));
typedef unsigned u32x4 __attribute__((ext_vector_type(4)));
typedef unsigned u32x2 __attribute__((ext_vector_type(2)));
typedef short s16x4 __attribute__((ext_vector_type(4)));

constexpr int BATCH = 2, SEQ = 8192, DM = 2048, DEPTH = 4, MROWS = BATCH * SEQ;
constexpr int INW = 5796, INP = 5888, DFF = 5632, UPW = 2 * DFF;
constexpr int A_OFF = 0, B_OFF = 2304, CQ_OFF = 3840, CKV_OFF = 4608, CG_OFF = 5760;
constexpr int LUTN = 1536;
constexpr float LOG2E = 1.4426950408889634f, LN2 = 0.6931471805599453f;
constexpr int NTHREADS = 512, NWAVES = 8;

constexpr size_t al256(size_t x) { return (x + 255) & ~(size_t)255; }
constexpr size_t WS_CTL = 0, CTL_BYTES = 1u << 20;
constexpr size_t SZ_WIN = (size_t)INP * DM * 2, SZ_WOUT = (size_t)DM * DM * 2, SZ_WUP = (size_t)UPW * DM * 2, SZ_WDN = (size_t)DM * DFF * 2;
constexpr size_t WS_WIN = CTL_BYTES;
constexpr size_t WS_WOUT = WS_WIN + DEPTH * SZ_WIN;
constexpr size_t WS_WUP = WS_WOUT + DEPTH * SZ_WOUT;
constexpr size_t WS_WDN = WS_WUP + DEPTH * SZ_WUP;
constexpr size_t WS_W1T = WS_WDN + DEPTH * SZ_WDN;
constexpr size_t WS_W2T = WS_W1T + (size_t)DEPTH * 2 * 128 * 2048 * 2;
constexpr size_t WS_CPE = WS_W2T + (size_t)DEPTH * 2 * 64 * 128 * 2;
constexpr size_t WS_GLUT = al256(WS_CPE + (size_t)DEPTH * 2 * 128 * 4);
constexpr size_t WS_X = al256(WS_GLUT + (size_t)32 * LUTN * 4);
constexpr size_t WS_XB = WS_X + (size_t)MROWS * DM * 4;
constexpr size_t WS_SSP = WS_XB + (size_t)MROWS * DM * 2;
constexpr size_t WS_R1 = WS_SSP + (size_t)MROWS * 32 * 4;
constexpr size_t WS_PROJ = WS_R1;
constexpr size_t WS_O = WS_R1 + (size_t)MROWS * INP * 2;
constexpr size_t WS_U = WS_R1;
constexpr size_t SZ_R1 = (size_t)MROWS * UPW * 2;
static_assert((size_t)MROWS * INP * 2 + (size_t)MROWS * DM * 2 <= SZ_R1, "overlay");
constexpr size_t WS_ACT = WS_R1 + SZ_R1;
constexpr size_t WS_TOT = WS_ACT + (size_t)MROWS * DFF * 2;
constexpr size_t WS_LSE = WS_TOT + (size_t)MROWS * 768 * 4;
constexpr size_t WS_KC = WS_LSE + (size_t)MROWS * 12 * 4;
constexpr size_t WS_VC = WS_KC + (size_t)BATCH * 3 * 512 * 64 * 2;
constexpr size_t WS_KMEAN = WS_VC + (size_t)BATCH * 3 * 512 * 64 * 2;
constexpr size_t WS_UB = WS_KMEAN + (size_t)BATCH * 8 * 32 * 64 * 4;
constexpr size_t WS_END = WS_UB + (size_t)(MROWS / 64) * 4 * UPW * 2;

constexpr int KP = 160;
constexpr int TILE_B = 64 * KP;
constexpr int L_K0 = 0, L_V0 = TILE_B, L_K1 = 2 * TILE_B, L_V1 = 3 * TILE_B;
constexpr int L_LUT = 4 * TILE_B;
constexpr int L_IMP = L_LUT + 4 * LUTN * 4;
constexpr int L_SEL = L_IMP + 65536;
constexpr int L_TL = L_SEL + 2048;
constexpr int L_MISC = L_TL + 2048;
constexpr int L_WUN = L_MISC + 64;
constexpr int LDS_BYTES = 147456;
static_assert(L_MISC + 256 <= LDS_BYTES, "lds map");

struct Params {
    const float* x; const float* rel; const float* w_in; const float* w_out; const float* cmp_w1; const float* cmp_w2; const float* cmp_pe;
    const float* norm_attn; const float* norm_mlp; const float* w_up; const float* conv_w; const float* conv_b; const float* w_down; const float* norm_final;
    float* out; unsigned char* ws;
};

typedef float f32x2_t __attribute__((ext_vector_type(2))); typedef __bf16 bf16x2_t __attribute__((ext_vector_type(2)));
__device__ __forceinline__ unsigned cvtpk(float lo, float hi) { f32x2_t v = {lo, hi}; bf16x2_t b = __builtin_convertvector(v, bf16x2_t); return __builtin_bit_cast(unsigned, b); }
__device__ __forceinline__ float bf2f(unsigned short b) { return __uint_as_float(((unsigned)b) << 16); }
__device__ __forceinline__ float bflo(unsigned w) { return __uint_as_float(w << 16); }
__device__ __forceinline__ float bfhi(unsigned w) { return __uint_as_float(w & 0xffff0000u); }
__device__ __forceinline__ float fexp2(float x) { return __builtin_amdgcn_exp2f(x); }
__device__ __forceinline__ int lane_id_opaque() { int l_; asm volatile("v_mbcnt_lo_u32_b32 %0, -1, 0\n\tv_mbcnt_hi_u32_b32 %0, -1, %0" : "=v"(l_)); return l_; }
#define LDS_BARRIER() do { asm volatile("s_waitcnt lgkmcnt(0)" ::: "memory"); __builtin_amdgcn_s_barrier(); asm volatile("" ::: "memory"); } while (0)
__device__ __forceinline__ void lds_wait() { asm volatile("s_waitcnt lgkmcnt(0)" ::: "memory"); }
__device__ __forceinline__ s16x4 tr_read(const LAS unsigned char* p) { return __builtin_bit_cast(s16x4, __builtin_amdgcn_ds_read_tr16_b64_v4i16((LAS s16x4*)p)); }
__device__ __forceinline__ f32x4 mfma16(bf16x8 a, bf16x8 b, f32x4 c) { return __builtin_amdgcn_mfma_f32_16x16x32_bf16(a, b, c, 0, 0, 0); }

__device__ __forceinline__ int t5_bucket(int n) {
    if (n < 16) return n < 0 ? 0 : n;
    int b = 16;
    b += n >= 22; b += n >= 30; b += n >= 40; b += n >= 54; b += n >= 73; b += n >= 99; b += n >= 134; b += n >= 182;
    b += n >= 246; b += n >= 332; b += n >= 450; b += n >= 609; b += n >= 825; b += n >= 1117; b += n >= 1513;
    return b;
}
__device__ __forceinline__ bool is_qcol(int n) { return (n < 2304) ? ((n % 768) < 256) : ((n < 2816) || (n >= 3840 && n < 4608)); }

template <int MODE>
__device__ __forceinline__ void p0_item(const float* W, int K, int Nsrc, bf16_t* WT, const float* kscale, LAS float* scr, int kb, int nb, int lane) {
    const int k0 = 64 * kb, n0 = 32 * nb;
    const int nd = n0 + (lane & 31);
    int sc = nd; float cs = 1.f; bool ok = true;
    if (MODE == 0) { ok = nd < INW; if (is_qcol(nd)) cs = 0.125f; }
    if (MODE == 2) { const int pn = nd >> 8, r = nd & 255; sc = (r >= 128 ? DFF : 0) + 128 * pn + (r & 127); }
    float wv[32], kv_[32];
    const float* wp_ = W + (size_t)(k0 + (lane >> 5)) * Nsrc + (ok ? sc : 0);
#pragma unroll
    for (int i = 0; i < 32; ++i) { wv[i] = wp_[(size_t)(2 * i) * Nsrc]; kv_[i] = (MODE != 1) ? kscale[k0 + 2 * i + (lane >> 5)] : 1.f; }
    __builtin_amdgcn_sched_barrier(0);
#pragma unroll
    for (int i = 0; i < 32; ++i) { const int kk = 2 * i + (lane >> 5); scr[kk * 33 + (lane & 31)] = ok ? wv[i] * cs * kv_[i] : 0.f; }
    lds_wait();
    const int c = lane & 7;
#pragma unroll
    for (int j = 0; j < 4; ++j) { const int n = (lane >> 3) + 8 * j; const LAS float* s = scr + (8 * c) * 33 + n;
        u32x4 o; o.x = cvtpk(s[0 * 33], s[1 * 33]); o.y = cvtpk(s[2 * 33], s[3 * 33]); o.z = cvtpk(s[4 * 33], s[5 * 33]); o.w = cvtpk(s[6 * 33], s[7 * 33]);
        *(u32x4*)(WT + (size_t)(n0 + n) * K + k0 + 8 * c) = o; }
    lds_wait();
}

constexpr int I_IN = 32 * (INP / 32), I_OUT = 32 * 64, I_UP = 32 * (UPW / 32), I_DN = (DFF / 64) * 64, I_W1 = 2 * 32 * 4, I_W2 = 2 * 2 * 2;
constexpr int I_LAYER = I_IN + I_OUT + I_UP + I_DN + I_W1 + I_W2;
__device__ __forceinline__ void p0_layer_item(const Params& P, LAS float* scr, int l, int r, int lane) {
    unsigned char* ws = P.ws;
    if (r < I_IN) { p0_item<0>(P.w_in + (size_t)l * DM * INW, DM, INW, (bf16_t*)(ws + WS_WIN + l * SZ_WIN), P.norm_attn + l * DM, scr, r / (INP / 32), r % (INP / 32), lane); return; } r -= I_IN;
    if (r < I_OUT) { p0_item<1>(P.w_out + (size_t)l * DM * DM, DM, DM, (bf16_t*)(ws + WS_WOUT + l * SZ_WOUT), nullptr, scr, r / 64, r % 64, lane); return; } r -= I_OUT;
    if (r < I_UP) { p0_item<2>(P.w_up + (size_t)l * DM * UPW, DM, UPW, (bf16_t*)(ws + WS_WUP + l * SZ_WUP), P.norm_mlp + l * DM, scr, r / (UPW / 32), r % (UPW / 32), lane); return; } r -= I_UP;
    if (r < I_DN) { p0_item<1>(P.w_down + (size_t)l * DFF * DM, DFF, DM, (bf16_t*)(ws + WS_WDN + l * SZ_WDN), nullptr, scr, r / 64, r % 64, lane); return; } r -= I_DN;
    if (r < I_W1) { const int i = r / 128, rr = r % 128; p0_item<1>(P.cmp_w1 + (size_t)(l * 2 + i) * 2048 * 128, 2048, 128, (bf16_t*)(ws + WS_W1T) + (size_t)(l * 2 + i) * 128 * 2048, nullptr, scr, rr / 4, rr % 4, lane); return; } r -= I_W1;
    { const int i = r / 4, rr = r % 4; p0_item<1>(P.cmp_w2 + (size_t)(l * 2 + i) * 128 * 64, 128, 64, (bf16_t*)(ws + WS_W2T) + (size_t)(l * 2 + i) * 64 * 128, nullptr, scr, rr / 2, rr % 2, lane); }
}
#ifdef NO_TAILFILL
constexpr int P0_LAYERS = DEPTH;
#else
constexpr int P0_LAYERS = 1;
#endif
constexpr int CONV_UNIT_ITEMS = 64, N_CONV_UNITS = (I_LAYER + CONV_UNIT_ITEMS - 1) / CONV_UNIT_ITEMS;

__device__ __forceinline__ void p0_prologue(const Params& P, LAS unsigned char* lds, int tid, int lane, int wave) {
    unsigned char* ws = P.ws;
    LAS float* scr = (LAS float*)(lds + wave * 16384);
    const int G = gridDim.x, gw = blockIdx.x * NWAVES + wave, NGW = G * NWAVES;
    for (int it = gw; it < P0_LAYERS * I_LAYER; it += NGW) p0_layer_item(P, scr, it / I_LAYER, it % I_LAYER, lane);
    for (int m = gw; m < MROWS; m += NGW) {
        const f32x4* xr = (const f32x4*)(P.x + (size_t)m * DM) + lane; float s = 0.f;
        u32x2* ob = (u32x2*)((bf16_t*)(ws + WS_XB) + (size_t)m * DM) + lane;
#pragma unroll
        for (int j = 0; j < 8; ++j) { const f32x4 v = xr[64 * j]; s += (v[0] * v[0] + v[1] * v[1]) + (v[2] * v[2] + v[3] * v[3]); u32x2 w; w.x = cvtpk(v[0], v[1]); w.y = cvtpk(v[2], v[3]); ob[64 * j] = w; }
#pragma unroll
        for (int o = 1; o < 64; o <<= 1) s += __shfl_xor(s, o);
        if (lane < 32) ((float*)(ws + WS_SSP))[(size_t)m * 32 + lane] = (lane == 0) ? s : 0.f;
    }
    for (int i = blockIdx.x * NTHREADS + tid; i < 32 * LUTN; i += G * NTHREADS) { const int h = i / LUTN, n = i % LUTN; ((float*)(ws + WS_GLUT))[i] = P.rel[h * 32 + t5_bucket(n)] * LOG2E; }
    if (blockIdx.x < DEPTH * 2) {
        __syncthreads();
        const int li = blockIdx.x, kp = tid >> 7, hid = tid & 127; const float* pe = P.cmp_pe + (size_t)li * 2048; const float* w1 = P.cmp_w1 + (size_t)li * 2048 * 128;
        float s = 0.f;
#pragma unroll 8
        for (int k = kp * 512; k < kp * 512 + 512; ++k) s += pe[k] * w1[(size_t)k * 128 + hid];
        LAS float* red = (LAS float*)lds; red[tid] = s; __syncthreads();
        if (tid < 128) ((float*)(ws + WS_CPE))[li * 128 + tid] = (red[tid] + red[tid + 128]) + (red[tid + 256] + red[tid + 384]);
        __syncthreads();
    }
}

struct Src { const bf16_t* kb; const bf16_t* vb; int stride; int dil; int roff; };

template <int QG, int MODE>
__device__ __forceinline__ void flash_tile(LAS unsigned char* lds, const int buf, const int k0, const int tag, const int dil, const bf16x8 (&qf)[QG][2], f32x4 (&o)[QG][4], float (&m)[QG], float (&l)[QG],
                                           const int qc, const int qcw_min, const int qcw_max, const int maxrel, const LAS unsigned* selp, const LAS unsigned* wunp,
                                           const float (&invl)[QG], LAS float* impw, const bool imp_acc, const LAS float* lut, float& carryB, const int lane) {
    const int g = lane >> 4, i16 = lane & 15;
    bool skip = (k0 > qcw_max) || (maxrel != 0x7fffffff && k0 + 63 < qcw_min - maxrel);
    if (tag >= 0) { const unsigned w = (unsigned)__builtin_amdgcn_readfirstlane((int)wunp[tag >> 5]); if (!((w >> (tag & 31)) & 1u)) skip = true; }
    if (MODE & 4) skip = false;
    if (!skip) {
        const LAS unsigned char* Ks = lds + (buf ? L_K1 : L_K0);
        const LAS unsigned char* Vs = lds + (buf ? L_V1 : L_V0);
        bool allowed = true;
        if (tag >= 0) { const unsigned w = selp[tag >> 5]; allowed = ((w >> (tag & 31)) & 1u) != 0u; }
        float impA[4] = {0.f, 0.f, 0.f, 0.f}, impB[4] = {0.f, 0.f, 0.f, 0.f};
        const int dl_ = qcw_min - (k0 + 63), dh_ = qcw_max - k0;
        bool uni = (k0 >= 0) && (dl_ >= 0) && (maxrel == 0x7fffffff || dh_ <= maxrel);
        if (MODE & 1) uni = uni && (dl_ * dil >= 1513);
        const unsigned uni_di = (unsigned)(dl_ * dil) < (unsigned)(LUTN - 1) ? (unsigned)(dl_ * dil) : (unsigned)(LUTN - 1);
        const bool mid = (MODE & 1) && !uni && (dil == 1) && (k0 >= 0) && (dl_ >= 0) && (maxrel == 0x7fffffff || dh_ <= maxrel) && (dh_ <= LUTN - 1);
#pragma unroll
        for (int qg = 0; qg < QG; ++qg) {
            bf16x8 kf[4][2];
#pragma unroll
            for (int kt = 0; kt < 4; ++kt)
#pragma unroll
                for (int ks = 0; ks < 2; ++ks) kf[kt][ks] = *(const LAS bf16x8*)(Ks + (16 * kt + i16) * KP + ks * 64 + g * 16);
            __builtin_amdgcn_sched_barrier(0);
            f32x4 s[4];
#pragma unroll
            for (int kt = 0; kt < 4; ++kt) { s[kt] = (f32x4){0.f, 0.f, 0.f, 0.f};
#pragma unroll
                for (int ks = 0; ks < 2; ++ks) s[kt] = mfma16(kf[kt][ks], qf[qg][ks], s[kt]); }
            bf16x8 vfr[4][2];
            if (!(MODE & 2)) {
#pragma unroll
                for (int dt = 0; dt < 4; ++dt)
#pragma unroll
                    for (int s2 = 0; s2 < 2; ++s2) { const LAS unsigned char* vp = Vs + (32 * s2 + 4 * g + (i16 >> 2)) * KP + (16 * dt + 4 * (i16 & 3)) * 2;
                        const s16x4 lo = tr_read(vp), hi = tr_read(vp + 16 * KP);
                        vfr[dt][s2] = (bf16x8){lo[0], lo[1], lo[2], lo[3], hi[0], hi[1], hi[2], hi[3]}; }
            }
            __builtin_amdgcn_sched_barrier(0);
            float mx = -INFINITY; float lanebias = 0.f;
            if (uni) {
                float lb = 0.f;
                if (MODE & 1) lb = lut[qg * LUTN + uni_di];
                lanebias = allowed ? lb : -INFINITY;
                float mr = -INFINITY;
#pragma unroll
                for (int kt = 0; kt < 4; ++kt)
#pragma unroll
                    for (int r = 0; r < 4; ++r) mr = fmaxf(mr, s[kt][r]);
                mx = allowed ? __builtin_fmaf(mr, LOG2E, lb) : -INFINITY;
            } else if (mid) {
                const LAS float* lp = lut + qg * LUTN + (qc - k0 - 4 * g - 63);
                float bv[4][4];
#pragma unroll
                for (int kt = 0; kt < 4; ++kt)
#pragma unroll
                    for (int r = 0; r < 4; ++r) bv[kt][r] = lp[63 - 16 * kt - r];
                __builtin_amdgcn_sched_barrier(0);
#pragma unroll
                for (int kt = 0; kt < 4; ++kt)
#pragma unroll
                    for (int r = 0; r < 4; ++r) { float sc = __builtin_fmaf(s[kt][r], LOG2E, bv[kt][r]); sc = allowed ? sc : -INFINITY; s[kt][r] = sc; mx = fmaxf(mx, sc); }
            } else {
                float bv[4][4];
#pragma unroll
                for (int kt = 0; kt < 4; ++kt)
#pragma unroll
                    for (int r = 0; r < 4; ++r) { bv[kt][r] = 0.f;
                        if (MODE & 1) { const int rel = qc - (k0 + 16 * kt + 4 * g + r); unsigned di = (unsigned)(rel * dil); di = di < (unsigned)(LUTN - 1) ? di : (unsigned)(LUTN - 1); bv[kt][r] = lut[qg * LUTN + di]; } }
                if (MODE & 1) __builtin_amdgcn_sched_barrier(0);
#pragma unroll
                for (int kt = 0; kt < 4; ++kt)
#pragma unroll
                    for (int r = 0; r < 4; ++r) { const int kc = k0 + 16 * kt + 4 * g + r; const int rel = qc - kc;
                        const bool ok = allowed && ((unsigned)rel <= (unsigned)maxrel) && (kc >= 0);
                        float sc = __builtin_fmaf(s[kt][r], LOG2E, bv[kt][r]);
                        sc = ok ? sc : -INFINITY; s[kt][r] = sc; mx = fmaxf(mx, sc); }
            }
            mx = fmaxf(mx, __shfl_xor(mx, 16)); mx = fmaxf(mx, __shfl_xor(mx, 32));
            const float mnew = fmaxf(m[qg], mx); const float alpha = fexp2(m[qg] - mnew); m[qg] = mnew;
            float rs = 0.f;
            if (uni) { const float cb_ = lanebias - mnew;
#pragma unroll
                for (int kt = 0; kt < 4; ++kt)
#pragma unroll
                    for (int r = 0; r < 4; ++r) { const float p = fexp2(__builtin_fmaf(s[kt][r], LOG2E, cb_)); s[kt][r] = p; rs += p; }
            } else {
#pragma unroll
                for (int kt = 0; kt < 4; ++kt)
#pragma unroll
                    for (int r = 0; r < 4; ++r) { const float p = fexp2(s[kt][r] - mnew); s[kt][r] = p; rs += p; }
            }
            rs += __shfl_xor(rs, 16); rs += __shfl_xor(rs, 32);
            l[qg] = l[qg] * alpha + rs;
            if (MODE & 4) {
#pragma unroll
                for (int kt = 0; kt < 4; ++kt) { impA[kt] += ((s[kt][0] + s[kt][1]) + (s[kt][2] + s[kt][3])) * invl[qg]; impB[kt] += s[kt][3] * invl[qg]; }
            }
            if (!(MODE & 2)) {
#pragma unroll
                for (int dt = 0; dt < 4; ++dt) o[qg][dt] = o[qg][dt] * alpha;
                bf16x8 pf[2];
#pragma unroll
                for (int s2 = 0; s2 < 2; ++s2) { u32x4 w; w.x = cvtpk(s[2 * s2][0], s[2 * s2][1]); w.y = cvtpk(s[2 * s2][2], s[2 * s2][3]); w.z = cvtpk(s[2 * s2 + 1][0], s[2 * s2 + 1][1]); w.w = cvtpk(s[2 * s2 + 1][2], s[2 * s2 + 1][3]);
                    pf[s2] = __builtin_bit_cast(bf16x8, w); }
#pragma unroll
                for (int dt = 0; dt < 4; ++dt)
#pragma unroll
                    for (int s2 = 0; s2 < 2; ++s2) o[qg][dt] = mfma16(vfr[dt][s2], pf[s2], o[qg][dt]);
            }
            if (QG > 1) asm volatile("" ::: "memory");
        }
        if (MODE & 4) {
            const int srcl = (lane + 48) & 63;
#pragma unroll
            for (int kt = 0; kt < 4; ++kt) { const float pb = (kt == 0) ? carryB : impB[kt == 0 ? 0 : kt - 1];
                const float x0 = __shfl(pb, srcl), x1 = __shfl(impB[kt], srcl); const float add = (g == 0) ? x0 : x1;
                const int J = 4 * ((k0 >> 4) + kt) + g; const float prevv = imp_acc ? impw[i16 * 128 + J] : 0.f; impw[i16 * 128 + J] = prevv + impA[kt] + add; }
            carryB = impB[3];
        }
    }
}

template <int QG, int MODE>
__device__ __forceinline__ void flash_run(LAS unsigned char* lds, const Src S, const int ntiles, const bf16x8 (&qf)[QG][2], f32x4 (&o)[QG][4], float (&m)[QG], float (&l)[QG],
                                          const int qc, const int qcw_min, const int qcw_max, const int maxrel, const LAS unsigned* selp, const LAS unsigned* wunp,
                                          const float (&invl)[QG], LAS float* impw, const bool imp_acc, const int lutslot, const int lane, const int tid) {
    const LAS int* tl = (const LAS int*)(lds + L_TL);
    const LAS float* lut = (const LAS float*)(lds + L_LUT) + lutslot * LUTN;
    const int srow = tid >> 3, sch = tid & 7;
    u32x4 kr0 = {0, 0, 0, 0}, vr0 = {0, 0, 0, 0}, kr1 = {0, 0, 0, 0}, vr1 = {0, 0, 0, 0};
    float carryB = 0.f;
#define FL_ISSUE(i, KR, VR) do { int c_ = __builtin_amdgcn_readfirstlane(tl[2 * (i)]) + srow; c_ = c_ < 0 ? 0 : c_; const size_t off_ = (size_t)(c_ * S.dil + S.roff) * S.stride + sch * 8; \
        KR = *(const u32x4*)(S.kb + off_); if (!(MODE & 2)) VR = *(const u32x4*)(S.vb + off_); } while (0)
#define FL_COMMIT(b, KR, VR) do { *(LAS u32x4*)(lds + ((b) ? L_K1 : L_K0) + srow * KP + sch * 16) = KR; if (!(MODE & 2)) *(LAS u32x4*)(lds + ((b) ? L_V1 : L_V0) + srow * KP + sch * 16) = VR; } while (0)
#define FL_TILE(i, b) flash_tile<QG, MODE>(lds, b, __builtin_amdgcn_readfirstlane(tl[2 * (i)]), __builtin_amdgcn_readfirstlane(tl[2 * (i) + 1]), S.dil, qf, o, m, l, qc, qcw_min, qcw_max, maxrel, selp, wunp, invl, impw, imp_acc, lut, carryB, lane)
    LDS_BARRIER();
    if (ntiles > 0) { FL_ISSUE(0, kr0, vr0); if (ntiles > 1) FL_ISSUE(1, kr1, vr1); FL_COMMIT(0, kr0, vr0); }
    LDS_BARRIER();
    for (int i = 0; i < ntiles; i += 2) {
        if (i + 2 < ntiles) FL_ISSUE(i + 2, kr0, vr0);
        FL_TILE(i, 0);
        if (i + 1 < ntiles) FL_COMMIT(1, kr1, vr1);
        LDS_BARRIER();
        if (i + 1 >= ntiles) break;
        if (i + 3 < ntiles) FL_ISSUE(i + 3, kr1, vr1);
        FL_TILE(i + 1, 1);
        if (i + 2 < ntiles) FL_COMMIT(0, kr0, vr0);
        LDS_BARRIER();
    }
#undef FL_ISSUE
#undef FL_COMMIT
#undef FL_TILE
}

template <int QG> __device__ __forceinline__ void flash_init(f32x4 (&o)[QG][4], float (&m)[QG], float (&l)[QG]) {
#pragma unroll
    for (int q = 0; q < QG; ++q) { m[q] = -1e30f; l[q] = 0.f;
#pragma unroll
        for (int d = 0; d < 4; ++d) o[q][d] = (f32x4){0.f, 0.f, 0.f, 0.f}; }
}
template <int NH>
__device__ __forceinline__ void load_lut(LAS unsigned char* lds, const float* glut, int head0, int tid) {
    LAS float* lut = (LAS float*)(lds + L_LUT); const float* src = glut + (size_t)head0 * LUTN;
    float v[NH * 3];
#pragma unroll
    for (int i = 0; i < NH * 3; ++i) v[i] = src[tid + NTHREADS * i];
    __builtin_amdgcn_sched_barrier(0);
#pragma unroll
    for (int i = 0; i < NH * 3; ++i) lut[tid + NTHREADS * i] = v[i];
}
__device__ __forceinline__ int next_unit(unsigned* ctr, LAS unsigned char* lds, int tid) {
    LAS int* slot = (LAS int*)(lds + L_MISC);
    __syncthreads();
    if (tid == 0) *slot = (int)atomicAdd(ctr, 1u);
    __syncthreads();
    return *slot;
}

__device__ __forceinline__ void unit_mixA(const Params& P, LAS unsigned char* lds, int uid, int tid, int lane, int wave) {
    unsigned char* ws = P.ws; const bf16_t* proj = (const bf16_t*)(ws + WS_PROJ);
    const int b = uid / 768; int rem = uid % 768; const int gi = rem / 256; rem %= 256; const int hs = rem / 64, idx = rem % 64;
    const int d = gi == 0 ? 1 : (gi == 1 ? 4 : 16); const int rc = idx % d, nb = idx / d;
    const int g = lane >> 4, i16 = lane & 15;
    load_lut<1>(lds, (const float*)(ws + WS_GLUT), gi * 4 + hs, tid);
    const int ntiles = nb == 0 ? 2 : 4;
    if (tid < 4) { LAS int* tl = (LAS int*)(lds + L_TL); const int i = tid + (nb == 0 ? 2 : 0); if (i < 4) { tl[2 * tid] = nb * 128 - 128 + 64 * i; tl[2 * tid + 1] = -1; } }
    const int qi = nb * 128 + 16 * wave + i16; const int tok = qi * d + rc; const size_t row = (size_t)b * SEQ + tok;
    const int colq = A_OFF + gi * 768 + hs * 64;
    bf16x8 qf[1][2];
#pragma unroll
    for (int ks = 0; ks < 2; ++ks) qf[0][ks] = *(const bf16x8*)(proj + row * INP + colq + ks * 32 + g * 8);
    f32x4 o[1][4]; float m[1], l[1]; flash_init<1>(o, m, l);
    const float il[1] = {0.f};
    Src S{proj + (size_t)b * SEQ * INP + colq + 256, proj + (size_t)b * SEQ * INP + colq + 512, INP, d, rc};
    flash_run<1, 1>(lds, S, ntiles, qf, o, m, l, qi, nb * 128 + 16 * wave, nb * 128 + 16 * wave + 15, 128, nullptr, nullptr, il, nullptr, false, 0, lane, tid);
    const float inv = l[0] > 0.f ? 1.f / l[0] : 0.f;
    bf16_t* O = (bf16_t*)(ws + WS_O) + row * 2048 + gi * 256 + hs * 64;
#pragma unroll
    for (int dt = 0; dt < 4; ++dt) { u32x2 w; w.x = cvtpk(o[0][dt][0] * inv, o[0][dt][1] * inv); w.y = cvtpk(o[0][dt][2] * inv, o[0][dt][3] * inv); *(u32x2*)(O + 16 * dt + 4 * g) = w; }
    if (g == 0) ((float*)(ws + WS_LSE))[row * 12 + gi * 4 + hs] = (m[0] + __log2f(fmaxf(l[0], 1e-30f))) * LN2;
}

__device__ __forceinline__ void unit_moba(const Params& P, LAS unsigned char* lds, int b, int h, int c, int tid, int lane, int wave) {
    unsigned char* ws = P.ws; const bf16_t* proj = (const bf16_t*)(ws + WS_PROJ);
    const int g = lane >> 4, i16 = lane & 15;
    const int t0 = c * 128, ob = t0 >> 8;
    load_lut<1>(lds, (const float*)(ws + WS_GLUT), 12 + h, tid);
    LAS float* km = (LAS float*)(lds + L_IMP);
    { const float* src = (const float*)(ws + WS_KMEAN) + (size_t)(b * 8 + h) * 2048; float kv4[4];
#pragma unroll
      for (int i = 0; i < 4; ++i) kv4[i] = src[tid + NTHREADS * i];
      __builtin_amdgcn_sched_barrier(0);
#pragma unroll
      for (int i = 0; i < 4; ++i) km[tid + NTHREADS * i] = kv4[i]; }
    LAS unsigned* misc = (LAS unsigned*)(lds + L_MISC);
    if (tid == 0) misc[1] = 0u;
    __syncthreads();
    const int tok = t0 + 16 * wave + i16; const size_t row = (size_t)b * SEQ + tok;
    const int colq = B_OFF + h * 64;
    bf16x8 qf[1][2];
#pragma unroll
    for (int ks = 0; ks < 2; ++ks) qf[0][ks] = *(const bf16x8*)(proj + row * INP + colq + ks * 32 + g * 8);
    unsigned sel = 0u;
    if (ob > 0) {
        float gt[8];
#pragma unroll
        for (int k = 0; k < 8; ++k) gt[k] = 0.f;
#pragma unroll 1
        for (int dc = 0; dc < 8; ++dc) { const u32x4 qw = *(const u32x4*)(proj + row * INP + colq + dc * 8);
            const float q0 = bflo(qw.x), q1 = bfhi(qw.x), q2 = bflo(qw.y), q3 = bfhi(qw.y), q4 = bflo(qw.z), q5 = bfhi(qw.z), q6 = bflo(qw.w), q7 = bfhi(qw.w);
#pragma unroll
            for (int k = 0; k < 8; ++k) { const LAS f32x4* kr = (const LAS f32x4*)(km + (8 * g + k) * 64 + dc * 8); const f32x4 a = kr[0], bq = kr[1];
                gt[k] += (q0 * a[0] + q1 * a[1]) + (q2 * a[2] + q3 * a[3]) + (q4 * bq[0] + q5 * bq[1]) + (q6 * bq[2] + q7 * bq[3]); } }
#pragma unroll
        for (int k = 0; k < 8; ++k) if (8 * g + k >= ob) gt[k] = -INFINITY;
#pragma unroll
        for (int it = 0; it < 3; ++it) {
            float best = -INFINITY; int bi = 99;
#pragma unroll
            for (int k = 0; k < 8; ++k) if (gt[k] > best) { best = gt[k]; bi = 8 * g + k; }
#pragma unroll
            for (int off = 16; off <= 32; off <<= 1) { const float ob_ = __shfl_xor(best, off); const int oi = __shfl_xor(bi, off); if (ob_ > best || (ob_ == best && oi < bi)) { best = ob_; bi = oi; } }
            if (bi < 32) { sel |= 1u << bi;
#pragma unroll
                for (int k = 0; k < 8; ++k) if (8 * g + k == bi) gt[k] = -INFINITY; }
        }
    }
    unsigned wu = sel;
#pragma unroll
    for (int off = 1; off < 16; off <<= 1) wu |= (unsigned)__shfl_xor((int)wu, off);
    wu = (unsigned)__builtin_amdgcn_readfirstlane((int)wu);
    LAS unsigned* selS = (LAS unsigned*)(lds + L_SEL); LAS unsigned* wunS = (LAS unsigned*)(lds + L_WUN) + wave * 4;
    if (g == 0) selS[(16 * wave + i16) * 4] = sel;
    if (lane == 0) wunS[0] = wu;
    __syncthreads();
    unsigned um = 0u;
#pragma unroll
    for (int w8 = 0; w8 < 8; ++w8) um |= ((const LAS unsigned*)(lds + L_WUN))[w8 * 4];
    if (tid == 0) { LAS int* tl = (LAS int*)(lds + L_TL); int n = 0;
        for (int blk = 0; blk < ob; ++blk) if ((um >> blk) & 1u) for (int s4 = 0; s4 < 4; ++s4) { tl[2 * n] = blk * 256 + 64 * s4; tl[2 * n + 1] = blk; ++n; }
        for (int k0 = ob * 256; k0 < t0 + 128; k0 += 64) { tl[2 * n] = k0; tl[2 * n + 1] = -1; ++n; }
        misc[2] = (unsigned)n; }
    __syncthreads();
    const int ntiles = (int)misc[2];
    f32x4 o[1][4]; float m[1], l[1]; flash_init<1>(o, m, l);
    const float il[1] = {0.f};
    Src S{proj + (size_t)b * SEQ * INP + colq + 512, proj + (size_t)b * SEQ * INP + colq + 1024, INP, 1, 0};
    flash_run<1, 1>(lds, S, ntiles, qf, o, m, l, tok, t0 + 16 * wave, t0 + 16 * wave + 15, 0x7fffffff, selS + (16 * wave + i16) * 4, wunS, il, nullptr, false, 0, lane, tid);
    const float inv = l[0] > 0.f ? 1.f / l[0] : 0.f;
    bf16_t* O = (bf16_t*)(ws + WS_O) + row * 2048 + 768 + h * 64;
#pragma unroll
    for (int dt = 0; dt < 4; ++dt) { u32x2 w; w.x = cvtpk(o[0][dt][0] * inv, o[0][dt][1] * inv); w.y = cvtpk(o[0][dt][2] * inv, o[0][dt][3] * inv); *(u32x2*)(O + 16 * dt + 4 * g) = w; }
}

__device__ __forceinline__ float sigmoidf_(float x) { return 1.f / (1.f + __expf(-x)); }
#ifndef NSA_QG
#define NSA_QG 2
#endif
__device__ __forceinline__ void unit_nsa(const Params& P, LAS unsigned char* lds, int b, int kv, int c, int tid, int lane, int wave) {
    unsigned char* ws = P.ws; const bf16_t* proj = (const bf16_t*)(ws + WS_PROJ);
    const int g = lane >> 4, i16 = lane & 15;
    const int t0 = c * 128;
    const int tok = t0 + 16 * wave + i16; const size_t row = (size_t)b * SEQ + tok;
    load_lut<4>(lds, (const float*)(ws + WS_GLUT), 20 + kv * 4, tid);
    LAS int* tl = (LAS int*)(lds + L_TL);
    LAS unsigned* misc = (LAS unsigned*)(lds + L_MISC);
    LAS unsigned* selS = (LAS unsigned*)(lds + L_SEL);
    LAS float* impw = (LAS float*)(lds + L_IMP) + wave * 2048;
    const int ntc = ((t0 + 96) >> 4) / 64 + 1;
    if (tid < ntc) { tl[2 * tid] = 64 * tid; tl[2 * tid + 1] = -1; }
    if (tid < 4) misc[4 + tid] = 0u;
    LAS unsigned* wunS = (LAS unsigned*)(lds + L_WUN) + wave * 4;
    float* tot = (float*)(ws + WS_TOT) + row * 768 + (kv * 4) * 64;
    const bf16_t* gatep = proj + row * INP + CG_OFF + (kv * 4) * 3;
    const int qcc = (tok - 31) >> 4;
    const int qcw0 = (t0 + 16 * wave - 31) >> 4, qcw1 = (t0 + 16 * wave + 15 - 31) >> 4;
#pragma unroll 1
    for (int hp = 0; hp < 4 / NSA_QG; ++hp) {
        bf16x8 qf[NSA_QG][2];
#pragma unroll
        for (int q = 0; q < NSA_QG; ++q)
#pragma unroll
            for (int ks = 0; ks < 2; ++ks) qf[q][ks] = *(const bf16x8*)(proj + row * INP + CQ_OFF + (kv * 4 + hp * NSA_QG + q) * 64 + ks * 32 + g * 8);
        f32x4 o[NSA_QG][4]; float m[NSA_QG], l[NSA_QG]; flash_init<NSA_QG>(o, m, l);
        float il[NSA_QG]; for (int q_ = 0; q_ < NSA_QG; ++q_) il[q_] = 0.f;
#ifdef NSA_CMP_FAKEKV
        Src S{proj + (size_t)b * SEQ * INP + CKV_OFF + 4 * 192 + kv * 64, proj + (size_t)b * SEQ * INP + CKV_OFF + 5 * 192 + kv * 64, INP, 1, 0};
#else
        Src S{(const bf16_t*)(ws + WS_KC) + (size_t)(b * 3 + kv) * 512 * 64, (const bf16_t*)(ws + WS_VC) + (size_t)(b * 3 + kv) * 512 * 64, 64, 1, 0};
#endif
#ifdef NSA_CMP_SINGLE
        flash_run<NSA_QG, 0>(lds, S, ntc, qf, o, m, l, qcc, qcw0, qcw1, 0x7fffffff, nullptr, nullptr, il, nullptr, false, 0, lane, tid);
#pragma unroll
        for (int q = 0; q < NSA_QG; ++q) il[q] = l[q] > 0.f ? 1.f / l[q] : 0.f;
        (void)impw;
#elif !defined(NSA_NO_CMP)
        flash_run<NSA_QG, 2>(lds, S, ntc, qf, o, m, l, qcc, qcw0, qcw1, 0x7fffffff, nullptr, nullptr, il, nullptr, false, 0, lane, tid);
#pragma unroll
        for (int q = 0; q < NSA_QG; ++q) { il[q] = l[q] > 0.f ? 1.f / l[q] : 0.f; l[q] = 0.f; }
        flash_run<NSA_QG, 4>(lds, S, ntc, qf, o, m, l, qcc, qcw0, qcw1, 0x7fffffff, nullptr, nullptr, il, impw, hp != 0, 0, lane, tid);
#else
        (void)S; (void)impw;
#endif
#pragma unroll
        for (int q = 0; q < NSA_QG; ++q) { const float gt = sigmoidf_(bf2f(gatep[(hp * NSA_QG + q) * 3 + 0])); const float sc = il[q] * gt;
#pragma unroll
            for (int dt = 0; dt < 4; ++dt) *(f32x4*)(tot + (hp * NSA_QG + q) * 64 + 16 * dt + 4 * g) = o[q][dt] * sc; }
    }
#ifndef NSA_NO_TOPK
    lds_wait();
    unsigned wun0 = 0u, wun1 = 0u, wun2 = 0u, wun3 = 0u;
#pragma unroll 1
    for (int q = 0; q < 16; ++q) {
        const int t = t0 + 16 * wave + q, own = t >> 6;
        const int ncand = own - 2 > 0 ? own - 2 : 0; const int nforced = own >= 2 ? 3 : own + 1; const int K = 16 - nforced;
        const int j0 = lane, j1 = lane + 64;
        const bool c0 = (j0 >= 1) && (j0 <= own - 2), c1 = (j1 <= own - 2);
        const unsigned k0 = c0 ? (__float_as_uint(impw[q * 128 + j0]) + 1u) : 0u, k1 = c1 ? (__float_as_uint(impw[q * 128 + j1]) + 1u) : 0u;
        bool s0 = c0, s1 = c1;
        if (ncand > K) {
            unsigned T = 0u;
            for (int bit = 31; bit >= 0; --bit) { const unsigned Tn = T | (1u << bit);
                const int cnt = __popcll(__ballot(k0 >= Tn)) + __popcll(__ballot(k1 >= Tn)); if (cnt >= K) T = Tn; }
            const bool g0 = k0 > T, g1 = k1 > T; const int ng = __popcll(__ballot(g0)) + __popcll(__ballot(g1)); const int need = K - ng;
            const unsigned long long e0 = __ballot(k0 == T), e1 = __ballot(k1 == T); const unsigned long long lt = (1ull << lane) - 1ull;
            const int r0 = __popcll(e0 & lt), r1 = __popcll(e0) + __popcll(e1 & lt);
            s0 = g0 || (k0 == T && r0 < need); s1 = g1 || (k1 == T && r1 < need);
        }
        s0 = s0 || (j0 == 0) || (j0 == own) || (j0 == own - 1); s1 = s1 || (j1 == own) || (j1 == own - 1);
        const unsigned long long m0 = __ballot(s0), m1 = __ballot(s1);
        const unsigned w0 = (unsigned)m0, w1 = (unsigned)(m0 >> 32), w2 = (unsigned)m1, w3 = (unsigned)(m1 >> 32);
        if (lane == 0) { selS[(16 * wave + q) * 4 + 0] = w0; selS[(16 * wave + q) * 4 + 1] = w1; selS[(16 * wave + q) * 4 + 2] = w2; selS[(16 * wave + q) * 4 + 3] = w3; }
        wun0 |= w0; wun1 |= w1; wun2 |= w2; wun3 |= w3;
    }
    if (lane == 0) { wunS[0] = wun0; wunS[1] = wun1; wunS[2] = wun2; wunS[3] = wun3; }
    __syncthreads();
    if (tid < 4) { unsigned u_ = 0u; for (int w8 = 0; w8 < 8; ++w8) u_ |= ((const LAS unsigned*)(lds + L_WUN))[w8 * 4 + tid]; misc[4 + tid] = u_; }
    __syncthreads();
    const LAS unsigned* selp = selS + (16 * wave + i16) * 4;
    const int ownmax = (t0 + 127) >> 6;
    if (tid == 0) { int n = 0; for (int j = 0; j <= ownmax; ++j) if ((misc[4 + (j >> 5)] >> (j & 31)) & 1u) { tl[2 * n] = 64 * j; tl[2 * n + 1] = j; ++n; } misc[2] = (unsigned)n; }
    __syncthreads();
    const int nts = (int)misc[2];
#else
    const int ownmax = (t0 + 127) >> 6; const int nts = 0; const LAS unsigned* selp = nullptr; (void)selS; (void)wunS;
#endif
    const int kfirst = t0 - 512 > 0 ? t0 - 512 : 0; const int ntw = (t0 + 128 - kfirst) / 64;
#pragma unroll 1
    for (int hp = 0; hp < 4 / NSA_QG; ++hp) {
        bf16x8 qf[NSA_QG][2];
#pragma unroll
        for (int q = 0; q < NSA_QG; ++q)
#pragma unroll
            for (int ks = 0; ks < 2; ++ks) qf[q][ks] = *(const bf16x8*)(proj + row * INP + CQ_OFF + (kv * 4 + hp * NSA_QG + q) * 64 + ks * 32 + g * 8);
        f32x4 o[NSA_QG][4]; float m[NSA_QG], l[NSA_QG];
        float il[NSA_QG]; for (int q_ = 0; q_ < NSA_QG; ++q_) il[q_] = 0.f;
        __syncthreads();
        if (tid == 0) { int n = 0; for (int j = 0; j <= ownmax; ++j) if ((misc[4 + (j >> 5)] >> (j & 31)) & 1u) { tl[2 * n] = 64 * j; tl[2 * n + 1] = j; ++n; } }
#ifndef NSA_NO_SLC
        { flash_init<NSA_QG>(o, m, l);
          Src S{proj + (size_t)b * SEQ * INP + CKV_OFF + 2 * 192 + kv * 64, proj + (size_t)b * SEQ * INP + CKV_OFF + 3 * 192 + kv * 64, INP, 1, 0};
          flash_run<NSA_QG, 1>(lds, S, nts, qf, o, m, l, tok, t0 + 16 * wave, t0 + 16 * wave + 15, 0x7fffffff, selp, wunS, il, nullptr, false, hp * NSA_QG, lane, tid);
#pragma unroll
          for (int q = 0; q < NSA_QG; ++q) { const float gt = sigmoidf_(bf2f(gatep[(hp * NSA_QG + q) * 3 + 1])); const float sc = (l[q] > 0.f ? 1.f / l[q] : 0.f) * gt;
#pragma unroll
              for (int dt = 0; dt < 4; ++dt) { float* tp = tot + (hp * NSA_QG + q) * 64 + 16 * dt + 4 * g; *(f32x4*)tp = *(const f32x4*)tp + o[q][dt] * sc; } }
        }
#endif
        if (tid < ntw) { tl[2 * tid] = kfirst + 64 * tid; tl[2 * tid + 1] = -1; }
        { flash_init<NSA_QG>(o, m, l);
          Src S{proj + (size_t)b * SEQ * INP + CKV_OFF + 4 * 192 + kv * 64, proj + (size_t)b * SEQ * INP + CKV_OFF + 5 * 192 + kv * 64, INP, 1, 0};
#ifndef NSA_NO_WIN
          flash_run<NSA_QG, 1>(lds, S, ntw, qf, o, m, l, tok, t0 + 16 * wave, t0 + 16 * wave + 15, 511, nullptr, nullptr, il, nullptr, false, hp * NSA_QG, lane, tid);
#else
          (void)S;
#endif
          bf16_t* O = (bf16_t*)(ws + WS_O) + row * 2048 + 1280 + (kv * 4) * 64;
#pragma unroll
          for (int q = 0; q < NSA_QG; ++q) { const float gt = sigmoidf_(bf2f(gatep[(hp * NSA_QG + q) * 3 + 2])); const float sc = (l[q] > 0.f ? 1.f / l[q] : 0.f) * gt;
#pragma unroll
              for (int dt = 0; dt < 4; ++dt) { const f32x4 v = *(const f32x4*)(tot + (hp * NSA_QG + q) * 64 + 16 * dt + 4 * g) + o[q][dt] * sc;
                  u32x2 w; w.x = cvtpk(v[0], v[1]); w.y = cvtpk(v[2], v[3]); *(u32x2*)(O + (hp * NSA_QG + q) * 64 + 16 * dt + 4 * g) = w; } }
        }
    }
}

__device__ __forceinline__ float gelu_tanh(float x) { const float u = 0.7978845608028654f * (x + 0.044715f * x * x * x); const float e = __expf(2.f * u); const float th = 1.f - 2.f / (1.f + e); return 0.5f * x * (1.f + th); }
__device__ __forceinline__ void item_compress(const Params& P, int layer, int it, int lane) {
    unsigned char* ws = P.ws; const bf16_t* proj = (const bf16_t*)(ws + WS_PROJ);
    const int nt = it & 31; int r = it >> 5; const int which = r & 1; r >>= 1; const int kv = r % 3, b = r / 3;
    const int g = lane >> 4, i16 = lane & 15;
    int n = 16 * nt + i16; const int nld = n > 510 ? 510 : n;
    const bf16_t* w1t = (const bf16_t*)(ws + WS_W1T) + (size_t)(layer * 2 + which) * 128 * 2048;
    const bf16_t* w2t = (const bf16_t*)(ws + WS_W2T) + (size_t)(layer * 2 + which) * 64 * 128;
    const float* cpe = (const float*)(ws + WS_CPE) + (layer * 2 + which) * 128;
    const bf16_t* src = proj + ((size_t)b * SEQ + 16 * nld) * INP + CKV_OFF + which * 192 + kv * 64 + 8 * g;
    f32x4 acc[8];
#pragma unroll
    for (int h = 0; h < 8; ++h) acc[h] = (f32x4){0.f, 0.f, 0.f, 0.f};
    const bf16_t* w1l = w1t + (size_t)i16 * 2048 + 8 * g;
#pragma unroll 1
    for (int ks = 0; ks < 64; ks += 4) {
        bf16x8 bq[4], af[4][8];
#pragma unroll
        for (int u = 0; u < 4; ++u) { bq[u] = *(const bf16x8*)(src + (size_t)((ks + u) >> 1) * INP + (u & 1) * 32);
#pragma unroll
            for (int h = 0; h < 8; ++h) af[u][h] = *(const bf16x8*)(w1l + (size_t)(16 * h) * 2048 + 32 * (ks + u)); }
        __builtin_amdgcn_sched_barrier(0);
#pragma unroll
        for (int u = 0; u < 4; ++u)
#pragma unroll
            for (int h = 0; h < 8; ++h) acc[h] = mfma16(af[u][h], bq[u], acc[h]);
    }
    bf16x8 pf[4];
#pragma unroll
    for (int s = 0; s < 4; ++s) { float hv[8];
#pragma unroll
        for (int r2 = 0; r2 < 4; ++r2) { hv[r2] = gelu_tanh(acc[2 * s][r2] + cpe[32 * s + 4 * g + r2]); hv[4 + r2] = gelu_tanh(acc[2 * s + 1][r2] + cpe[32 * s + 16 + 4 * g + r2]); }
        u32x4 w; w.x = cvtpk(hv[0], hv[1]); w.y = cvtpk(hv[2], hv[3]); w.z = cvtpk(hv[4], hv[5]); w.w = cvtpk(hv[6], hv[7]); pf[s] = __builtin_bit_cast(bf16x8, w); }
    bf16_t* dst = (bf16_t*)(ws + (which ? WS_VC : WS_KC)) + ((size_t)(b * 3 + kv) * 512 + n) * 64;
#pragma unroll
    for (int et = 0; et < 4; ++et) { f32x4 oc = {0.f, 0.f, 0.f, 0.f};
#pragma unroll
        for (int s = 0; s < 4; ++s) { const bf16_t* wp = w2t + (size_t)(16 * et + i16) * 128 + 32 * s + 4 * g; const u32x2 lo = *(const u32x2*)wp, hi = *(const u32x2*)(wp + 16);
            u32x4 w; w.x = lo.x; w.y = lo.y; w.z = hi.x; w.w = hi.y; oc = mfma16(__builtin_bit_cast(bf16x8, w), pf[s], oc); }
#ifdef PROBE_CLAMP
#pragma unroll
        for (int r2 = 0; r2 < 4; ++r2) oc[r2] = fminf(fmaxf(oc[r2], -100.f), 100.f);
#endif
        u32x2 w; w.x = cvtpk(oc[0], oc[1]); w.y = cvtpk(oc[2], oc[3]); *(u32x2*)(dst + 16 * et + 4 * g) = w; }
}
__device__ __forceinline__ void item_kmean(const Params& P, int it, int lane) {
    unsigned char* ws = P.ws; const bf16_t* proj = (const bf16_t*)(ws + WS_PROJ);
    const int blk = it & 31, h = (it >> 5) & 7, b = it >> 8;
    const int rg = lane >> 3, dch = lane & 7;
    const bf16_t* src = proj + ((size_t)b * SEQ + blk * 256 + rg) * INP + B_OFF + 512 + h * 64 + dch * 8;
    u32x4 v[32];
#pragma unroll
    for (int i = 0; i < 32; ++i) v[i] = *(const u32x4*)(src + (size_t)(8 * i) * INP);
    __builtin_amdgcn_sched_barrier(0);
    float sm[8];
#pragma unroll
    for (int e = 0; e < 8; ++e) sm[e] = 0.f;
#pragma unroll
    for (int i = 0; i < 32; ++i)
#pragma unroll
        for (int w = 0; w < 4; ++w) { sm[2 * w] += bflo(v[i][w]); sm[2 * w + 1] += bfhi(v[i][w]); }
#pragma unroll
    for (int e = 0; e < 8; ++e) { sm[e] += __shfl_xor(sm[e], 8); sm[e] += __shfl_xor(sm[e], 16); sm[e] += __shfl_xor(sm[e], 32); }
    if (rg == 0) { float* dst = (float*)(ws + WS_KMEAN) + (size_t)it * 64 + dch * 8;
        *(f32x4*)dst = (f32x4){sm[0], sm[1], sm[2], sm[3]} * (1.f / 256.f); *(f32x4*)(dst + 4) = (f32x4){sm[4], sm[5], sm[6], sm[7]} * (1.f / 256.f); }
}
__device__ __forceinline__ void item_combineA(const Params& P, int row, int lane) {
    unsigned char* ws = P.ws; const float* lse = (const float*)(ws + WS_LSE) + (size_t)row * 12; bf16_t* O = (bf16_t*)(ws + WS_O) + (size_t)row * 2048;
#pragma unroll
    for (int k = 0; k < 3; ++k) { const int chunk = lane + 64 * k; const int col = 4 * chunk; const int gi = col >> 8, hs = (col >> 6) & 3;
        const float a0 = lse[hs], a1 = lse[4 + hs], a2 = lse[8 + hs]; const float mx = fmaxf(a0, fmaxf(a1, a2));
        const float e0 = __expf(a0 - mx), e1 = __expf(a1 - mx), e2 = __expf(a2 - mx); const float al = (gi == 0 ? e0 : (gi == 1 ? e1 : e2)) / (e0 + e1 + e2);
        const u32x2 w = *(const u32x2*)(O + col); u32x2 r; r.x = cvtpk(bflo(w.x) * al, bfhi(w.x) * al); r.y = cvtpk(bflo(w.y) * al, bfhi(w.y) * al); *(u32x2*)(O + col) = r; }
}

__device__ __forceinline__ void phase_conv(const Params& P, int layer, int tid) {
    unsigned char* ws = P.ws; const bf16_t* U = (const bf16_t*)(ws + WS_U); bf16_t* ACT = (bf16_t*)(ws + WS_ACT);
    const float* cw = P.conv_w + (size_t)layer * 3 * UPW; const float* cb = P.conv_b + (size_t)layer * UPW;
    constexpr int NCH = DFF / 8, TB = 8, NTB = MROWS / TB;
    for (int it = blockIdx.x * NTHREADS + tid; it < NCH * NTB; it += gridDim.x * NTHREADS) {
        const int ch = it % NCH, tb = it / NCH; const int c = ch * 8; const int ua = 256 * (c >> 7) + (c & 127);
        const int row0 = tb * TB; const bool first = (row0 % SEQ) == 0;
        u32x4 pa[TB + 2], pg[TB + 2];
#pragma unroll
        for (int t = 0; t < TB + 2; ++t) { const int r = row0 - 2 + t; const size_t off = (size_t)(r < 0 ? 0 : r) * UPW + ua; pa[t] = *(const u32x4*)(U + off); pg[t] = *(const u32x4*)(U + off + 128); }
        f32x4 wa4[3][2], wg4[3][2], ba4[2], bg4[2];
#pragma unroll
        for (int j = 0; j < 3; ++j)
#pragma unroll
            for (int h = 0; h < 2; ++h) { wa4[j][h] = *(const f32x4*)(cw + (size_t)j * UPW + c + 4 * h); wg4[j][h] = *(const f32x4*)(cw + (size_t)j * UPW + DFF + c + 4 * h); }
#pragma unroll
        for (int h = 0; h < 2; ++h) { ba4[h] = *(const f32x4*)(cb + c + 4 * h); bg4[h] = *(const f32x4*)(cb + DFF + c + 4 * h); }
        __builtin_amdgcn_sched_barrier(0);
        if (first) { pa[0] = (u32x4){0, 0, 0, 0}; pa[1] = pa[0]; pg[0] = pa[0]; pg[1] = pa[0]; }
#pragma unroll
        for (int t = 0; t < TB; ++t) {
            float r[8];
#pragma unroll
            for (int e = 0; e < 8; ++e) { const int w_ = e >> 1; const int h = e >> 2, x = e & 3;
                const float a0 = (e & 1) ? bfhi(pa[t + 2][w_]) : bflo(pa[t + 2][w_]), a1 = (e & 1) ? bfhi(pa[t + 1][w_]) : bflo(pa[t + 1][w_]), a2 = (e & 1) ? bfhi(pa[t][w_]) : bflo(pa[t][w_]);
                const float g0 = (e & 1) ? bfhi(pg[t + 2][w_]) : bflo(pg[t + 2][w_]), g1 = (e & 1) ? bfhi(pg[t + 1][w_]) : bflo(pg[t + 1][w_]), g2 = (e & 1) ? bfhi(pg[t][w_]) : bflo(pg[t][w_]);
                const float ya = ba4[h][x] + wa4[0][h][x] * a0 + wa4[1][h][x] * a1 + wa4[2][h][x] * a2;
                const float yg = bg4[h][x] + wg4[0][h][x] * g0 + wg4[1][h][x] * g1 + wg4[2][h][x] * g2;
                r[e] = ya * yg / (1.f + __expf(-yg)); }
            u32x4 w; w.x = cvtpk(r[0], r[1]); w.y = cvtpk(r[2], r[3]); w.z = cvtpk(r[4], r[5]); w.w = cvtpk(r[6], r[7]);
            *(u32x4*)(ACT + (size_t)(row0 + t) * DFF + c) = w;
        }
    }
}

__device__ __forceinline__ void phase_convfix(const Params& P, int layer, int tid) {
    unsigned char* ws = P.ws; const bf16_t* UB = (const bf16_t*)(ws + WS_UB); bf16_t* ACT = (bf16_t*)(ws + WS_ACT);
    const float* cw = P.conv_w + (size_t)layer * 3 * UPW; const float* cb = P.conv_b + (size_t)layer * UPW;
    constexpr int NCH = DFF / 8, NS = MROWS / 64;
    for (int it = blockIdx.x * NTHREADS + tid; it < NCH * 2 * NS; it += gridDim.x * NTHREADS) {
        const int ch = it % NCH, lr = (it / NCH) & 1, sl = it / (2 * NCH); const int c = ch * 8; const int ua = 256 * (c >> 7) + (c & 127);
        const bool first = (sl % (SEQ / 64)) == 0;
        const int slp = sl > 0 ? sl - 1 : 0;
        const bf16_t* r0 = UB + ((size_t)sl * 4 + lr) * UPW + ua;
        const bf16_t* r1 = lr == 0 ? UB + ((size_t)slp * 4 + 3) * UPW + ua : UB + ((size_t)sl * 4 + 0) * UPW + ua;
        const bf16_t* r2 = lr == 0 ? UB + ((size_t)slp * 4 + 2) * UPW + ua : UB + ((size_t)slp * 4 + 3) * UPW + ua;
        u32x4 a0 = *(const u32x4*)r0, g0 = *(const u32x4*)(r0 + 128), a1 = *(const u32x4*)r1, g1 = *(const u32x4*)(r1 + 128), a2 = *(const u32x4*)r2, g2 = *(const u32x4*)(r2 + 128);
        const u32x4 z = {0, 0, 0, 0};
        if (first && lr == 0) { a1 = z; g1 = z; }
        if (first) { a2 = z; g2 = z; }
        float r[8];
#pragma unroll
        for (int e = 0; e < 8; ++e) { const int w_ = e >> 1;
            const float x0 = (e & 1) ? bfhi(a0[w_]) : bflo(a0[w_]), x1 = (e & 1) ? bfhi(a1[w_]) : bflo(a1[w_]), x2 = (e & 1) ? bfhi(a2[w_]) : bflo(a2[w_]);
            const float y0 = (e & 1) ? bfhi(g0[w_]) : bflo(g0[w_]), y1 = (e & 1) ? bfhi(g1[w_]) : bflo(g1[w_]), y2 = (e & 1) ? bfhi(g2[w_]) : bflo(g2[w_]);
            const float ya = cb[c + e] + cw[c + e] * x0 + cw[UPW + c + e] * x1 + cw[2 * UPW + c + e] * x2;
            const float yg = cb[DFF + c + e] + cw[DFF + c + e] * y0 + cw[UPW + DFF + c + e] * y1 + cw[2 * UPW + DFF + c + e] * y2;
            r[e] = ya * yg / (1.f + __expf(-yg)); }
        u32x4 w; w.x = cvtpk(r[0], r[1]); w.y = cvtpk(r[2], r[3]); w.z = cvtpk(r[4], r[5]); w.w = cvtpk(r[6], r[7]);
        *(u32x4*)(ACT + (size_t)(sl * 64 + lr) * DFF + c) = w;
    }
}

#define XB_TMO      128
#define XB_XCNT(j)  (256  + 64 * (j))
#define XB_XSUB(j)  (1280 + 64 * (j))
#define XB_XGEN(j)  (2304 + 64 * (j))
#define XB_TOP      3328
#define XB_TOPGEN   3392
#define XCD_BAR_WORDS 3456
#define XB_SPIN_CAP (1u << 27)

__device__ __forceinline__ unsigned xb_ld(unsigned* p)              { return __hip_atomic_load(p, __ATOMIC_RELAXED, __HIP_MEMORY_SCOPE_AGENT); }
__device__ __forceinline__ unsigned xb_add(unsigned* p, unsigned v) { return __hip_atomic_fetch_add(p, v, __ATOMIC_RELAXED, __HIP_MEMORY_SCOPE_AGENT); }
__device__ __forceinline__ unsigned xb_xcc_id() { return (unsigned)__builtin_amdgcn_s_getreg((3 << 11) | 20) & 0xFu; }
#define XB_SPIN(cond, bar) do { unsigned _sp = 0; while (cond) { __builtin_amdgcn_s_sleep(1); \
    if ((++_sp & 255u) == 0u) { if (xb_ld(&(bar)[XB_TMO])) break; if (_sp > XB_SPIN_CAP) { atomicAdd(&(bar)[XB_TMO], 1u); break; } } } } while (0)

struct XcdBarrier {
    unsigned* bar; unsigned x;
    volatile LAS unsigned* st;
};

__device__ __forceinline__ XcdBarrier xcd_barrier_post(unsigned* bar, volatile LAS unsigned* st) {
    XcdBarrier b; b.bar = bar; b.x = xb_xcc_id(); b.st = st;
    if (threadIdx.x == 0) (void)xb_add(&bar[XB_XCNT(b.x)], 1u);
    return b;
}
__device__ __forceinline__ void xcd_barrier_complete(unsigned* bar, unsigned x, unsigned& nloc, unsigned& nx) {
    const unsigned G = gridDim.x * gridDim.y * gridDim.z;
    unsigned sum, cnt, mine, sp = 0u;
    for (;;) {
        sum = 0u; cnt = 0u; mine = 0u;
#pragma unroll
        for (unsigned j = 0; j < 16; ++j) { const unsigned c = xb_ld(&bar[XB_XCNT(j)]); sum += c; cnt += (c > 0u) ? 1u : 0u; mine = (j == x) ? c : mine; }
        if (sum == G) break;
        __builtin_amdgcn_s_sleep(1);
        if ((++sp & 255u) == 0u) { if (xb_ld(&bar[XB_TMO])) break; if (sp > XB_SPIN_CAP) { atomicAdd(&bar[XB_TMO], 1u); break; } }
    }
    nloc = mine > 0u ? mine : 1u; nx = cnt > 0u ? cnt : 1u;
}

__device__ __forceinline__ void xcd_barrier(const XcdBarrier& b) {
    asm volatile("s_waitcnt vmcnt(0)" ::: "memory");
    __syncthreads();
    if (threadIdx.x == 0) {
        unsigned* bar = b.bar;
        __builtin_amdgcn_s_waitcnt(0);
        unsigned nloc = b.st[0], nx = b.st[1];
        if (nloc == 0u) { xcd_barrier_complete(bar, b.x, nloc, nx); b.st[0] = nloc; b.st[1] = nx; }
        const unsigned old = xb_add(&bar[XB_XSUB(b.x)], 1u);
        const unsigned gen = old / nloc;
        if (old + 1u == (gen + 1u) * nloc) {
            __builtin_amdgcn_fence(__ATOMIC_RELEASE, "agent");
            asm volatile("s_waitcnt vmcnt(0)" ::: "memory");
            const unsigned og = xb_add(&bar[XB_TOP], 1u);
            const unsigned tg = og / nx;
            if (og + 1u == (tg + 1u) * nx) xb_add(&bar[XB_TOPGEN], 1u);
            else XB_SPIN(xb_ld(&bar[XB_TOPGEN]) == tg, bar);
            __builtin_amdgcn_fence(__ATOMIC_ACQUIRE, "agent");
            xb_add(&bar[XB_XGEN(b.x)], 1u);
            asm volatile("s_waitcnt vmcnt(0)" ::: "memory");
        } else {
            XB_SPIN(xb_ld(&bar[XB_XGEN(b.x)]) == gen, bar);
            __builtin_amdgcn_fence(__ATOMIC_ACQUIRE, "agent");
            asm volatile("s_waitcnt vmcnt(0)" ::: "memory");
        }
    }
    __syncthreads();
}

__global__ void __launch_bounds__(NTHREADS) fwd_megakernel(Params P) {
    extern __shared__ __attribute__((aligned(16))) unsigned char lds_raw[];
    LAS unsigned char* lds = (LAS unsigned char*)lds_raw;
    int wave0 = __builtin_amdgcn_readfirstlane((int)threadIdx.x >> 6);
    unsigned char* ws0 = P.ws;
    volatile LAS unsigned* bst = (volatile LAS unsigned*)(lds + LDS_BYTES - 64);
    if (threadIdx.x < 2) bst[threadIdx.x] = 0u;
    __syncthreads();
    (void)xcd_barrier_post((unsigned*)(P.ws + WS_CTL) + 4096, bst);
#define GRID_BAR() do { XcdBarrier b_; b_.bar = (unsigned*)(ws0 + WS_CTL) + 4096; b_.x = xb_xcc_id(); b_.st = (volatile LAS unsigned*)(lds + LDS_BYTES - 64); xcd_barrier(b_); } while (0)
    { const int wave = wave0, lane = lane_id_opaque(), tid = wave * 64 + lane;

#ifndef SKIP_P0
    p0_prologue(P, lds, tid, lane, wave);
#ifdef DUP_P0
    p0_prologue(P, lds, tid, lane, wave);
#endif
#endif
    }
    GRID_BAR();

#pragma unroll 1
    for (int layer = 0; layer < DEPTH; ++layer) {
        asm volatile("" : "+s"(wave0), "+s"(ws0));
        const int wave = wave0, lane = lane_id_opaque(), tid = wave * 64 + lane;
        const int G = gridDim.x, gw = blockIdx.x * NWAVES + wave, NGW = G * NWAVES;
        unsigned char* ws = ws0;
        unsigned* ctl = (unsigned*)(ws + WS_CTL);
        const float* xbase = layer == 0 ? P.x : (const float*)(ws + WS_X);
#ifdef PROBE_ZERO_O
        for (size_t i = (size_t)blockIdx.x * NTHREADS + tid; i < (size_t)MROWS * 2048 / 8; i += (size_t)G * NTHREADS) ((u32x4*)(ws + WS_O))[i] = (u32x4){0u, 0u, 0u, 0u};
#endif
        { pg8::Gemm gm{(const pg8::bf16_t*)(ws + WS_XB), (const pg8::bf16_t*)(ws + WS_WIN + layer * SZ_WIN), MROWS, INP, DM};
          pg8::StaticOrder S; S.init(MROWS, INP, G, (int)blockIdx.x);
          pg8::EpiScaleBf16 E{(pg8::bf16_t*)(ws + WS_PROJ), INP, (const float*)(ws + WS_SSP)};
          pg8::gemm_phase<pg8::EpiScaleBf16, pg8::StaticOrder, true, true>(lds, gm, S, E, wave); }
        GRID_BAR();
#ifndef SKIP_CMP
        for (int it = gw; it < 384 + 512; it += NGW) { if (it < 384) item_compress(P, layer, it, lane); else item_kmean(P, it - 384, lane); }
#ifdef DUP_CMP
        for (int it = gw; it < 384 + 512; it += NGW) { if (it < 384) item_compress(P, layer, it, lane); else item_kmean(P, it - 384, lane); }
#endif
#endif
#ifndef SKIP_MIXA
#ifdef DUP_P2A
        for (int rep_ = 0; rep_ < 2; ++rep_)
        for (;;) { const int u = next_unit(ctl + 64 * (layer * 2 + 0 + 8 * rep_), lds, tid); if (u >= 1536) break; const int ln_ = lane_id_opaque(); unit_mixA(P, lds, u, wave * 64 + ln_, ln_, wave); }
#else
        for (;;) { const int u = next_unit(ctl + 64 * (layer * 2 + 0), lds, tid); if (u >= 1536) break; const int ln_ = lane_id_opaque(); unit_mixA(P, lds, u, wave * 64 + ln_, ln_, wave); }
#endif
#endif
        GRID_BAR();
        for (int r = gw; r < MROWS; r += NGW) item_combineA(P, r, lane);
#ifdef DUP_P2B
        for (int rep_ = 0; rep_ < 2; ++rep_)
        for (;;) { const int u = next_unit(ctl + 64 * (layer * 2 + 1 + 8 * rep_), lds, tid); if (u >= 384 + 1024) break;
#else
        const int n_units_b = 384 + 1024 + ((P0_LAYERS == 1 && layer + 1 < DEPTH) ? N_CONV_UNITS : 0);
        for (;;) { const int u = next_unit(ctl + 64 * (layer * 2 + 1), lds, tid); if (u >= n_units_b) break;
            if (u >= 384 + 1024) {
                LAS float* scr = (LAS float*)(lds + wave * 16384); const int ln_ = lane_id_opaque();
                for (int k = 0; k < CONV_UNIT_ITEMS / NWAVES; ++k) { const int r = (u - 384 - 1024) * CONV_UNIT_ITEMS + wave * (CONV_UNIT_ITEMS / NWAVES) + k; if (r < I_LAYER) p0_layer_item(P, scr, layer + 1, r, ln_); }
                continue; }
#endif
            if (u < 384) {
#ifndef SKIP_NSA
                { const int ln_ = lane_id_opaque(); unit_nsa(P, lds, (u % 6) / 3, (u % 6) % 3, 63 - u / 6, wave * 64 + ln_, ln_, wave); }
#endif
            } else { const int v = u - 384;
#ifndef SKIP_MOBA
                { const int ln_ = lane_id_opaque(); unit_moba(P, lds, (v % 16) / 8, (v % 16) % 8, 63 - v / 16, wave * 64 + ln_, ln_, wave); }
#endif
            } }
        GRID_BAR();
        { pg8::Gemm gm{(const pg8::bf16_t*)(ws + WS_O), (const pg8::bf16_t*)(ws + WS_WOUT + layer * SZ_WOUT), MROWS, DM, DM};
          pg8::StaticOrder S; S.init(MROWS, DM, G, (int)blockIdx.x);
          pg8::EpiResid E{xbase, (float*)(ws + WS_X), (pg8::bf16_t*)(ws + WS_XB), (float*)(ws + WS_SSP)};
          pg8::gemm_phase<pg8::EpiResid, pg8::StaticOrder, true, true>(lds, gm, S, E, wave); }
        GRID_BAR();
#ifdef FUSE_CONV
        { pg8::Gemm gm{(const pg8::bf16_t*)(ws + WS_XB), (const pg8::bf16_t*)(ws + WS_WUP + layer * SZ_WUP), MROWS, UPW, DM};
          pg8::StaticOrder S; S.init(MROWS, UPW, G, (int)blockIdx.x);
          pg8::EpiConvGate E{(pg8::bf16_t*)(ws + WS_ACT), (pg8::bf16_t*)(ws + WS_UB), (const float*)(ws + WS_SSP), P.conv_w + (size_t)layer * 3 * UPW, P.conv_b + (size_t)layer * UPW, DFF};
          pg8::gemm_phase<pg8::EpiConvGate, pg8::StaticOrder, true, true>(lds, gm, S, E, wave); }
        GRID_BAR();
        phase_convfix(P, layer, tid);
        GRID_BAR();
#else
        { pg8::Gemm gm{(const pg8::bf16_t*)(ws + WS_XB), (const pg8::bf16_t*)(ws + WS_WUP + layer * SZ_WUP), MROWS, UPW, DM};
          pg8::StaticOrder S; S.init(MROWS, UPW, G, (int)blockIdx.x);
          pg8::EpiScaleBf16 E{(pg8::bf16_t*)(ws + WS_U), UPW, (const float*)(ws + WS_SSP)};
#ifdef DUP_G3
          pg8::gemm_phase<pg8::EpiScaleBf16, pg8::StaticOrder, true, true>(lds, gm, S, E, wave);
#endif
          pg8::gemm_phase<pg8::EpiScaleBf16, pg8::StaticOrder, true, true>(lds, gm, S, E, wave); }
        GRID_BAR();
#ifndef SKIP_CONV
        phase_conv(P, layer, tid);
#ifdef DUP_CONV
        phase_conv(P, layer, tid);
#endif
#endif
        GRID_BAR();
#endif
        { pg8::Gemm gm{(const pg8::bf16_t*)(ws + WS_ACT), (const pg8::bf16_t*)(ws + WS_WDN + layer * SZ_WDN), MROWS, DM, DFF};
          pg8::StaticOrder S; S.init(MROWS, DM, G, (int)blockIdx.x);
          pg8::EpiResid E{(const float*)(ws + WS_X), (float*)(ws + WS_X), (pg8::bf16_t*)(ws + WS_XB), (float*)(ws + WS_SSP)};
          pg8::gemm_phase<pg8::EpiResid, pg8::StaticOrder, true, true>(lds, gm, S, E, wave); }
        GRID_BAR();
    }
    const int wave = wave0, lane = lane_id_opaque();
    const int G = gridDim.x, gw = blockIdx.x * NWAVES + wave, NGW = G * NWAVES;
    unsigned char* ws = ws0; (void)G;
    for (int mrow = gw; mrow < MROWS; mrow += NGW) {
        const f32x4* xr = (const f32x4*)((const float*)(ws + WS_X) + (size_t)mrow * DM) + lane; const f32x4* gr = (const f32x4*)P.norm_final + lane;
        f32x4 v[8]; float s = 0.f;
#pragma unroll
        for (int j = 0; j < 8; ++j) { v[j] = xr[64 * j]; s += (v[j][0] * v[j][0] + v[j][1] * v[j][1]) + (v[j][2] * v[j][2] + v[j][3] * v[j][3]); }
#pragma unroll
        for (int o = 1; o < 64; o <<= 1) s += __shfl_xor(s, o);
        const float rs = 1.0f / sqrtf(s * (1.0f / DM) + 1e-6f);
        f32x4* orow = (f32x4*)(P.out + (size_t)mrow * DM) + lane;
#pragma unroll
        for (int j = 0; j < 8; ++j) orow[64 * j] = v[j] * rs * gr[64 * j];
    }
}

extern "C" void kernel_launch(void* const* d_in, const int* in_sizes, int n_in, void* d_out, int out_size, void* d_ws, size_t ws_size, hipStream_t stream) {
    static int grid = 0;
    if (grid == 0) {
        if (n_in != 14 || ws_size < WS_END) { fprintf(stderr, "kernel_launch: unexpected n_in %d or workspace %zu < %zu\n", n_in, ws_size, (size_t)WS_END); grid = -1; return; }
        int dev = 0, cus = 0, per_cu = 0;
        hipGetDevice(&dev); hipDeviceGetAttribute(&cus, hipDeviceAttributeMultiprocessorCount, dev);
        if (hipFuncSetAttribute((const void*)fwd_megakernel, hipFuncAttributeMaxDynamicSharedMemorySize, LDS_BYTES) != hipSuccess) { fprintf(stderr, "kernel_launch: hipFuncSetAttribute failed\n"); grid = -1; return; }
        if (hipOccupancyMaxActiveBlocksPerMultiprocessor(&per_cu, (const void*)fwd_megakernel, NTHREADS, LDS_BYTES) != hipSuccess || per_cu < 1) { fprintf(stderr, "kernel_launch: occupancy query says %d\n", per_cu); per_cu = 1; }
        (void)hipGetLastError();
        grid = cus * 1;
    }
    if (grid < 0) return;
    hipMemsetAsync((char*)d_ws + WS_CTL, 0, CTL_BYTES, stream);
    Params p{};
    p.x = (const float*)d_in[0]; p.rel = (const float*)d_in[1]; p.w_in = (const float*)d_in[2]; p.w_out = (const float*)d_in[3]; p.cmp_w1 = (const float*)d_in[4]; p.cmp_w2 = (const float*)d_in[5];
    p.cmp_pe = (const float*)d_in[6]; p.norm_attn = (const float*)d_in[7]; p.norm_mlp = (const float*)d_in[8]; p.w_up = (const float*)d_in[9]; p.conv_w = (const float*)d_in[10]; p.conv_b = (const float*)d_in[11];
    p.w_down = (const float*)d_in[12]; p.norm_final = (const float*)d_in[13]; p.out = (float*)d_out; p.ws = (unsigned char*)d_ws;
    void* args[] = {&p};
    hipError_t e = hipLaunchCooperativeKernel((const void*)fwd_megakernel, dim3(grid), dim3(NTHREADS), args, LDS_BYTES, stream);
    if (e != hipSuccess) fprintf(stderr, "kernel_launch: cooperative launch failed: %s (grid %d)\n", hipGetErrorString(e), grid);
}
```

```cpp
#define NO_TAILFILL
#define FUSE_CONV
#define CONV_DPP
#include <hip/hip_runtime.h>
#include <hip/hip_cooperative_groups.h>
#include <cstdio>
#include <cstdint>
namespace cg = cooperative_groups;
namespace pg8 {
#define PG8_LAS __attribute__((address_space(3)))
typedef unsigned short bf16_t;
typedef short bf16x8 __attribute__((ext_vector_type(8)));
typedef float f32x4 __attribute__((ext_vector_type(4)));
typedef unsigned u32x4 __attribute__((ext_vector_type(4)));
constexpr int BM = 256, BK = 64, HALF = 128, HTB = HALF * BK * 2  , STAGE_BYTES = 8 * HTB, NXCD = 8, WGM = 8;

__host__ __device__ __forceinline__ int lds_byte(int r, int c) { const int st = (r >> 4) * 2 + (c >> 5), rr = r & 15, cc = c & 31, ob = rr * 64 + cc * 2; return st * 1024 + (ob ^ (((ob >> 9) & 1) << 5)); }
__host__ __device__ __forceinline__ void stage_rc(int b, int& R, int& C) { const int st = b / 1024, sb = b % 1024, swz = sb ^ (((sb >> 9) & 1) << 5); R = (st >> 1) * 16 + swz / 64; C = (st & 1) * 32 + (swz % 64) / 2; }
__host__ __device__ __forceinline__ int perm32(int rho) { const int n = rho >> 4, i = rho & 15; return 8 * (i >> 2) + 4 * n + (i & 3); }

struct Unit { int pm, pn; };
struct Gemm { const bf16_t* A; const bf16_t* Bt; int M, N, K; };

struct StaticOrder {
    int nM, nN, nwg, G, c;
    __host__ __device__ void init(int M, int N, int G_, int c_) { nM = M / BM; nN = N / BM; nwg = nM * nN; G = G_; c = c_; }
    __host__ __device__ bool next(int i, Unit& u) const {
        const long L = (long)i * G + c; if (L >= nwg) return false;
        int wgid = (int)L; { const int q = nwg / NXCD, r = nwg % NXCD, xcd = wgid % NXCD, off = wgid / NXCD; wgid = (xcd < r ? xcd * (q + 1) : r * (q + 1) + (xcd - r) * q) + off; }
        const int nig = WGM * nN, gid = wgid / nig, fm = gid * WGM, gsz = (nM - fm) < WGM ? (nM - fm) : WGM;
        u.pm = fm + ((wgid % nig) % gsz); u.pn = (wgid % nig) / gsz; return true;
    }
    __device__ __forceinline__ void a_ready(const Unit&) const {}
    __device__ __forceinline__ void done(const Unit&) const {}
};
typedef float f32x2 __attribute__((ext_vector_type(2)));
typedef __bf16 bf16x2_pk __attribute__((ext_vector_type(2)));
__device__ __forceinline__ unsigned cvt_pk_bf16(float lo, float hi) { f32x2 v = {lo, hi}; bf16x2_pk b = __builtin_convertvector(v, bf16x2_pk); return __builtin_bit_cast(unsigned, b); }
__device__ __forceinline__ float row_rstd(const float* ssp, int row) {
    const f32x4* p = (const f32x4*)(ssp + (size_t)row * 32); float s = 0.f;
#pragma unroll
    for (int i = 0; i < 8; ++i) { const f32x4 v = p[i]; s += (v[0] + v[1]) + (v[2] + v[3]); }
    return 1.0f / sqrtf(s * (1.0f / 2048.0f) + 1e-6f);
}
struct EpiScaleBf16 {
    static constexpr bool PERM = true, AFTER_DRAIN = false;
    bf16_t* O; int ldc; const float* ssp;
    __device__ __forceinline__ void operator()(const f32x4 (&acc)[2][2][4][2], const Unit& u, int wr, int wc, int fr, int fq) const {
        const int lane = fq * 16 + fr;
        const int rbase = u.pm * BM + wr * 64;
        f32x4 t[2][8];
#pragma unroll
        for (int j = 0; j < 2; ++j) { const int q = 2 * lane + j; const int row = rbase + (q >> 6) * HALF + (q & 63);
            const f32x4* p = (const f32x4*)(ssp + (size_t)row * 32);
#pragma unroll
            for (int i = 0; i < 8; ++i) t[j][i] = p[i]; }
        __builtin_amdgcn_sched_barrier(0);
        float rsv[2];
#pragma unroll
        for (int j = 0; j < 2; ++j) { float sm = 0.f;
#pragma unroll
            for (int i = 0; i < 8; ++i) sm += (t[j][i][0] + t[j][i][1]) + (t[j][i][2] + t[j][i][3]);
            rsv[j] = 1.0f / sqrtf(sm * (1.0f / 2048.0f) + 1e-6f); }
        const int row0 = rbase + fr; const int col0 = u.pn * BM + wc * 32 + 8 * fq;
#pragma unroll
        for (int ai = 0; ai < 2; ++ai)
#pragma unroll
            for (int m = 0; m < 4; ++m) { const int q = ai * 64 + m * 16 + fr; const float v0 = __shfl(rsv[0], q >> 1), v1 = __shfl(rsv[1], q >> 1); const float rs = (q & 1) ? v1 : v0;
                bf16_t* rowp = O + (size_t)(row0 + ai * HALF + m * 16) * ldc + col0;
#pragma unroll
                for (int bj = 0; bj < 2; ++bj) { const f32x4 v0_ = acc[ai][bj][m][0] * rs, v1_ = acc[ai][bj][m][1] * rs; u32x4 w;
                    w.x = cvt_pk_bf16(v0_[0], v0_[1]); w.y = cvt_pk_bf16(v0_[2], v0_[3]); w.z = cvt_pk_bf16(v1_[0], v1_[1]); w.w = cvt_pk_bf16(v1_[2], v1_[3]);
                    *(u32x4*)(rowp + bj * HALF) = w; } }
    }
};
struct EpiResid {
    static constexpr bool PERM = false, AFTER_DRAIN = false;
    bf16_t* XB; float* ssp;
    __device__ __forceinline__ void operator()(const f32x4 (&acc)[2][2][4][2], const Unit& u, int wr, int wc, int fr, int fq) const {
        typedef unsigned u32x2v __attribute__((ext_vector_type(2)));
        const int row0 = u.pm * BM + wr * 64 + fr; const int col0 = u.pn * BM + wc * 32 + 4 * fq;
#pragma unroll
        for (int ai = 0; ai < 2; ++ai) {
            u32x2v bs[4][2][2];
#pragma unroll
            for (int m = 0; m < 4; ++m)
#pragma unroll
                for (int bj = 0; bj < 2; ++bj)
#pragma unroll
                    for (int n = 0; n < 2; ++n) bs[m][bj][n] = *(const u32x2v*)(XB + (size_t)(row0 + ai * HALF + m * 16) * 2048 + col0 + bj * HALF + n * 16);
            __builtin_amdgcn_sched_barrier(0);
#pragma unroll
            for (int m = 0; m < 4; ++m) { const int row = row0 + ai * HALF + m * 16; const size_t off = (size_t)row * 2048 + col0; float ss = 0.f;
#pragma unroll
                for (int bj = 0; bj < 2; ++bj)
#pragma unroll
                    for (int n = 0; n < 2; ++n) { const size_t o2 = off + bj * HALF + n * 16; const u32x2v b2 = bs[m][bj][n];
                        const f32x4 bv = {__uint_as_float(b2.x << 16), __uint_as_float(b2.x & 0xffff0000u), __uint_as_float(b2.y << 16), __uint_as_float(b2.y & 0xffff0000u)};
                        const f32x4 v = bv + acc[ai][bj][m][n];
                        u32x2v w; w.x = cvt_pk_bf16(v[0], v[1]); w.y = cvt_pk_bf16(v[2], v[3]); *(u32x2v*)(XB + o2) = w;
                        ss += (v[0] * v[0] + v[1] * v[1]) + (v[2] * v[2] + v[3] * v[3]); }
                ss += __shfl_xor(ss, 16); ss += __shfl_xor(ss, 32);
                if (fq == 0) ssp[(size_t)row * 32 + u.pn * 4 + wc] = ss; }
            asm volatile("" ::: "memory");
        }
    }
};
template <int CTRL> __device__ __forceinline__ float dpp_f(float v) { return __builtin_bit_cast(float, __builtin_amdgcn_update_dpp(0, __builtin_bit_cast(int, v), CTRL, 0xf, 0xf, false)); }
#ifdef CONV_DPP
#define ROWM1(v) dpp_f<0x121>(v)
#define ROWM2(v) dpp_f<0x122>(v)
#else
#define ROWM1(v) __shfl(v, src1)
#define ROWM2(v) __shfl(v, src2)
#endif
struct EpiConvGate {
    static constexpr bool PERM = true, AFTER_DRAIN = false;
    bf16_t* ACT; bf16_t* UB; const float* ssp; const float* cw; const float* cb; int dff;
    __device__ __forceinline__ void operator()(const f32x4 (&acc)[2][2][4][2], const Unit& u, int wr, int wc, int fr, int fq) const {
        typedef unsigned u32x2v __attribute__((ext_vector_type(2)));
        const int lane = fq * 16 + fr;
        const int rbase = u.pm * BM + wr * 64;
        const int upw = 2 * dff;
        float rsv[2];
        { f32x4 t[2][8];
#pragma unroll
          for (int j = 0; j < 2; ++j) { const int q = 2 * lane + j; const int row = rbase + (q >> 6) * HALF + (q & 63);
              const f32x4* p = (const f32x4*)(ssp + (size_t)row * 32);
#pragma unroll
              for (int i = 0; i < 8; ++i) t[j][i] = p[i]; }
          __builtin_amdgcn_sched_barrier(0);
#pragma unroll
          for (int j = 0; j < 2; ++j) { float sm = 0.f;
#pragma unroll
              for (int i = 0; i < 8; ++i) sm += (t[j][i][0] + t[j][i][1]) + (t[j][i][2] + t[j][i][3]);
              rsv[j] = 1.0f / sqrtf(sm * (1.0f / 2048.0f) + 1e-6f); } }
        const int src1 = fq * 16 + ((fr + 15) & 15), src2 = fq * 16 + ((fr + 14) & 15); (void)src1; (void)src2;
        const int chb = u.pn * HALF + wc * 32 + 8 * fq;
        const int ucb = u.pn * BM + wc * 32 + 8 * fq;
#pragma unroll
        for (int n = 0; n < 2; ++n) {
            const int ch = chb + 4 * n;
            const f32x4 wa0 = *(const f32x4*)(cw + ch), wa1 = *(const f32x4*)(cw + upw + ch), wa2 = *(const f32x4*)(cw + 2 * upw + ch);
            const f32x4 wg0 = *(const f32x4*)(cw + dff + ch), wg1 = *(const f32x4*)(cw + upw + dff + ch), wg2 = *(const f32x4*)(cw + 2 * upw + dff + ch);
            const f32x4 ba = *(const f32x4*)(cb + ch), bg = *(const f32x4*)(cb + dff + ch);
            __builtin_amdgcn_sched_barrier(0);
#pragma unroll
            for (int ai = 0; ai < 2; ++ai) {
                f32x4 pa = {0.f, 0.f, 0.f, 0.f}, pg = {0.f, 0.f, 0.f, 0.f};
#pragma unroll
                for (int m = 0; m < 4; ++m) {
                    const int q = ai * 64 + m * 16 + fr; const float rv0 = __shfl(rsv[0], q >> 1), rv1 = __shfl(rsv[1], q >> 1); const float rsm = (q & 1) ? rv1 : rv0;
                    const f32x4 va = acc[ai][0][m][n] * rsm, vg = acc[ai][1][m][n] * rsm;
                    f32x4 a1, a2, g1, g2;
#pragma unroll
                    for (int x = 0; x < 4; ++x) {
                        const float c1 = ROWM1(va[x]), c2 = ROWM2(va[x]), e1 = ROWM1(vg[x]), e2 = ROWM2(vg[x]);
                        float d1 = 0.f, d2 = 0.f, f1 = 0.f, f2 = 0.f;
                        if (m > 0) { d1 = ROWM1(pa[x]); d2 = ROWM2(pa[x]); f1 = ROWM1(pg[x]); f2 = ROWM2(pg[x]); }
                        a1[x] = fr >= 1 ? c1 : d1; a2[x] = fr >= 2 ? c2 : d2; g1[x] = fr >= 1 ? e1 : f1; g2[x] = fr >= 2 ? e2 : f2; }
                    const f32x4 ya = ba + wa0 * va + wa1 * a1 + wa2 * a2, yg = bg + wg0 * vg + wg1 * g1 + wg2 * g2;
                    float r4[4];
#pragma unroll
                    for (int x = 0; x < 4; ++x) r4[x] = ya[x] * yg[x] / (1.f + __expf(-yg[x]));
                    const int row = rbase + ai * HALF + m * 16 + fr;
                    if (m > 0 || fr >= 2) { u32x2v w; w.x = cvt_pk_bf16(r4[0], r4[1]); w.y = cvt_pk_bf16(r4[2], r4[3]); *(u32x2v*)(ACT + (size_t)row * dff + ch) = w; }
                    if ((m == 0 && fr < 2) || (m == 3 && fr >= 14)) { const int k = (m == 0) ? fr : fr - 12; bf16_t* ub = UB + ((size_t)(row >> 6) * 4 + k) * upw + ucb + 4 * n;
                        u32x2v w; w.x = cvt_pk_bf16(va[0], va[1]); w.y = cvt_pk_bf16(va[2], va[3]); *(u32x2v*)ub = w;
                        w.x = cvt_pk_bf16(vg[0], vg[1]); w.y = cvt_pk_bf16(vg[2], vg[3]); *(u32x2v*)(ub + HALF) = w; }
                    pa = va; pg = vg;
                }
                asm volatile("" ::: "memory");
            }
        }
    }
};
template <class Epi, class Sched, bool ALIGN_EPI = false, bool SP2 = false>
__device__ __forceinline__ void gemm_phase(PG8_LAS unsigned char* lds, const Gemm g, const Sched& S, const Epi& E, const int wid_in) {
    int lane_; asm volatile("v_mbcnt_lo_u32_b32 %0, -1, 0\n\tv_mbcnt_hi_u32_b32 %0, -1, %0" : "=v"(lane_)); const int wid = wid_in, lane = lane_, tid = wid * 64 + lane, wr = wid >> 2, wc = wid & 3, fr = lane & 15, fq = lane >> 4;
    const int K = g.K, nt = K / BK;
    unsigned voffA[2], voffB[2];
#pragma unroll
    for (int i = 0; i < 2; ++i) { int R, C; stage_rc(tid * 16 + i * 8192, R, C); const int Rb = Epi::PERM ? ((R & ~31) + perm32(R & 31)) : R;
        voffA[i] = (unsigned)(R * K + C) * 2u; voffB[i] = (unsigned)(Rb * K + C) * 2u; }
    const size_t kstep = (size_t)(BK * 2);
    const size_t hstep = (size_t)HALF * K * 2;
    const size_t tstep = 2 * hstep;
    const unsigned ldsw = (unsigned)wid * 1024u;
    const int aoff = lds_byte(wr * 64 + fr, fq * 8), boff = lds_byte(wc * 32 + fr, fq * 8);
#define PG8_SA(b, h) (((b) * 2 + (h)) * HTB)
#define PG8_SB(b, h) ((4 + (b) * 2 + (h)) * HTB)
#define PG8_STAGE(bufoff, gbase, voff) do { _Pragma("unroll") for (int _i = 0; _i < 2; ++_i) \
        __builtin_amdgcn_global_load_lds((const unsigned*)((const char*)(gbase) + (voff)[_i]), (PG8_LAS unsigned*)(lds + (bufoff) + ldsw + _i * 8192), 16, 0, 0); } while (0)
#define PG8_LDA(dst, b, h) do { _Pragma("unroll") for (int m = 0; m < 4; ++m) _Pragma("unroll") for (int k = 0; k < 2; ++k) dst[m][k] = *(const PG8_LAS bf16x8*)(lds + PG8_SA(b, h) + aoff + m * 2048 + k * 1024); } while (0)
#define PG8_LDB(dst, b, h) do { _Pragma("unroll") for (int n = 0; n < 2; ++n) _Pragma("unroll") for (int k = 0; k < 2; ++k) dst[n][k] = *(const PG8_LAS bf16x8*)(lds + PG8_SB(b, h) + boff + n * 2048 + k * 1024); } while (0)
#define PG8_MMA(ai, bj, At, Bt) do { __builtin_amdgcn_s_setprio(1); _Pragma("unroll") for (int m = 0; m < 4; ++m) _Pragma("unroll") for (int n = 0; n < 2; ++n) _Pragma("unroll") for (int k = 0; k < 2; ++k) \
        acc[ai][bj][m][n] = __builtin_amdgcn_mfma_f32_16x16x32_bf16(Bt[n][k], At[m][k], acc[ai][bj][m][n], 0, 0, 0); __builtin_amdgcn_s_setprio(0); } while (0)
#define PG8_WAIT_V(n) asm volatile("s_waitcnt vmcnt(" #n ")" ::: "memory")
#define PG8_WAIT_L(n) asm volatile("s_waitcnt lgkmcnt(" #n ")" ::: "memory")
#define PG8_BAR __builtin_amdgcn_s_barrier()
#define PG8_SCHED __builtin_amdgcn_sched_barrier(0)
    Unit cur, nxt; int ui = 0;
    if (!S.next(0, cur)) return;
    f32x4 acc[2][2][4][2];
#pragma unroll
    for (int a = 0; a < 2; ++a)
#pragma unroll
        for (int b = 0; b < 2; ++b)
#pragma unroll
            for (int m = 0; m < 4; ++m)
#pragma unroll
                for (int n = 0; n < 2; ++n) acc[a][b][m][n] = (f32x4){0.f, 0.f, 0.f, 0.f};
    bf16x8 At[4][2], B0[2][2], B1[2][2];
    const char* cA = (const char*)g.A + (size_t)cur.pm * tstep; const char* cB = (const char*)g.Bt + (size_t)cur.pn * tstep;
    S.a_ready(cur);
    if constexpr (SP2) {
        PG8_STAGE(PG8_SB(0, 0), cB, voffB); PG8_STAGE(PG8_SB(0, 1), cB + hstep, voffB); PG8_STAGE(PG8_SA(0, 0), cA, voffA); PG8_STAGE(PG8_SA(0, 1), cA + hstep, voffA);
        if (wr == 1) PG8_BAR;
        PG8_WAIT_V(2); PG8_BAR;
        PG8_STAGE(PG8_SB(1, 0), cB + kstep, voffB); PG8_STAGE(PG8_SA(1, 0), cA + kstep, voffA); PG8_STAGE(PG8_SB(1, 1), cB + hstep + kstep, voffB);
        PG8_WAIT_V(6); PG8_BAR;
    } else {
        PG8_STAGE(PG8_SB(0, 0), cB, voffB); PG8_STAGE(PG8_SA(0, 0), cA, voffA); PG8_STAGE(PG8_SB(0, 1), cB + hstep, voffB); PG8_STAGE(PG8_SA(0, 1), cA + hstep, voffA);
        if (wr == 1) PG8_BAR;
        PG8_WAIT_V(4); PG8_BAR;
        PG8_STAGE(PG8_SB(1, 0), cB + kstep, voffB); PG8_STAGE(PG8_SA(1, 0), cA + kstep, voffA); PG8_STAGE(PG8_SB(1, 1), cB + hstep + kstep, voffB);
        PG8_WAIT_V(6); PG8_BAR;
    }
    for (;;) {
        const bool has_next = S.next(ui + 1, nxt);
        const char* nA = has_next ? (const char*)g.A + (size_t)nxt.pm * tstep : cA; const char* nB = has_next ? (const char*)g.Bt + (size_t)nxt.pn * tstep : cB;
        for (int t = 0; t < nt; t += 2) {
            const bool last = (t == nt - 2);
            const char* a1 = cA + (size_t)(t + 1) * kstep;
            const char* a2 = last ? nA : cA + (size_t)(t + 2) * kstep; const char* b2 = last ? nB : cB + (size_t)(t + 2) * kstep;
            const char* a3 = a2 + kstep; const char* b3 = b2 + kstep;
            if (last && has_next) S.a_ready(nxt);
            if constexpr (SP2) {
            PG8_LDB(B0, 0, 0); PG8_LDB(B1, 0, 1); PG8_SCHED; PG8_LDA(At, 0, 0); PG8_STAGE(PG8_SA(1, 1), a1 + hstep, voffA);
            PG8_WAIT_V(8); PG8_WAIT_L(0); PG8_BAR; PG8_MMA(0, 0, At, B0); PG8_MMA(0, 1, At, B1); PG8_BAR; PG8_SCHED;
            PG8_LDA(At, 0, 1); PG8_STAGE(PG8_SB(0, 0), b2, voffB); PG8_STAGE(PG8_SB(0, 1), b2 + hstep, voffB); PG8_STAGE(PG8_SA(0, 0), a2, voffA);
            PG8_WAIT_V(8); PG8_WAIT_L(0); PG8_BAR; PG8_MMA(1, 0, At, B0); PG8_MMA(1, 1, At, B1); PG8_BAR; PG8_SCHED;
            PG8_LDB(B0, 1, 0); PG8_LDB(B1, 1, 1); PG8_SCHED; PG8_LDA(At, 1, 0); PG8_STAGE(PG8_SA(0, 1), a2 + hstep, voffA);
            PG8_WAIT_V(8); PG8_WAIT_L(0); PG8_BAR; PG8_MMA(0, 0, At, B0); PG8_MMA(0, 1, At, B1); PG8_BAR; PG8_SCHED;
            PG8_LDA(At, 1, 1); PG8_STAGE(PG8_SB(1, 0), b3, voffB); PG8_STAGE(PG8_SB(1, 1), b3 + hstep, voffB); PG8_STAGE(PG8_SA(1, 0), a3, voffA);
            PG8_WAIT_V(8); PG8_WAIT_L(0); PG8_BAR; PG8_MMA(1, 0, At, B0); PG8_MMA(1, 1, At, B1); PG8_BAR; PG8_SCHED;
            } else {
            PG8_LDB(B0, 0, 0); PG8_SCHED; PG8_LDA(At, 0, 0); PG8_STAGE(PG8_SA(1, 1), a1 + hstep, voffA);
            PG8_WAIT_L(8); PG8_BAR; PG8_WAIT_L(0); PG8_MMA(0, 0, At, B0); PG8_BAR; PG8_SCHED;
            PG8_LDB(B1, 0, 1); PG8_STAGE(PG8_SB(0, 0), b2, voffB);
            PG8_BAR; PG8_WAIT_L(0); PG8_MMA(0, 1, At, B1); PG8_BAR;
            PG8_LDA(At, 0, 1); PG8_STAGE(PG8_SA(0, 0), a2, voffA);
            PG8_BAR; PG8_WAIT_L(0); PG8_MMA(1, 0, At, B0); PG8_BAR; PG8_SCHED;
            PG8_STAGE(PG8_SB(0, 1), b2 + hstep, voffB);
            PG8_WAIT_V(6); PG8_BAR; PG8_MMA(1, 1, At, B1); PG8_BAR;
            PG8_LDB(B0, 1, 0); PG8_SCHED; PG8_LDA(At, 1, 0); PG8_STAGE(PG8_SA(0, 1), a2 + hstep, voffA);
            PG8_WAIT_L(8); PG8_BAR; PG8_WAIT_L(0); PG8_MMA(0, 0, At, B0); PG8_BAR; PG8_SCHED;
            PG8_LDB(B1, 1, 1); PG8_STAGE(PG8_SB(1, 0), b3, voffB);
            PG8_BAR; PG8_WAIT_L(0); PG8_MMA(0, 1, At, B1); PG8_BAR;
            PG8_LDA(At, 1, 1); PG8_STAGE(PG8_SA(1, 0), a3, voffA);
            PG8_BAR; PG8_WAIT_L(0); PG8_MMA(1, 0, At, B0); PG8_BAR; PG8_SCHED;
            PG8_STAGE(PG8_SB(1, 1), b3 + hstep, voffB);
            PG8_WAIT_V(6); PG8_BAR; PG8_MMA(1, 1, At, B1); PG8_BAR;
            }
        }
        if constexpr (ALIGN_EPI) { if (wr == 0) PG8_BAR; }
        if constexpr (!Epi::AFTER_DRAIN) { E(acc, cur, wr, wc, fr, fq); S.done(cur); }
        if (!has_next) break;
#pragma unroll
        for (int a = 0; a < 2; ++a)
#pragma unroll
            for (int b = 0; b < 2; ++b)
#pragma unroll
                for (int m = 0; m < 4; ++m)
#pragma unroll
                    for (int n = 0; n < 2; ++n) acc[a][b][m][n] = (f32x4){0.f, 0.f, 0.f, 0.f};
        cur = nxt; cA = nA; cB = nB; ++ui;
        if constexpr (ALIGN_EPI) { if (wr == 1) PG8_BAR; }
    }
    PG8_WAIT_V(0);
    if constexpr (!ALIGN_EPI) { if (wr == 0) PG8_BAR; }
    PG8_BAR;
    if constexpr (Epi::AFTER_DRAIN) { E.fused(acc, cur, wr, wc, fr, fq, lds, wid, lane); S.done(cur); }
#undef PG8_SA
#undef PG8_SB
#undef PG8_STAGE
#undef PG8_LDA
#undef PG8_LDB
#undef PG8_MMA
#undef PG8_WAIT_V
#undef PG8_WAIT_L
#undef PG8_BAR
#undef PG8_SCHED
}
}

#define GAS __attribute__((address_space(1)))
#define LAS __attribute__((address_space(3)))
typedef unsigned short bf16_t;
typedef short bf16x8 __attribute__((ext_vector_type(8)));
typedef float f32x4 __attribute__((ext_vector_type(4)));
typedef unsigned u32x4 __attribute__((ext_vector_type(4)));
typedef unsigned u32x2 __attribute__((ext_vector_type(2)));
typedef short s16x4 __attribute__((ext_vector_type(4)));

constexpr int BATCH = 2, SEQ = 8192, DM = 2048, DEPTH = 4, MROWS = BATCH * SEQ;
constexpr int INW = 5796, INP = 5888, DFF = 5632, UPW = 2 * DFF;
constexpr int A_OFF = 0, B_OFF = 2304, CQ_OFF = 3840, CKV_OFF = 4608, CG_OFF = 5760;
constexpr int LUTN = 1536;
constexpr float LOG2E = 1.4426950408889634f, LN2 = 0.6931471805599453f;
constexpr int NTHREADS = 512, NWAVES = 8;

constexpr size_t al256(size_t x) { return (x + 255) & ~(size_t)255; }
constexpr size_t WS_CTL = 0, CTL_BYTES = 1u << 20;
constexpr size_t SZ_WIN = (size_t)INP * DM * 2, SZ_WOUT = (size_t)DM * DM * 2, SZ_WUP = (size_t)UPW * DM * 2, SZ_WDN = (size_t)DM * DFF * 2;
constexpr size_t WS_WIN = CTL_BYTES;
constexpr size_t WS_WOUT = WS_WIN + DEPTH * SZ_WIN;
constexpr size_t WS_WUP = WS_WOUT + DEPTH * SZ_WOUT;
constexpr size_t WS_WDN = WS_WUP + DEPTH * SZ_WUP;
constexpr size_t WS_W1T = WS_WDN + DEPTH * SZ_WDN;
constexpr size_t WS_W2T = WS_W1T + (size_t)DEPTH * 2 * 128 * 2048 * 2;
constexpr size_t WS_CPE = WS_W2T + (size_t)DEPTH * 2 * 64 * 128 * 2;
constexpr size_t WS_GLUT = al256(WS_CPE + (size_t)DEPTH * 2 * 128 * 4);
constexpr size_t WS_X = al256(WS_GLUT + (size_t)32 * LUTN * 4);
constexpr size_t WS_XB = WS_X + (size_t)MROWS * DM * 4;
constexpr size_t WS_SSP = WS_XB + (size_t)MROWS * DM * 2;
constexpr size_t WS_R1 = WS_SSP + (size_t)MROWS * 32 * 4;
constexpr size_t WS_PROJ = WS_R1;
constexpr size_t WS_O = WS_R1 + (size_t)MROWS * INP * 2;
constexpr size_t WS_U = WS_R1;
constexpr size_t SZ_R1 = (size_t)MROWS * UPW * 2;
static_assert((size_t)MROWS * INP * 2 + (size_t)MROWS * DM * 2 <= SZ_R1, "overlay");
constexpr size_t WS_ACT = WS_R1 + SZ_R1;
constexpr size_t WS_TOT = WS_ACT + (size_t)MROWS * DFF * 2;
constexpr size_t WS_LSE = WS_TOT + (size_t)MROWS * 768 * 4;
constexpr size_t WS_KC = WS_LSE + (size_t)MROWS * 12 * 4;
constexpr size_t WS_VC = WS_KC + (size_t)BATCH * 3 * 512 * 64 * 2;
constexpr size_t WS_KMEAN = WS_VC + (size_t)BATCH * 3 * 512 * 64 * 2;
constexpr size_t WS_UB = WS_KMEAN + (size_t)BATCH * 8 * 32 * 64 * 4;
constexpr size_t WS_END = WS_UB + (size_t)(MROWS / 64) * 4 * UPW * 2;

constexpr int KP = 160;
constexpr int TILE_B = 64 * KP;
constexpr int L_K0 = 0, L_V0 = TILE_B, L_K1 = 2 * TILE_B, L_V1 = 3 * TILE_B;
constexpr int L_LUT = 4 * TILE_B;
constexpr int L_IMP = L_LUT + 4 * LUTN * 4;
constexpr int L_SEL = L_IMP + 65536;
constexpr int L_TL = L_SEL + 2048;
constexpr int L_MISC = L_TL + 2048;
constexpr int L_WUN = L_MISC + 64;
constexpr int LDS_BYTES = 147456;
static_assert(L_MISC + 256 <= LDS_BYTES, "lds map");

struct Params {
    const float* x; const float* rel; const float* w_in; const float* w_out; const float* cmp_w1; const float* cmp_w2; const float* cmp_pe;
    const float* norm_attn; const float* norm_mlp; const float* w_up; const float* conv_w; const float* conv_b; const float* w_down; const float* norm_final;
    float* out; unsigned char* ws;
};

typedef float f32x2_t __attribute__((ext_vector_type(2))); typedef __bf16 bf16x2_t __attribute__((ext_vector_type(2)));
__device__ __forceinline__ unsigned cvtpk(float lo, float hi) { f32x2_t v = {lo, hi}; bf16x2_t b = __builtin_convertvector(v, bf16x2_t); return __builtin_bit_cast(unsigned, b); }
__device__ __forceinline__ float bf2f(unsigned short b) { return __uint_as_float(((unsigned)b) << 16); }
__device__ __forceinline__ float bflo(unsigned w) { return __uint_as_float(w << 16); }
__device__ __forceinline__ float bfhi(unsigned w) { return __uint_as_float(w & 0xffff0000u); }
__device__ __forceinline__ float fexp2(float x) { return __builtin_amdgcn_exp2f(x); }
__device__ __forceinline__ int lane_id_opaque() { int l_; asm volatile("v_mbcnt_lo_u32_b32 %0, -1, 0\n\tv_mbcnt_hi_u32_b32 %0, -1, %0" : "=v"(l_)); return l_; }
#define LDS_BARRIER() do { asm volatile("s_waitcnt lgkmcnt(0)" ::: "memory"); __builtin_amdgcn_s_barrier(); asm volatile("" ::: "memory"); } while (0)
__device__ __forceinline__ float fma_1(float a, float b, float c) { float r; asm("v_fma_f32 %0, %1, %2, %3" : "=v"(r) : "v"(a), "v"(b), "v"(c)); return r; }
__device__ __forceinline__ void lds_wait() { asm volatile("s_waitcnt lgkmcnt(0)" ::: "memory"); }
__device__ __forceinline__ s16x4 tr_read(const LAS unsigned char* p) { return __builtin_bit_cast(s16x4, __builtin_amdgcn_ds_read_tr16_b64_v4i16((LAS s16x4*)p)); }
__device__ __forceinline__ f32x4 mfma16(bf16x8 a, bf16x8 b, f32x4 c) { return __builtin_amdgcn_mfma_f32_16x16x32_bf16(a, b, c, 0, 0, 0); }

__device__ __forceinline__ int t5_bucket(int n) {
    if (n < 16) return n < 0 ? 0 : n;
    int b = 16;
    b += n >= 22; b += n >= 30; b += n >= 40; b += n >= 54; b += n >= 73; b += n >= 99; b += n >= 134; b += n >= 182;
    b += n >= 246; b += n >= 332; b += n >= 450; b += n >= 609; b += n >= 825; b += n >= 1117; b += n >= 1513;
    return b;
}
__device__ __forceinline__ bool is_qcol(int n) { return (n < 2304) ? ((n % 768) < 256) : ((n < 2816) || (n >= 3840 && n < 4608)); }

template <int MODE>
__device__ __forceinline__ void p0_item(const float* W, int K, int Nsrc, bf16_t* WT, const float* kscale, LAS float* scr, int kb, int nb, int lane) {
    const int k0 = 64 * kb, n0 = 32 * nb;
    const int nd = n0 + (lane & 31);
    int sc = nd; float cs = 1.f; bool ok = true;
    if (MODE == 0) { ok = nd < INW; if (is_qcol(nd)) cs = 0.125f; }
    if (MODE == 2) { const int pn = nd >> 8, r = nd & 255; sc = (r >= 128 ? DFF : 0) + 128 * pn + (r & 127); }
    float wv[32], kv_[32];
    const float* wp_ = W + (size_t)(k0 + (lane >> 5)) * Nsrc + (ok ? sc : 0);
#pragma unroll
    for (int i = 0; i < 32; ++i) { wv[i] = wp_[(size_t)(2 * i) * Nsrc]; kv_[i] = (MODE != 1) ? kscale[k0 + 2 * i + (lane >> 5)] : 1.f; }
    __builtin_amdgcn_sched_barrier(0);
#pragma unroll
    for (int i = 0; i < 32; ++i) { const int kk = 2 * i + (lane >> 5); scr[kk * 33 + (lane & 31)] = ok ? wv[i] * cs * kv_[i] : 0.f; }
    lds_wait();
    const int c = lane & 7;
#pragma unroll
    for (int j = 0; j < 4; ++j) { const int n = (lane >> 3) + 8 * j; const LAS float* s = scr + (8 * c) * 33 + n;
        u32x4 o; o.x = cvtpk(s[0 * 33], s[1 * 33]); o.y = cvtpk(s[2 * 33], s[3 * 33]); o.z = cvtpk(s[4 * 33], s[5 * 33]); o.w = cvtpk(s[6 * 33], s[7 * 33]);
        *(u32x4*)(WT + (size_t)(n0 + n) * K + k0 + 8 * c) = o; }
    lds_wait();
}

constexpr int I_IN = 32 * (INP / 32), I_OUT = 32 * 64, I_UP = 32 * (UPW / 32), I_DN = (DFF / 64) * 64, I_W1 = 2 * 32 * 4, I_W2 = 2 * 2 * 2;
constexpr int I_LAYER = I_IN + I_OUT + I_UP + I_DN + I_W1 + I_W2;
__device__ __forceinline__ void p0_layer_item(const Params& P, LAS float* scr, int l, int r, int lane) {
    unsigned char* ws = P.ws;
    if (r < I_IN) { p0_item<0>(P.w_in + (size_t)l * DM * INW, DM, INW, (bf16_t*)(ws + WS_WIN + l * SZ_WIN), P.norm_attn + l * DM, scr, r / (INP / 32), r % (INP / 32), lane); return; } r -= I_IN;
    if (r < I_OUT) { p0_item<1>(P.w_out + (size_t)l * DM * DM, DM, DM, (bf16_t*)(ws + WS_WOUT + l * SZ_WOUT), nullptr, scr, r / 64, r % 64, lane); return; } r -= I_OUT;
    if (r < I_UP) { p0_item<2>(P.w_up + (size_t)l * DM * UPW, DM, UPW, (bf16_t*)(ws + WS_WUP + l * SZ_WUP), P.norm_mlp + l * DM, scr, r / (UPW / 32), r % (UPW / 32), lane); return; } r -= I_UP;
    if (r < I_DN) { p0_item<1>(P.w_down + (size_t)l * DFF * DM, DFF, DM, (bf16_t*)(ws + WS_WDN + l * SZ_WDN), nullptr, scr, r / 64, r % 64, lane); return; } r -= I_DN;
    if (r < I_W1) { const int i = r / 128, rr = r % 128; p0_item<1>(P.cmp_w1 + (size_t)(l * 2 + i) * 2048 * 128, 2048, 128, (bf16_t*)(ws + WS_W1T) + (size_t)(l * 2 + i) * 128 * 2048, nullptr, scr, rr / 4, rr % 4, lane); return; } r -= I_W1;
    { const int i = r / 4, rr = r % 4; p0_item<1>(P.cmp_w2 + (size_t)(l * 2 + i) * 128 * 64, 128, 64, (bf16_t*)(ws + WS_W2T) + (size_t)(l * 2 + i) * 64 * 128, nullptr, scr, rr / 2, rr % 2, lane); }
}
#ifdef NO_TAILFILL
constexpr int P0_LAYERS = DEPTH;
#else
constexpr int P0_LAYERS = 1;
#endif
constexpr int CONV_UNIT_ITEMS = 64, N_CONV_UNITS = (I_LAYER + CONV_UNIT_ITEMS - 1) / CONV_UNIT_ITEMS;

__device__ __forceinline__ void p0_prologue(const Params& P, LAS unsigned char* lds, int tid, int lane, int wave) {
    unsigned char* ws = P.ws;
    LAS float* scr = (LAS float*)(lds + wave * 16384);
    const int G = gridDim.x, gw = blockIdx.x * NWAVES + wave, NGW = G * NWAVES;
    for (int it = gw; it < P0_LAYERS * I_LAYER; it += NGW) p0_layer_item(P, scr, it / I_LAYER, it % I_LAYER, lane);
    for (int m = gw; m < MROWS; m += NGW) {
        const f32x4* xr = (const f32x4*)(P.x + (size_t)m * DM) + lane; float s = 0.f;
        u32x2* ob = (u32x2*)((bf16_t*)(ws + WS_XB) + (size_t)m * DM) + lane;
#pragma unroll
        for (int j = 0; j < 8; ++j) { const f32x4 v = xr[64 * j]; s += (v[0] * v[0] + v[1] * v[1]) + (v[2] * v[2] + v[3] * v[3]); u32x2 w; w.x = cvtpk(v[0], v[1]); w.y = cvtpk(v[2], v[3]); ob[64 * j] = w; }
#pragma unroll
        for (int o = 1; o < 64; o <<= 1) s += __shfl_xor(s, o);
        if (lane < 32) ((float*)(ws + WS_SSP))[(size_t)m * 32 + lane] = (lane == 0) ? s : 0.f;
    }
    for (int i = blockIdx.x * NTHREADS + tid; i < 32 * LUTN; i += G * NTHREADS) { const int h = i / LUTN, n = i % LUTN; ((float*)(ws + WS_GLUT))[i] = P.rel[h * 32 + t5_bucket(n)] * LOG2E; }
    if (blockIdx.x < DEPTH * 2) {
        __syncthreads();
        const int li = blockIdx.x, kp = tid >> 7, hid = tid & 127; const float* pe = P.cmp_pe + (size_t)li * 2048; const float* w1 = P.cmp_w1 + (size_t)li * 2048 * 128;
        float s = 0.f;
#pragma unroll 8
        for (int k = kp * 512; k < kp * 512 + 512; ++k) s += pe[k] * w1[(size_t)k * 128 + hid];
        LAS float* red = (LAS float*)lds; red[tid] = s; __syncthreads();
        if (tid < 128) ((float*)(ws + WS_CPE))[li * 128 + tid] = (red[tid] + red[tid + 128]) + (red[tid + 256] + red[tid + 384]);
        __syncthreads();
    }
}

struct Src { const bf16_t* kb; const bf16_t* vb; int stride; int dil; int roff; };

template <int QG, int MODE>
__device__ __forceinline__ void flash_tile(LAS unsigned char* lds, const int buf, const int k0, const int tag, const int dil, const bf16x8 (&qf)[QG][2], f32x4 (&o)[QG][4], float (&m)[QG], float (&l)[QG],
                                           const int qc, const int qcw_min, const int qcw_max, const int maxrel, const LAS unsigned* selp, const LAS unsigned* wunp,
                                           const float (&invl)[QG], LAS float* impw, const bool imp_acc, const LAS float* lut, float& carryB, const int lane) {
    const int g = lane >> 4, i16 = lane & 15;
    bool skip = (k0 > qcw_max) || (maxrel != 0x7fffffff && k0 + 63 < qcw_min - maxrel);
    if (tag >= 0) { const unsigned w = (unsigned)__builtin_amdgcn_readfirstlane((int)wunp[tag >> 5]); if (!((w >> (tag & 31)) & 1u)) skip = true; }
    if (MODE & 4) skip = false;
    if (!skip) {
        const LAS unsigned char* Ks = lds + (buf ? L_K1 : L_K0);
        const LAS unsigned char* Vs = lds + (buf ? L_V1 : L_V0);
        bool allowed = true;
        if (tag >= 0) { const unsigned w = selp[tag >> 5]; allowed = ((w >> (tag & 31)) & 1u) != 0u; }
        float impA[4] = {0.f, 0.f, 0.f, 0.f}, impB[4] = {0.f, 0.f, 0.f, 0.f};
        const int dl_ = qcw_min - (k0 + 63), dh_ = qcw_max - k0;
        bool uni = (k0 >= 0) && (dl_ >= 0) && (maxrel == 0x7fffffff || dh_ <= maxrel);
        if (MODE & 1) uni = uni && (dl_ * dil >= 1513);
        const unsigned uni_di = (unsigned)(dl_ * dil) < (unsigned)(LUTN - 1) ? (unsigned)(dl_ * dil) : (unsigned)(LUTN - 1);
        const bool mid = (MODE & 1) && !uni && (dil == 1) && (k0 >= 0) && (dl_ >= 0) && (maxrel == 0x7fffffff || dh_ <= maxrel) && (dh_ <= LUTN - 1);
#pragma unroll
        for (int qg = 0; qg < QG; ++qg) {
            bf16x8 kf[4][2];
#pragma unroll
            for (int kt = 0; kt < 4; ++kt)
#pragma unroll
                for (int ks = 0; ks < 2; ++ks) kf[kt][ks] = *(const LAS bf16x8*)(Ks + (16 * kt + i16) * KP + ks * 64 + g * 16);
            __builtin_amdgcn_sched_barrier(0);
            f32x4 s[4];
#pragma unroll
            for (int kt = 0; kt < 4; ++kt) { s[kt] = (f32x4){0.f, 0.f, 0.f, 0.f};
#pragma unroll
                for (int ks = 0; ks < 2; ++ks) s[kt] = mfma16(kf[kt][ks], qf[qg][ks], s[kt]); }
            bf16x8 vfr[4][2];
            if (!(MODE & 2)) {
#pragma unroll
                for (int dt = 0; dt < 4; ++dt)
#pragma unroll
                    for (int s2 = 0; s2 < 2; ++s2) { const LAS unsigned char* vp = Vs + (32 * s2 + 4 * g + (i16 >> 2)) * KP + (16 * dt + 4 * (i16 & 3)) * 2;
                        const s16x4 lo = tr_read(vp), hi = tr_read(vp + 16 * KP);
                        vfr[dt][s2] = (bf16x8){lo[0], lo[1], lo[2], lo[3], hi[0], hi[1], hi[2], hi[3]}; }
            }
            __builtin_amdgcn_sched_barrier(0);
            float mx = -INFINITY; float lanebias = 0.f;
            if (uni) {
                float lb = 0.f;
                if (MODE & 1) lb = lut[qg * LUTN + uni_di];
                lanebias = allowed ? lb : -INFINITY;
                float mr = -INFINITY;
#pragma unroll
                for (int kt = 0; kt < 4; ++kt)
#pragma unroll
                    for (int r = 0; r < 4; ++r) mr = fmaxf(mr, s[kt][r]);
                mx = allowed ? __builtin_fmaf(mr, LOG2E, lb) : -INFINITY;
            } else if (mid) {
                const LAS float* lp = lut + qg * LUTN + (qc - k0 - 4 * g - 63);
                float bv[4][4];
#pragma unroll
                for (int kt = 0; kt < 4; ++kt)
#pragma unroll
                    for (int r = 0; r < 4; ++r) bv[kt][r] = lp[63 - 16 * kt - r];
                __builtin_amdgcn_sched_barrier(0);
#pragma unroll
                for (int kt = 0; kt < 4; ++kt)
#pragma unroll
                    for (int r = 0; r < 4; ++r) { float sc = __builtin_fmaf(s[kt][r], LOG2E, bv[kt][r]); sc = allowed ? sc : -INFINITY; s[kt][r] = sc; mx = fmaxf(mx, sc); }
            } else {
                float bv[4][4];
#pragma unroll
                for (int kt = 0; kt < 4; ++kt)
#pragma unroll
                    for (int r = 0; r < 4; ++r) { bv[kt][r] = 0.f;
                        if (MODE & 1) { const int rel = qc - (k0 + 16 * kt + 4 * g + r); unsigned di = (unsigned)(rel * dil); di = di < (unsigned)(LUTN - 1) ? di : (unsigned)(LUTN - 1); bv[kt][r] = lut[qg * LUTN + di]; } }
                if (MODE & 1) __builtin_amdgcn_sched_barrier(0);
#pragma unroll
                for (int kt = 0; kt < 4; ++kt)
#pragma unroll
                    for (int r = 0; r < 4; ++r) { const int kc = k0 + 16 * kt + 4 * g + r; const int rel = qc - kc;
                        const bool ok = allowed && ((unsigned)rel <= (unsigned)maxrel) && (kc >= 0);
                        float sc = __builtin_fmaf(s[kt][r], LOG2E, bv[kt][r]);
                        sc = ok ? sc : -INFINITY; s[kt][r] = sc; mx = fmaxf(mx, sc); }
            }
            mx = fmaxf(mx, __shfl_xor(mx, 16)); mx = fmaxf(mx, __shfl_xor(mx, 32));
            const float mnew = fmaxf(m[qg], mx); const float alpha = fexp2(m[qg] - mnew); m[qg] = mnew;
            float rs = 0.f;
            if (uni) { const float cb_ = lanebias - mnew;
#pragma unroll
                for (int kt = 0; kt < 4; ++kt)
#pragma unroll
                    for (int r = 0; r < 4; ++r) { const float p = fexp2(__builtin_fmaf(s[kt][r], LOG2E, cb_)); s[kt][r] = p; rs += p; }
            } else {
#pragma unroll
                for (int kt = 0; kt < 4; ++kt)
#pragma unroll
                    for (int r = 0; r < 4; ++r) { const float p = fexp2(s[kt][r] - mnew); s[kt][r] = p; rs += p; }
            }
            rs += __shfl_xor(rs, 16); rs += __shfl_xor(rs, 32);
            l[qg] = l[qg] * alpha + rs;
            if (MODE & 4) {
#pragma unroll
                for (int kt = 0; kt < 4; ++kt) { impA[kt] += ((s[kt][0] + s[kt][1]) + (s[kt][2] + s[kt][3])) * invl[qg]; impB[kt] += s[kt][3] * invl[qg]; }
            }
            if (!(MODE & 2)) {
#pragma unroll
                for (int dt = 0; dt < 4; ++dt) o[qg][dt] = o[qg][dt] * alpha;
                bf16x8 pf[2];
#pragma unroll
                for (int s2 = 0; s2 < 2; ++s2) { u32x4 w; w.x = cvtpk(s[2 * s2][0], s[2 * s2][1]); w.y = cvtpk(s[2 * s2][2], s[2 * s2][3]); w.z = cvtpk(s[2 * s2 + 1][0], s[2 * s2 + 1][1]); w.w = cvtpk(s[2 * s2 + 1][2], s[2 * s2 + 1][3]);
                    pf[s2] = __builtin_bit_cast(bf16x8, w); }
#pragma unroll
                for (int dt = 0; dt < 4; ++dt)
#pragma unroll
                    for (int s2 = 0; s2 < 2; ++s2) o[qg][dt] = mfma16(vfr[dt][s2], pf[s2], o[qg][dt]);
            }
            if (QG > 1) asm volatile("" ::: "memory");
        }
        if (MODE & 4) {
            const int srcl = (lane + 48) & 63;
#pragma unroll
            for (int kt = 0; kt < 4; ++kt) { const float pb = (kt == 0) ? carryB : impB[kt == 0 ? 0 : kt - 1];
                const float x0 = __shfl(pb, srcl), x1 = __shfl(impB[kt], srcl); const float add = (g == 0) ? x0 : x1;
                const int J = 4 * ((k0 >> 4) + kt) + g; const float prevv = imp_acc ? impw[i16 * 128 + J] : 0.f; impw[i16 * 128 + J] = prevv + impA[kt] + add; }
            carryB = impB[3];
        }
    }
}

template <int QG, int MODE>
__device__ __forceinline__ void flash_run(LAS unsigned char* lds, const Src S, const int ntiles, const bf16x8 (&qf)[QG][2], f32x4 (&o)[QG][4], float (&m)[QG], float (&l)[QG],
                                          const int qc, const int qcw_min, const int qcw_max, const int maxrel, const LAS unsigned* selp, const LAS unsigned* wunp,
                                          const float (&invl)[QG], LAS float* impw, const bool imp_acc, const int lutslot, const int lane, const int tid) {
    const LAS int* tl = (const LAS int*)(lds + L_TL);
    const LAS float* lut = (const LAS float*)(lds + L_LUT) + lutslot * LUTN;
    const int srow = tid >> 3, sch = tid & 7;
    u32x4 kr0 = {0, 0, 0, 0}, vr0 = {0, 0, 0, 0}, kr1 = {0, 0, 0, 0}, vr1 = {0, 0, 0, 0};
    float carryB = 0.f;
#define FL_ISSUE(i, KR, VR) do { int c_ = __builtin_amdgcn_readfirstlane(tl[2 * (i)]) + srow; c_ = c_ < 0 ? 0 : c_; const size_t off_ = (size_t)(c_ * S.dil + S.roff) * S.stride + sch * 8; \
        KR = *(const u32x4*)(S.kb + off_); if (!(MODE & 2)) VR = *(const u32x4*)(S.vb + off_); } while (0)
#define FL_COMMIT(b, KR, VR) do { *(LAS u32x4*)(lds + ((b) ? L_K1 : L_K0) + srow * KP + sch * 16) = KR; if (!(MODE & 2)) *(LAS u32x4*)(lds + ((b) ? L_V1 : L_V0) + srow * KP + sch * 16) = VR; } while (0)
#define FL_TILE(i, b) flash_tile<QG, MODE>(lds, b, __builtin_amdgcn_readfirstlane(tl[2 * (i)]), __builtin_amdgcn_readfirstlane(tl[2 * (i) + 1]), S.dil, qf, o, m, l, qc, qcw_min, qcw_max, maxrel, selp, wunp, invl, impw, imp_acc, lut, carryB, lane)
    LDS_BARRIER();
    if (ntiles > 0) { FL_ISSUE(0, kr0, vr0); if (ntiles > 1) FL_ISSUE(1, kr1, vr1); FL_COMMIT(0, kr0, vr0); }
    LDS_BARRIER();
    for (int i = 0; i < ntiles; i += 2) {
        if (i + 2 < ntiles) FL_ISSUE(i + 2, kr0, vr0);
        FL_TILE(i, 0);
        if (i + 1 < ntiles) FL_COMMIT(1, kr1, vr1);
        LDS_BARRIER();
        if (i + 1 >= ntiles) break;
        if (i + 3 < ntiles) FL_ISSUE(i + 3, kr1, vr1);
        FL_TILE(i + 1, 1);
        if (i + 2 < ntiles) FL_COMMIT(0, kr0, vr0);
        LDS_BARRIER();
    }
#undef FL_ISSUE
#undef FL_COMMIT
#undef FL_TILE
}

template <int QG> __device__ __forceinline__ void flash_init(f32x4 (&o)[QG][4], float (&m)[QG], float (&l)[QG]) {
#pragma unroll
    for (int q = 0; q < QG; ++q) { m[q] = -1e30f; l[q] = 0.f;
#pragma unroll
        for (int d = 0; d < 4; ++d) o[q][d] = (f32x4){0.f, 0.f, 0.f, 0.f}; }
}
template <int NH>
__device__ __forceinline__ void load_lut(LAS unsigned char* lds, const float* glut, int head0, int tid) {
    LAS float* lut = (LAS float*)(lds + L_LUT); const float* src = glut + (size_t)head0 * LUTN;
    float v[NH * 3];
#pragma unroll
    for (int i = 0; i < NH * 3; ++i) v[i] = src[tid + NTHREADS * i];
    __builtin_amdgcn_sched_barrier(0);
#pragma unroll
    for (int i = 0; i < NH * 3; ++i) lut[tid + NTHREADS * i] = v[i];
}
__device__ __forceinline__ int next_unit(unsigned* ctr, LAS unsigned char* lds, int tid) {
    LAS int* slot = (LAS int*)(lds + L_MISC);
    __syncthreads();
    if (tid == 0) *slot = (int)atomicAdd(ctr, 1u);
    __syncthreads();
    return *slot;
}

__device__ __forceinline__ void unit_mixA(const Params& P, LAS unsigned char* lds, int uid, int tid, int lane, int wave) {
    unsigned char* ws = P.ws; const bf16_t* proj = (const bf16_t*)(ws + WS_PROJ);
    const int b = uid / 768; int rem = uid % 768; const int gi = rem / 256; rem %= 256; const int hs = rem / 64, idx = rem % 64;
    const int d = gi == 0 ? 1 : (gi == 1 ? 4 : 16); const int rc = idx % d, nb = idx / d;
    const int g = lane >> 4, i16 = lane & 15;
    load_lut<1>(lds, (const float*)(ws + WS_GLUT), gi * 4 + hs, tid);
    const int ntiles = nb == 0 ? 2 : 4;
    if (tid < 4) { LAS int* tl = (LAS int*)(lds + L_TL); const int i = tid + (nb == 0 ? 2 : 0); if (i < 4) { tl[2 * tid] = nb * 128 - 128 + 64 * i; tl[2 * tid + 1] = -1; } }
    const int qi = nb * 128 + 16 * wave + i16; const int tok = qi * d + rc; const size_t row = (size_t)b * SEQ + tok;
    const int colq = A_OFF + gi * 768 + hs * 64;
    bf16x8 qf[1][2];
#pragma unroll
    for (int ks = 0; ks < 2; ++ks) qf[0][ks] = *(const bf16x8*)(proj + row * INP + colq + ks * 32 + g * 8);
    f32x4 o[1][4]; float m[1], l[1]; flash_init<1>(o, m, l);
    const float il[1] = {0.f};
    Src S{proj + (size_t)b * SEQ * INP + colq + 256, proj + (size_t)b * SEQ * INP + colq + 512, INP, d, rc};
    flash_run<1, 1>(lds, S, ntiles, qf, o, m, l, qi, nb * 128 + 16 * wave, nb * 128 + 16 * wave + 15, 128, nullptr, nullptr, il, nullptr, false, 0, lane, tid);
    const float inv = l[0] > 0.f ? 1.f / l[0] : 0.f;
    bf16_t* O = (bf16_t*)(ws + WS_O) + row * 2048 + gi * 256 + hs * 64;
#pragma unroll
    for (int dt = 0; dt < 4; ++dt) { u32x2 w; w.x = cvtpk(o[0][dt][0] * inv, o[0][dt][1] * inv); w.y = cvtpk(o[0][dt][2] * inv, o[0][dt][3] * inv); *(u32x2*)(O + 16 * dt + 4 * g) = w; }
    if (g == 0) ((float*)(ws + WS_LSE))[row * 12 + gi * 4 + hs] = (m[0] + __log2f(fmaxf(l[0], 1e-30f))) * LN2;
}

__device__ __forceinline__ void unit_moba(const Params& P, LAS unsigned char* lds, int b, int h, int c, int tid, int lane, int wave) {
    unsigned char* ws = P.ws; const bf16_t* proj = (const bf16_t*)(ws + WS_PROJ);
    const int g = lane >> 4, i16 = lane & 15;
    const int t0 = c * 128, ob = t0 >> 8;
    load_lut<1>(lds, (const float*)(ws + WS_GLUT), 12 + h, tid);
    LAS float* km = (LAS float*)(lds + L_IMP);
    LAS unsigned char* qS = lds + L_IMP + 8192;
    { const float* src = (const float*)(ws + WS_KMEAN) + (size_t)(b * 8 + h) * 2048; float kv4[4]; u32x4 qv[2];
#pragma unroll
      for (int i = 0; i < 4; ++i) kv4[i] = src[tid + NTHREADS * i];
#pragma unroll
      for (int i = 0; i < 2; ++i) { const int e = tid + NTHREADS * i; qv[i] = *(const u32x4*)(proj + ((size_t)b * SEQ + t0 + (e >> 3)) * INP + B_OFF + h * 64 + (e & 7) * 8); }
      __builtin_amdgcn_sched_barrier(0);
#pragma unroll
      for (int i = 0; i < 4; ++i) km[tid + NTHREADS * i] = kv4[i];
#pragma unroll
      for (int i = 0; i < 2; ++i) { const int e = tid + NTHREADS * i; *(LAS u32x4*)(qS + (e >> 3) * 128 + (e & 7) * 16) = qv[i]; } }
    LAS unsigned* misc = (LAS unsigned*)(lds + L_MISC);
    if (tid == 0) misc[1] = 0u;
    __syncthreads();
    const int tok = t0 + 16 * wave + i16; const size_t row = (size_t)b * SEQ + tok;
    const int colq = B_OFF + h * 64;
    bf16x8 qf[1][2];
#pragma unroll
    for (int ks = 0; ks < 2; ++ks) qf[0][ks] = *(const bf16x8*)(proj + row * INP + colq + ks * 32 + g * 8);
    unsigned sel = 0u;
    if (ob > 0) {
        float gt[8];
#pragma unroll
        for (int k = 0; k < 8; ++k) gt[k] = 0.f;
#pragma unroll 1
        for (int dc = 0; dc < 8; ++dc) { const u32x4 qw = *(const LAS u32x4*)(qS + (16 * wave + i16) * 128 + dc * 16);
            const float q0 = bflo(qw.x), q1 = bfhi(qw.x), q2 = bflo(qw.y), q3 = bfhi(qw.y), q4 = bflo(qw.z), q5 = bfhi(qw.z), q6 = bflo(qw.w), q7 = bfhi(qw.w);
#pragma unroll
            for (int k = 0; k < 8; ++k) { const LAS f32x4* kr = (const LAS f32x4*)(km + (8 * g + k) * 64 + dc * 8); const f32x4 a = kr[0], bq = kr[1];
                gt[k] += (q0 * a[0] + q1 * a[1]) + (q2 * a[2] + q3 * a[3]) + (q4 * bq[0] + q5 * bq[1]) + (q6 * bq[2] + q7 * bq[3]); } }
#pragma unroll
        for (int k = 0; k < 8; ++k) if (8 * g + k >= ob) gt[k] = -INFINITY;
#pragma unroll
        for (int it = 0; it < 3; ++it) {
            float best = -INFINITY; int bi = 99;
#pragma unroll
            for (int k = 0; k < 8; ++k) if (gt[k] > best) { best = gt[k]; bi = 8 * g + k; }
#pragma unroll
            for (int off = 16; off <= 32; off <<= 1) { const float ob_ = __shfl_xor(best, off); const int oi = __shfl_xor(bi, off); if (ob_ > best || (ob_ == best && oi < bi)) { best = ob_; bi = oi; } }
            if (bi < 32) { sel |= 1u << bi;
#pragma unroll
                for (int k = 0; k < 8; ++k) if (8 * g + k == bi) gt[k] = -INFINITY; }
        }
    }
    unsigned wu = sel;
#pragma unroll
    for (int off = 1; off < 16; off <<= 1) wu |= (unsigned)__shfl_xor((int)wu, off);
    wu = (unsigned)__builtin_amdgcn_readfirstlane((int)wu);
    LAS unsigned* selS = (LAS unsigned*)(lds + L_SEL); LAS unsigned* wunS = (LAS unsigned*)(lds + L_WUN) + wave * 4;
    if (g == 0) selS[(16 * wave + i16) * 4] = sel;
    if (lane == 0) wunS[0] = wu;
    __syncthreads();
    unsigned um = 0u;
#pragma unroll
    for (int w8 = 0; w8 < 8; ++w8) um |= ((const LAS unsigned*)(lds + L_WUN))[w8 * 4];
    if (tid == 0) { LAS int* tl = (LAS int*)(lds + L_TL); int n = 0;
        for (int blk = 0; blk < ob; ++blk) if ((um >> blk) & 1u) for (int s4 = 0; s4 < 4; ++s4) { tl[2 * n] = blk * 256 + 64 * s4; tl[2 * n + 1] = blk; ++n; }
        for (int k0 = ob * 256; k0 < t0 + 128; k0 += 64) { tl[2 * n] = k0; tl[2 * n + 1] = -1; ++n; }
        misc[2] = (unsigned)n; }
    __syncthreads();
    const int ntiles = (int)misc[2];
    f32x4 o[1][4]; float m[1], l[1]; flash_init<1>(o, m, l);
    const float il[1] = {0.f};
    Src S{proj + (size_t)b * SEQ * INP + colq + 512, proj + (size_t)b * SEQ * INP + colq + 1024, INP, 1, 0};
    flash_run<1, 1>(lds, S, ntiles, qf, o, m, l, tok, t0 + 16 * wave, t0 + 16 * wave + 15, 0x7fffffff, selS + (16 * wave + i16) * 4, wunS, il, nullptr, false, 0, lane, tid);
    const float inv = l[0] > 0.f ? 1.f / l[0] : 0.f;
    bf16_t* O = (bf16_t*)(ws + WS_O) + row * 2048 + 768 + h * 64;
#pragma unroll
    for (int dt = 0; dt < 4; ++dt) { u32x2 w; w.x = cvtpk(o[0][dt][0] * inv, o[0][dt][1] * inv); w.y = cvtpk(o[0][dt][2] * inv, o[0][dt][3] * inv); *(u32x2*)(O + 16 * dt + 4 * g) = w; }
}

__device__ __forceinline__ float sigmoidf_(float x) { return 1.f / (1.f + __expf(-x)); }
#ifndef NSA_QG
#define NSA_QG 2
#endif
__device__ __forceinline__ void unit_nsa(const Params& P, LAS unsigned char* lds, int b, int kv, int c, int tid, int lane, int wave) {
    unsigned char* ws = P.ws; const bf16_t* proj = (const bf16_t*)(ws + WS_PROJ);
    const int g = lane >> 4, i16 = lane & 15;
    const int t0 = c * 128;
    const int tok = t0 + 16 * wave + i16; const size_t row = (size_t)b * SEQ + tok;
    load_lut<4>(lds, (const float*)(ws + WS_GLUT), 20 + kv * 4, tid);
    LAS int* tl = (LAS int*)(lds + L_TL);
    LAS unsigned* misc = (LAS unsigned*)(lds + L_MISC);
    LAS unsigned* selS = (LAS unsigned*)(lds + L_SEL);
    LAS float* impw = (LAS float*)(lds + L_IMP) + wave * 2048;
    const int ntc = ((t0 + 96) >> 4) / 64 + 1;
    if (tid < ntc) { tl[2 * tid] = 64 * tid; tl[2 * tid + 1] = -1; }
    if (tid < 4) misc[4 + tid] = 0u;
    LAS unsigned* wunS = (LAS unsigned*)(lds + L_WUN) + wave * 4;
    float* tot = (float*)(ws + WS_TOT) + row * 768 + (kv * 4) * 64;
    const bf16_t* gatep = proj + row * INP + CG_OFF + (kv * 4) * 3;
    const int qcc = (tok - 31) >> 4;
    const int qcw0 = (t0 + 16 * wave - 31) >> 4, qcw1 = (t0 + 16 * wave + 15 - 31) >> 4;
#pragma unroll 1
    for (int hp = 0; hp < 4 / NSA_QG; ++hp) {
        bf16x8 qf[NSA_QG][2];
#pragma unroll
        for (int q = 0; q < NSA_QG; ++q)
#pragma unroll
            for (int ks = 0; ks < 2; ++ks) qf[q][ks] = *(const bf16x8*)(proj + row * INP + CQ_OFF + (kv * 4 + hp * NSA_QG + q) * 64 + ks * 32 + g * 8);
        f32x4 o[NSA_QG][4]; float m[NSA_QG], l[NSA_QG]; flash_init<NSA_QG>(o, m, l);
        float il[NSA_QG]; for (int q_ = 0; q_ < NSA_QG; ++q_) il[q_] = 0.f;
#ifdef NSA_CMP_FAKEKV
        Src S{proj + (size_t)b * SEQ * INP + CKV_OFF + 4 * 192 + kv * 64, proj + (size_t)b * SEQ * INP + CKV_OFF + 5 * 192 + kv * 64, INP, 1, 0};
#else
        Src S{(const bf16_t*)(ws + WS_KC) + (size_t)(b * 3 + kv) * 512 * 64, (const bf16_t*)(ws + WS_VC) + (size_t)(b * 3 + kv) * 512 * 64, 64, 1, 0};
#endif
#ifdef NSA_CMP_SINGLE
        flash_run<NSA_QG, 0>(lds, S, ntc, qf, o, m, l, qcc, qcw0, qcw1, 0x7fffffff, nullptr, nullptr, il, nullptr, false, 0, lane, tid);
#pragma unroll
        for (int q = 0; q < NSA_QG; ++q) il[q] = l[q] > 0.f ? 1.f / l[q] : 0.f;
        (void)impw;
#elif !defined(NSA_NO_CMP)
        flash_run<NSA_QG, 2>(lds, S, ntc, qf, o, m, l, qcc, qcw0, qcw1, 0x7fffffff, nullptr, nullptr, il, nullptr, false, 0, lane, tid);
#pragma unroll
        for (int q = 0; q < NSA_QG; ++q) { il[q] = l[q] > 0.f ? 1.f / l[q] : 0.f; l[q] = 0.f; }
        flash_run<NSA_QG, 4>(lds, S, ntc, qf, o, m, l, qcc, qcw0, qcw1, 0x7fffffff, nullptr, nullptr, il, impw, hp != 0, 0, lane, tid);
#else
        (void)S; (void)impw;
#endif
#pragma unroll
        for (int q = 0; q < NSA_QG; ++q) { const float gt = sigmoidf_(bf2f(gatep[(hp * NSA_QG + q) * 3 + 0])); const float sc = il[q] * gt;
#pragma unroll
            for (int dt = 0; dt < 4; ++dt) *(f32x4*)(tot + (hp * NSA_QG + q) * 64 + 16 * dt + 4 * g) = o[q][dt] * sc; }
    }
#ifndef NSA_NO_TOPK
    lds_wait();
    unsigned wun0 = 0u, wun1 = 0u, wun2 = 0u, wun3 = 0u;
#pragma unroll 1
    for (int q = 0; q < 16; ++q) {
        const int t = t0 + 16 * wave + q, own = t >> 6;
        const int ncand = own - 2 > 0 ? own - 2 : 0; const int nforced = own >= 2 ? 3 : own + 1; const int K = 16 - nforced;
        const int j0 = lane, j1 = lane + 64;
        const bool c0 = (j0 >= 1) && (j0 <= own - 2), c1 = (j1 <= own - 2);
        const unsigned k0 = c0 ? (__float_as_uint(impw[q * 128 + j0]) + 1u) : 0u, k1 = c1 ? (__float_as_uint(impw[q * 128 + j1]) + 1u) : 0u;
        bool s0 = c0, s1 = c1;
        if (ncand > K) {
            unsigned T = 0u;
            for (int bit = 31; bit >= 0; --bit) { const unsigned Tn = T | (1u << bit);
                const int cnt = __popcll(__ballot(k0 >= Tn)) + __popcll(__ballot(k1 >= Tn)); if (cnt >= K) T = Tn; }
            const bool g0 = k0 > T, g1 = k1 > T; const int ng = __popcll(__ballot(g0)) + __popcll(__ballot(g1)); const int need = K - ng;
            const unsigned long long e0 = __ballot(k0 == T), e1 = __ballot(k1 == T); const unsigned long long lt = (1ull << lane) - 1ull;
            const int r0 = __popcll(e0 & lt), r1 = __popcll(e0) + __popcll(e1 & lt);
            s0 = g0 || (k0 == T && r0 < need); s1 = g1 || (k1 == T && r1 < need);
        }
        s0 = s0 || (j0 == 0) || (j0 == own) || (j0 == own - 1); s1 = s1 || (j1 == own) || (j1 == own - 1);
        const unsigned long long m0 = __ballot(s0), m1 = __ballot(s1);
        const unsigned w0 = (unsigned)m0, w1 = (unsigned)(m0 >> 32), w2 = (unsigned)m1, w3 = (unsigned)(m1 >> 32);
        if (lane == 0) { selS[(16 * wave + q) * 4 + 0] = w0; selS[(16 * wave + q) * 4 + 1] = w1; selS[(16 * wave + q) * 4 + 2] = w2; selS[(16 * wave + q) * 4 + 3] = w3; }
        wun0 |= w0; wun1 |= w1; wun2 |= w2; wun3 |= w3;
    }
    if (lane == 0) { wunS[0] = wun0; wunS[1] = wun1; wunS[2] = wun2; wunS[3] = wun3; }
    __syncthreads();
    if (tid < 4) { unsigned u_ = 0u; for (int w8 = 0; w8 < 8; ++w8) u_ |= ((const LAS unsigned*)(lds + L_WUN))[w8 * 4 + tid]; misc[4 + tid] = u_; }
    __syncthreads();
    const LAS unsigned* selp = selS + (16 * wave + i16) * 4;
    const int ownmax = (t0 + 127) >> 6;
    if (tid == 0) { int n = 0; for (int j = 0; j <= ownmax; ++j) if ((misc[4 + (j >> 5)] >> (j & 31)) & 1u) { tl[2 * n] = 64 * j; tl[2 * n + 1] = j; ++n; } misc[2] = (unsigned)n; }
    __syncthreads();
    const int nts = (int)misc[2];
#else
    const int ownmax = (t0 + 127) >> 6; const int nts = 0; const LAS unsigned* selp = nullptr; (void)selS; (void)wunS;
#endif
    const int kfirst = t0 - 512 > 0 ? t0 - 512 : 0; const int ntw = (t0 + 128 - kfirst) / 64;
#pragma unroll 1
    for (int hp = 0; hp < 4 / NSA_QG; ++hp) {
        bf16x8 qf[NSA_QG][2];
#pragma unroll
        for (int q = 0; q < NSA_QG; ++q)
#pragma unroll
            for (int ks = 0; ks < 2; ++ks) qf[q][ks] = *(const bf16x8*)(proj + row * INP + CQ_OFF + (kv * 4 + hp * NSA_QG + q) * 64 + ks * 32 + g * 8);
        f32x4 o[NSA_QG][4]; float m[NSA_QG], l[NSA_QG];
        float il[NSA_QG]; for (int q_ = 0; q_ < NSA_QG; ++q_) il[q_] = 0.f;
        __syncthreads();
        if (tid == 0) { int n = 0; for (int j = 0; j <= ownmax; ++j) if ((misc[4 + (j >> 5)] >> (j & 31)) & 1u) { tl[2 * n] = 64 * j; tl[2 * n + 1] = j; ++n; } }
#ifndef NSA_NO_SLC
        { flash_init<NSA_QG>(o, m, l);
          Src S{proj + (size_t)b * SEQ * INP + CKV_OFF + 2 * 192 + kv * 64, proj + (size_t)b * SEQ * INP + CKV_OFF + 3 * 192 + kv * 64, INP, 1, 0};
          flash_run<NSA_QG, 1>(lds, S, nts, qf, o, m, l, tok, t0 + 16 * wave, t0 + 16 * wave + 15, 0x7fffffff, selp, wunS, il, nullptr, false, hp * NSA_QG, lane, tid);
#pragma unroll
          for (int q = 0; q < NSA_QG; ++q) { const float gt = sigmoidf_(bf2f(gatep[(hp * NSA_QG + q) * 3 + 1])); const float sc = (l[q] > 0.f ? 1.f / l[q] : 0.f) * gt;
#pragma unroll
              for (int dt = 0; dt < 4; ++dt) { float* tp = tot + (hp * NSA_QG + q) * 64 + 16 * dt + 4 * g; *(f32x4*)tp = *(const f32x4*)tp + o[q][dt] * sc; } }
        }
#endif
        if (tid < ntw) { tl[2 * tid] = kfirst + 64 * tid; tl[2 * tid + 1] = -1; }
        { flash_init<NSA_QG>(o, m, l);
          Src S{proj + (size_t)b * SEQ * INP + CKV_OFF + 4 * 192 + kv * 64, proj + (size_t)b * SEQ * INP + CKV_OFF + 5 * 192 + kv * 64, INP, 1, 0};
#ifndef NSA_NO_WIN
          flash_run<NSA_QG, 1>(lds, S, ntw, qf, o, m, l, tok, t0 + 16 * wave, t0 + 16 * wave + 15, 511, nullptr, nullptr, il, nullptr, false, hp * NSA_QG, lane, tid);
#else
          (void)S;
#endif
          bf16_t* O = (bf16_t*)(ws + WS_O) + row * 2048 + 1280 + (kv * 4) * 64;
#pragma unroll
          for (int q = 0; q < NSA_QG; ++q) { const float gt = sigmoidf_(bf2f(gatep[(hp * NSA_QG + q) * 3 + 2])); const float sc = (l[q] > 0.f ? 1.f / l[q] : 0.f) * gt;
#pragma unroll
              for (int dt = 0; dt < 4; ++dt) { const f32x4 v = *(const f32x4*)(tot + (hp * NSA_QG + q) * 64 + 16 * dt + 4 * g) + o[q][dt] * sc;
                  u32x2 w; w.x = cvtpk(v[0], v[1]); w.y = cvtpk(v[2], v[3]); *(u32x2*)(O + (hp * NSA_QG + q) * 64 + 16 * dt + 4 * g) = w; } }
        }
    }
}

__device__ __forceinline__ float gelu_tanh(float x) { const float u = 0.7978845608028654f * (x + 0.044715f * x * x * x); const float e = __expf(2.f * u); const float th = 1.f - 2.f / (1.f + e); return 0.5f * x * (1.f + th); }
__device__ __forceinline__ void item_compress(const Params& P, int layer, int it, int lane) {
    unsigned char* ws = P.ws; const bf16_t* proj = (const bf16_t*)(ws + WS_PROJ);
    const int nt = it & 31; int r = it >> 5; const int which = r & 1; r >>= 1; const int kv = r % 3, b = r / 3;
    const int g = lane >> 4, i16 = lane & 15;
    int n = 16 * nt + i16; const int nld = n > 510 ? 510 : n;
    const bf16_t* w1t = (const bf16_t*)(ws + WS_W1T) + (size_t)(layer * 2 + which) * 128 * 2048;
    const bf16_t* w2t = (const bf16_t*)(ws + WS_W2T) + (size_t)(layer * 2 + which) * 64 * 128;
    const float* cpe = (const float*)(ws + WS_CPE) + (layer * 2 + which) * 128;
    const bf16_t* src = proj + ((size_t)b * SEQ + 16 * nld) * INP + CKV_OFF + which * 192 + kv * 64 + 8 * g;
    f32x4 acc[8];
#pragma unroll
    for (int h = 0; h < 8; ++h) acc[h] = (f32x4){0.f, 0.f, 0.f, 0.f};
    const bf16_t* w1l = w1t + (size_t)i16 * 2048 + 8 * g;
#pragma unroll 1
    for (int ks = 0; ks < 64; ks += 4) {
        bf16x8 bq[4], af[4][8];
#pragma unroll
        for (int u = 0; u < 4; ++u) { bq[u] = *(const bf16x8*)(src + (size_t)((ks + u) >> 1) * INP + (u & 1) * 32);
#pragma unroll
            for (int h = 0; h < 8; ++h) af[u][h] = *(const bf16x8*)(w1l + (size_t)(16 * h) * 2048 + 32 * (ks + u)); }
        __builtin_amdgcn_sched_barrier(0);
#pragma unroll
        for (int u = 0; u < 4; ++u)
#pragma unroll
            for (int h = 0; h < 8; ++h) acc[h] = mfma16(af[u][h], bq[u], acc[h]);
    }
    bf16x8 pf[4];
#pragma unroll
    for (int s = 0; s < 4; ++s) { float hv[8];
#pragma unroll
        for (int r2 = 0; r2 < 4; ++r2) { hv[r2] = gelu_tanh(acc[2 * s][r2] + cpe[32 * s + 4 * g + r2]); hv[4 + r2] = gelu_tanh(acc[2 * s + 1][r2] + cpe[32 * s + 16 + 4 * g + r2]); }
        u32x4 w; w.x = cvtpk(hv[0], hv[1]); w.y = cvtpk(hv[2], hv[3]); w.z = cvtpk(hv[4], hv[5]); w.w = cvtpk(hv[6], hv[7]); pf[s] = __builtin_bit_cast(bf16x8, w); }
    bf16_t* dst = (bf16_t*)(ws + (which ? WS_VC : WS_KC)) + ((size_t)(b * 3 + kv) * 512 + n) * 64;
#pragma unroll
    for (int et = 0; et < 4; ++et) { f32x4 oc = {0.f, 0.f, 0.f, 0.f};
#pragma unroll
        for (int s = 0; s < 4; ++s) { const bf16_t* wp = w2t + (size_t)(16 * et + i16) * 128 + 32 * s + 4 * g; const u32x2 lo = *(const u32x2*)wp, hi = *(const u32x2*)(wp + 16);
            u32x4 w; w.x = lo.x; w.y = lo.y; w.z = hi.x; w.w = hi.y; oc = mfma16(__builtin_bit_cast(bf16x8, w), pf[s], oc); }
#ifdef PROBE_CLAMP
#pragma unroll
        for (int r2 = 0; r2 < 4; ++r2) oc[r2] = fminf(fmaxf(oc[r2], -100.f), 100.f);
#endif
        u32x2 w; w.x = cvtpk(oc[0], oc[1]); w.y = cvtpk(oc[2], oc[3]); *(u32x2*)(dst + 16 * et + 4 * g) = w; }
}
__device__ __forceinline__ void item_kmean(const Params& P, int it, int lane) {
    unsigned char* ws = P.ws; const bf16_t* proj = (const bf16_t*)(ws + WS_PROJ);
    const int blk = it & 31, h = (it >> 5) & 7, b = it >> 8;
    const int rg = lane >> 3, dch = lane & 7;
    const bf16_t* src = proj + ((size_t)b * SEQ + blk * 256 + rg) * INP + B_OFF + 512 + h * 64 + dch * 8;
    u32x4 v[32];
#pragma unroll
    for (int i = 0; i < 32; ++i) v[i] = *(const u32x4*)(src + (size_t)(8 * i) * INP);
    __builtin_amdgcn_sched_barrier(0);
    float sm[8];
#pragma unroll
    for (int e = 0; e < 8; ++e) sm[e] = 0.f;
#pragma unroll
    for (int i = 0; i < 32; ++i)
#pragma unroll
        for (int w = 0; w < 4; ++w) { sm[2 * w] += bflo(v[i][w]); sm[2 * w + 1] += bfhi(v[i][w]); }
#pragma unroll
    for (int e = 0; e < 8; ++e) { sm[e] += __shfl_xor(sm[e], 8); sm[e] += __shfl_xor(sm[e], 16); sm[e] += __shfl_xor(sm[e], 32); }
    if (rg == 0) { float* dst = (float*)(ws + WS_KMEAN) + (size_t)it * 64 + dch * 8;
        *(f32x4*)dst = (f32x4){sm[0], sm[1], sm[2], sm[3]} * (1.f / 256.f); *(f32x4*)(dst + 4) = (f32x4){sm[4], sm[5], sm[6], sm[7]} * (1.f / 256.f); }
}
__device__ __forceinline__ void item_combineA(const Params& P, int row, int lane) {
    unsigned char* ws = P.ws; const float* lse = (const float*)(ws + WS_LSE) + (size_t)row * 12; bf16_t* O = (bf16_t*)(ws + WS_O) + (size_t)row * 2048;
#pragma unroll
    for (int k = 0; k < 3; ++k) { const int chunk = lane + 64 * k; const int col = 4 * chunk; const int gi = col >> 8, hs = (col >> 6) & 3;
        const float a0 = lse[hs], a1 = lse[4 + hs], a2 = lse[8 + hs]; const float mx = fmaxf(a0, fmaxf(a1, a2));
        const float e0 = __expf(a0 - mx), e1 = __expf(a1 - mx), e2 = __expf(a2 - mx); const float al = (gi == 0 ? e0 : (gi == 1 ? e1 : e2)) / (e0 + e1 + e2);
        const u32x2 w = *(const u32x2*)(O + col); u32x2 r; r.x = cvtpk(bflo(w.x) * al, bfhi(w.x) * al); r.y = cvtpk(bflo(w.y) * al, bfhi(w.y) * al); *(u32x2*)(O + col) = r; }
}

__device__ __forceinline__ void phase_conv(const Params& P, int layer, int tid) {
    unsigned char* ws = P.ws; const bf16_t* U = (const bf16_t*)(ws + WS_U); bf16_t* ACT = (bf16_t*)(ws + WS_ACT);
    const float* cw = P.conv_w + (size_t)layer * 3 * UPW; const float* cb = P.conv_b + (size_t)layer * UPW;
    constexpr int NCH = DFF / 8, TB = 8, NTB = MROWS / TB;
    for (int it = blockIdx.x * NTHREADS + tid; it < NCH * NTB; it += gridDim.x * NTHREADS) {
        const int ch = it % NCH, tb = it / NCH; const int c = ch * 8; const int ua = 256 * (c >> 7) + (c & 127);
        const int row0 = tb * TB; const bool first = (row0 % SEQ) == 0;
        u32x4 pa[TB + 2], pg[TB + 2];
#pragma unroll
        for (int t = 0; t < TB + 2; ++t) { const int r = row0 - 2 + t; const size_t off = (size_t)(r < 0 ? 0 : r) * UPW + ua; pa[t] = *(const u32x4*)(U + off); pg[t] = *(const u32x4*)(U + off + 128); }
        f32x4 wa4[3][2], wg4[3][2], ba4[2], bg4[2];
#pragma unroll
        for (int j = 0; j < 3; ++j)
#pragma unroll
            for (int h = 0; h < 2; ++h) { wa4[j][h] = *(const f32x4*)(cw + (size_t)j * UPW + c + 4 * h); wg4[j][h] = *(const f32x4*)(cw + (size_t)j * UPW + DFF + c + 4 * h); }
#pragma unroll
        for (int h = 0; h < 2; ++h) { ba4[h] = *(const f32x4*)(cb + c + 4 * h); bg4[h] = *(const f32x4*)(cb + DFF + c + 4 * h); }
        __builtin_amdgcn_sched_barrier(0);
        if (first) { pa[0] = (u32x4){0, 0, 0, 0}; pa[1] = pa[0]; pg[0] = pa[0]; pg[1] = pa[0]; }
#pragma unroll
        for (int t = 0; t < TB; ++t) {
            float r[8];
#pragma unroll
            for (int e = 0; e < 8; ++e) { const int w_ = e >> 1; const int h = e >> 2, x = e & 3;
                const float a0 = (e & 1) ? bfhi(pa[t + 2][w_]) : bflo(pa[t + 2][w_]), a1 = (e & 1) ? bfhi(pa[t + 1][w_]) : bflo(pa[t + 1][w_]), a2 = (e & 1) ? bfhi(pa[t][w_]) : bflo(pa[t][w_]);
                const float g0 = (e & 1) ? bfhi(pg[t + 2][w_]) : bflo(pg[t + 2][w_]), g1 = (e & 1) ? bfhi(pg[t + 1][w_]) : bflo(pg[t + 1][w_]), g2 = (e & 1) ? bfhi(pg[t][w_]) : bflo(pg[t][w_]);
                const float ya = ba4[h][x] + wa4[0][h][x] * a0 + wa4[1][h][x] * a1 + wa4[2][h][x] * a2;
                const float yg = bg4[h][x] + wg4[0][h][x] * g0 + wg4[1][h][x] * g1 + wg4[2][h][x] * g2;
                r[e] = ya * yg / (1.f + __expf(-yg)); }
            u32x4 w; w.x = cvtpk(r[0], r[1]); w.y = cvtpk(r[2], r[3]); w.z = cvtpk(r[4], r[5]); w.w = cvtpk(r[6], r[7]);
            *(u32x4*)(ACT + (size_t)(row0 + t) * DFF + c) = w;
        }
    }
}

__device__ __forceinline__ void phase_convfix(const Params& P, int layer, int tid) {
    unsigned char* ws = P.ws; const bf16_t* UB = (const bf16_t*)(ws + WS_UB); bf16_t* ACT = (bf16_t*)(ws + WS_ACT);
    const float* cw = P.conv_w + (size_t)layer * 3 * UPW; const float* cb = P.conv_b + (size_t)layer * UPW;
    constexpr int NCH = DFF / 8, NS = MROWS / 64;
    for (int it = blockIdx.x * NTHREADS + tid; it < NCH * 2 * NS; it += gridDim.x * NTHREADS) {
        const int ch = it % NCH, lr = (it / NCH) & 1, sl = it / (2 * NCH); const int c = ch * 8; const int ua = 256 * (c >> 7) + (c & 127);
        const bool first = (sl % (SEQ / 64)) == 0;
        const int slp = sl > 0 ? sl - 1 : 0;
        const bf16_t* r0 = UB + ((size_t)sl * 4 + lr) * UPW + ua;
        const bf16_t* r1 = lr == 0 ? UB + ((size_t)slp * 4 + 3) * UPW + ua : UB + ((size_t)sl * 4 + 0) * UPW + ua;
        const bf16_t* r2 = lr == 0 ? UB + ((size_t)slp * 4 + 2) * UPW + ua : UB + ((size_t)slp * 4 + 3) * UPW + ua;
        u32x4 a0 = *(const u32x4*)r0, g0 = *(const u32x4*)(r0 + 128), a1 = *(const u32x4*)r1, g1 = *(const u32x4*)(r1 + 128), a2 = *(const u32x4*)r2, g2 = *(const u32x4*)(r2 + 128);
        const u32x4 z = {0, 0, 0, 0};
        if (first && lr == 0) { a1 = z; g1 = z; }
        if (first) { a2 = z; g2 = z; }
        float r[8];
#pragma unroll
        for (int e = 0; e < 8; ++e) { const int w_ = e >> 1;
            const float x0 = (e & 1) ? bfhi(a0[w_]) : bflo(a0[w_]), x1 = (e & 1) ? bfhi(a1[w_]) : bflo(a1[w_]), x2 = (e & 1) ? bfhi(a2[w_]) : bflo(a2[w_]);
            const float y0 = (e & 1) ? bfhi(g0[w_]) : bflo(g0[w_]), y1 = (e & 1) ? bfhi(g1[w_]) : bflo(g1[w_]), y2 = (e & 1) ? bfhi(g2[w_]) : bflo(g2[w_]);
            const float ya = cb[c + e] + cw[c + e] * x0 + cw[UPW + c + e] * x1 + cw[2 * UPW + c + e] * x2;
            const float yg = cb[DFF + c + e] + cw[DFF + c + e] * y0 + cw[UPW + DFF + c + e] * y1 + cw[2 * UPW + DFF + c + e] * y2;
            r[e] = ya * yg / (1.f + __expf(-yg)); }
        u32x4 w; w.x = cvtpk(r[0], r[1]); w.y = cvtpk(r[2], r[3]); w.z = cvtpk(r[4], r[5]); w.w = cvtpk(r[6], r[7]);
        *(u32x4*)(ACT + (size_t)(sl * 64 + lr) * DFF + c) = w;
    }
}

#define XB_TMO      128
#define XB_XCNT(j)  (256  + 64 * (j))
#define XB_XSUB(j)  (1280 + 64 * (j))
#define XB_XGEN(j)  (2304 + 64 * (j))
#define XB_TOP      3328
#define XB_TOPGEN   3392
#define XCD_BAR_WORDS 3456
#define XB_SPIN_CAP (1u << 27)

__device__ __forceinline__ unsigned xb_ld(unsigned* p)              { return __hip_atomic_load(p, __ATOMIC_RELAXED, __HIP_MEMORY_SCOPE_AGENT); }
__device__ __forceinline__ unsigned xb_add(unsigned* p, unsigned v) { return __hip_atomic_fetch_add(p, v, __ATOMIC_RELAXED, __HIP_MEMORY_SCOPE_AGENT); }
__device__ __forceinline__ unsigned xb_xcc_id() { return (unsigned)__builtin_amdgcn_s_getreg((3 << 11) | 20) & 0xFu; }
#define XB_SPIN(cond, bar) do { unsigned _sp = 0; while (cond) { __builtin_amdgcn_s_sleep(1); \
    if ((++_sp & 255u) == 0u) { if (xb_ld(&(bar)[XB_TMO])) break; if (_sp > XB_SPIN_CAP) { atomicAdd(&(bar)[XB_TMO], 1u); break; } } } } while (0)

struct XcdBarrier {
    unsigned* bar; unsigned x;
    volatile LAS unsigned* st;
};

__device__ __forceinline__ XcdBarrier xcd_barrier_post(unsigned* bar, volatile LAS unsigned* st) {
    XcdBarrier b; b.bar = bar; b.x = xb_xcc_id(); b.st = st;
    if (threadIdx.x == 0) (void)xb_add(&bar[XB_XCNT(b.x)], 1u);
    return b;
}
__device__ __forceinline__ void xcd_barrier_complete(unsigned* bar, unsigned x, unsigned& nloc, unsigned& nx) {
    const unsigned G = gridDim.x * gridDim.y * gridDim.z;
    unsigned sum, cnt, mine, sp = 0u;
    for (;;) {
        sum = 0u; cnt = 0u; mine = 0u;
#pragma unroll
        for (unsigned j = 0; j < 16; ++j) { const unsigned c = xb_ld(&bar[XB_XCNT(j)]); sum += c; cnt += (c > 0u) ? 1u : 0u; mine = (j == x) ? c : mine; }
        if (sum == G) break;
        __builtin_amdgcn_s_sleep(1);
        if ((++sp & 255u) == 0u) { if (xb_ld(&bar[XB_TMO])) break; if (sp > XB_SPIN_CAP) { atomicAdd(&bar[XB_TMO], 1u); break; } }
    }
    nloc = mine > 0u ? mine : 1u; nx = cnt > 0u ? cnt : 1u;
}

__device__ __forceinline__ void xcd_barrier(const XcdBarrier& b) {
    asm volatile("s_waitcnt vmcnt(0)" ::: "memory");
    __syncthreads();
    if (threadIdx.x == 0) {
        unsigned* bar = b.bar;
        __builtin_amdgcn_s_waitcnt(0);
        unsigned nloc = b.st[0], nx = b.st[1];
        if (nloc == 0u) { xcd_barrier_complete(bar, b.x, nloc, nx); b.st[0] = nloc; b.st[1] = nx; }
        const unsigned old = xb_add(&bar[XB_XSUB(b.x)], 1u);
        const unsigned gen = old / nloc;
        if (old + 1u == (gen + 1u) * nloc) {
            __builtin_amdgcn_fence(__ATOMIC_RELEASE, "agent");
            asm volatile("s_waitcnt vmcnt(0)" ::: "memory");
            const unsigned og = xb_add(&bar[XB_TOP], 1u);
            const unsigned tg = og / nx;
            if (og + 1u == (tg + 1u) * nx) xb_add(&bar[XB_TOPGEN], 1u);
            else XB_SPIN(xb_ld(&bar[XB_TOPGEN]) == tg, bar);
            __builtin_amdgcn_fence(__ATOMIC_ACQUIRE, "agent");
            xb_add(&bar[XB_XGEN(b.x)], 1u);
            asm volatile("s_waitcnt vmcnt(0)" ::: "memory");
        } else {
            XB_SPIN(xb_ld(&bar[XB_XGEN(b.x)]) == gen, bar);
            __builtin_amdgcn_fence(__ATOMIC_ACQUIRE, "agent");
            asm volatile("s_waitcnt vmcnt(0)" ::: "memory");
        }
    }
    __syncthreads();
}

__global__ void __launch_bounds__(NTHREADS) fwd_megakernel(Params P) {
    extern __shared__ __attribute__((aligned(16))) unsigned char lds_raw[];
    LAS unsigned char* lds = (LAS unsigned char*)lds_raw;
    int wave0 = __builtin_amdgcn_readfirstlane((int)threadIdx.x >> 6);
    unsigned char* ws0 = P.ws;
    volatile LAS unsigned* bst = (volatile LAS unsigned*)(lds + LDS_BYTES - 64);
    if (threadIdx.x < 2) bst[threadIdx.x] = 0u;
    __syncthreads();
    (void)xcd_barrier_post((unsigned*)(P.ws + WS_CTL) + 4096, bst);
#define GRID_BAR() do { XcdBarrier b_; b_.bar = (unsigned*)(ws0 + WS_CTL) + 4096; b_.x = xb_xcc_id(); b_.st = (volatile LAS unsigned*)(lds + LDS_BYTES - 64); xcd_barrier(b_); } while (0)
    { const int wave = wave0, lane = lane_id_opaque(), tid = wave * 64 + lane;

#ifndef SKIP_P0
    p0_prologue(P, lds, tid, lane, wave);
#ifdef DUP_P0
    p0_prologue(P, lds, tid, lane, wave);
#endif
#endif
    }
    GRID_BAR();

#pragma unroll 1
    for (int layer = 0; layer < DEPTH; ++layer) {
        asm volatile("" : "+s"(wave0), "+s"(ws0));
        const int wave = wave0, lane = lane_id_opaque(), tid = wave * 64 + lane;
        const int G = gridDim.x, gw = blockIdx.x * NWAVES + wave, NGW = G * NWAVES;
        unsigned char* ws = ws0;
        unsigned* ctl = (unsigned*)(ws + WS_CTL);
#ifdef PROBE_ZERO_O
        for (size_t i = (size_t)blockIdx.x * NTHREADS + tid; i < (size_t)MROWS * 2048 / 8; i += (size_t)G * NTHREADS) ((u32x4*)(ws + WS_O))[i] = (u32x4){0u, 0u, 0u, 0u};
#endif
        { pg8::Gemm gm{(const pg8::bf16_t*)(ws + WS_XB), (const pg8::bf16_t*)(ws + WS_WIN + layer * SZ_WIN), MROWS, INP, DM};
          pg8::StaticOrder S; S.init(MROWS, INP, G, (int)blockIdx.x);
          pg8::EpiScaleBf16 E{(pg8::bf16_t*)(ws + WS_PROJ), INP, (const float*)(ws + WS_SSP)};
          pg8::gemm_phase<pg8::EpiScaleBf16, pg8::StaticOrder, true, true>(lds, gm, S, E, wave); }
        GRID_BAR();
#ifndef SKIP_CMP
        for (int it = gw; it < 384 + 512; it += NGW) { if (it < 384) item_compress(P, layer, it, lane); else item_kmean(P, it - 384, lane); }
#ifdef DUP_CMP
        for (int it = gw; it < 384 + 512; it += NGW) { if (it < 384) item_compress(P, layer, it, lane); else item_kmean(P, it - 384, lane); }
#endif
#endif
#ifndef SKIP_MIXA
#ifdef DUP_P2A
        for (int rep_ = 0; rep_ < 2; ++rep_)
        for (;;) { const int u = next_unit(ctl + 64 * (layer * 2 + 0 + 8 * rep_), lds, tid); if (u >= 1536) break; const int ln_ = lane_id_opaque(); unit_mixA(P, lds, u, wave * 64 + ln_, ln_, wave); }
#else
        for (;;) { const int u = next_unit(ctl + 64 * (layer * 2 + 0), lds, tid); if (u >= 1536) break; const int ln_ = lane_id_opaque(); unit_mixA(P, lds, u, wave * 64 + ln_, ln_, wave); }
#endif
#endif
        GRID_BAR();
        for (int r = gw; r < MROWS; r += NGW) item_combineA(P, r, lane);
#ifdef DUP_P2B
        for (int rep_ = 0; rep_ < 2; ++rep_)
        for (;;) { const int u = next_unit(ctl + 64 * (layer * 2 + 1 + 8 * rep_), lds, tid); if (u >= 384 + 1024) break;
#else
        const int n_units_b = 384 + 1024 + ((P0_LAYERS == 1 && layer + 1 < DEPTH) ? N_CONV_UNITS : 0);
        for (;;) { const int u = next_unit(ctl + 64 * (layer * 2 + 1), lds, tid); if (u >= n_units_b) break;
            if (u >= 384 + 1024) {
                LAS float* scr = (LAS float*)(lds + wave * 16384); const int ln_ = lane_id_opaque();
                for (int k = 0; k < CONV_UNIT_ITEMS / NWAVES; ++k) { const int r = (u - 384 - 1024) * CONV_UNIT_ITEMS + wave * (CONV_UNIT_ITEMS / NWAVES) + k; if (r < I_LAYER) p0_layer_item(P, scr, layer + 1, r, ln_); }
                continue; }
#endif
            if (u < 384) {
#ifndef SKIP_NSA
                { const int ln_ = lane_id_opaque(); unit_nsa(P, lds, (u % 6) / 3, (u % 6) % 3, 63 - u / 6, wave * 64 + ln_, ln_, wave); }
#endif
            } else { const int v = u - 384;
#ifndef SKIP_MOBA
                { const int ln_ = lane_id_opaque(); unit_moba(P, lds, (v % 16) / 8, (v % 16) % 8, 63 - v / 16, wave * 64 + ln_, ln_, wave); }
#endif
            } }
        GRID_BAR();
        { pg8::Gemm gm{(const pg8::bf16_t*)(ws + WS_O), (const pg8::bf16_t*)(ws + WS_WOUT + layer * SZ_WOUT), MROWS, DM, DM};
          pg8::StaticOrder S; S.init(MROWS, DM, G, (int)blockIdx.x);
          pg8::EpiResid E{(pg8::bf16_t*)(ws + WS_XB), (float*)(ws + WS_SSP)};
          pg8::gemm_phase<pg8::EpiResid, pg8::StaticOrder, true, true>(lds, gm, S, E, wave); }
        GRID_BAR();
#ifdef FUSE_CONV
        { pg8::Gemm gm{(const pg8::bf16_t*)(ws + WS_XB), (const pg8::bf16_t*)(ws + WS_WUP + layer * SZ_WUP), MROWS, UPW, DM};
          pg8::StaticOrder S; S.init(MROWS, UPW, G, (int)blockIdx.x);
          pg8::EpiConvGate E{(pg8::bf16_t*)(ws + WS_ACT), (pg8::bf16_t*)(ws + WS_UB), (const float*)(ws + WS_SSP), P.conv_w + (size_t)layer * 3 * UPW, P.conv_b + (size_t)layer * UPW, DFF};
          pg8::gemm_phase<pg8::EpiConvGate, pg8::StaticOrder, true, true>(lds, gm, S, E, wave); }
        GRID_BAR();
        phase_convfix(P, layer, tid);
        GRID_BAR();
#else
        { pg8::Gemm gm{(const pg8::bf16_t*)(ws + WS_XB), (const pg8::bf16_t*)(ws + WS_WUP + layer * SZ_WUP), MROWS, UPW, DM};
          pg8::StaticOrder S; S.init(MROWS, UPW, G, (int)blockIdx.x);
          pg8::EpiScaleBf16 E{(pg8::bf16_t*)(ws + WS_U), UPW, (const float*)(ws + WS_SSP)};
#ifdef DUP_G3
          pg8::gemm_phase<pg8::EpiScaleBf16, pg8::StaticOrder, true, true>(lds, gm, S, E, wave);
#endif
          pg8::gemm_phase<pg8::EpiScaleBf16, pg8::StaticOrder, true, true>(lds, gm, S, E, wave); }
        GRID_BAR();
#ifndef SKIP_CONV
        phase_conv(P, layer, tid);
#ifdef DUP_CONV
        phase_conv(P, layer, tid);
#endif
#endif
        GRID_BAR();
#endif
        { pg8::Gemm gm{(const pg8::bf16_t*)(ws + WS_ACT), (const pg8::bf16_t*)(ws + WS_WDN + layer * SZ_WDN), MROWS, DM, DFF};
          pg8::StaticOrder S; S.init(MROWS, DM, G, (int)blockIdx.x);
          pg8::EpiResid E{(pg8::bf16_t*)(ws + WS_XB), (float*)(ws + WS_SSP)};
          pg8::gemm_phase<pg8::EpiResid, pg8::StaticOrder, true, true>(lds, gm, S, E, wave); }
        GRID_BAR();
    }
    const int wave = wave0, lane = lane_id_opaque();
    const int G = gridDim.x, gw = blockIdx.x * NWAVES + wave, NGW = G * NWAVES;
    unsigned char* ws = ws0; (void)G;
    for (int mrow = gw; mrow < MROWS; mrow += NGW) {
        const u32x2* xr = (const u32x2*)((const bf16_t*)(ws + WS_XB) + (size_t)mrow * DM) + lane; const f32x4* gr = (const f32x4*)P.norm_final + lane;
        f32x4 v[8]; float s = 0.f;
#pragma unroll
        for (int j = 0; j < 8; ++j) { const u32x2 w = xr[64 * j]; v[j] = (f32x4){bflo(w.x), bfhi(w.x), bflo(w.y), bfhi(w.y)}; s += (v[j][0] * v[j][0] + v[j][1] * v[j][1]) + (v[j][2] * v[j][2] + v[j][3] * v[j][3]); }
#pragma unroll
        for (int o = 1; o < 64; o <<= 1) s += __shfl_xor(s, o);
        const float rs = 1.0f / sqrtf(s * (1.0f / DM) + 1e-6f);
        f32x4* orow = (f32x4*)(P.out + (size_t)mrow * DM) + lane;
#pragma unroll
        for (int j = 0; j < 8; ++j) orow[64 * j] = v[j] * rs * gr[64 * j];
    }
}

extern "C" void kernel_launch(void* const* d_in, const int* in_sizes, int n_in, void* d_out, int out_size, void* d_ws, size_t ws_size, hipStream_t stream) {
    static int grid = 0;
    if (grid == 0) {
        if (n_in != 14 || ws_size < WS_END) { fprintf(stderr, "kernel_launch: unexpected n_in %d or workspace %zu < %zu\n", n_in, ws_size, (size_t)WS_END); grid = -1; return; }
        int dev = 0, cus = 0, per_cu = 0;
        hipGetDevice(&dev); hipDeviceGetAttribute(&cus, hipDeviceAttributeMultiprocessorCount, dev);
        if (hipFuncSetAttribute((const void*)fwd_megakernel, hipFuncAttributeMaxDynamicSharedMemorySize, LDS_BYTES) != hipSuccess) { fprintf(stderr, "kernel_launch: hipFuncSetAttribute failed\n"); grid = -1; return; }
        if (hipOccupancyMaxActiveBlocksPerMultiprocessor(&per_cu, (const void*)fwd_megakernel, NTHREADS, LDS_BYTES) != hipSuccess || per_cu < 1) { fprintf(stderr, "kernel_launch: occupancy query says %d\n", per_cu); per_cu = 1; }
        (void)hipGetLastError();
        grid = cus * 1;
    }
    if (grid < 0) return;
    hipMemsetAsync((char*)d_ws + WS_CTL, 0, CTL_BYTES, stream);
    Params p{};
    p.x = (const float*)d_in[0]; p.rel = (const float*)d_in[1]; p.w_in = (const float*)d_in[2]; p.w_out = (const float*)d_in[3]; p.cmp_w1 = (const float*)d_in[4]; p.cmp_w2 = (const float*)d_in[5];
    p.cmp_pe = (const float*)d_in[6]; p.norm_attn = (const float*)d_in[7]; p.norm_mlp = (const float*)d_in[8]; p.w_up = (const float*)d_in[9]; p.conv_w = (const float*)d_in[10]; p.conv_b = (const float*)d_in[11];
    p.w_down = (const float*)d_in[12]; p.norm_final = (const float*)d_in[13]; p.out = (float*)d_out; p.ws = (unsigned char*)d_ws;
    void* args[] = {&p};
    hipError_t e = hipLaunchCooperativeKernel((const void*)fwd_megakernel, dim3(grid), dim3(NTHREADS), args, LDS_BYTES, stream);
    if (e != hipSuccess) fprintf(stderr, "kernel_launch: cooperative launch failed: %s (grid %d)\n", hipGetErrorString(e), grid);
}
```

```cpp
#define NO_TAILFILL
#define FUSE_CONV
#define CONV_DPP
#include <hip/hip_runtime.h>
#include <hip/hip_cooperative_groups.h>
#include <cstdio>
#include <cstdint>
namespace cg = cooperative_groups;
namespace pg8 {
#define PG8_LAS __attribute__((address_space(3)))
typedef unsigned short bf16_t;
typedef short bf16x8 __attribute__((ext_vector_type(8)));
typedef float f32x4 __attribute__((ext_vector_type(4)));
typedef unsigned u32x4 __attribute__((ext_vector_type(4)));
constexpr int BM = 256, BK = 64, HALF = 128, HTB = HALF * BK * 2  , STAGE_BYTES = 8 * HTB, NXCD = 8, WGM = 8;

__host__ __device__ __forceinline__ int lds_byte(int r, int c) { const int st = (r >> 4) * 2 + (c >> 5), rr = r & 15, cc = c & 31, ob = rr * 64 + cc * 2; return st * 1024 + (ob ^ (((ob >> 9) & 1) << 5)); }
__host__ __device__ __forceinline__ void stage_rc(int b, int& R, int& C) { const int st = b / 1024, sb = b % 1024, swz = sb ^ (((sb >> 9) & 1) << 5); R = (st >> 1) * 16 + swz / 64; C = (st & 1) * 32 + (swz % 64) / 2; }
__host__ __device__ __forceinline__ int perm32(int rho) { const int n = rho >> 4, i = rho & 15; return 8 * (i >> 2) + 4 * n + (i & 3); }

struct Unit { int pm, pn; };
struct Gemm { const bf16_t* A; const bf16_t* Bt; int M, N, K; };

struct StaticOrder {
    int nM, nN, nwg, G, c;
    __host__ __device__ void init(int M, int N, int G_, int c_) { nM = M / BM; nN = N / BM; nwg = nM * nN; G = G_; c = c_; }
    __host__ __device__ bool next(int i, Unit& u) const {
        const long L = (long)i * G + c; if (L >= nwg) return false;
        int wgid = (int)L; { const int q = nwg / NXCD, r = nwg % NXCD, xcd = wgid % NXCD, off = wgid / NXCD; wgid = (xcd < r ? xcd * (q + 1) : r * (q + 1) + (xcd - r) * q) + off; }
        const int nig = WGM * nN, gid = wgid / nig, fm = gid * WGM, gsz = (nM - fm) < WGM ? (nM - fm) : WGM;
        u.pm = fm + ((wgid % nig) % gsz); u.pn = (wgid % nig) / gsz; return true;
    }
    __device__ __forceinline__ void a_ready(const Unit&) const {}
    __device__ __forceinline__ void done(const Unit&) const {}
};
typedef float f32x2 __attribute__((ext_vector_type(2)));
typedef __bf16 bf16x2_pk __attribute__((ext_vector_type(2)));
__device__ __forceinline__ unsigned cvt_pk_bf16(float lo, float hi) { f32x2 v = {lo, hi}; bf16x2_pk b = __builtin_convertvector(v, bf16x2_pk); return __builtin_bit_cast(unsigned, b); }
__device__ __forceinline__ float row_rstd(const float* ssp, int row) {
    const f32x4* p = (const f32x4*)(ssp + (size_t)row * 32); float s = 0.f;
#pragma unroll
    for (int i = 0; i < 8; ++i) { const f32x4 v = p[i]; s += (v[0] + v[1]) + (v[2] + v[3]); }
    return 1.0f / sqrtf(s * (1.0f / 2048.0f) + 1e-6f);
}
struct EpiScaleBf16 {
    static constexpr bool PERM = true, AFTER_DRAIN = false;
    bf16_t* O; int ldc; const float* ssp;
    __device__ __forceinline__ void operator()(const f32x4 (&acc)[2][2][4][2], const Unit& u, int wr, int wc, int fr, int fq) const {
        const int lane = fq * 16 + fr;
        const int rbase = u.pm * BM + wr * 64;
        f32x4 t[2][8];
#pragma unroll
        for (int j = 0; j < 2; ++j) { const int q = 2 * lane + j; const int row = rbase + (q >> 6) * HALF + (q & 63);
            const f32x4* p = (const f32x4*)(ssp + (size_t)row * 32);
#pragma unroll
            for (int i = 0; i < 8; ++i) t[j][i] = p[i]; }
        __builtin_amdgcn_sched_barrier(0);
        float rsv[2];
#pragma unroll
        for (int j = 0; j < 2; ++j) { float sm = 0.f;
#pragma unroll
            for (int i = 0; i < 8; ++i) sm += (t[j][i][0] + t[j][i][1]) + (t[j][i][2] + t[j][i][3]);
            rsv[j] = 1.0f / sqrtf(sm * (1.0f / 2048.0f) + 1e-6f); }
        const int row0 = rbase + fr; const int col0 = u.pn * BM + wc * 32 + 8 * fq;
#pragma unroll
        for (int ai = 0; ai < 2; ++ai)
#pragma unroll
            for (int m = 0; m < 4; ++m) { const int q = ai * 64 + m * 16 + fr; const float v0 = __shfl(rsv[0], q >> 1), v1 = __shfl(rsv[1], q >> 1); const float rs = (q & 1) ? v1 : v0;
                bf16_t* rowp = O + (size_t)(row0 + ai * HALF + m * 16) * ldc + col0;
#pragma unroll
                for (int bj = 0; bj < 2; ++bj) { const f32x4 v0_ = acc[ai][bj][m][0] * rs, v1_ = acc[ai][bj][m][1] * rs; u32x4 w;
                    w.x = cvt_pk_bf16(v0_[0], v0_[1]); w.y = cvt_pk_bf16(v0_[2], v0_[3]); w.z = cvt_pk_bf16(v1_[0], v1_[1]); w.w = cvt_pk_bf16(v1_[2], v1_[3]);
                    *(u32x4*)(rowp + bj * HALF) = w; } }
    }
};
struct EpiResid {
    static constexpr bool PERM = false, AFTER_DRAIN = false;
    bf16_t* XB; float* ssp;
    __device__ __forceinline__ void operator()(const f32x4 (&acc)[2][2][4][2], const Unit& u, int wr, int wc, int fr, int fq) const {
        typedef unsigned u32x2v __attribute__((ext_vector_type(2)));
        const int row0 = u.pm * BM + wr * 64 + fr; const int col0 = u.pn * BM + wc * 32 + 4 * fq;
#pragma unroll
        for (int ai = 0; ai < 2; ++ai) {
            u32x2v bs[4][2][2];
#pragma unroll
            for (int m = 0; m < 4; ++m)
#pragma unroll
                for (int bj = 0; bj < 2; ++bj)
#pragma unroll
                    for (int n = 0; n < 2; ++n) bs[m][bj][n] = *(const u32x2v*)(XB + (size_t)(row0 + ai * HALF + m * 16) * 2048 + col0 + bj * HALF + n * 16);
            __builtin_amdgcn_sched_barrier(0);
#pragma unroll
            for (int m = 0; m < 4; ++m) { const int row = row0 + ai * HALF + m * 16; const size_t off = (size_t)row * 2048 + col0; float ss = 0.f;
#pragma unroll
                for (int bj = 0; bj < 2; ++bj)
#pragma unroll
                    for (int n = 0; n < 2; ++n) { const size_t o2 = off + bj * HALF + n * 16; const u32x2v b2 = bs[m][bj][n];
                        const f32x4 bv = {__uint_as_float(b2.x << 16), __uint_as_float(b2.x & 0xffff0000u), __uint_as_float(b2.y << 16), __uint_as_float(b2.y & 0xffff0000u)};
                        const f32x4 v = bv + acc[ai][bj][m][n];
                        u32x2v w; w.x = cvt_pk_bf16(v[0], v[1]); w.y = cvt_pk_bf16(v[2], v[3]); *(u32x2v*)(XB + o2) = w;
                        ss += (v[0] * v[0] + v[1] * v[1]) + (v[2] * v[2] + v[3] * v[3]); }
                ss += __shfl_xor(ss, 16); ss += __shfl_xor(ss, 32);
                if (fq == 0) ssp[(size_t)row * 32 + u.pn * 4 + wc] = ss; }
            asm volatile("" ::: "memory");
        }
    }
};
template <int CTRL> __device__ __forceinline__ float dpp_f(float v) { return __builtin_bit_cast(float, __builtin_amdgcn_update_dpp(0, __builtin_bit_cast(int, v), CTRL, 0xf, 0xf, false)); }
#ifdef CONV_DPP
#define ROWM1(v) dpp_f<0x121>(v)
#define ROWM2(v) dpp_f<0x122>(v)
#else
#define ROWM1(v) __shfl(v, src1)
#define ROWM2(v) __shfl(v, src2)
#endif
struct EpiConvGate {
    static constexpr bool PERM = true, AFTER_DRAIN = false;
    bf16_t* ACT; bf16_t* UB; const float* ssp; const float* cw; const float* cb; int dff;
    __device__ __forceinline__ void operator()(const f32x4 (&acc)[2][2][4][2], const Unit& u, int wr, int wc, int fr, int fq) const {
        typedef unsigned u32x2v __attribute__((ext_vector_type(2)));
        const int lane = fq * 16 + fr;
        const int rbase = u.pm * BM + wr * 64;
        const int upw = 2 * dff;
        float rsv[2];
        { f32x4 t[2][8];
#pragma unroll
          for (int j = 0; j < 2; ++j) { const int q = 2 * lane + j; const int row = rbase + (q >> 6) * HALF + (q & 63);
              const f32x4* p = (const f32x4*)(ssp + (size_t)row * 32);
#pragma unroll
              for (int i = 0; i < 8; ++i) t[j][i] = p[i]; }
          __builtin_amdgcn_sched_barrier(0);
#pragma unroll
          for (int j = 0; j < 2; ++j) { float sm = 0.f;
#pragma unroll
              for (int i = 0; i < 8; ++i) sm += (t[j][i][0] + t[j][i][1]) + (t[j][i][2] + t[j][i][3]);
              rsv[j] = 1.0f / sqrtf(sm * (1.0f / 2048.0f) + 1e-6f); } }
        const int src1 = fq * 16 + ((fr + 15) & 15), src2 = fq * 16 + ((fr + 14) & 15); (void)src1; (void)src2;
        const int chb = u.pn * HALF + wc * 32 + 8 * fq;
        const int ucb = u.pn * BM + wc * 32 + 8 * fq;
#pragma unroll
        for (int n = 0; n < 2; ++n) {
            const int ch = chb + 4 * n;
            const f32x4 wa0 = *(const f32x4*)(cw + ch), wa1 = *(const f32x4*)(cw + upw + ch), wa2 = *(const f32x4*)(cw + 2 * upw + ch);
            const f32x4 wg0 = *(const f32x4*)(cw + dff + ch), wg1 = *(const f32x4*)(cw + upw + dff + ch), wg2 = *(const f32x4*)(cw + 2 * upw + dff + ch);
            const f32x4 ba = *(const f32x4*)(cb + ch), bg = *(const f32x4*)(cb + dff + ch);
            __builtin_amdgcn_sched_barrier(0);
#pragma unroll
            for (int ai = 0; ai < 2; ++ai) {
                f32x4 pa = {0.f, 0.f, 0.f, 0.f}, pg = {0.f, 0.f, 0.f, 0.f};
#pragma unroll
                for (int m = 0; m < 4; ++m) {
                    const int q = ai * 64 + m * 16 + fr; const float rv0 = __shfl(rsv[0], q >> 1), rv1 = __shfl(rsv[1], q >> 1); const float rsm = (q & 1) ? rv1 : rv0;
                    const f32x4 va = acc[ai][0][m][n] * rsm, vg = acc[ai][1][m][n] * rsm;
                    f32x4 a1, a2, g1, g2;
#pragma unroll
                    for (int x = 0; x < 4; ++x) {
                        const float c1 = ROWM1(va[x]), c2 = ROWM2(va[x]), e1 = ROWM1(vg[x]), e2 = ROWM2(vg[x]);
                        float d1 = 0.f, d2 = 0.f, f1 = 0.f, f2 = 0.f;
                        if (m > 0) { d1 = ROWM1(pa[x]); d2 = ROWM2(pa[x]); f1 = ROWM1(pg[x]); f2 = ROWM2(pg[x]); }
                        a1[x] = fr >= 1 ? c1 : d1; a2[x] = fr >= 2 ? c2 : d2; g1[x] = fr >= 1 ? e1 : f1; g2[x] = fr >= 2 ? e2 : f2; }
                    const f32x4 ya = ba + wa0 * va + wa1 * a1 + wa2 * a2, yg = bg + wg0 * vg + wg1 * g1 + wg2 * g2;
                    float r4[4];
#pragma unroll
                    for (int x = 0; x < 4; ++x) r4[x] = ya[x] * yg[x] / (1.f + __expf(-yg[x]));
                    const int row = rbase + ai * HALF + m * 16 + fr;
                    if (m > 0 || fr >= 2) { u32x2v w; w.x = cvt_pk_bf16(r4[0], r4[1]); w.y = cvt_pk_bf16(r4[2], r4[3]); *(u32x2v*)(ACT + (size_t)row * dff + ch) = w; }
                    if ((m == 0 && fr < 2) || (m == 3 && fr >= 14)) { const int k = (m == 0) ? fr : fr - 12; bf16_t* ub = UB + ((size_t)(row >> 6) * 4 + k) * upw + ucb + 4 * n;
                        u32x2v w; w.x = cvt_pk_bf16(va[0], va[1]); w.y = cvt_pk_bf16(va[2], va[3]); *(u32x2v*)ub = w;
                        w.x = cvt_pk_bf16(vg[0], vg[1]); w.y = cvt_pk_bf16(vg[2], vg[3]); *(u32x2v*)(ub + HALF) = w; }
                    pa = va; pg = vg;
                }
                asm volatile("" ::: "memory");
            }
        }
    }
};
template <class Epi, class Sched, bool ALIGN_EPI = false, bool SP2 = false>
__device__ __forceinline__ void gemm_phase(PG8_LAS unsigned char* lds, const Gemm g, const Sched& S, const Epi& E, const int wid_in) {
    int lane_; asm volatile("v_mbcnt_lo_u32_b32 %0, -1, 0\n\tv_mbcnt_hi_u32_b32 %0, -1, %0" : "=v"(lane_)); const int wid = wid_in, lane = lane_, tid = wid * 64 + lane, wr = wid >> 2, wc = wid & 3, fr = lane & 15, fq = lane >> 4;
    const int K = g.K, nt = K / BK;
    unsigned voffA[2], voffB[2];
#pragma unroll
    for (int i = 0; i < 2; ++i) { int R, C; stage_rc(tid * 16 + i * 8192, R, C); const int Rb = Epi::PERM ? ((R & ~31) + perm32(R & 31)) : R;
        voffA[i] = (unsigned)(R * K + C) * 2u; voffB[i] = (unsigned)(Rb * K + C) * 2u; }
    const size_t kstep = (size_t)(BK * 2);
    const size_t hstep = (size_t)HALF * K * 2;
    const size_t tstep = 2 * hstep;
    const unsigned ldsw = (unsigned)wid * 1024u;
    const int aoff = lds_byte(wr * 64 + fr, fq * 8), boff = lds_byte(wc * 32 + fr, fq * 8);
#define PG8_SA(b, h) (((b) * 2 + (h)) * HTB)
#define PG8_SB(b, h) ((4 + (b) * 2 + (h)) * HTB)
#define PG8_STAGE(bufoff, gbase, voff) do { _Pragma("unroll") for (int _i = 0; _i < 2; ++_i) \
        __builtin_amdgcn_global_load_lds((const unsigned*)((const char*)(gbase) + (voff)[_i]), (PG8_LAS unsigned*)(lds + (bufoff) + ldsw + _i * 8192), 16, 0, 0); } while (0)
#define PG8_LDA(dst, b, h) do { _Pragma("unroll") for (int m = 0; m < 4; ++m) _Pragma("unroll") for (int k = 0; k < 2; ++k) dst[m][k] = *(const PG8_LAS bf16x8*)(lds + PG8_SA(b, h) + aoff + m * 2048 + k * 1024); } while (0)
#define PG8_LDB(dst, b, h) do { _Pragma("unroll") for (int n = 0; n < 2; ++n) _Pragma("unroll") for (int k = 0; k < 2; ++k) dst[n][k] = *(const PG8_LAS bf16x8*)(lds + PG8_SB(b, h) + boff + n * 2048 + k * 1024); } while (0)
#define PG8_MMA(ai, bj, At, Bt) do { __builtin_amdgcn_s_setprio(1); _Pragma("unroll") for (int m = 0; m < 4; ++m) _Pragma("unroll") for (int n = 0; n < 2; ++n) _Pragma("unroll") for (int k = 0; k < 2; ++k) \
        acc[ai][bj][m][n] = __builtin_amdgcn_mfma_f32_16x16x32_bf16(Bt[n][k], At[m][k], acc[ai][bj][m][n], 0, 0, 0); __builtin_amdgcn_s_setprio(0); } while (0)
#define PG8_WAIT_V(n) asm volatile("s_waitcnt vmcnt(" #n ")" ::: "memory")
#define PG8_WAIT_L(n) asm volatile("s_waitcnt lgkmcnt(" #n ")" ::: "memory")
#define PG8_BAR __builtin_amdgcn_s_barrier()
#define PG8_SCHED __builtin_amdgcn_sched_barrier(0)
    Unit cur, nxt; int ui = 0;
    if (!S.next(0, cur)) return;
    f32x4 acc[2][2][4][2];
#pragma unroll
    for (int a = 0; a < 2; ++a)
#pragma unroll
        for (int b = 0; b < 2; ++b)
#pragma unroll
            for (int m = 0; m < 4; ++m)
#pragma unroll
                for (int n = 0; n < 2; ++n) acc[a][b][m][n] = (f32x4){0.f, 0.f, 0.f, 0.f};
    bf16x8 At[4][2], B0[2][2], B1[2][2];
    const char* cA = (const char*)g.A + (size_t)cur.pm * tstep; const char* cB = (const char*)g.Bt + (size_t)cur.pn * tstep;
    S.a_ready(cur);
    if constexpr (SP2) {
        PG8_STAGE(PG8_SB(0, 0), cB, voffB); PG8_STAGE(PG8_SB(0, 1), cB + hstep, voffB); PG8_STAGE(PG8_SA(0, 0), cA, voffA); PG8_STAGE(PG8_SA(0, 1), cA + hstep, voffA);
        if (wr == 1) PG8_BAR;
        PG8_WAIT_V(2); PG8_BAR;
        PG8_STAGE(PG8_SB(1, 0), cB + kstep, voffB); PG8_STAGE(PG8_SA(1, 0), cA + kstep, voffA); PG8_STAGE(PG8_SB(1, 1), cB + hstep + kstep, voffB);
        PG8_WAIT_V(6); PG8_BAR;
    } else {
        PG8_STAGE(PG8_SB(0, 0), cB, voffB); PG8_STAGE(PG8_SA(0, 0), cA, voffA); PG8_STAGE(PG8_SB(0, 1), cB + hstep, voffB); PG8_STAGE(PG8_SA(0, 1), cA + hstep, voffA);
        if (wr == 1) PG8_BAR;
        PG8_WAIT_V(4); PG8_BAR;
        PG8_STAGE(PG8_SB(1, 0), cB + kstep, voffB); PG8_STAGE(PG8_SA(1, 0), cA + kstep, voffA); PG8_STAGE(PG8_SB(1, 1), cB + hstep + kstep, voffB);
        PG8_WAIT_V(6); PG8_BAR;
    }
    for (;;) {
        const bool has_next = S.next(ui + 1, nxt);
        const char* nA = has_next ? (const char*)g.A + (size_t)nxt.pm * tstep : cA; const char* nB = has_next ? (const char*)g.Bt + (size_t)nxt.pn * tstep : cB;
        for (int t = 0; t < nt; t += 2) {
            const bool last = (t == nt - 2);
            const char* a1 = cA + (size_t)(t + 1) * kstep;
            const char* a2 = last ? nA : cA + (size_t)(t + 2) * kstep; const char* b2 = last ? nB : cB + (size_t)(t + 2) * kstep;
            const char* a3 = a2 + kstep; const char* b3 = b2 + kstep;
            if (last && has_next) S.a_ready(nxt);
            if constexpr (SP2) {
            PG8_LDB(B0, 0, 0); PG8_LDB(B1, 0, 1); PG8_SCHED; PG8_LDA(At, 0, 0); PG8_STAGE(PG8_SA(1, 1), a1 + hstep, voffA);
            PG8_WAIT_V(8); PG8_WAIT_L(0); PG8_BAR; PG8_MMA(0, 0, At, B0); PG8_MMA(0, 1, At, B1); PG8_BAR; PG8_SCHED;
            PG8_LDA(At, 0, 1); PG8_STAGE(PG8_SB(0, 0), b2, voffB); PG8_STAGE(PG8_SB(0, 1), b2 + hstep, voffB); PG8_STAGE(PG8_SA(0, 0), a2, voffA);
            PG8_WAIT_V(8); PG8_WAIT_L(0); PG8_BAR; PG8_MMA(1, 0, At, B0); PG8_MMA(1, 1, At, B1); PG8_BAR; PG8_SCHED;
            PG8_LDB(B0, 1, 0); PG8_LDB(B1, 1, 1); PG8_SCHED; PG8_LDA(At, 1, 0); PG8_STAGE(PG8_SA(0, 1), a2 + hstep, voffA);
            PG8_WAIT_V(8); PG8_WAIT_L(0); PG8_BAR; PG8_MMA(0, 0, At, B0); PG8_MMA(0, 1, At, B1); PG8_BAR; PG8_SCHED;
            PG8_LDA(At, 1, 1); PG8_STAGE(PG8_SB(1, 0), b3, voffB); PG8_STAGE(PG8_SB(1, 1), b3 + hstep, voffB); PG8_STAGE(PG8_SA(1, 0), a3, voffA);
            PG8_WAIT_V(8); PG8_WAIT_L(0); PG8_BAR; PG8_MMA(1, 0, At, B0); PG8_MMA(1, 1, At, B1); PG8_BAR; PG8_SCHED;
            } else {
            PG8_LDB(B0, 0, 0); PG8_SCHED; PG8_LDA(At, 0, 0); PG8_STAGE(PG8_SA(1, 1), a1 + hstep, voffA);
            PG8_WAIT_L(8); PG8_BAR; PG8_WAIT_L(0); PG8_MMA(0, 0, At, B0); PG8_BAR; PG8_SCHED;
            PG8_LDB(B1, 0, 1); PG8_STAGE(PG8_SB(0, 0), b2, voffB);
            PG8_BAR; PG8_WAIT_L(0); PG8_MMA(0, 1, At, B1); PG8_BAR;
            PG8_LDA(At, 0, 1); PG8_STAGE(PG8_SA(0, 0), a2, voffA);
            PG8_BAR; PG8_WAIT_L(0); PG8_MMA(1, 0, At, B0); PG8_BAR; PG8_SCHED;
            PG8_STAGE(PG8_SB(0, 1), b2 + hstep, voffB);
            PG8_WAIT_V(6); PG8_BAR; PG8_MMA(1, 1, At, B1); PG8_BAR;
            PG8_LDB(B0, 1, 0); PG8_SCHED; PG8_LDA(At, 1, 0); PG8_STAGE(PG8_SA(0, 1), a2 + hstep, voffA);
            PG8_WAIT_L(8); PG8_BAR; PG8_WAIT_L(0); PG8_MMA(0, 0, At, B0); PG8_BAR; PG8_SCHED;
            PG8_LDB(B1, 1, 1); PG8_STAGE(PG8_SB(1, 0), b3, voffB);
            PG8_BAR; PG8_WAIT_L(0); PG8_MMA(0, 1, At, B1); PG8_BAR;
            PG8_LDA(At, 1, 1); PG8_STAGE(PG8_SA(1, 0), a3, voffA);
            PG8_BAR; PG8_WAIT_L(0); PG8_MMA(1, 0, At, B0); PG8_BAR; PG8_SCHED;
            PG8_STAGE(PG8_SB(1, 1), b3 + hstep, voffB);
            PG8_WAIT_V(6); PG8_BAR; PG8_MMA(1, 1, At, B1); PG8_BAR;
            }
        }
        if constexpr (ALIGN_EPI) { if (wr == 0) PG8_BAR; }
        if constexpr (!Epi::AFTER_DRAIN) { E(acc, cur, wr, wc, fr, fq); S.done(cur); }
        if (!has_next) break;
#pragma unroll
        for (int a = 0; a < 2; ++a)
#pragma unroll
            for (int b = 0; b < 2; ++b)
#pragma unroll
                for (int m = 0; m < 4; ++m)
#pragma unroll
                    for (int n = 0; n < 2; ++n) acc[a][b][m][n] = (f32x4){0.f, 0.f, 0.f, 0.f};
        cur = nxt; cA = nA; cB = nB; ++ui;
        if constexpr (ALIGN_EPI) { if (wr == 1) PG8_BAR; }
    }
    PG8_WAIT_V(0);
    if constexpr (!ALIGN_EPI) { if (wr == 0) PG8_BAR; }
    PG8_BAR;
    if constexpr (Epi::AFTER_DRAIN) { E.fused(acc, cur, wr, wc, fr, fq, lds, wid, lane); S.done(cur); }
#undef PG8_SA
#undef PG8_SB
#undef PG8_STAGE
#undef PG8_LDA
#undef PG8_LDB
#undef PG8_MMA
#undef PG8_WAIT_V
#undef PG8_WAIT_L
#undef PG8_BAR
#undef PG8_SCHED
}
}

#define GAS __attribute__((address_space(1)))
#define LAS __attribute__((address_space(3)))
typedef unsigned short bf16_t;
typedef short bf16x8 __attribute__((ext_vector_type(8)));
typedef float f32x4 __attribute__((ext_vector_type(4)));
typedef unsigned u32x4 __attribute__((ext_vector_type(4)));
typedef unsigned u32x2 __attribute__((ext_vector_type(2)));
typedef short s16x4 __attribute__((ext_vector_type(4)));

constexpr int BATCH = 2, SEQ = 8192, DM = 2048, DEPTH = 4, MROWS = BATCH * SEQ;
constexpr int INW = 5796, INP = 5888, DFF = 5632, UPW = 2 * DFF;
constexpr int A_OFF = 0, B_OFF = 2304, CQ_OFF = 3840, CKV_OFF = 4608, CG_OFF = 5760;
constexpr int LUTN = 1536;
constexpr float LOG2E = 1.4426950408889634f, LN2 = 0.6931471805599453f;
constexpr int NTHREADS = 512, NWAVES = 8;

constexpr size_t al256(size_t x) { return (x + 255) & ~(size_t)255; }
constexpr size_t WS_CTL = 0, CTL_BYTES = 1u << 20;
constexpr size_t SZ_WIN = (size_t)INP * DM * 2, SZ_WOUT = (size_t)DM * DM * 2, SZ_WUP = (size_t)UPW * DM * 2, SZ_WDN = (size_t)DM * DFF * 2;
constexpr size_t WS_WIN = CTL_BYTES;
constexpr size_t WS_WOUT = WS_WIN + DEPTH * SZ_WIN;
constexpr size_t WS_WUP = WS_WOUT + DEPTH * SZ_WOUT;
constexpr size_t WS_WDN = WS_WUP + DEPTH * SZ_WUP;
constexpr size_t WS_W1T = WS_WDN + DEPTH * SZ_WDN;
constexpr size_t WS_W2T = WS_W1T + (size_t)DEPTH * 2 * 128 * 2048 * 2;
constexpr size_t WS_CPE = WS_W2T + (size_t)DEPTH * 2 * 64 * 128 * 2;
constexpr size_t WS_GLUT = al256(WS_CPE + (size_t)DEPTH * 2 * 128 * 4);
constexpr size_t WS_X = al256(WS_GLUT + (size_t)32 * LUTN * 4);
constexpr size_t WS_XB = WS_X + (size_t)MROWS * DM * 4;
constexpr size_t WS_SSP = WS_XB + (size_t)MROWS * DM * 2;
constexpr size_t WS_R1 = WS_SSP + (size_t)MROWS * 32 * 4;
constexpr size_t WS_PROJ = WS_R1;
constexpr size_t WS_O = WS_R1 + (size_t)MROWS * INP * 2;
constexpr size_t WS_U = WS_R1;
constexpr size_t SZ_R1 = (size_t)MROWS * UPW * 2;
static_assert((size_t)MROWS * INP * 2 + (size_t)MROWS * DM * 2 <= SZ_R1, "overlay");
constexpr size_t WS_ACT = WS_R1 + SZ_R1;
constexpr size_t WS_TOT = WS_ACT + (size_t)MROWS * DFF * 2;
constexpr size_t WS_LSE = WS_TOT + (size_t)MROWS * 768 * 4;
constexpr size_t WS_KC = WS_LSE + (size_t)MROWS * 12 * 4;
constexpr size_t WS_VC = WS_KC + (size_t)BATCH * 3 * 512 * 64 * 2;
constexpr size_t WS_KMEAN = WS_VC + (size_t)BATCH * 3 * 512 * 64 * 2;
constexpr size_t WS_UB = WS_KMEAN + (size_t)BATCH * 8 * 32 * 64 * 4;
constexpr size_t WS_END = WS_UB + (size_t)(MROWS / 64) * 4 * UPW * 2;

constexpr int KP = 160;
constexpr int TILE_B = 64 * KP;
constexpr int L_K0 = 0, L_V0 = TILE_B, L_K1 = 2 * TILE_B, L_V1 = 3 * TILE_B;
constexpr int L_LUT = 4 * TILE_B;
constexpr int L_IMP = L_LUT + 4 * LUTN * 4;
constexpr int L_SEL = L_IMP + 65536;
constexpr int L_TL = L_SEL + 2048;
constexpr int L_MISC = L_TL + 2048;
constexpr int L_WUN = L_MISC + 64;
constexpr int LDS_BYTES = 147456;
static_assert(L_MISC + 256 <= LDS_BYTES, "lds map");

struct Params {
    const float* x; const float* rel; const float* w_in; const float* w_out; const float* cmp_w1; const float* cmp_w2; const float* cmp_pe;
    const float* norm_attn; const float* norm_mlp; const float* w_up; const float* conv_w; const float* conv_b; const float* w_down; const float* norm_final;
    float* out; unsigned char* ws;
};

typedef float f32x2_t __attribute__((ext_vector_type(2))); typedef __bf16 bf16x2_t __attribute__((ext_vector_type(2)));
__device__ __forceinline__ unsigned cvtpk(float lo, float hi) { f32x2_t v = {lo, hi}; bf16x2_t b = __builtin_convertvector(v, bf16x2_t); return __builtin_bit_cast(unsigned, b); }
__device__ __forceinline__ float bf2f(unsigned short b) { return __uint_as_float(((unsigned)b) << 16); }
__device__ __forceinline__ float bflo(unsigned w) { return __uint_as_float(w << 16); }
__device__ __forceinline__ float bfhi(unsigned w) { return __uint_as_float(w & 0xffff0000u); }
__device__ __forceinline__ float fexp2(float x) { return __builtin_amdgcn_exp2f(x); }
__device__ __forceinline__ int lane_id_opaque() { int l_; asm volatile("v_mbcnt_lo_u32_b32 %0, -1, 0\n\tv_mbcnt_hi_u32_b32 %0, -1, %0" : "=v"(l_)); return l_; }
#define LDS_BARRIER() do { asm volatile("s_waitcnt lgkmcnt(0)" ::: "memory"); __builtin_amdgcn_s_barrier(); asm volatile("" ::: "memory"); } while (0)
__device__ __forceinline__ float fma_1(float a, float b, float c) { float r; asm("v_fma_f32 %0, %1, %2, %3" : "=v"(r) : "v"(a), "v"(b), "v"(c)); return r; }
__device__ __forceinline__ float xrow16_max(float x) {
  auto s_ = __builtin_amdgcn_permlane16_swap(__float_as_uint(x), __float_as_uint(x), false, false);
  x = fmaxf(__uint_as_float(s_[0]), __uint_as_float(s_[1]));
  auto t_ = __builtin_amdgcn_permlane32_swap(__float_as_uint(x), __float_as_uint(x), false, false);
  return fmaxf(__uint_as_float(t_[0]), __uint_as_float(t_[1]));
}
__device__ __forceinline__ float xrow16_sum(float x) {
  auto s_ = __builtin_amdgcn_permlane16_swap(__float_as_uint(x), __float_as_uint(x), false, false);
  x = __uint_as_float(s_[0]) + __uint_as_float(s_[1]);
  auto t_ = __builtin_amdgcn_permlane32_swap(__float_as_uint(x), __float_as_uint(x), false, false);
  return __uint_as_float(t_[0]) + __uint_as_float(t_[1]);
}
__device__ __forceinline__ void lds_wait() { asm volatile("s_waitcnt lgkmcnt(0)" ::: "memory"); }
__device__ __forceinline__ s16x4 tr_read(const LAS unsigned char* p) { return __builtin_bit_cast(s16x4, __builtin_amdgcn_ds_read_tr16_b64_v4i16((LAS s16x4*)p)); }
__device__ __forceinline__ f32x4 mfma16(bf16x8 a, bf16x8 b, f32x4 c) { return __builtin_amdgcn_mfma_f32_16x16x32_bf16(a, b, c, 0, 0, 0); }

__device__ __forceinline__ int t5_bucket(int n) {
    if (n < 16) return n < 0 ? 0 : n;
    int b = 16;
    b += n >= 22; b += n >= 30; b += n >= 40; b += n >= 54; b += n >= 73; b += n >= 99; b += n >= 134; b += n >= 182;
    b += n >= 246; b += n >= 332; b += n >= 450; b += n >= 609; b += n >= 825; b += n >= 1117; b += n >= 1513;
    return b;
}
__device__ __forceinline__ bool is_qcol(int n) { return (n < 2304) ? ((n % 768) < 256) : ((n < 2816) || (n >= 3840 && n < 4608)); }

template <int MODE>
__device__ __forceinline__ void p0_item(const float* W, int K, int Nsrc, bf16_t* WT, const float* kscale, LAS float* scr, int kb, int nb, int lane) {
    const int k0 = 64 * kb, n0 = 32 * nb;
    const int nd = n0 + (lane & 31);
    int sc = nd; float cs = 1.f; bool ok = true;
    if (MODE == 0) { ok = nd < INW; if (is_qcol(nd)) cs = 0.125f; }
    if (MODE == 2) { const int pn = nd >> 8, r = nd & 255; sc = (r >= 128 ? DFF : 0) + 128 * pn + (r & 127); }
    float wv[32], kv_[32];
    const float* wp_ = W + (size_t)(k0 + (lane >> 5)) * Nsrc + (ok ? sc : 0);
#pragma unroll
    for (int i = 0; i < 32; ++i) { wv[i] = wp_[(size_t)(2 * i) * Nsrc]; kv_[i] = (MODE != 1) ? kscale[k0 + 2 * i + (lane >> 5)] : 1.f; }
    __builtin_amdgcn_sched_barrier(0);
#pragma unroll
    for (int i = 0; i < 32; ++i) { const int kk = 2 * i + (lane >> 5); scr[kk * 33 + (lane & 31)] = ok ? wv[i] * cs * kv_[i] : 0.f; }
    lds_wait();
    const int c = lane & 7;
#pragma unroll
    for (int j = 0; j < 4; ++j) { const int n = (lane >> 3) + 8 * j; const LAS float* s = scr + (8 * c) * 33 + n;
        u32x4 o; o.x = cvtpk(s[0 * 33], s[1 * 33]); o.y = cvtpk(s[2 * 33], s[3 * 33]); o.z = cvtpk(s[4 * 33], s[5 * 33]); o.w = cvtpk(s[6 * 33], s[7 * 33]);
        *(u32x4*)(WT + (size_t)(n0 + n) * K + k0 + 8 * c) = o; }
    lds_wait();
}

constexpr int I_IN = 32 * (INP / 32), I_OUT = 32 * 64, I_UP = 32 * (UPW / 32), I_DN = (DFF / 64) * 64, I_W1 = 2 * 32 * 4, I_W2 = 2 * 2 * 2;
constexpr int I_LAYER = I_IN + I_OUT + I_UP + I_DN + I_W1 + I_W2;
__device__ __forceinline__ void p0_layer_item(const Params& P, LAS float* scr, int l, int r, int lane) {
    unsigned char* ws = P.ws;
    if (r < I_IN) { p0_item<0>(P.w_in + (size_t)l * DM * INW, DM, INW, (bf16_t*)(ws + WS_WIN + l * SZ_WIN), P.norm_attn + l * DM, scr, r / (INP / 32), r % (INP / 32), lane); return; } r -= I_IN;
    if (r < I_OUT) { p0_item<1>(P.w_out + (size_t)l * DM * DM, DM, DM, (bf16_t*)(ws + WS_WOUT + l * SZ_WOUT), nullptr, scr, r / 64, r % 64, lane); return; } r -= I_OUT;
    if (r < I_UP) { p0_item<2>(P.w_up + (size_t)l * DM * UPW, DM, UPW, (bf16_t*)(ws + WS_WUP + l * SZ_WUP), P.norm_mlp + l * DM, scr, r / (UPW / 32), r % (UPW / 32), lane); return; } r -= I_UP;
    if (r < I_DN) { p0_item<1>(P.w_down + (size_t)l * DFF * DM, DFF, DM, (bf16_t*)(ws + WS_WDN + l * SZ_WDN), nullptr, scr, r / 64, r % 64, lane); return; } r -= I_DN;
    if (r < I_W1) { const int i = r / 128, rr = r % 128; p0_item<1>(P.cmp_w1 + (size_t)(l * 2 + i) * 2048 * 128, 2048, 128, (bf16_t*)(ws + WS_W1T) + (size_t)(l * 2 + i) * 128 * 2048, nullptr, scr, rr / 4, rr % 4, lane); return; } r -= I_W1;
    { const int i = r / 4, rr = r % 4; p0_item<1>(P.cmp_w2 + (size_t)(l * 2 + i) * 128 * 64, 128, 64, (bf16_t*)(ws + WS_W2T) + (size_t)(l * 2 + i) * 64 * 128, nullptr, scr, rr / 2, rr % 2, lane); }
}
#ifdef NO_TAILFILL
constexpr int P0_LAYERS = DEPTH;
#else
constexpr int P0_LAYERS = 1;
#endif
constexpr int CONV_UNIT_ITEMS = 64, N_CONV_UNITS = (I_LAYER + CONV_UNIT_ITEMS - 1) / CONV_UNIT_ITEMS;

__device__ __forceinline__ void p0_prologue(const Params& P, LAS unsigned char* lds, int tid, int lane, int wave) {
    unsigned char* ws = P.ws;
    LAS float* scr = (LAS float*)(lds + wave * 16384);
    const int G = gridDim.x, gw = blockIdx.x * NWAVES + wave, NGW = G * NWAVES;
    for (int it = gw; it < P0_LAYERS * I_LAYER; it += NGW) p0_layer_item(P, scr, it / I_LAYER, it % I_LAYER, lane);
    for (int m = gw; m < MROWS; m += NGW) {
        const f32x4* xr = (const f32x4*)(P.x + (size_t)m * DM) + lane; float s = 0.f;
        u32x2* ob = (u32x2*)((bf16_t*)(ws + WS_XB) + (size_t)m * DM) + lane;
#pragma unroll
        for (int j = 0; j < 8; ++j) { const f32x4 v = xr[64 * j]; s += (v[0] * v[0] + v[1] * v[1]) + (v[2] * v[2] + v[3] * v[3]); u32x2 w; w.x = cvtpk(v[0], v[1]); w.y = cvtpk(v[2], v[3]); ob[64 * j] = w; }
#pragma unroll
        for (int o = 1; o < 64; o <<= 1) s += __shfl_xor(s, o);
        if (lane < 32) ((float*)(ws + WS_SSP))[(size_t)m * 32 + lane] = (lane == 0) ? s : 0.f;
    }
    for (int i = blockIdx.x * NTHREADS + tid; i < 32 * LUTN; i += G * NTHREADS) { const int h = i / LUTN, n = i % LUTN; ((float*)(ws + WS_GLUT))[i] = P.rel[h * 32 + t5_bucket(n)] * LOG2E; }
    if (blockIdx.x < DEPTH * 2) {
        __syncthreads();
        const int li = blockIdx.x, kp = tid >> 7, hid = tid & 127; const float* pe = P.cmp_pe + (size_t)li * 2048; const float* w1 = P.cmp_w1 + (size_t)li * 2048 * 128;
        float s = 0.f;
#pragma unroll 8
        for (int k = kp * 512; k < kp * 512 + 512; ++k) s += pe[k] * w1[(size_t)k * 128 + hid];
        LAS float* red = (LAS float*)lds; red[tid] = s; __syncthreads();
        if (tid < 128) ((float*)(ws + WS_CPE))[li * 128 + tid] = (red[tid] + red[tid + 128]) + (red[tid + 256] + red[tid + 384]);
        __syncthreads();
    }
}

struct Src { const bf16_t* kb; const bf16_t* vb; int stride; int dil; int roff; };

template <int QG, int MODE>
__device__ __forceinline__ void flash_tile(LAS unsigned char* lds, const int buf, const int k0, const int tag, const int dil, const bf16x8 (&qf)[QG][2], f32x4 (&o)[QG][4], float (&m)[QG], float (&l)[QG],
                                           const int qc, const int qcw_min, const int qcw_max, const int maxrel, const LAS unsigned* selp, const LAS unsigned* wunp,
                                           const float (&invl)[QG], LAS float* impw, const bool imp_acc, const LAS float* lut, float& carryB, const int lane) {
    const int g = lane >> 4, i16 = lane & 15;
    bool skip = (k0 > qcw_max) || (maxrel != 0x7fffffff && k0 + 63 < qcw_min - maxrel);
    if (tag >= 0) { const unsigned w = (unsigned)__builtin_amdgcn_readfirstlane((int)wunp[tag >> 5]); if (!((w >> (tag & 31)) & 1u)) skip = true; }
    if (MODE & 4) skip = false;
    if (!skip) {
        const LAS unsigned char* Ks = lds + (buf ? L_K1 : L_K0);
        const LAS unsigned char* Vs = lds + (buf ? L_V1 : L_V0);
        bool allowed = true;
        if (tag >= 0) { const unsigned w = selp[tag >> 5]; allowed = ((w >> (tag & 31)) & 1u) != 0u; }
        float impA[4] = {0.f, 0.f, 0.f, 0.f}, impB[4] = {0.f, 0.f, 0.f, 0.f};
        const int dl_ = qcw_min - (k0 + 63), dh_ = qcw_max - k0;
        bool uni = (k0 >= 0) && (dl_ >= 0) && (maxrel == 0x7fffffff || dh_ <= maxrel);
        if (MODE & 1) uni = uni && (dl_ * dil >= 1513);
        const unsigned uni_di = (unsigned)(dl_ * dil) < (unsigned)(LUTN - 1) ? (unsigned)(dl_ * dil) : (unsigned)(LUTN - 1);
        const bool mid = (MODE & 1) && !uni && (dil == 1) && (k0 >= 0) && (dl_ >= 0) && (maxrel == 0x7fffffff || dh_ <= maxrel) && (dh_ <= LUTN - 1);
#pragma unroll
        for (int qg = 0; qg < QG; ++qg) {
            bf16x8 kf[4][2];
#pragma unroll
            for (int kt = 0; kt < 4; ++kt)
#pragma unroll
                for (int ks = 0; ks < 2; ++ks) kf[kt][ks] = *(const LAS bf16x8*)(Ks + (16 * kt + i16) * KP + ks * 64 + g * 16);
            __builtin_amdgcn_sched_barrier(0);
            f32x4 s[4];
#pragma unroll
            for (int kt = 0; kt < 4; ++kt) { s[kt] = (f32x4){0.f, 0.f, 0.f, 0.f};
#pragma unroll
                for (int ks = 0; ks < 2; ++ks) s[kt] = mfma16(kf[kt][ks], qf[qg][ks], s[kt]); }
            bf16x8 vfr[4][2];
            if (!(MODE & 2)) {
#pragma unroll
                for (int dt = 0; dt < 4; ++dt)
#pragma unroll
                    for (int s2 = 0; s2 < 2; ++s2) { const LAS unsigned char* vp = Vs + (32 * s2 + 4 * g + (i16 >> 2)) * KP + (16 * dt + 4 * (i16 & 3)) * 2;
                        const s16x4 lo = tr_read(vp), hi = tr_read(vp + 16 * KP);
                        vfr[dt][s2] = (bf16x8){lo[0], lo[1], lo[2], lo[3], hi[0], hi[1], hi[2], hi[3]}; }
            }
            __builtin_amdgcn_sched_barrier(0);
            float mx = -INFINITY; float lanebias = 0.f;
            if (uni) {
                float lb = 0.f;
                if (MODE & 1) lb = lut[qg * LUTN + uni_di];
                lanebias = allowed ? lb : -INFINITY;
                float mr = -INFINITY;
#pragma unroll
                for (int kt = 0; kt < 4; ++kt)
#pragma unroll
                    for (int r = 0; r < 4; ++r) mr = fmaxf(mr, s[kt][r]);
                mx = allowed ? __builtin_fmaf(mr, LOG2E, lb) : -INFINITY;
            } else if (mid) {
                const LAS float* lp = lut + qg * LUTN + (qc - k0 - 4 * g - 63);
                float bv[4][4];
#pragma unroll
                for (int kt = 0; kt < 4; ++kt)
#pragma unroll
                    for (int r = 0; r < 4; ++r) bv[kt][r] = lp[63 - 16 * kt - r];
                __builtin_amdgcn_sched_barrier(0);
#pragma unroll
                for (int kt = 0; kt < 4; ++kt)
#pragma unroll
                    for (int r = 0; r < 4; ++r) { float sc = __builtin_fmaf(s[kt][r], LOG2E, bv[kt][r]); sc = allowed ? sc : -INFINITY; s[kt][r] = sc; mx = fmaxf(mx, sc); }
            } else {
                float bv[4][4];
#pragma unroll
                for (int kt = 0; kt < 4; ++kt)
#pragma unroll
                    for (int r = 0; r < 4; ++r) { bv[kt][r] = 0.f;
                        if (MODE & 1) { const int rel = qc - (k0 + 16 * kt + 4 * g + r); unsigned di = (unsigned)(rel * dil); di = di < (unsigned)(LUTN - 1) ? di : (unsigned)(LUTN - 1); bv[kt][r] = lut[qg * LUTN + di]; } }
                if (MODE & 1) __builtin_amdgcn_sched_barrier(0);
#pragma unroll
                for (int kt = 0; kt < 4; ++kt)
#pragma unroll
                    for (int r = 0; r < 4; ++r) { const int kc = k0 + 16 * kt + 4 * g + r; const int rel = qc - kc;
                        const bool ok = allowed && ((unsigned)rel <= (unsigned)maxrel) && (kc >= 0);
                        float sc = __builtin_fmaf(s[kt][r], LOG2E, bv[kt][r]);
                        sc = ok ? sc : -INFINITY; s[kt][r] = sc; mx = fmaxf(mx, sc); }
            }
            mx = xrow16_max(mx);
            const float mnew = fmaxf(m[qg], mx); const float alpha = fexp2(m[qg] - mnew); m[qg] = mnew;
            float rs = 0.f;
            if (uni) { const float cb_ = lanebias - mnew;
#pragma unroll
                for (int kt = 0; kt < 4; ++kt)
#pragma unroll
                    for (int r = 0; r < 4; ++r) { const float p = fexp2(__builtin_fmaf(s[kt][r], LOG2E, cb_)); s[kt][r] = p; rs += p; }
            } else {
#pragma unroll
                for (int kt = 0; kt < 4; ++kt)
#pragma unroll
                    for (int r = 0; r < 4; ++r) { const float p = fexp2(s[kt][r] - mnew); s[kt][r] = p; rs += p; }
            }
            rs = xrow16_sum(rs);
            l[qg] = l[qg] * alpha + rs;
            if (MODE & 4) {
#pragma unroll
                for (int kt = 0; kt < 4; ++kt) { impA[kt] += ((s[kt][0] + s[kt][1]) + (s[kt][2] + s[kt][3])) * invl[qg]; impB[kt] += s[kt][3] * invl[qg]; }
            }
            if (!(MODE & 2)) {
#pragma unroll
                for (int dt = 0; dt < 4; ++dt) o[qg][dt] = o[qg][dt] * alpha;
                bf16x8 pf[2];
#pragma unroll
                for (int s2 = 0; s2 < 2; ++s2) { u32x4 w; w.x = cvtpk(s[2 * s2][0], s[2 * s2][1]); w.y = cvtpk(s[2 * s2][2], s[2 * s2][3]); w.z = cvtpk(s[2 * s2 + 1][0], s[2 * s2 + 1][1]); w.w = cvtpk(s[2 * s2 + 1][2], s[2 * s2 + 1][3]);
                    pf[s2] = __builtin_bit_cast(bf16x8, w); }
#pragma unroll
                for (int dt = 0; dt < 4; ++dt)
#pragma unroll
                    for (int s2 = 0; s2 < 2; ++s2) o[qg][dt] = mfma16(vfr[dt][s2], pf[s2], o[qg][dt]);
            }
            if (QG > 1) asm volatile("" ::: "memory");
        }
        if (MODE & 4) {
            const int srcl = (lane + 48) & 63;
#pragma unroll
            for (int kt = 0; kt < 4; ++kt) { const float pb = (kt == 0) ? carryB : impB[kt == 0 ? 0 : kt - 1];
                const float x0 = __shfl(pb, srcl), x1 = __shfl(impB[kt], srcl); const float add = (g == 0) ? x0 : x1;
                const int J = 4 * ((k0 >> 4) + kt) + g; const float prevv = imp_acc ? impw[i16 * 128 + J] : 0.f; impw[i16 * 128 + J] = prevv + impA[kt] + add; }
            carryB = impB[3];
        }
    }
}

template <int QG, int MODE>
__device__ __forceinline__ void flash_run(LAS unsigned char* lds, const Src S, const int ntiles, const bf16x8 (&qf)[QG][2], f32x4 (&o)[QG][4], float (&m)[QG], float (&l)[QG],
                                          const int qc, const int qcw_min, const int qcw_max, const int maxrel, const LAS unsigned* selp, const LAS unsigned* wunp,
                                          const float (&invl)[QG], LAS float* impw, const bool imp_acc, const int lutslot, const int lane, const int tid) {
    const LAS int* tl = (const LAS int*)(lds + L_TL);
    const LAS float* lut = (const LAS float*)(lds + L_LUT) + lutslot * LUTN;
    const int srow = tid >> 3, sch = tid & 7;
    u32x4 kr0 = {0, 0, 0, 0}, vr0 = {0, 0, 0, 0}, kr1 = {0, 0, 0, 0}, vr1 = {0, 0, 0, 0};
    float carryB = 0.f;
#define FL_ISSUE(i, KR, VR) do { int c_ = __builtin_amdgcn_readfirstlane(tl[2 * (i)]) + srow; c_ = c_ < 0 ? 0 : c_; const size_t off_ = (size_t)(c_ * S.dil + S.roff) * S.stride + sch * 8; \
        KR = *(const u32x4*)(S.kb + off_); if (!(MODE & 2)) VR = *(const u32x4*)(S.vb + off_); } while (0)
#define FL_COMMIT(b, KR, VR) do { *(LAS u32x4*)(lds + ((b) ? L_K1 : L_K0) + srow * KP + sch * 16) = KR; if (!(MODE & 2)) *(LAS u32x4*)(lds + ((b) ? L_V1 : L_V0) + srow * KP + sch * 16) = VR; } while (0)
#define FL_TILE(i, b) flash_tile<QG, MODE>(lds, b, __builtin_amdgcn_readfirstlane(tl[2 * (i)]), __builtin_amdgcn_readfirstlane(tl[2 * (i) + 1]), S.dil, qf, o, m, l, qc, qcw_min, qcw_max, maxrel, selp, wunp, invl, impw, imp_acc, lut, carryB, lane)
    LDS_BARRIER();
    if (ntiles > 0) { FL_ISSUE(0, kr0, vr0); if (ntiles > 1) FL_ISSUE(1, kr1, vr1); FL_COMMIT(0, kr0, vr0); }
    LDS_BARRIER();
    for (int i = 0; i < ntiles; i += 2) {
        if (i + 2 < ntiles) FL_ISSUE(i + 2, kr0, vr0);
        FL_TILE(i, 0);
        if (i + 1 < ntiles) FL_COMMIT(1, kr1, vr1);
        LDS_BARRIER();
        if (i + 1 >= ntiles) break;
        if (i + 3 < ntiles) FL_ISSUE(i + 3, kr1, vr1);
        FL_TILE(i + 1, 1);
        if (i + 2 < ntiles) FL_COMMIT(0, kr0, vr0);
        LDS_BARRIER();
    }
#undef FL_ISSUE
#undef FL_COMMIT
#undef FL_TILE
}

template <int QG> __device__ __forceinline__ void flash_init(f32x4 (&o)[QG][4], float (&m)[QG], float (&l)[QG]) {
#pragma unroll
    for (int q = 0; q < QG; ++q) { m[q] = -1e30f; l[q] = 0.f;
#pragma unroll
        for (int d = 0; d < 4; ++d) o[q][d] = (f32x4){0.f, 0.f, 0.f, 0.f}; }
}
template <int NH>
__device__ __forceinline__ void load_lut(LAS unsigned char* lds, const float* glut, int head0, int tid) {
    LAS float* lut = (LAS float*)(lds + L_LUT); const float* src = glut + (size_t)head0 * LUTN;
    float v[NH * 3];
#pragma unroll
    for (int i = 0; i < NH * 3; ++i) v[i] = src[tid + NTHREADS * i];
    __builtin_amdgcn_sched_barrier(0);
#pragma unroll
    for (int i = 0; i < NH * 3; ++i) lut[tid + NTHREADS * i] = v[i];
}
__device__ __forceinline__ int next_unit(unsigned* ctr, LAS unsigned char* lds, int tid) {
    LAS int* slot = (LAS int*)(lds + L_MISC);
    __syncthreads();
    if (tid == 0) *slot = (int)atomicAdd(ctr, 1u);
    __syncthreads();
    return *slot;
}

__device__ __forceinline__ void unit_mixA(const Params& P, LAS unsigned char* lds, int uid, int tid, int lane, int wave) {
    unsigned char* ws = P.ws; const bf16_t* proj = (const bf16_t*)(ws + WS_PROJ);
    const int b = uid / 768; int rem = uid % 768; const int gi = rem / 256; rem %= 256; const int hs = rem / 64, idx = rem % 64;
    const int d = gi == 0 ? 1 : (gi == 1 ? 4 : 16); const int rc = idx % d, nb = idx / d;
    const int g = lane >> 4, i16 = lane & 15;
    load_lut<1>(lds, (const float*)(ws + WS_GLUT), gi * 4 + hs, tid);
    const int ntiles = nb == 0 ? 2 : 4;
    if (tid < 4) { LAS int* tl = (LAS int*)(lds + L_TL); const int i = tid + (nb == 0 ? 2 : 0); if (i < 4) { tl[2 * tid] = nb * 128 - 128 + 64 * i; tl[2 * tid + 1] = -1; } }
    const int qi = nb * 128 + 16 * wave + i16; const int tok = qi * d + rc; const size_t row = (size_t)b * SEQ + tok;
    const int colq = A_OFF + gi * 768 + hs * 64;
    bf16x8 qf[1][2];
#pragma unroll
    for (int ks = 0; ks < 2; ++ks) qf[0][ks] = *(const bf16x8*)(proj + row * INP + colq + ks * 32 + g * 8);
    f32x4 o[1][4]; float m[1], l[1]; flash_init<1>(o, m, l);
    const float il[1] = {0.f};
    Src S{proj + (size_t)b * SEQ * INP + colq + 256, proj + (size_t)b * SEQ * INP + colq + 512, INP, d, rc};
    flash_run<1, 1>(lds, S, ntiles, qf, o, m, l, qi, nb * 128 + 16 * wave, nb * 128 + 16 * wave + 15, 128, nullptr, nullptr, il, nullptr, false, 0, lane, tid);
    const float inv = l[0] > 0.f ? 1.f / l[0] : 0.f;
    bf16_t* O = (bf16_t*)(ws + WS_O) + row * 2048 + gi * 256 + hs * 64;
#pragma unroll
    for (int dt = 0; dt < 4; ++dt) { u32x2 w; w.x = cvtpk(o[0][dt][0] * inv, o[0][dt][1] * inv); w.y = cvtpk(o[0][dt][2] * inv, o[0][dt][3] * inv); *(u32x2*)(O + 16 * dt + 4 * g) = w; }
    if (g == 0) ((float*)(ws + WS_LSE))[row * 12 + gi * 4 + hs] = (m[0] + __log2f(fmaxf(l[0], 1e-30f))) * LN2;
}

__device__ __forceinline__ void unit_moba(const Params& P, LAS unsigned char* lds, int b, int h, int c, int tid, int lane, int wave) {
    unsigned char* ws = P.ws; const bf16_t* proj = (const bf16_t*)(ws + WS_PROJ);
    const int g = lane >> 4, i16 = lane & 15;
    const int t0 = c * 128, ob = t0 >> 8;
    load_lut<1>(lds, (const float*)(ws + WS_GLUT), 12 + h, tid);
    LAS float* km = (LAS float*)(lds + L_IMP);
    LAS unsigned char* qS = lds + L_IMP + 8192;
    { const float* src = (const float*)(ws + WS_KMEAN) + (size_t)(b * 8 + h) * 2048; float kv4[4]; u32x4 qv[2];
#pragma unroll
      for (int i = 0; i < 4; ++i) kv4[i] = src[tid + NTHREADS * i];
#pragma unroll
      for (int i = 0; i < 2; ++i) { const int e = tid + NTHREADS * i; qv[i] = *(const u32x4*)(proj + ((size_t)b * SEQ + t0 + (e >> 3)) * INP + B_OFF + h * 64 + (e & 7) * 8); }
      __builtin_amdgcn_sched_barrier(0);
#pragma unroll
      for (int i = 0; i < 4; ++i) km[tid + NTHREADS * i] = kv4[i];
#pragma unroll
      for (int i = 0; i < 2; ++i) { const int e = tid + NTHREADS * i; *(LAS u32x4*)(qS + (e >> 3) * 128 + (e & 7) * 16) = qv[i]; } }
    LAS unsigned* misc = (LAS unsigned*)(lds + L_MISC);
    if (tid == 0) misc[1] = 0u;
    __syncthreads();
    const int tok = t0 + 16 * wave + i16; const size_t row = (size_t)b * SEQ + tok;
    const int colq = B_OFF + h * 64;
    bf16x8 qf[1][2];
#pragma unroll
    for (int ks = 0; ks < 2; ++ks) qf[0][ks] = *(const bf16x8*)(proj + row * INP + colq + ks * 32 + g * 8);
    unsigned sel = 0u;
    if (ob > 0) {
        float gt[8];
#pragma unroll
        for (int k = 0; k < 8; ++k) gt[k] = 0.f;
#pragma unroll 1
        for (int dc = 0; dc < 8; ++dc) { const u32x4 qw = *(const LAS u32x4*)(qS + (16 * wave + i16) * 128 + dc * 16);
            const float q0 = bflo(qw.x), q1 = bfhi(qw.x), q2 = bflo(qw.y), q3 = bfhi(qw.y), q4 = bflo(qw.z), q5 = bfhi(qw.z), q6 = bflo(qw.w), q7 = bfhi(qw.w);
#pragma unroll
            for (int k = 0; k < 8; ++k) { const LAS f32x4* kr = (const LAS f32x4*)(km + (8 * g + k) * 64 + dc * 8); const f32x4 a = kr[0], bq = kr[1];
                gt[k] += (q0 * a[0] + q1 * a[1]) + (q2 * a[2] + q3 * a[3]) + (q4 * bq[0] + q5 * bq[1]) + (q6 * bq[2] + q7 * bq[3]); } }
#pragma unroll
        for (int k = 0; k < 8; ++k) if (8 * g + k >= ob) gt[k] = -INFINITY;
#pragma unroll
        for (int it = 0; it < 3; ++it) {
            float best = -INFINITY; int bi = 99;
#pragma unroll
            for (int k = 0; k < 8; ++k) if (gt[k] > best) { best = gt[k]; bi = 8 * g + k; }
#pragma unroll
            for (int off = 16; off <= 32; off <<= 1) { const float ob_ = __shfl_xor(best, off); const int oi = __shfl_xor(bi, off); if (ob_ > best || (ob_ == best && oi < bi)) { best = ob_; bi = oi; } }
            if (bi < 32) { sel |= 1u << bi;
#pragma unroll
                for (int k = 0; k < 8; ++k) if (8 * g + k == bi) gt[k] = -INFINITY; }
        }
    }
    unsigned wu = sel;
#pragma unroll
    for (int off = 1; off < 16; off <<= 1) wu |= (unsigned)__shfl_xor((int)wu, off);
    wu = (unsigned)__builtin_amdgcn_readfirstlane((int)wu);
    LAS unsigned* selS = (LAS unsigned*)(lds + L_SEL); LAS unsigned* wunS = (LAS unsigned*)(lds + L_WUN) + wave * 4;
    if (g == 0) selS[(16 * wave + i16) * 4] = sel;
    if (lane == 0) wunS[0] = wu;
    __syncthreads();
    unsigned um = 0u;
#pragma unroll
    for (int w8 = 0; w8 < 8; ++w8) um |= ((const LAS unsigned*)(lds + L_WUN))[w8 * 4];
    if (tid == 0) { LAS int* tl = (LAS int*)(lds + L_TL); int n = 0;
        for (int blk = 0; blk < ob; ++blk) if ((um >> blk) & 1u) for (int s4 = 0; s4 < 4; ++s4) { tl[2 * n] = blk * 256 + 64 * s4; tl[2 * n + 1] = blk; ++n; }
        for (int k0 = ob * 256; k0 < t0 + 128; k0 += 64) { tl[2 * n] = k0; tl[2 * n + 1] = -1; ++n; }
        misc[2] = (unsigned)n; }
    __syncthreads();
    const int ntiles = (int)misc[2];
    f32x4 o[1][4]; float m[1], l[1]; flash_init<1>(o, m, l);
    const float il[1] = {0.f};
    Src S{proj + (size_t)b * SEQ * INP + colq + 512, proj + (size_t)b * SEQ * INP + colq + 1024, INP, 1, 0};
    flash_run<1, 1>(lds, S, ntiles, qf, o, m, l, tok, t0 + 16 * wave, t0 + 16 * wave + 15, 0x7fffffff, selS + (16 * wave + i16) * 4, wunS, il, nullptr, false, 0, lane, tid);
    const float inv = l[0] > 0.f ? 1.f / l[0] : 0.f;
    bf16_t* O = (bf16_t*)(ws + WS_O) + row * 2048 + 768 + h * 64;
#pragma unroll
    for (int dt = 0; dt < 4; ++dt) { u32x2 w; w.x = cvtpk(o[0][dt][0] * inv, o[0][dt][1] * inv); w.y = cvtpk(o[0][dt][2] * inv, o[0][dt][3] * inv); *(u32x2*)(O + 16 * dt + 4 * g) = w; }
}

__device__ __forceinline__ float sigmoidf_(float x) { return 1.f / (1.f + __expf(-x)); }
#ifndef NSA_QG
#define NSA_QG 2
#endif
__device__ __forceinline__ void unit_nsa(const Params& P, LAS unsigned char* lds, int b, int kv, int c, int tid, int lane, int wave) {
    unsigned char* ws = P.ws; const bf16_t* proj = (const bf16_t*)(ws + WS_PROJ);
    const int g = lane >> 4, i16 = lane & 15;
    const int t0 = c * 128;
    const int tok = t0 + 16 * wave + i16; const size_t row = (size_t)b * SEQ + tok;
    load_lut<4>(lds, (const float*)(ws + WS_GLUT), 20 + kv * 4, tid);
    LAS int* tl = (LAS int*)(lds + L_TL);
    LAS unsigned* misc = (LAS unsigned*)(lds + L_MISC);
    LAS unsigned* selS = (LAS unsigned*)(lds + L_SEL);
    LAS float* impw = (LAS float*)(lds + L_IMP) + wave * 2048;
    const int ntc = ((t0 + 96) >> 4) / 64 + 1;
    if (tid < ntc) { tl[2 * tid] = 64 * tid; tl[2 * tid + 1] = -1; }
    if (tid < 4) misc[4 + tid] = 0u;
    LAS unsigned* wunS = (LAS unsigned*)(lds + L_WUN) + wave * 4;
    float* tot = (float*)(ws + WS_TOT) + row * 768 + (kv * 4) * 64;
    const bf16_t* gatep = proj + row * INP + CG_OFF + (kv * 4) * 3;
    const int qcc = (tok - 31) >> 4;
    const int qcw0 = (t0 + 16 * wave - 31) >> 4, qcw1 = (t0 + 16 * wave + 15 - 31) >> 4;
#pragma unroll 1
    for (int hp = 0; hp < 4 / NSA_QG; ++hp) {
        bf16x8 qf[NSA_QG][2];
#pragma unroll
        for (int q = 0; q < NSA_QG; ++q)
#pragma unroll
            for (int ks = 0; ks < 2; ++ks) qf[q][ks] = *(const bf16x8*)(proj + row * INP + CQ_OFF + (kv * 4 + hp * NSA_QG + q) * 64 + ks * 32 + g * 8);
        f32x4 o[NSA_QG][4]; float m[NSA_QG], l[NSA_QG]; flash_init<NSA_QG>(o, m, l);
        float il[NSA_QG]; for (int q_ = 0; q_ < NSA_QG; ++q_) il[q_] = 0.f;
#ifdef NSA_CMP_FAKEKV
        Src S{proj + (size_t)b * SEQ * INP + CKV_OFF + 4 * 192 + kv * 64, proj + (size_t)b * SEQ * INP + CKV_OFF + 5 * 192 + kv * 64, INP, 1, 0};
#else
        Src S{(const bf16_t*)(ws + WS_KC) + (size_t)(b * 3 + kv) * 512 * 64, (const bf16_t*)(ws + WS_VC) + (size_t)(b * 3 + kv) * 512 * 64, 64, 1, 0};
#endif
#ifdef NSA_CMP_SINGLE
        flash_run<NSA_QG, 0>(lds, S, ntc, qf, o, m, l, qcc, qcw0, qcw1, 0x7fffffff, nullptr, nullptr, il, nullptr, false, 0, lane, tid);
#pragma unroll
        for (int q = 0; q < NSA_QG; ++q) il[q] = l[q] > 0.f ? 1.f / l[q] : 0.f;
        (void)impw;
#elif !defined(NSA_NO_CMP)
        flash_run<NSA_QG, 2>(lds, S, ntc, qf, o, m, l, qcc, qcw0, qcw1, 0x7fffffff, nullptr, nullptr, il, nullptr, false, 0, lane, tid);
#pragma unroll
        for (int q = 0; q < NSA_QG; ++q) { il[q] = l[q] > 0.f ? 1.f / l[q] : 0.f; l[q] = 0.f; }
        flash_run<NSA_QG, 4>(lds, S, ntc, qf, o, m, l, qcc, qcw0, qcw1, 0x7fffffff, nullptr, nullptr, il, impw, hp != 0, 0, lane, tid);
#else
        (void)S; (void)impw;
#endif
#pragma unroll
        for (int q = 0; q < NSA_QG; ++q) { const float gt = sigmoidf_(bf2f(gatep[(hp * NSA_QG + q) * 3 + 0])); const float sc = il[q] * gt;
#pragma unroll
            for (int dt = 0; dt < 4; ++dt) *(f32x4*)(tot + (hp * NSA_QG + q) * 64 + 16 * dt + 4 * g) = o[q][dt] * sc; }
    }
#ifndef NSA_NO_TOPK
    lds_wait();
    unsigned wun0 = 0u, wun1 = 0u, wun2 = 0u, wun3 = 0u;
#pragma unroll 1
    for (int q = 0; q < 16; ++q) {
        const int t = t0 + 16 * wave + q, own = t >> 6;
        const int ncand = own - 2 > 0 ? own - 2 : 0; const int nforced = own >= 2 ? 3 : own + 1; const int K = 16 - nforced;
        const int j0 = lane, j1 = lane + 64;
        const bool c0 = (j0 >= 1) && (j0 <= own - 2), c1 = (j1 <= own - 2);
        const unsigned k0 = c0 ? (__float_as_uint(impw[q * 128 + j0]) + 1u) : 0u, k1 = c1 ? (__float_as_uint(impw[q * 128 + j1]) + 1u) : 0u;
        bool s0 = c0, s1 = c1;
        if (ncand > K) {
            unsigned T = 0u;
            for (int bit = 31; bit >= 0; --bit) { const unsigned Tn = T | (1u << bit);
                const int cnt = __popcll(__ballot(k0 >= Tn)) + __popcll(__ballot(k1 >= Tn)); if (cnt >= K) T = Tn; }
            const bool g0 = k0 > T, g1 = k1 > T; const int ng = __popcll(__ballot(g0)) + __popcll(__ballot(g1)); const int need = K - ng;
            const unsigned long long e0 = __ballot(k0 == T), e1 = __ballot(k1 == T); const unsigned long long lt = (1ull << lane) - 1ull;
            const int r0 = __popcll(e0 & lt), r1 = __popcll(e0) + __popcll(e1 & lt);
            s0 = g0 || (k0 == T && r0 < need); s1 = g1 || (k1 == T && r1 < need);
        }
        s0 = s0 || (j0 == 0) || (j0 == own) || (j0 == own - 1); s1 = s1 || (j1 == own) || (j1 == own - 1);
        const unsigned long long m0 = __ballot(s0), m1 = __ballot(s1);
        const unsigned w0 = (unsigned)m0, w1 = (unsigned)(m0 >> 32), w2 = (unsigned)m1, w3 = (unsigned)(m1 >> 32);
        if (lane == 0) { selS[(16 * wave + q) * 4 + 0] = w0; selS[(16 * wave + q) * 4 + 1] = w1; selS[(16 * wave + q) * 4 + 2] = w2; selS[(16 * wave + q) * 4 + 3] = w3; }
        wun0 |= w0; wun1 |= w1; wun2 |= w2; wun3 |= w3;
    }
    if (lane == 0) { wunS[0] = wun0; wunS[1] = wun1; wunS[2] = wun2; wunS[3] = wun3; }
    __syncthreads();
    if (tid < 4) { unsigned u_ = 0u; for (int w8 = 0; w8 < 8; ++w8) u_ |= ((const LAS unsigned*)(lds + L_WUN))[w8 * 4 + tid]; misc[4 + tid] = u_; }
    __syncthreads();
    const LAS unsigned* selp = selS + (16 * wave + i16) * 4;
    const int ownmax = (t0 + 127) >> 6;
    if (tid == 0) { int n = 0; for (int j = 0; j <= ownmax; ++j) if ((misc[4 + (j >> 5)] >> (j & 31)) & 1u) { tl[2 * n] = 64 * j; tl[2 * n + 1] = j; ++n; } misc[2] = (unsigned)n; }
    __syncthreads();
    const int nts = (int)misc[2];
#else
    const int ownmax = (t0 + 127) >> 6; const int nts = 0; const LAS unsigned* selp = nullptr; (void)selS; (void)wunS;
#endif
    const int kfirst = t0 - 512 > 0 ? t0 - 512 : 0; const int ntw = (t0 + 128 - kfirst) / 64;
#ifdef NSA_PACK4
    __syncthreads();
    if (tid == 0) { int n = 0; for (int j = 0; j <= ownmax; ++j) if ((misc[4 + (j >> 5)] >> (j & 31)) & 1u) { tl[2 * n] = 64 * j; tl[2 * n + 1] = j; ++n; } }
#pragma unroll 1
    for (int ps = 0; ps < 4; ++ps) {
        const int tli = 32 * ps + 4 * wave + (i16 >> 2), hd = i16 & 3;
        const int tokp = t0 + tli; const size_t rowp = (size_t)b * SEQ + tokp;
        bf16x8 qf[1][2];
#pragma unroll
        for (int ks = 0; ks < 2; ++ks) qf[0][ks] = *(const bf16x8*)(proj + rowp * INP + CQ_OFF + (kv * 4 + hd) * 64 + ks * 32 + g * 8);
        if (lane < 4) { unsigned w_ = 0u;
#pragma unroll
            for (int k = 0; k < 4; ++k) w_ |= selS[(32 * ps + 4 * wave + k) * 4 + lane];
            wunS[lane] = w_; }
        lds_wait();
        f32x4 o[1][4]; float m[1], l[1]; flash_init<1>(o, m, l);
        const float il[1] = {0.f};
        Src S{proj + (size_t)b * SEQ * INP + CKV_OFF + 2 * 192 + kv * 64, proj + (size_t)b * SEQ * INP + CKV_OFF + 3 * 192 + kv * 64, INP, 1, 0};
        flash_run<1, 1>(lds, S, nts, qf, o, m, l, tokp, t0 + 32 * ps + 4 * wave, t0 + 32 * ps + 4 * wave + 3, 0x7fffffff, selS + tli * 4, wunS, il, nullptr, false, hd, lane, tid);
        const float gt = sigmoidf_(bf2f(proj[rowp * INP + CG_OFF + (kv * 4 + hd) * 3 + 1])); const float sc = (l[0] > 0.f ? 1.f / l[0] : 0.f) * gt;
        float* tp0 = (float*)(ws + WS_TOT) + rowp * 768 + (kv * 4 + hd) * 64;
#pragma unroll
        for (int dt = 0; dt < 4; ++dt) { float* tp = tp0 + 16 * dt + 4 * g; *(f32x4*)tp = *(const f32x4*)tp + o[0][dt] * sc; }
    }
    __syncthreads();
#pragma unroll 1
    for (int hp = 0; hp < 2; ++hp) {
        bf16x8 qf[2][2];
#pragma unroll
        for (int q = 0; q < 2; ++q)
#pragma unroll
            for (int ks = 0; ks < 2; ++ks) qf[q][ks] = *(const bf16x8*)(proj + row * INP + CQ_OFF + (kv * 4 + hp * 2 + q) * 64 + ks * 32 + g * 8);
        f32x4 o[2][4]; float m[2], l[2];
        float il[2] = {0.f, 0.f};
        __syncthreads();
        if (tid < ntw) { tl[2 * tid] = kfirst + 64 * tid; tl[2 * tid + 1] = -1; }
        flash_init<2>(o, m, l);
        Src S{proj + (size_t)b * SEQ * INP + CKV_OFF + 4 * 192 + kv * 64, proj + (size_t)b * SEQ * INP + CKV_OFF + 5 * 192 + kv * 64, INP, 1, 0};
        flash_run<2, 1>(lds, S, ntw, qf, o, m, l, tok, t0 + 16 * wave, t0 + 16 * wave + 15, 511, nullptr, nullptr, il, nullptr, false, hp * 2, lane, tid);
        bf16_t* O = (bf16_t*)(ws + WS_O) + row * 2048 + 1280 + (kv * 4) * 64;
#pragma unroll
        for (int q = 0; q < 2; ++q) { const float gt = sigmoidf_(bf2f(gatep[(hp * 2 + q) * 3 + 2])); const float sc = (l[q] > 0.f ? 1.f / l[q] : 0.f) * gt;
#pragma unroll
            for (int dt = 0; dt < 4; ++dt) { const f32x4 v = *(const f32x4*)(tot + (hp * 2 + q) * 64 + 16 * dt + 4 * g) + o[q][dt] * sc;
                u32x2 w; w.x = cvtpk(v[0], v[1]); w.y = cvtpk(v[2], v[3]); *(u32x2*)(O + (hp * 2 + q) * 64 + 16 * dt + 4 * g) = w; } }
    }
}
#else
#pragma unroll 1
    for (int hp = 0; hp < 4 / NSA_QG; ++hp) {
        bf16x8 qf[NSA_QG][2];
#pragma unroll
        for (int q = 0; q < NSA_QG; ++q)
#pragma unroll
            for (int ks = 0; ks < 2; ++ks) qf[q][ks] = *(const bf16x8*)(proj + row * INP + CQ_OFF + (kv * 4 + hp * NSA_QG + q) * 64 + ks * 32 + g * 8);
        f32x4 o[NSA_QG][4]; float m[NSA_QG], l[NSA_QG];
        float il[NSA_QG]; for (int q_ = 0; q_ < NSA_QG; ++q_) il[q_] = 0.f;
        __syncthreads();
        if (tid == 0) { int n = 0; for (int j = 0; j <= ownmax; ++j) if ((misc[4 + (j >> 5)] >> (j & 31)) & 1u) { tl[2 * n] = 64 * j; tl[2 * n + 1] = j; ++n; } }
#ifndef NSA_NO_SLC
        { flash_init<NSA_QG>(o, m, l);
          Src S{proj + (size_t)b * SEQ * INP + CKV_OFF + 2 * 192 + kv * 64, proj + (size_t)b * SEQ * INP + CKV_OFF + 3 * 192 + kv * 64, INP, 1, 0};
          flash_run<NSA_QG, 1>(lds, S, nts, qf, o, m, l, tok, t0 + 16 * wave, t0 + 16 * wave + 15, 0x7fffffff, selp, wunS, il, nullptr, false, hp * NSA_QG, lane, tid);
#pragma unroll
          for (int q = 0; q < NSA_QG; ++q) { const float gt = sigmoidf_(bf2f(gatep[(hp * NSA_QG + q) * 3 + 1])); const float sc = (l[q] > 0.f ? 1.f / l[q] : 0.f) * gt;
#pragma unroll
              for (int dt = 0; dt < 4; ++dt) { float* tp = tot + (hp * NSA_QG + q) * 64 + 16 * dt + 4 * g; *(f32x4*)tp = *(const f32x4*)tp + o[q][dt] * sc; } }
        }
#endif
        if (tid < ntw) { tl[2 * tid] = kfirst + 64 * tid; tl[2 * tid + 1] = -1; }
        { flash_init<NSA_QG>(o, m, l);
          Src S{proj + (size_t)b * SEQ * INP + CKV_OFF + 4 * 192 + kv * 64, proj + (size_t)b * SEQ * INP + CKV_OFF + 5 * 192 + kv * 64, INP, 1, 0};
#ifndef NSA_NO_WIN
          flash_run<NSA_QG, 1>(lds, S, ntw, qf, o, m, l, tok, t0 + 16 * wave, t0 + 16 * wave + 15, 511, nullptr, nullptr, il, nullptr, false, hp * NSA_QG, lane, tid);
#else
          (void)S;
#endif
          bf16_t* O = (bf16_t*)(ws + WS_O) + row * 2048 + 1280 + (kv * 4) * 64;
#pragma unroll
          for (int q = 0; q < NSA_QG; ++q) { const float gt = sigmoidf_(bf2f(gatep[(hp * NSA_QG + q) * 3 + 2])); const float sc = (l[q] > 0.f ? 1.f / l[q] : 0.f) * gt;
#pragma unroll
              for (int dt = 0; dt < 4; ++dt) { const f32x4 v = *(const f32x4*)(tot + (hp * NSA_QG + q) * 64 + 16 * dt + 4 * g) + o[q][dt] * sc;
                  u32x2 w; w.x = cvtpk(v[0], v[1]); w.y = cvtpk(v[2], v[3]); *(u32x2*)(O + (hp * NSA_QG + q) * 64 + 16 * dt + 4 * g) = w; } }
        }
    }
}

#endif

__device__ __forceinline__ float gelu_tanh(float x) { const float u = 0.7978845608028654f * (x + 0.044715f * x * x * x); const float e = __expf(2.f * u); const float th = 1.f - 2.f / (1.f + e); return 0.5f * x * (1.f + th); }
__device__ __forceinline__ void item_compress(const Params& P, int layer, int it, int lane) {
    unsigned char* ws = P.ws; const bf16_t* proj = (const bf16_t*)(ws + WS_PROJ);
    const int nt = it & 31; int r = it >> 5; const int which = r & 1; r >>= 1; const int kv = r % 3, b = r / 3;
    const int g = lane >> 4, i16 = lane & 15;
    int n = 16 * nt + i16; const int nld = n > 510 ? 510 : n;
    const bf16_t* w1t = (const bf16_t*)(ws + WS_W1T) + (size_t)(layer * 2 + which) * 128 * 2048;
    const bf16_t* w2t = (const bf16_t*)(ws + WS_W2T) + (size_t)(layer * 2 + which) * 64 * 128;
    const float* cpe = (const float*)(ws + WS_CPE) + (layer * 2 + which) * 128;
    const bf16_t* src = proj + ((size_t)b * SEQ + 16 * nld) * INP + CKV_OFF + which * 192 + kv * 64 + 8 * g;
    f32x4 acc[8];
#pragma unroll
    for (int h = 0; h < 8; ++h) acc[h] = (f32x4){0.f, 0.f, 0.f, 0.f};
    const bf16_t* w1l = w1t + (size_t)i16 * 2048 + 8 * g;
#pragma unroll 1
    for (int ks = 0; ks < 64; ks += 4) {
        bf16x8 bq[4], af[4][8];
#pragma unroll
        for (int u = 0; u < 4; ++u) { bq[u] = *(const bf16x8*)(src + (size_t)((ks + u) >> 1) * INP + (u & 1) * 32);
#pragma unroll
            for (int h = 0; h < 8; ++h) af[u][h] = *(const bf16x8*)(w1l + (size_t)(16 * h) * 2048 + 32 * (ks + u)); }
        __builtin_amdgcn_sched_barrier(0);
#pragma unroll
        for (int u = 0; u < 4; ++u)
#pragma unroll
            for (int h = 0; h < 8; ++h) acc[h] = mfma16(af[u][h], bq[u], acc[h]);
    }
    bf16x8 pf[4];
#pragma unroll
    for (int s = 0; s < 4; ++s) { float hv[8];
#pragma unroll
        for (int r2 = 0; r2 < 4; ++r2) { hv[r2] = gelu_tanh(acc[2 * s][r2] + cpe[32 * s + 4 * g + r2]); hv[4 + r2] = gelu_tanh(acc[2 * s + 1][r2] + cpe[32 * s + 16 + 4 * g + r2]); }
        u32x4 w; w.x = cvtpk(hv[0], hv[1]); w.y = cvtpk(hv[2], hv[3]); w.z = cvtpk(hv[4], hv[5]); w.w = cvtpk(hv[6], hv[7]); pf[s] = __builtin_bit_cast(bf16x8, w); }
    bf16_t* dst = (bf16_t*)(ws + (which ? WS_VC : WS_KC)) + ((size_t)(b * 3 + kv) * 512 + n) * 64;
#pragma unroll
    for (int et = 0; et < 4; ++et) { f32x4 oc = {0.f, 0.f, 0.f, 0.f};
#pragma unroll
        for (int s = 0; s < 4; ++s) { const bf16_t* wp = w2t + (size_t)(16 * et + i16) * 128 + 32 * s + 4 * g; const u32x2 lo = *(const u32x2*)wp, hi = *(const u32x2*)(wp + 16);
            u32x4 w; w.x = lo.x; w.y = lo.y; w.z = hi.x; w.w = hi.y; oc = mfma16(__builtin_bit_cast(bf16x8, w), pf[s], oc); }
#ifdef PROBE_CLAMP
#pragma unroll
        for (int r2 = 0; r2 < 4; ++r2) oc[r2] = fminf(fmaxf(oc[r2], -100.f), 100.f);
#endif
        u32x2 w; w.x = cvtpk(oc[0], oc[1]); w.y = cvtpk(oc[2], oc[3]); *(u32x2*)(dst + 16 * et + 4 * g) = w; }
}
__device__ __forceinline__ void item_kmean(const Params& P, int it, int lane) {
    unsigned char* ws = P.ws; const bf16_t* proj = (const bf16_t*)(ws + WS_PROJ);
    const int blk = it & 31, h = (it >> 5) & 7, b = it >> 8;
    const int rg = lane >> 3, dch = lane & 7;
    const bf16_t* src = proj + ((size_t)b * SEQ + blk * 256 + rg) * INP + B_OFF + 512 + h * 64 + dch * 8;
    u32x4 v[32];
#pragma unroll
    for (int i = 0; i < 32; ++i) v[i] = *(const u32x4*)(src + (size_t)(8 * i) * INP);
    __builtin_amdgcn_sched_barrier(0);
    float sm[8];
#pragma unroll
    for (int e = 0; e < 8; ++e) sm[e] = 0.f;
#pragma unroll
    for (int i = 0; i < 32; ++i)
#pragma unroll
        for (int w = 0; w < 4; ++w) { sm[2 * w] += bflo(v[i][w]); sm[2 * w + 1] += bfhi(v[i][w]); }
#pragma unroll
    for (int e = 0; e < 8; ++e) { sm[e] += __shfl_xor(sm[e], 8); sm[e] += __shfl_xor(sm[e], 16); sm[e] += __shfl_xor(sm[e], 32); }
    if (rg == 0) { float* dst = (float*)(ws + WS_KMEAN) + (size_t)it * 64 + dch * 8;
        *(f32x4*)dst = (f32x4){sm[0], sm[1], sm[2], sm[3]} * (1.f / 256.f); *(f32x4*)(dst + 4) = (f32x4){sm[4], sm[5], sm[6], sm[7]} * (1.f / 256.f); }
}
__device__ __forceinline__ void item_combineA(const Params& P, int row, int lane) {
    unsigned char* ws = P.ws; const float* lse = (const float*)(ws + WS_LSE) + (size_t)row * 12; bf16_t* O = (bf16_t*)(ws + WS_O) + (size_t)row * 2048;
#pragma unroll
    for (int k = 0; k < 3; ++k) { const int chunk = lane + 64 * k; const int col = 4 * chunk; const int gi = col >> 8, hs = (col >> 6) & 3;
        const float a0 = lse[hs], a1 = lse[4 + hs], a2 = lse[8 + hs]; const float mx = fmaxf(a0, fmaxf(a1, a2));
        const float e0 = __expf(a0 - mx), e1 = __expf(a1 - mx), e2 = __expf(a2 - mx); const float al = (gi == 0 ? e0 : (gi == 1 ? e1 : e2)) / (e0 + e1 + e2);
        const u32x2 w = *(const u32x2*)(O + col); u32x2 r; r.x = cvtpk(bflo(w.x) * al, bfhi(w.x) * al); r.y = cvtpk(bflo(w.y) * al, bfhi(w.y) * al); *(u32x2*)(O + col) = r; }
}

__device__ __forceinline__ void phase_conv(const Params& P, int layer, int tid) {
    unsigned char* ws = P.ws; const bf16_t* U = (const bf16_t*)(ws + WS_U); bf16_t* ACT = (bf16_t*)(ws + WS_ACT);
    const float* cw = P.conv_w + (size_t)layer * 3 * UPW; const float* cb = P.conv_b + (size_t)layer * UPW;
    constexpr int NCH = DFF / 8, TB = 8, NTB = MROWS / TB;
    for (int it = blockIdx.x * NTHREADS + tid; it < NCH * NTB; it += gridDim.x * NTHREADS) {
        const int ch = it % NCH, tb = it / NCH; const int c = ch * 8; const int ua = 256 * (c >> 7) + (c & 127);
        const int row0 = tb * TB; const bool first = (row0 % SEQ) == 0;
        u32x4 pa[TB + 2], pg[TB + 2];
#pragma unroll
        for (int t = 0; t < TB + 2; ++t) { const int r = row0 - 2 + t; const size_t off = (size_t)(r < 0 ? 0 : r) * UPW + ua; pa[t] = *(const u32x4*)(U + off); pg[t] = *(const u32x4*)(U + off + 128); }
        f32x4 wa4[3][2], wg4[3][2], ba4[2], bg4[2];
#pragma unroll
        for (int j = 0; j < 3; ++j)
#pragma unroll
            for (int h = 0; h < 2; ++h) { wa4[j][h] = *(const f32x4*)(cw + (size_t)j * UPW + c + 4 * h); wg4[j][h] = *(const f32x4*)(cw + (size_t)j * UPW + DFF + c + 4 * h); }
#pragma unroll
        for (int h = 0; h < 2; ++h) { ba4[h] = *(const f32x4*)(cb + c + 4 * h); bg4[h] = *(const f32x4*)(cb + DFF + c + 4 * h); }
        __builtin_amdgcn_sched_barrier(0);
        if (first) { pa[0] = (u32x4){0, 0, 0, 0}; pa[1] = pa[0]; pg[0] = pa[0]; pg[1] = pa[0]; }
#pragma unroll
        for (int t = 0; t < TB; ++t) {
            float r[8];
#pragma unroll
            for (int e = 0; e < 8; ++e) { const int w_ = e >> 1; const int h = e >> 2, x = e & 3;
                const float a0 = (e & 1) ? bfhi(pa[t + 2][w_]) : bflo(pa[t + 2][w_]), a1 = (e & 1) ? bfhi(pa[t + 1][w_]) : bflo(pa[t + 1][w_]), a2 = (e & 1) ? bfhi(pa[t][w_]) : bflo(pa[t][w_]);
                const float g0 = (e & 1) ? bfhi(pg[t + 2][w_]) : bflo(pg[t + 2][w_]), g1 = (e & 1) ? bfhi(pg[t + 1][w_]) : bflo(pg[t + 1][w_]), g2 = (e & 1) ? bfhi(pg[t][w_]) : bflo(pg[t][w_]);
                const float ya = ba4[h][x] + wa4[0][h][x] * a0 + wa4[1][h][x] * a1 + wa4[2][h][x] * a2;
                const float yg = bg4[h][x] + wg4[0][h][x] * g0 + wg4[1][h][x] * g1 + wg4[2][h][x] * g2;
                r[e] = ya * yg / (1.f + __expf(-yg)); }
            u32x4 w; w.x = cvtpk(r[0], r[1]); w.y = cvtpk(r[2], r[3]); w.z = cvtpk(r[4], r[5]); w.w = cvtpk(r[6], r[7]);
            *(u32x4*)(ACT + (size_t)(row0 + t) * DFF + c) = w;
        }
    }
}

__device__ __forceinline__ void phase_convfix(const Params& P, int layer, int tid) {
    unsigned char* ws = P.ws; const bf16_t* UB = (const bf16_t*)(ws + WS_UB); bf16_t* ACT = (bf16_t*)(ws + WS_ACT);
    const float* cw = P.conv_w + (size_t)layer * 3 * UPW; const float* cb = P.conv_b + (size_t)layer * UPW;
    constexpr int NCH = DFF / 8, NS = MROWS / 64;
    for (int it = blockIdx.x * NTHREADS + tid; it < NCH * 2 * NS; it += gridDim.x * NTHREADS) {
        const int ch = it % NCH, lr = (it / NCH) & 1, sl = it / (2 * NCH); const int c = ch * 8; const int ua = 256 * (c >> 7) + (c & 127);
        const bool first = (sl % (SEQ / 64)) == 0;
        const int slp = sl > 0 ? sl - 1 : 0;
        const bf16_t* r0 = UB + ((size_t)sl * 4 + lr) * UPW + ua;
        const bf16_t* r1 = lr == 0 ? UB + ((size_t)slp * 4 + 3) * UPW + ua : UB + ((size_t)sl * 4 + 0) * UPW + ua;
        const bf16_t* r2 = lr == 0 ? UB + ((size_t)slp * 4 + 2) * UPW + ua : UB + ((size_t)slp * 4 + 3) * UPW + ua;
        u32x4 a0 = *(const u32x4*)r0, g0 = *(const u32x4*)(r0 + 128), a1 = *(const u32x4*)r1, g1 = *(const u32x4*)(r1 + 128), a2 = *(const u32x4*)r2, g2 = *(const u32x4*)(r2 + 128);
        const u32x4 z = {0, 0, 0, 0};
        if (first && lr == 0) { a1 = z; g1 = z; }
        if (first) { a2 = z; g2 = z; }
        float r[8];
#pragma unroll
        for (int e = 0; e < 8; ++e) { const int w_ = e >> 1;
            const float x0 = (e & 1) ? bfhi(a0[w_]) : bflo(a0[w_]), x1 = (e & 1) ? bfhi(a1[w_]) : bflo(a1[w_]), x2 = (e & 1) ? bfhi(a2[w_]) : bflo(a2[w_]);
            const float y0 = (e & 1) ? bfhi(g0[w_]) : bflo(g0[w_]), y1 = (e & 1) ? bfhi(g1[w_]) : bflo(g1[w_]), y2 = (e & 1) ? bfhi(g2[w_]) : bflo(g2[w_]);
            const float ya = cb[c + e] + cw[c + e] * x0 + cw[UPW + c + e] * x1 + cw[2 * UPW + c + e] * x2;
            const float yg = cb[DFF + c + e] + cw[DFF + c + e] * y0 + cw[UPW + DFF + c + e] * y1 + cw[2 * UPW + DFF + c + e] * y2;
            r[e] = ya * yg / (1.f + __expf(-yg)); }
        u32x4 w; w.x = cvtpk(r[0], r[1]); w.y = cvtpk(r[2], r[3]); w.z = cvtpk(r[4], r[5]); w.w = cvtpk(r[6], r[7]);
        *(u32x4*)(ACT + (size_t)(sl * 64 + lr) * DFF + c) = w;
    }
}

#define XB_TMO      128
#define XB_XCNT(j)  (256  + 64 * (j))
#define XB_XSUB(j)  (1280 + 64 * (j))
#define XB_XGEN(j)  (2304 + 64 * (j))
#define XB_TOP      3328
#define XB_TOPGEN   3392
#define XCD_BAR_WORDS 3456
#define XB_SPIN_CAP (1u << 27)

__device__ __forceinline__ unsigned xb_ld(unsigned* p)              { return __hip_atomic_load(p, __ATOMIC_RELAXED, __HIP_MEMORY_SCOPE_AGENT); }
__device__ __forceinline__ unsigned xb_add(unsigned* p, unsigned v) { return __hip_atomic_fetch_add(p, v, __ATOMIC_RELAXED, __HIP_MEMORY_SCOPE_AGENT); }
__device__ __forceinline__ unsigned xb_xcc_id() { return (unsigned)__builtin_amdgcn_s_getreg((3 << 11) | 20) & 0xFu; }
#define XB_SPIN(cond, bar) do { unsigned _sp = 0; while (cond) { __builtin_amdgcn_s_sleep(1); \
    if ((++_sp & 255u) == 0u) { if (xb_ld(&(bar)[XB_TMO])) break; if (_sp > XB_SPIN_CAP) { atomicAdd(&(bar)[XB_TMO], 1u); break; } } } } while (0)

struct XcdBarrier {
    unsigned* bar; unsigned x;
    volatile LAS unsigned* st;
};

__device__ __forceinline__ XcdBarrier xcd_barrier_post(unsigned* bar, volatile LAS unsigned* st) {
    XcdBarrier b; b.bar = bar; b.x = xb_xcc_id(); b.st = st;
    if (threadIdx.x == 0) (void)xb_add(&bar[XB_XCNT(b.x)], 1u);
    return b;
}
__device__ __forceinline__ void xcd_barrier_complete(unsigned* bar, unsigned x, unsigned& nloc, unsigned& nx) {
    const unsigned G = gridDim.x * gridDim.y * gridDim.z;
    unsigned sum, cnt, mine, sp = 0u;
    for (;;) {
        sum = 0u; cnt = 0u; mine = 0u;
#pragma unroll
        for (unsigned j = 0; j < 16; ++j) { const unsigned c = xb_ld(&bar[XB_XCNT(j)]); sum += c; cnt += (c > 0u) ? 1u : 0u; mine = (j == x) ? c : mine; }
        if (sum == G) break;
        __builtin_amdgcn_s_sleep(1);
        if ((++sp & 255u) == 0u) { if (xb_ld(&bar[XB_TMO])) break; if (sp > XB_SPIN_CAP) { atomicAdd(&bar[XB_TMO], 1u); break; } }
    }
    nloc = mine > 0u ? mine : 1u; nx = cnt > 0u ? cnt : 1u;
}

__device__ __forceinline__ void xcd_barrier(const XcdBarrier& b) {
    asm volatile("s_waitcnt vmcnt(0)" ::: "memory");
    __syncthreads();
    if (threadIdx.x == 0) {
        unsigned* bar = b.bar;
        __builtin_amdgcn_s_waitcnt(0);
        unsigned nloc = b.st[0], nx = b.st[1];
        if (nloc == 0u) { xcd_barrier_complete(bar, b.x, nloc, nx); b.st[0] = nloc; b.st[1] = nx; }
        const unsigned old = xb_add(&bar[XB_XSUB(b.x)], 1u);
        const unsigned gen = old / nloc;
        if (old + 1u == (gen + 1u) * nloc) {
            __builtin_amdgcn_fence(__ATOMIC_RELEASE, "agent");
            asm volatile("s_waitcnt vmcnt(0)" ::: "memory");
            const unsigned og = xb_add(&bar[XB_TOP], 1u);
            const unsigned tg = og / nx;
            if (og + 1u == (tg + 1u) * nx) xb_add(&bar[XB_TOPGEN], 1u);
            else XB_SPIN(xb_ld(&bar[XB_TOPGEN]) == tg, bar);
            __builtin_amdgcn_fence(__ATOMIC_ACQUIRE, "agent");
            xb_add(&bar[XB_XGEN(b.x)], 1u);
            asm volatile("s_waitcnt vmcnt(0)" ::: "memory");
        } else {
            XB_SPIN(xb_ld(&bar[XB_XGEN(b.x)]) == gen, bar);
            __builtin_amdgcn_fence(__ATOMIC_ACQUIRE, "agent");
            asm volatile("s_waitcnt vmcnt(0)" ::: "memory");
        }
    }
    __syncthreads();
}

__global__ void __launch_bounds__(NTHREADS) fwd_megakernel(Params P) {
    extern __shared__ __attribute__((aligned(16))) unsigned char lds_raw[];
    LAS unsigned char* lds = (LAS unsigned char*)lds_raw;
    int wave0 = __builtin_amdgcn_readfirstlane((int)threadIdx.x >> 6);
    unsigned char* ws0 = P.ws;
    volatile LAS unsigned* bst = (volatile LAS unsigned*)(lds + LDS_BYTES - 64);
    if (threadIdx.x < 2) bst[threadIdx.x] = 0u;
    __syncthreads();
    (void)xcd_barrier_post((unsigned*)(P.ws + WS_CTL) + 4096, bst);
#define GRID_BAR() do { XcdBarrier b_; b_.bar = (unsigned*)(ws0 + WS_CTL) + 4096; b_.x = xb_xcc_id(); b_.st = (volatile LAS unsigned*)(lds + LDS_BYTES - 64); xcd_barrier(b_); } while (0)
    { const int wave = wave0, lane = lane_id_opaque(), tid = wave * 64 + lane;

#ifndef SKIP_P0
    p0_prologue(P, lds, tid, lane, wave);
#ifdef DUP_P0
    p0_prologue(P, lds, tid, lane, wave);
#endif
#endif
    }
    GRID_BAR();

#pragma unroll 1
    for (int layer = 0; layer < DEPTH; ++layer) {
        asm volatile("" : "+s"(wave0), "+s"(ws0));
        const int wave = wave0, lane = lane_id_opaque(), tid = wave * 64 + lane;
        const int G = gridDim.x, gw = blockIdx.x * NWAVES + wave, NGW = G * NWAVES;
        unsigned char* ws = ws0;
        unsigned* ctl = (unsigned*)(ws + WS_CTL);
#ifdef PROBE_ZERO_O
        for (size_t i = (size_t)blockIdx.x * NTHREADS + tid; i < (size_t)MROWS * 2048 / 8; i += (size_t)G * NTHREADS) ((u32x4*)(ws + WS_O))[i] = (u32x4){0u, 0u, 0u, 0u};
#endif
        { pg8::Gemm gm{(const pg8::bf16_t*)(ws + WS_XB), (const pg8::bf16_t*)(ws + WS_WIN + layer * SZ_WIN), MROWS, INP, DM};
          pg8::StaticOrder S; S.init(MROWS, INP, G, (int)blockIdx.x);
          pg8::EpiScaleBf16 E{(pg8::bf16_t*)(ws + WS_PROJ), INP, (const float*)(ws + WS_SSP)};
          pg8::gemm_phase<pg8::EpiScaleBf16, pg8::StaticOrder, true, true>(lds, gm, S, E, wave); }
        GRID_BAR();
#ifndef SKIP_CMP
        for (int it = gw; it < 384 + 512; it += NGW) { if (it < 384) item_compress(P, layer, it, lane); else item_kmean(P, it - 384, lane); }
#ifdef DUP_CMP
        for (int it = gw; it < 384 + 512; it += NGW) { if (it < 384) item_compress(P, layer, it, lane); else item_kmean(P, it - 384, lane); }
#endif
#endif
#ifndef SKIP_MIXA
#ifdef DUP_P2A
        for (int rep_ = 0; rep_ < 2; ++rep_)
        for (;;) { const int u = next_unit(ctl + 64 * (layer * 2 + 0 + 8 * rep_), lds, tid); if (u >= 1536) break; const int ln_ = lane_id_opaque(); unit_mixA(P, lds, u, wave * 64 + ln_, ln_, wave); }
#else
        for (;;) { const int u = next_unit(ctl + 64 * (layer * 2 + 0), lds, tid); if (u >= 1536) break; const int ln_ = lane_id_opaque(); unit_mixA(P, lds, u, wave * 64 + ln_, ln_, wave); }
#endif
#endif
        GRID_BAR();
        for (int r = gw; r < MROWS; r += NGW) item_combineA(P, r, lane);
#ifdef DUP_P2B
        for (int rep_ = 0; rep_ < 2; ++rep_)
        for (;;) { const int u = next_unit(ctl + 64 * (layer * 2 + 1 + 8 * rep_), lds, tid); if (u >= 384 + 1024) break;
#ifdef DUP_NSA_ONLY
            if (rep_ == 1 && u >= 384) continue;
#endif
#else
        const int n_units_b = 384 + 1024 + ((P0_LAYERS == 1 && layer + 1 < DEPTH) ? N_CONV_UNITS : 0);
        for (;;) { const int u = next_unit(ctl + 64 * (layer * 2 + 1), lds, tid); if (u >= n_units_b) break;
            if (u >= 384 + 1024) {
                LAS float* scr = (LAS float*)(lds + wave * 16384); const int ln_ = lane_id_opaque();
                for (int k = 0; k < CONV_UNIT_ITEMS / NWAVES; ++k) { const int r = (u - 384 - 1024) * CONV_UNIT_ITEMS + wave * (CONV_UNIT_ITEMS / NWAVES) + k; if (r < I_LAYER) p0_layer_item(P, scr, layer + 1, r, ln_); }
                continue; }
#endif
            if (u < 384) {
#ifndef SKIP_NSA
                { const int ln_ = lane_id_opaque(); unit_nsa(P, lds, (u % 6) / 3, (u % 6) % 3, 63 - u / 6, wave * 64 + ln_, ln_, wave); }
#endif
            } else { const int v = u - 384;
#ifndef SKIP_MOBA
                { const int ln_ = lane_id_opaque(); unit_moba(P, lds, (v % 16) / 8, (v % 16) % 8, 63 - v / 16, wave * 64 + ln_, ln_, wave); }
#endif
            } }
        GRID_BAR();
        { pg8::Gemm gm{(const pg8::bf16_t*)(ws + WS_O), (const pg8::bf16_t*)(ws + WS_WOUT + layer * SZ_WOUT), MROWS, DM, DM};
          pg8::StaticOrder S; S.init(MROWS, DM, G, (int)blockIdx.x);
          pg8::EpiResid E{(pg8::bf16_t*)(ws + WS_XB), (float*)(ws + WS_SSP)};
          pg8::gemm_phase<pg8::EpiResid, pg8::StaticOrder, true, true>(lds, gm, S, E, wave); }
        GRID_BAR();
#ifdef FUSE_CONV
        { pg8::Gemm gm{(const pg8::bf16_t*)(ws + WS_XB), (const pg8::bf16_t*)(ws + WS_WUP + layer * SZ_WUP), MROWS, UPW, DM};
          pg8::StaticOrder S; S.init(MROWS, UPW, G, (int)blockIdx.x);
          pg8::EpiConvGate E{(pg8::bf16_t*)(ws + WS_ACT), (pg8::bf16_t*)(ws + WS_UB), (const float*)(ws + WS_SSP), P.conv_w + (size_t)layer * 3 * UPW, P.conv_b + (size_t)layer * UPW, DFF};
          pg8::gemm_phase<pg8::EpiConvGate, pg8::StaticOrder, true, true>(lds, gm, S, E, wave); }
        GRID_BAR();
        phase_convfix(P, layer, tid);
        GRID_BAR();
#else
        { pg8::Gemm gm{(const pg8::bf16_t*)(ws + WS_XB), (const pg8::bf16_t*)(ws + WS_WUP + layer * SZ_WUP), MROWS, UPW, DM};
          pg8::StaticOrder S; S.init(MROWS, UPW, G, (int)blockIdx.x);
          pg8::EpiScaleBf16 E{(pg8::bf16_t*)(ws + WS_U), UPW, (const float*)(ws + WS_SSP)};
#ifdef DUP_G3
          pg8::gemm_phase<pg8::EpiScaleBf16, pg8::StaticOrder, true, true>(lds, gm, S, E, wave);
#endif
          pg8::gemm_phase<pg8::EpiScaleBf16, pg8::StaticOrder, true, true>(lds, gm, S, E, wave); }
        GRID_BAR();
#ifndef SKIP_CONV
        phase_conv(P, layer, tid);
#ifdef DUP_CONV
        phase_conv(P, layer, tid);
#endif
#endif
        GRID_BAR();
#endif
        { pg8::Gemm gm{(const pg8::bf16_t*)(ws + WS_ACT), (const pg8::bf16_t*)(ws + WS_WDN + layer * SZ_WDN), MROWS, DM, DFF};
          pg8::StaticOrder S; S.init(MROWS, DM, G, (int)blockIdx.x);
          pg8::EpiResid E{(pg8::bf16_t*)(ws + WS_XB), (float*)(ws + WS_SSP)};
          pg8::gemm_phase<pg8::EpiResid, pg8::StaticOrder, true, true>(lds, gm, S, E, wave); }
        GRID_BAR();
    }
    const int wave = wave0, lane = lane_id_opaque();
    const int G = gridDim.x, gw = blockIdx.x * NWAVES + wave, NGW = G * NWAVES;
    unsigned char* ws = ws0; (void)G;
    for (int mrow = gw; mrow < MROWS; mrow += NGW) {
        const u32x2* xr = (const u32x2*)((const bf16_t*)(ws + WS_XB) + (size_t)mrow * DM) + lane; const f32x4* gr = (const f32x4*)P.norm_final + lane;
        f32x4 v[8]; float s = 0.f;
#pragma unroll
        for (int j = 0; j < 8; ++j) { const u32x2 w = xr[64 * j]; v[j] = (f32x4){bflo(w.x), bfhi(w.x), bflo(w.y), bfhi(w.y)}; s += (v[j][0] * v[j][0] + v[j][1] * v[j][1]) + (v[j][2] * v[j][2] + v[j][3] * v[j][3]); }
#pragma unroll
        for (int o = 1; o < 64; o <<= 1) s += __shfl_xor(s, o);
        const float rs = 1.0f / sqrtf(s * (1.0f / DM) + 1e-6f);
        f32x4* orow = (f32x4*)(P.out + (size_t)mrow * DM) + lane;
#pragma unroll
        for (int j = 0; j < 8; ++j) orow[64 * j] = v[j] * rs * gr[64 * j];
    }
}

extern "C" void kernel_launch(void* const* d_in, const int* in_sizes, int n_in, void* d_out, int out_size, void* d_ws, size_t ws_size, hipStream_t stream) {
    static int grid = 0;
    if (grid == 0) {
        if (n_in != 14 || ws_size < WS_END) { fprintf(stderr, "kernel_launch: unexpected n_in %d or workspace %zu < %zu\n", n_in, ws_size, (size_t)WS_END); grid = -1; return; }
        int dev = 0, cus = 0, per_cu = 0;
        hipGetDevice(&dev); hipDeviceGetAttribute(&cus, hipDeviceAttributeMultiprocessorCount, dev);
        if (hipFuncSetAttribute((const void*)fwd_megakernel, hipFuncAttributeMaxDynamicSharedMemorySize, LDS_BYTES) != hipSuccess) { fprintf(stderr, "kernel_launch: hipFuncSetAttribute failed\n"); grid = -1; return; }
        if (hipOccupancyMaxActiveBlocksPerMultiprocessor(&per_cu, (const void*)fwd_megakernel, NTHREADS, LDS_BYTES) != hipSuccess || per_cu < 1) { fprintf(stderr, "kernel_launch: occupancy query says %d\n", per_cu); per_cu = 1; }
        (void)hipGetLastError();
        grid = cus * 1;
    }
    if (grid < 0) return;
    hipMemsetAsync((char*)d_ws + WS_CTL, 0, CTL_BYTES, stream);
    Params p{};
    p.x = (const float*)d_in[0]; p.rel = (const float*)d_in[1]; p.w_in = (const float*)d_in[2]; p.w_out = (const float*)d_in[3]; p.cmp_w1 = (const float*)d_in[4]; p.cmp_w2 = (const float*)d_in[5];
    p.cmp_pe = (const float*)d_in[6]; p.norm_attn = (const float*)d_in[7]; p.norm_mlp = (const float*)d_in[8]; p.w_up = (const float*)d_in[9]; p.conv_w = (const float*)d_in[10]; p.conv_b = (const float*)d_in[11];
    p.w_down = (const float*)d_in[12]; p.norm_final = (const float*)d_in[13]; p.out = (float*)d_out; p.ws = (unsigned char*)d_ws;
    void* args[] = {&p};
    hipError_t e = hipLaunchCooperativeKernel((const void*)fwd_megakernel, dim3(grid), dim3(NTHREADS), args, LDS_BYTES, stream);
    if (e != hipSuccess) fprintf(stderr, "kernel_launch: cooperative launch failed: %s (grid %d)\n", hipGetErrorString(e), grid);
}
```

```cpp
#define NO_TAILFILL
#define FUSE_CONV
#define CONV_DPP
#include <hip/hip_runtime.h>
#include <hip/hip_cooperative_groups.h>
#include <cstdio>
#include <cstdint>
namespace cg = cooperative_groups;
namespace pg8 {
#define PG8_LAS __attribute__((address_space(3)))
typedef unsigned short bf16_t;
typedef short bf16x8 __attribute__((ext_vector_type(8)));
typedef float f32x4 __attribute__((ext_vector_type(4)));
typedef unsigned u32x4 __attribute__((ext_vector_type(4)));
constexpr int BM = 256, BK = 64, HALF = 128, HTB = HALF * BK * 2  , STAGE_BYTES = 8 * HTB, NXCD = 8, WGM = 8;

__host__ __device__ __forceinline__ int lds_byte(int r, int c) { const int st = (r >> 4) * 2 + (c >> 5), rr = r & 15, cc = c & 31, ob = rr * 64 + cc * 2; return st * 1024 + (ob ^ (((ob >> 9) & 1) << 5)); }
__host__ __device__ __forceinline__ void stage_rc(int b, int& R, int& C) { const int st = b / 1024, sb = b % 1024, swz = sb ^ (((sb >> 9) & 1) << 5); R = (st >> 1) * 16 + swz / 64; C = (st & 1) * 32 + (swz % 64) / 2; }
__host__ __device__ __forceinline__ int perm32(int rho) { const int n = rho >> 4, i = rho & 15; return 8 * (i >> 2) + 4 * n + (i & 3); }

struct Unit { int pm, pn; };
struct Gemm { const bf16_t* A; const bf16_t* Bt; int M, N, K; };

struct StaticOrder {
    int nM, nN, nwg, G, c;
    __host__ __device__ void init(int M, int N, int G_, int c_) { nM = M / BM; nN = N / BM; nwg = nM * nN; G = G_; c = c_; }
    __host__ __device__ bool next(int i, Unit& u) const {
        const long L = (long)i * G + c; if (L >= nwg) return false;
        int wgid = (int)L; { const int q = nwg / NXCD, r = nwg % NXCD, xcd = wgid % NXCD, off = wgid / NXCD; wgid = (xcd < r ? xcd * (q + 1) : r * (q + 1) + (xcd - r) * q) + off; }
        const int nig = WGM * nN, gid = wgid / nig, fm = gid * WGM, gsz = (nM - fm) < WGM ? (nM - fm) : WGM;
        u.pm = fm + ((wgid % nig) % gsz); u.pn = (wgid % nig) / gsz; return true;
    }
    __device__ __forceinline__ void a_ready(const Unit&) const {}
    __device__ __forceinline__ void done(const Unit&) const {}
};
typedef float f32x2 __attribute__((ext_vector_type(2)));
typedef __bf16 bf16x2_pk __attribute__((ext_vector_type(2)));
__device__ __forceinline__ unsigned cvt_pk_bf16(float lo, float hi) { f32x2 v = {lo, hi}; bf16x2_pk b = __builtin_convertvector(v, bf16x2_pk); return __builtin_bit_cast(unsigned, b); }
__device__ __forceinline__ float row_rstd(const float* ssp, int row) {
    const f32x4* p = (const f32x4*)(ssp + (size_t)row * 32); float s = 0.f;
#pragma unroll
    for (int i = 0; i < 8; ++i) { const f32x4 v = p[i]; s += (v[0] + v[1]) + (v[2] + v[3]); }
    return 1.0f / sqrtf(s * (1.0f / 2048.0f) + 1e-6f);
}
struct EpiScaleBf16 {
    static constexpr bool PERM = true, AFTER_DRAIN = false;
    bf16_t* O; int ldc; const float* ssp;
    __device__ __forceinline__ void operator()(const f32x4 (&acc)[2][2][4][2], const Unit& u, int wr, int wc, int fr, int fq) const {
        const int lane = fq * 16 + fr;
        const int rbase = u.pm * BM + wr * 64;
        f32x4 t[2][8];
#pragma unroll
        for (int j = 0; j < 2; ++j) { const int q = 2 * lane + j; const int row = rbase + (q >> 6) * HALF + (q & 63);
            const f32x4* p = (const f32x4*)(ssp + (size_t)row * 32);
#pragma unroll
            for (int i = 0; i < 8; ++i) t[j][i] = p[i]; }
        __builtin_amdgcn_sched_barrier(0);
        float rsv[2];
#pragma unroll
        for (int j = 0; j < 2; ++j) { float sm = 0.f;
#pragma unroll
            for (int i = 0; i < 8; ++i) sm += (t[j][i][0] + t[j][i][1]) + (t[j][i][2] + t[j][i][3]);
            rsv[j] = 1.0f / sqrtf(sm * (1.0f / 2048.0f) + 1e-6f); }
        const int row0 = rbase + fr; const int col0 = u.pn * BM + wc * 32 + 8 * fq;
#pragma unroll
        for (int ai = 0; ai < 2; ++ai)
#pragma unroll
            for (int m = 0; m < 4; ++m) { const int q = ai * 64 + m * 16 + fr; const float v0 = __shfl(rsv[0], q >> 1), v1 = __shfl(rsv[1], q >> 1); const float rs = (q & 1) ? v1 : v0;
                bf16_t* rowp = O + (size_t)(row0 + ai * HALF + m * 16) * ldc + col0;
#pragma unroll
                for (int bj = 0; bj < 2; ++bj) { const f32x4 v0_ = acc[ai][bj][m][0] * rs, v1_ = acc[ai][bj][m][1] * rs; u32x4 w;
                    w.x = cvt_pk_bf16(v0_[0], v0_[1]); w.y = cvt_pk_bf16(v0_[2], v0_[3]); w.z = cvt_pk_bf16(v1_[0], v1_[1]); w.w = cvt_pk_bf16(v1_[2], v1_[3]);
                    *(u32x4*)(rowp + bj * HALF) = w; } }
    }
};
struct EpiResid {
    static constexpr bool PERM = false, AFTER_DRAIN = false;
    bf16_t* XB; float* ssp;
    __device__ __forceinline__ void operator()(const f32x4 (&acc)[2][2][4][2], const Unit& u, int wr, int wc, int fr, int fq) const {
        typedef unsigned u32x2v __attribute__((ext_vector_type(2)));
        const int row0 = u.pm * BM + wr * 64 + fr; const int col0 = u.pn * BM + wc * 32 + 4 * fq;
#pragma unroll
        for (int ai = 0; ai < 2; ++ai) {
            u32x2v bs[4][2][2];
#pragma unroll
            for (int m = 0; m < 4; ++m)
#pragma unroll
                for (int bj = 0; bj < 2; ++bj)
#pragma unroll
                    for (int n = 0; n < 2; ++n) bs[m][bj][n] = *(const u32x2v*)(XB + (size_t)(row0 + ai * HALF + m * 16) * 2048 + col0 + bj * HALF + n * 16);
            __builtin_amdgcn_sched_barrier(0);
#pragma unroll
            for (int m = 0; m < 4; ++m) { const int row = row0 + ai * HALF + m * 16; const size_t off = (size_t)row * 2048 + col0; float ss = 0.f;
#pragma unroll
                for (int bj = 0; bj < 2; ++bj)
#pragma unroll
                    for (int n = 0; n < 2; ++n) { const size_t o2 = off + bj * HALF + n * 16; const u32x2v b2 = bs[m][bj][n];
                        const f32x4 bv = {__uint_as_float(b2.x << 16), __uint_as_float(b2.x & 0xffff0000u), __uint_as_float(b2.y << 16), __uint_as_float(b2.y & 0xffff0000u)};
                        const f32x4 v = bv + acc[ai][bj][m][n];
                        u32x2v w; w.x = cvt_pk_bf16(v[0], v[1]); w.y = cvt_pk_bf16(v[2], v[3]); *(u32x2v*)(XB + o2) = w;
                        ss += (v[0] * v[0] + v[1] * v[1]) + (v[2] * v[2] + v[3] * v[3]); }
                ss += __shfl_xor(ss, 16); ss += __shfl_xor(ss, 32);
                if (fq == 0) ssp[(size_t)row * 32 + u.pn * 4 + wc] = ss; }
            asm volatile("" ::: "memory");
        }
    }
};
template <int CTRL> __device__ __forceinline__ float dpp_f(float v) { return __builtin_bit_cast(float, __builtin_amdgcn_update_dpp(0, __builtin_bit_cast(int, v), CTRL, 0xf, 0xf, false)); }
#ifdef CONV_DPP
#define ROWM1(v) dpp_f<0x121>(v)
#define ROWM2(v) dpp_f<0x122>(v)
#else
#define ROWM1(v) __shfl(v, src1)
#define ROWM2(v) __shfl(v, src2)
#endif
struct EpiConvGate {
    static constexpr bool PERM = true, AFTER_DRAIN = false;
    bf16_t* ACT; bf16_t* UB; const float* ssp; const float* cw; const float* cb; int dff;
    __device__ __forceinline__ void operator()(const f32x4 (&acc)[2][2][4][2], const Unit& u, int wr, int wc, int fr, int fq) const {
        typedef unsigned u32x2v __attribute__((ext_vector_type(2)));
        const int lane = fq * 16 + fr;
        const int rbase = u.pm * BM + wr * 64;
        const int upw = 2 * dff;
        float rsv[2];
        { f32x4 t[2][8];
#pragma unroll
          for (int j = 0; j < 2; ++j) { const int q = 2 * lane + j; const int row = rbase + (q >> 6) * HALF + (q & 63);
              const f32x4* p = (const f32x4*)(ssp + (size_t)row * 32);
#pragma unroll
              for (int i = 0; i < 8; ++i) t[j][i] = p[i]; }
          __builtin_amdgcn_sched_barrier(0);
#pragma unroll
          for (int j = 0; j < 2; ++j) { float sm = 0.f;
#pragma unroll
              for (int i = 0; i < 8; ++i) sm += (t[j][i][0] + t[j][i][1]) + (t[j][i][2] + t[j][i][3]);
              rsv[j] = 1.0f / sqrtf(sm * (1.0f / 2048.0f) + 1e-6f); } }
        const int src1 = fq * 16 + ((fr + 15) & 15), src2 = fq * 16 + ((fr + 14) & 15); (void)src1; (void)src2;
        const int chb = u.pn * HALF + wc * 32 + 8 * fq;
        const int ucb = u.pn * BM + wc * 32 + 8 * fq;
#pragma unroll
        for (int n = 0; n < 2; ++n) {
            const int ch = chb + 4 * n;
            const f32x4 wa0 = *(const f32x4*)(cw + ch), wa1 = *(const f32x4*)(cw + upw + ch), wa2 = *(const f32x4*)(cw + 2 * upw + ch);
            const f32x4 wg0 = *(const f32x4*)(cw + dff + ch), wg1 = *(const f32x4*)(cw + upw + dff + ch), wg2 = *(const f32x4*)(cw + 2 * upw + dff + ch);
            const f32x4 ba = *(const f32x4*)(cb + ch), bg = *(const f32x4*)(cb + dff + ch);
            __builtin_amdgcn_sched_barrier(0);
#pragma unroll
            for (int ai = 0; ai < 2; ++ai) {
                f32x4 pa = {0.f, 0.f, 0.f, 0.f}, pg = {0.f, 0.f, 0.f, 0.f};
#pragma unroll
                for (int m = 0; m < 4; ++m) {
                    const int q = ai * 64 + m * 16 + fr; const float rv0 = __shfl(rsv[0], q >> 1), rv1 = __shfl(rsv[1], q >> 1); const float rsm = (q & 1) ? rv1 : rv0;
                    const f32x4 va = acc[ai][0][m][n] * rsm, vg = acc[ai][1][m][n] * rsm;
                    f32x4 a1, a2, g1, g2;
#pragma unroll
                    for (int x = 0; x < 4; ++x) {
                        const float c1 = ROWM1(va[x]), c2 = ROWM2(va[x]), e1 = ROWM1(vg[x]), e2 = ROWM2(vg[x]);
                        float d1 = 0.f, d2 = 0.f, f1 = 0.f, f2 = 0.f;
                        if (m > 0) { d1 = ROWM1(pa[x]); d2 = ROWM2(pa[x]); f1 = ROWM1(pg[x]); f2 = ROWM2(pg[x]); }
                        a1[x] = fr >= 1 ? c1 : d1; a2[x] = fr >= 2 ? c2 : d2; g1[x] = fr >= 1 ? e1 : f1; g2[x] = fr >= 2 ? e2 : f2; }
                    const f32x4 ya = ba + wa0 * va + wa1 * a1 + wa2 * a2, yg = bg + wg0 * vg + wg1 * g1 + wg2 * g2;
                    float r4[4];
#pragma unroll
                    for (int x = 0; x < 4; ++x) r4[x] = ya[x] * yg[x] / (1.f + __expf(-yg[x]));
                    const int row = rbase + ai * HALF + m * 16 + fr;
                    if (m > 0 || fr >= 2) { u32x2v w; w.x = cvt_pk_bf16(r4[0], r4[1]); w.y = cvt_pk_bf16(r4[2], r4[3]); *(u32x2v*)(ACT + (size_t)row * dff + ch) = w; }
                    if ((m == 0 && fr < 2) || (m == 3 && fr >= 14)) { const int k = (m == 0) ? fr : fr - 12; bf16_t* ub = UB + ((size_t)(row >> 6) * 4 + k) * upw + ucb + 4 * n;
                        u32x2v w; w.x = cvt_pk_bf16(va[0], va[1]); w.y = cvt_pk_bf16(va[2], va[3]); *(u32x2v*)ub = w;
                        w.x = cvt_pk_bf16(vg[0], vg[1]); w.y = cvt_pk_bf16(vg[2], vg[3]); *(u32x2v*)(ub + HALF) = w; }
                    pa = va; pg = vg;
                }
                asm volatile("" ::: "memory");
            }
        }
    }
};
template <class Epi, class Sched, bool ALIGN_EPI = false, bool SP2 = false>
__device__ __forceinline__ void gemm_phase(PG8_LAS unsigned char* lds, const Gemm g, const Sched& S, const Epi& E, const int wid_in) {
    int lane_; asm volatile("v_mbcnt_lo_u32_b32 %0, -1, 0\n\tv_mbcnt_hi_u32_b32 %0, -1, %0" : "=v"(lane_)); const int wid = wid_in, lane = lane_, tid = wid * 64 + lane, wr = wid >> 2, wc = wid & 3, fr = lane & 15, fq = lane >> 4;
    const int K = g.K, nt = K / BK;
    unsigned voffA[2], voffB[2];
#pragma unroll
    for (int i = 0; i < 2; ++i) { int R, C; stage_rc(tid * 16 + i * 8192, R, C); const int Rb = Epi::PERM ? ((R & ~31) + perm32(R & 31)) : R;
        voffA[i] = (unsigned)(R * K + C) * 2u; voffB[i] = (unsigned)(Rb * K + C) * 2u; }
    const size_t kstep = (size_t)(BK * 2);
    const size_t hstep = (size_t)HALF * K * 2;
    const size_t tstep = 2 * hstep;
    const unsigned ldsw = (unsigned)wid * 1024u;
    const int aoff = lds_byte(wr * 64 + fr, fq * 8), boff = lds_byte(wc * 32 + fr, fq * 8);
#define PG8_SA(b, h) (((b) * 2 + (h)) * HTB)
#define PG8_SB(b, h) ((4 + (b) * 2 + (h)) * HTB)
#define PG8_STAGE(bufoff, gbase, voff) do { _Pragma("unroll") for (int _i = 0; _i < 2; ++_i) \
        __builtin_amdgcn_global_load_lds((const unsigned*)((const char*)(gbase) + (voff)[_i]), (PG8_LAS unsigned*)(lds + (bufoff) + ldsw + _i * 8192), 16, 0, 0); } while (0)
#define PG8_LDA(dst, b, h) do { _Pragma("unroll") for (int m = 0; m < 4; ++m) _Pragma("unroll") for (int k = 0; k < 2; ++k) dst[m][k] = *(const PG8_LAS bf16x8*)(lds + PG8_SA(b, h) + aoff + m * 2048 + k * 1024); } while (0)
#define PG8_LDB(dst, b, h) do { _Pragma("unroll") for (int n = 0; n < 2; ++n) _Pragma("unroll") for (int k = 0; k < 2; ++k) dst[n][k] = *(const PG8_LAS bf16x8*)(lds + PG8_SB(b, h) + boff + n * 2048 + k * 1024); } while (0)
#define PG8_MMA(ai, bj, At, Bt) do { __builtin_amdgcn_s_setprio(1); _Pragma("unroll") for (int m = 0; m < 4; ++m) _Pragma("unroll") for (int n = 0; n < 2; ++n) _Pragma("unroll") for (int k = 0; k < 2; ++k) \
        acc[ai][bj][m][n] = __builtin_amdgcn_mfma_f32_16x16x32_bf16(Bt[n][k], At[m][k], acc[ai][bj][m][n], 0, 0, 0); __builtin_amdgcn_s_setprio(0); } while (0)
#define PG8_WAIT_V(n) asm volatile("s_waitcnt vmcnt(" #n ")" ::: "memory")
#define PG8_WAIT_L(n) asm volatile("s_waitcnt lgkmcnt(" #n ")" ::: "memory")
#define PG8_BAR __builtin_amdgcn_s_barrier()
#define PG8_SCHED __builtin_amdgcn_sched_barrier(0)
    Unit cur, nxt; int ui = 0;
    if (!S.next(0, cur)) return;
    f32x4 acc[2][2][4][2];
#pragma unroll
    for (int a = 0; a < 2; ++a)
#pragma unroll
        for (int b = 0; b < 2; ++b)
#pragma unroll
            for (int m = 0; m < 4; ++m)
#pragma unroll
                for (int n = 0; n < 2; ++n) acc[a][b][m][n] = (f32x4){0.f, 0.f, 0.f, 0.f};
    bf16x8 At[4][2], B0[2][2], B1[2][2];
    const char* cA = (const char*)g.A + (size_t)cur.pm * tstep; const char* cB = (const char*)g.Bt + (size_t)cur.pn * tstep;
    S.a_ready(cur);
    if constexpr (SP2) {
        PG8_STAGE(PG8_SB(0, 0), cB, voffB); PG8_STAGE(PG8_SB(0, 1), cB + hstep, voffB); PG8_STAGE(PG8_SA(0, 0), cA, voffA); PG8_STAGE(PG8_SA(0, 1), cA + hstep, voffA);
        if (wr == 1) PG8_BAR;
        PG8_WAIT_V(2); PG8_BAR;
        PG8_STAGE(PG8_SB(1, 0), cB + kstep, voffB); PG8_STAGE(PG8_SA(1, 0), cA + kstep, voffA); PG8_STAGE(PG8_SB(1, 1), cB + hstep + kstep, voffB);
        PG8_WAIT_V(6); PG8_BAR;
    } else {
        PG8_STAGE(PG8_SB(0, 0), cB, voffB); PG8_STAGE(PG8_SA(0, 0), cA, voffA); PG8_STAGE(PG8_SB(0, 1), cB + hstep, voffB); PG8_STAGE(PG8_SA(0, 1), cA + hstep, voffA);
        if (wr == 1) PG8_BAR;
        PG8_WAIT_V(4); PG8_BAR;
        PG8_STAGE(PG8_SB(1, 0), cB + kstep, voffB); PG8_STAGE(PG8_SA(1, 0), cA + kstep, voffA); PG8_STAGE(PG8_SB(1, 1), cB + hstep + kstep, voffB);
        PG8_WAIT_V(6); PG8_BAR;
    }
    for (;;) {
        const bool has_next = S.next(ui + 1, nxt);
        const char* nA = has_next ? (const char*)g.A + (size_t)nxt.pm * tstep : cA; const char* nB = has_next ? (const char*)g.Bt + (size_t)nxt.pn * tstep : cB;
        for (int t = 0; t < nt; t += 2) {
            const bool last = (t == nt - 2);
            const char* a1 = cA + (size_t)(t + 1) * kstep;
            const char* a2 = last ? nA : cA + (size_t)(t + 2) * kstep; const char* b2 = last ? nB : cB + (size_t)(t + 2) * kstep;
            const char* a3 = a2 + kstep; const char* b3 = b2 + kstep;
            if (last && has_next) S.a_ready(nxt);
            if constexpr (SP2) {
            PG8_LDB(B0, 0, 0); PG8_LDB(B1, 0, 1); PG8_SCHED; PG8_LDA(At, 0, 0); PG8_STAGE(PG8_SA(1, 1), a1 + hstep, voffA);
            PG8_WAIT_V(8); PG8_WAIT_L(0); PG8_BAR; PG8_MMA(0, 0, At, B0); PG8_MMA(0, 1, At, B1); PG8_BAR; PG8_SCHED;
            PG8_LDA(At, 0, 1); PG8_STAGE(PG8_SB(0, 0), b2, voffB); PG8_STAGE(PG8_SB(0, 1), b2 + hstep, voffB); PG8_STAGE(PG8_SA(0, 0), a2, voffA);
            PG8_WAIT_V(8); PG8_WAIT_L(0); PG8_BAR; PG8_MMA(1, 0, At, B0); PG8_MMA(1, 1, At, B1); PG8_BAR; PG8_SCHED;
            PG8_LDB(B0, 1, 0); PG8_LDB(B1, 1, 1); PG8_SCHED; PG8_LDA(At, 1, 0); PG8_STAGE(PG8_SA(0, 1), a2 + hstep, voffA);
            PG8_WAIT_V(8); PG8_WAIT_L(0); PG8_BAR; PG8_MMA(0, 0, At, B0); PG8_MMA(0, 1, At, B1); PG8_BAR; PG8_SCHED;
            PG8_LDA(At, 1, 1); PG8_STAGE(PG8_SB(1, 0), b3, voffB); PG8_STAGE(PG8_SB(1, 1), b3 + hstep, voffB); PG8_STAGE(PG8_SA(1, 0), a3, voffA);
            PG8_WAIT_V(8); PG8_WAIT_L(0); PG8_BAR; PG8_MMA(1, 0, At, B0); PG8_MMA(1, 1, At, B1); PG8_BAR; PG8_SCHED;
            } else {
            PG8_LDB(B0, 0, 0); PG8_SCHED; PG8_LDA(At, 0, 0); PG8_STAGE(PG8_SA(1, 1), a1 + hstep, voffA);
            PG8_WAIT_L(8); PG8_BAR; PG8_WAIT_L(0); PG8_MMA(0, 0, At, B0); PG8_BAR; PG8_SCHED;
            PG8_LDB(B1, 0, 1); PG8_STAGE(PG8_SB(0, 0), b2, voffB);
            PG8_BAR; PG8_WAIT_L(0); PG8_MMA(0, 1, At, B1); PG8_BAR;
            PG8_LDA(At, 0, 1); PG8_STAGE(PG8_SA(0, 0), a2, voffA);
            PG8_BAR; PG8_WAIT_L(0); PG8_MMA(1, 0, At, B0); PG8_BAR; PG8_SCHED;
            PG8_STAGE(PG8_SB(0, 1), b2 + hstep, voffB);
            PG8_WAIT_V(6); PG8_BAR; PG8_MMA(1, 1, At, B1); PG8_BAR;
            PG8_LDB(B0, 1, 0); PG8_SCHED; PG8_LDA(At, 1, 0); PG8_STAGE(PG8_SA(0, 1), a2 + hstep, voffA);
            PG8_WAIT_L(8); PG8_BAR; PG8_WAIT_L(0); PG8_MMA(0, 0, At, B0); PG8_BAR; PG8_SCHED;
            PG8_LDB(B1, 1, 1); PG8_STAGE(PG8_SB(1, 0), b3, voffB);
            PG8_BAR; PG8_WAIT_L(0); PG8_MMA(0, 1, At, B1); PG8_BAR;
            PG8_LDA(At, 1, 1); PG8_STAGE(PG8_SA(1, 0), a3, voffA);
            PG8_BAR; PG8_WAIT_L(0); PG8_MMA(1, 0, At, B0); PG8_BAR; PG8_SCHED;
            PG8_STAGE(PG8_SB(1, 1), b3 + hstep, voffB);
            PG8_WAIT_V(6); PG8_BAR; PG8_MMA(1, 1, At, B1); PG8_BAR;
            }
        }
        if constexpr (ALIGN_EPI) { if (wr == 0) PG8_BAR; }
        if constexpr (!Epi::AFTER_DRAIN) { E(acc, cur, wr, wc, fr, fq); S.done(cur); }
        if (!has_next) break;
#pragma unroll
        for (int a = 0; a < 2; ++a)
#pragma unroll
            for (int b = 0; b < 2; ++b)
#pragma unroll
                for (int m = 0; m < 4; ++m)
#pragma unroll
                    for (int n = 0; n < 2; ++n) acc[a][b][m][n] = (f32x4){0.f, 0.f, 0.f, 0.f};
        cur = nxt; cA = nA; cB = nB; ++ui;
        if constexpr (ALIGN_EPI) { if (wr == 1) PG8_BAR; }
    }
    PG8_WAIT_V(0);
    if constexpr (!ALIGN_EPI) { if (wr == 0) PG8_BAR; }
    PG8_BAR;
    if constexpr (Epi::AFTER_DRAIN) { E.fused(acc, cur, wr, wc, fr, fq, lds, wid, lane); S.done(cur); }
#undef PG8_SA
#undef PG8_SB
#undef PG8_STAGE
#undef PG8_LDA
#undef PG8_LDB
#undef PG8_MMA
#undef PG8_WAIT_V
#undef PG8_WAIT_L
#undef PG8_BAR
#undef PG8_SCHED
}
}

#define GAS __attribute__((address_space(1)))
#define LAS __attribute__((address_space(3)))
typedef unsigned short bf16_t;
typedef short bf16x8 __attribute__((ext_vector_type(8)));
typedef float f32x4 __attribute__((ext_vector_type(4)));
typedef unsigned u32x4 __attribute__((ext_vector_type(4)));
typedef unsigned u32x2 __attribute__((ext_vector_type(2)));
typedef short s16x4 __attribute__((ext_vector_type(4)));

constexpr int BATCH = 2, SEQ = 8192, DM = 2048, DEPTH = 4, MROWS = BATCH * SEQ;
constexpr int INW = 5796, INP = 5888, DFF = 5632, UPW = 2 * DFF;
constexpr int A_OFF = 0, B_OFF = 2304, CQ_OFF = 3840, CKV_OFF = 4608, CG_OFF = 5760;
constexpr int LUTN = 1536;
constexpr float LOG2E = 1.4426950408889634f, LN2 = 0.6931471805599453f;
constexpr int NTHREADS = 512, NWAVES = 8;

constexpr size_t al256(size_t x) { return (x + 255) & ~(size_t)255; }
constexpr size_t WS_CTL = 0, CTL_BYTES = 1u << 20;
constexpr size_t SZ_WIN = (size_t)INP * DM * 2, SZ_WOUT = (size_t)DM * DM * 2, SZ_WUP = (size_t)UPW * DM * 2, SZ_WDN = (size_t)DM * DFF * 2;
constexpr size_t WS_WIN = CTL_BYTES;
constexpr size_t WS_WOUT = WS_WIN + DEPTH * SZ_WIN;
constexpr size_t WS_WUP = WS_WOUT + DEPTH * SZ_WOUT;
constexpr size_t WS_WDN = WS_WUP + DEPTH * SZ_WUP;
constexpr size_t WS_W1T = WS_WDN + DEPTH * SZ_WDN;
constexpr size_t WS_W2T = WS_W1T + (size_t)DEPTH * 2 * 128 * 2048 * 2;
constexpr size_t WS_CPE = WS_W2T + (size_t)DEPTH * 2 * 64 * 128 * 2;
constexpr size_t WS_GLUT = al256(WS_CPE + (size_t)DEPTH * 2 * 128 * 4);
constexpr size_t WS_X = al256(WS_GLUT + (size_t)32 * LUTN * 4);
constexpr size_t WS_XB = WS_X + (size_t)MROWS * DM * 4;
constexpr size_t WS_SSP = WS_XB + (size_t)MROWS * DM * 2;
constexpr size_t WS_R1 = WS_SSP + (size_t)MROWS * 32 * 4;
constexpr size_t WS_PROJ = WS_R1;
constexpr size_t WS_O = WS_R1 + (size_t)MROWS * INP * 2;
constexpr size_t WS_U = WS_R1;
constexpr size_t SZ_R1 = (size_t)MROWS * UPW * 2;
static_assert((size_t)MROWS * INP * 2 + (size_t)MROWS * DM * 2 <= SZ_R1, "overlay");
constexpr size_t WS_ACT = WS_R1 + SZ_R1;
constexpr size_t WS_TOT = WS_ACT + (size_t)MROWS * DFF * 2;
constexpr size_t WS_LSE = WS_TOT + (size_t)MROWS * 768 * 4;
constexpr size_t WS_KC = WS_LSE + (size_t)MROWS * 12 * 4;
constexpr size_t WS_VC = WS_KC + (size_t)BATCH * 3 * 512 * 64 * 2;
constexpr size_t WS_KMEAN = WS_VC + (size_t)BATCH * 3 * 512 * 64 * 2;
constexpr size_t WS_UB = WS_KMEAN + (size_t)BATCH * 8 * 32 * 64 * 4;
constexpr size_t WS_END = WS_UB + (size_t)(MROWS / 64) * 4 * UPW * 2;

constexpr int KP = 160;
constexpr int TILE_B = 64 * KP;
constexpr int L_K0 = 0, L_V0 = TILE_B, L_K1 = 2 * TILE_B, L_V1 = 3 * TILE_B;
constexpr int L_LUT = 4 * TILE_B;
constexpr int L_IMP = L_LUT + 4 * LUTN * 4;
constexpr int L_SEL = L_IMP + 65536;
constexpr int L_TL = L_SEL + 2048;
constexpr int L_MISC = L_TL + 2048;
constexpr int L_WUN = L_MISC + 64;
constexpr int LDS_BYTES = 147456;
static_assert(L_MISC + 256 <= LDS_BYTES, "lds map");

struct Params {
    const float* x; const float* rel; const float* w_in; const float* w_out; const float* cmp_w1; const float* cmp_w2; const float* cmp_pe;
    const float* norm_attn; const float* norm_mlp; const float* w_up; const float* conv_w; const float* conv_b; const float* w_down; const float* norm_final;
    float* out; unsigned char* ws;
};

typedef float f32x2_t __attribute__((ext_vector_type(2))); typedef __bf16 bf16x2_t __attribute__((ext_vector_type(2)));
__device__ __forceinline__ unsigned cvtpk(float lo, float hi) { f32x2_t v = {lo, hi}; bf16x2_t b = __builtin_convertvector(v, bf16x2_t); return __builtin_bit_cast(unsigned, b); }
__device__ __forceinline__ float bf2f(unsigned short b) { return __uint_as_float(((unsigned)b) << 16); }
__device__ __forceinline__ float bflo(unsigned w) { return __uint_as_float(w << 16); }
__device__ __forceinline__ float bfhi(unsigned w) { return __uint_as_float(w & 0xffff0000u); }
__device__ __forceinline__ float fexp2(float x) { return __builtin_amdgcn_exp2f(x); }
__device__ __forceinline__ int lane_id_opaque() { int l_; asm volatile("v_mbcnt_lo_u32_b32 %0, -1, 0\n\tv_mbcnt_hi_u32_b32 %0, -1, %0" : "=v"(l_)); return l_; }
#define LDS_BARRIER() do { asm volatile("s_waitcnt lgkmcnt(0)" ::: "memory"); __builtin_amdgcn_s_barrier(); asm volatile("" ::: "memory"); } while (0)
__device__ __forceinline__ float fma_1(float a, float b, float c) { float r; asm("v_fma_f32 %0, %1, %2, %3" : "=v"(r) : "v"(a), "v"(b), "v"(c)); return r; }
__device__ __forceinline__ float xrow16_max(float x) {
  auto s_ = __builtin_amdgcn_permlane16_swap(__float_as_uint(x), __float_as_uint(x), false, false);
  x = fmaxf(__uint_as_float(s_[0]), __uint_as_float(s_[1]));
  auto t_ = __builtin_amdgcn_permlane32_swap(__float_as_uint(x), __float_as_uint(x), false, false);
  return fmaxf(__uint_as_float(t_[0]), __uint_as_float(t_[1]));
}
__device__ __forceinline__ float xrow16_sum(float x) {
  auto s_ = __builtin_amdgcn_permlane16_swap(__float_as_uint(x), __float_as_uint(x), false, false);
  x = __uint_as_float(s_[0]) + __uint_as_float(s_[1]);
  auto t_ = __builtin_amdgcn_permlane32_swap(__float_as_uint(x), __float_as_uint(x), false, false);
  return __uint_as_float(t_[0]) + __uint_as_float(t_[1]);
}
__device__ __forceinline__ void lds_wait() { asm volatile("s_waitcnt lgkmcnt(0)" ::: "memory"); }
__device__ __forceinline__ s16x4 tr_read(const LAS unsigned char* p) { return __builtin_bit_cast(s16x4, __builtin_amdgcn_ds_read_tr16_b64_v4i16((LAS s16x4*)p)); }
__device__ __forceinline__ f32x4 mfma16(bf16x8 a, bf16x8 b, f32x4 c) { return __builtin_amdgcn_mfma_f32_16x16x32_bf16(a, b, c, 0, 0, 0); }

__device__ __forceinline__ int t5_bucket(int n) {
    if (n < 16) return n < 0 ? 0 : n;
    int b = 16;
    b += n >= 22; b += n >= 30; b += n >= 40; b += n >= 54; b += n >= 73; b += n >= 99; b += n >= 134; b += n >= 182;
    b += n >= 246; b += n >= 332; b += n >= 450; b += n >= 609; b += n >= 825; b += n >= 1117; b += n >= 1513;
    return b;
}
__device__ __forceinline__ bool is_qcol(int n) { return (n < 2304) ? ((n % 768) < 256) : ((n < 2816) || (n >= 3840 && n < 4608)); }

template <int MODE>
__device__ __forceinline__ void p0_item(const float* W, int K, int Nsrc, bf16_t* WT, const float* kscale, LAS float* scr, int kb, int nb, int lane) {
    const int k0 = 64 * kb, n0 = 32 * nb;
    const int nd = n0 + (lane & 31);
    int sc = nd; float cs = 1.f; bool ok = true;
    if (MODE == 0) { ok = nd < INW; if (is_qcol(nd)) cs = 0.125f; }
    if (MODE == 2) { const int pn = nd >> 8, r = nd & 255; sc = (r >= 128 ? DFF : 0) + 128 * pn + (r & 127); }
    float wv[32], kv_[32];
    const float* wp_ = W + (size_t)(k0 + (lane >> 5)) * Nsrc + (ok ? sc : 0);
#pragma unroll
    for (int i = 0; i < 32; ++i) { wv[i] = wp_[(size_t)(2 * i) * Nsrc]; kv_[i] = (MODE != 1) ? kscale[k0 + 2 * i + (lane >> 5)] : 1.f; }
    __builtin_amdgcn_sched_barrier(0);
#pragma unroll
    for (int i = 0; i < 32; ++i) { const int kk = 2 * i + (lane >> 5); scr[kk * 33 + (lane & 31)] = ok ? wv[i] * cs * kv_[i] : 0.f; }
    lds_wait();
    const int c = lane & 7;
#pragma unroll
    for (int j = 0; j < 4; ++j) { const int n = (lane >> 3) + 8 * j; const LAS float* s = scr + (8 * c) * 33 + n;
        u32x4 o; o.x = cvtpk(s[0 * 33], s[1 * 33]); o.y = cvtpk(s[2 * 33], s[3 * 33]); o.z = cvtpk(s[4 * 33], s[5 * 33]); o.w = cvtpk(s[6 * 33], s[7 * 33]);
        *(u32x4*)(WT + (size_t)(n0 + n) * K + k0 + 8 * c) = o; }
    lds_wait();
}

constexpr int I_IN = 32 * (INP / 32), I_OUT = 32 * 64, I_UP = 32 * (UPW / 32), I_DN = (DFF / 64) * 64, I_W1 = 2 * 32 * 4, I_W2 = 2 * 2 * 2;
constexpr int I_LAYER = I_IN + I_OUT + I_UP + I_DN + I_W1 + I_W2;
__device__ __forceinline__ void p0_layer_item(const Params& P, LAS float* scr, int l, int r, int lane) {
    unsigned char* ws = P.ws;
    if (r < I_IN) { p0_item<0>(P.w_in + (size_t)l * DM * INW, DM, INW, (bf16_t*)(ws + WS_WIN + l * SZ_WIN), P.norm_attn + l * DM, scr, r / (INP / 32), r % (INP / 32), lane); return; } r -= I_IN;
    if (r < I_OUT) { p0_item<1>(P.w_out + (size_t)l * DM * DM, DM, DM, (bf16_t*)(ws + WS_WOUT + l * SZ_WOUT), nullptr, scr, r / 64, r % 64, lane); return; } r -= I_OUT;
    if (r < I_UP) { p0_item<2>(P.w_up + (size_t)l * DM * UPW, DM, UPW, (bf16_t*)(ws + WS_WUP + l * SZ_WUP), P.norm_mlp + l * DM, scr, r / (UPW / 32), r % (UPW / 32), lane); return; } r -= I_UP;
    if (r < I_DN) { p0_item<1>(P.w_down + (size_t)l * DFF * DM, DFF, DM, (bf16_t*)(ws + WS_WDN + l * SZ_WDN), nullptr, scr, r / 64, r % 64, lane); return; } r -= I_DN;
    if (r < I_W1) { const int i = r / 128, rr = r % 128; p0_item<1>(P.cmp_w1 + (size_t)(l * 2 + i) * 2048 * 128, 2048, 128, (bf16_t*)(ws + WS_W1T) + (size_t)(l * 2 + i) * 128 * 2048, nullptr, scr, rr / 4, rr % 4, lane); return; } r -= I_W1;
    { const int i = r / 4, rr = r % 4; p0_item<1>(P.cmp_w2 + (size_t)(l * 2 + i) * 128 * 64, 128, 64, (bf16_t*)(ws + WS_W2T) + (size_t)(l * 2 + i) * 64 * 128, nullptr, scr, rr / 2, rr % 2, lane); }
}
#ifdef NO_TAILFILL
constexpr int P0_LAYERS = DEPTH;
#else
constexpr int P0_LAYERS = 1;
#endif
constexpr int CONV_UNIT_ITEMS = 64, N_CONV_UNITS = (I_LAYER + CONV_UNIT_ITEMS - 1) / CONV_UNIT_ITEMS;

__device__ __forceinline__ void p0_prologue(const Params& P, LAS unsigned char* lds, int tid, int lane, int wave) {
    unsigned char* ws = P.ws;
    LAS float* scr = (LAS float*)(lds + wave * 16384);
    const int G = gridDim.x, gw = blockIdx.x * NWAVES + wave, NGW = G * NWAVES;
    for (int it = gw; it < P0_LAYERS * I_LAYER; it += NGW) p0_layer_item(P, scr, it / I_LAYER, it % I_LAYER, lane);
    for (int m = gw; m < MROWS; m += NGW) {
        const f32x4* xr = (const f32x4*)(P.x + (size_t)m * DM) + lane; float s = 0.f;
        u32x2* ob = (u32x2*)((bf16_t*)(ws + WS_XB) + (size_t)m * DM) + lane;
#pragma unroll
        for (int j = 0; j < 8; ++j) { const f32x4 v = xr[64 * j]; s += (v[0] * v[0] + v[1] * v[1]) + (v[2] * v[2] + v[3] * v[3]); u32x2 w; w.x = cvtpk(v[0], v[1]); w.y = cvtpk(v[2], v[3]); ob[64 * j] = w; }
#pragma unroll
        for (int o = 1; o < 64; o <<= 1) s += __shfl_xor(s, o);
        if (lane < 32) ((float*)(ws + WS_SSP))[(size_t)m * 32 + lane] = (lane == 0) ? s : 0.f;
    }
    for (int i = blockIdx.x * NTHREADS + tid; i < 32 * LUTN; i += G * NTHREADS) { const int h = i / LUTN, n = i % LUTN; ((float*)(ws + WS_GLUT))[i] = P.rel[h * 32 + t5_bucket(n)] * LOG2E; }
    if (blockIdx.x < DEPTH * 2) {
        __syncthreads();
        const int li = blockIdx.x, kp = tid >> 7, hid = tid & 127; const float* pe = P.cmp_pe + (size_t)li * 2048; const float* w1 = P.cmp_w1 + (size_t)li * 2048 * 128;
        float s = 0.f;
#pragma unroll 8
        for (int k = kp * 512; k < kp * 512 + 512; ++k) s += pe[k] * w1[(size_t)k * 128 + hid];
        LAS float* red = (LAS float*)lds; red[tid] = s; __syncthreads();
        if (tid < 128) ((float*)(ws + WS_CPE))[li * 128 + tid] = (red[tid] + red[tid + 128]) + (red[tid + 256] + red[tid + 384]);
        __syncthreads();
    }
}

struct Src { const bf16_t* kb; const bf16_t* vb; int stride; int dil; int roff; };

template <int QG, int MODE>
__device__ __forceinline__ void flash_tile(LAS unsigned char* lds, const int buf, const int k0, const int tag, const int dil, const bf16x8 (&qf)[QG][2], f32x4 (&o)[QG][4], float (&m)[QG], float (&l)[QG],
                                           const int qc, const int qcw_min, const int qcw_max, const int maxrel, const LAS unsigned* selp, const LAS unsigned* wunp,
                                           const float (&invl)[QG], LAS float* impw, const bool imp_acc, const LAS float* lut, float& carryB, const int lane) {
    const int g = lane >> 4, i16 = lane & 15;
    bool skip = (k0 > qcw_max) || (maxrel != 0x7fffffff && k0 + 63 < qcw_min - maxrel);
    if (tag >= 0) { const unsigned w = (unsigned)__builtin_amdgcn_readfirstlane((int)wunp[tag >> 5]); if (!((w >> (tag & 31)) & 1u)) skip = true; }
    if (MODE & 4) skip = false;
    if (!skip) {
        const LAS unsigned char* Ks = lds + (buf ? L_K1 : L_K0);
        const LAS unsigned char* Vs = lds + (buf ? L_V1 : L_V0);
        bool allowed = true;
        if (tag >= 0) { const unsigned w = selp[tag >> 5]; allowed = ((w >> (tag & 31)) & 1u) != 0u; }
        float impA[4] = {0.f, 0.f, 0.f, 0.f}, impB[4] = {0.f, 0.f, 0.f, 0.f};
        const int dl_ = qcw_min - (k0 + 63), dh_ = qcw_max - k0;
        bool uni = (k0 >= 0) && (dl_ >= 0) && (maxrel == 0x7fffffff || dh_ <= maxrel);
        if (MODE & 1) uni = uni && (dl_ * dil >= 1513);
        const unsigned uni_di = (unsigned)(dl_ * dil) < (unsigned)(LUTN - 1) ? (unsigned)(dl_ * dil) : (unsigned)(LUTN - 1);
        const bool mid = (MODE & 1) && !uni && (dil == 1) && (k0 >= 0) && (dl_ >= 0) && (maxrel == 0x7fffffff || dh_ <= maxrel) && (dh_ <= LUTN - 1);
#pragma unroll
        for (int qg = 0; qg < QG; ++qg) {
            bf16x8 kf[4][2];
#pragma unroll
            for (int kt = 0; kt < 4; ++kt)
#pragma unroll
                for (int ks = 0; ks < 2; ++ks) kf[kt][ks] = *(const LAS bf16x8*)(Ks + (16 * kt + i16) * KP + ks * 64 + g * 16);
            __builtin_amdgcn_sched_barrier(0);
            f32x4 s[4];
#pragma unroll
            for (int kt = 0; kt < 4; ++kt) { s[kt] = (f32x4){0.f, 0.f, 0.f, 0.f};
#pragma unroll
                for (int ks = 0; ks < 2; ++ks) s[kt] = mfma16(kf[kt][ks], qf[qg][ks], s[kt]); }
            bf16x8 vfr[4][2];
            if (!(MODE & 2)) {
#pragma unroll
                for (int dt = 0; dt < 4; ++dt)
#pragma unroll
                    for (int s2 = 0; s2 < 2; ++s2) { const LAS unsigned char* vp = Vs + (32 * s2 + 4 * g + (i16 >> 2)) * KP + (16 * dt + 4 * (i16 & 3)) * 2;
                        const s16x4 lo = tr_read(vp), hi = tr_read(vp + 16 * KP);
                        vfr[dt][s2] = (bf16x8){lo[0], lo[1], lo[2], lo[3], hi[0], hi[1], hi[2], hi[3]}; }
            }
            __builtin_amdgcn_sched_barrier(0);
            float mx = -INFINITY; float lanebias = 0.f;
            if (uni) {
                float lb = 0.f;
                if (MODE & 1) lb = lut[qg * LUTN + uni_di];
                lanebias = allowed ? lb : -INFINITY;
                float mr = -INFINITY;
#pragma unroll
                for (int kt = 0; kt < 4; ++kt)
#pragma unroll
                    for (int r = 0; r < 4; ++r) mr = fmaxf(mr, s[kt][r]);
                mx = allowed ? __builtin_fmaf(mr, LOG2E, lb) : -INFINITY;
            } else if (mid) {
                const LAS float* lp = lut + qg * LUTN + (qc - k0 - 4 * g - 63);
                float bv[4][4];
#pragma unroll
                for (int kt = 0; kt < 4; ++kt)
#pragma unroll
                    for (int r = 0; r < 4; ++r) bv[kt][r] = lp[63 - 16 * kt - r];
                __builtin_amdgcn_sched_barrier(0);
#pragma unroll
                for (int kt = 0; kt < 4; ++kt)
#pragma unroll
                    for (int r = 0; r < 4; ++r) { float sc = __builtin_fmaf(s[kt][r], LOG2E, bv[kt][r]); sc = allowed ? sc : -INFINITY; s[kt][r] = sc; mx = fmaxf(mx, sc); }
            } else {
                float bv[4][4];
#pragma unroll
                for (int kt = 0; kt < 4; ++kt)
#pragma unroll
                    for (int r = 0; r < 4; ++r) { bv[kt][r] = 0.f;
                        if (MODE & 1) { const int rel = qc - (k0 + 16 * kt + 4 * g + r); unsigned di = (unsigned)(rel * dil); di = di < (unsigned)(LUTN - 1) ? di : (unsigned)(LUTN - 1); bv[kt][r] = lut[qg * LUTN + di]; } }
                if (MODE & 1) __builtin_amdgcn_sched_barrier(0);
#pragma unroll
                for (int kt = 0; kt < 4; ++kt)
#pragma unroll
                    for (int r = 0; r < 4; ++r) { const int kc = k0 + 16 * kt + 4 * g + r; const int rel = qc - kc;
                        const bool ok = allowed && ((unsigned)rel <= (unsigned)maxrel) && (kc >= 0);
                        float sc = __builtin_fmaf(s[kt][r], LOG2E, bv[kt][r]);
                        sc = ok ? sc : -INFINITY; s[kt][r] = sc; mx = fmaxf(mx, sc); }
            }
            mx = xrow16_max(mx);
            const float mnew = fmaxf(m[qg], mx); const float alpha = fexp2(m[qg] - mnew); m[qg] = mnew;
            float rs = 0.f;
            if (uni) { const float cb_ = lanebias - mnew;
#pragma unroll
                for (int kt = 0; kt < 4; ++kt)
#pragma unroll
                    for (int r = 0; r < 4; ++r) { const float p = fexp2(__builtin_fmaf(s[kt][r], LOG2E, cb_)); s[kt][r] = p; rs += p; }
            } else {
#pragma unroll
                for (int kt = 0; kt < 4; ++kt)
#pragma unroll
                    for (int r = 0; r < 4; ++r) { const float p = fexp2(s[kt][r] - mnew); s[kt][r] = p; rs += p; }
            }
            rs = xrow16_sum(rs);
            l[qg] = l[qg] * alpha + rs;
            if (MODE & 4) {
#pragma unroll
                for (int kt = 0; kt < 4; ++kt) { impA[kt] += ((s[kt][0] + s[kt][1]) + (s[kt][2] + s[kt][3])) * invl[qg]; impB[kt] += s[kt][3] * invl[qg]; }
            }
            if (!(MODE & 2)) {
#pragma unroll
                for (int dt = 0; dt < 4; ++dt) o[qg][dt] = o[qg][dt] * alpha;
                bf16x8 pf[2];
#pragma unroll
                for (int s2 = 0; s2 < 2; ++s2) { u32x4 w; w.x = cvtpk(s[2 * s2][0], s[2 * s2][1]); w.y = cvtpk(s[2 * s2][2], s[2 * s2][3]); w.z = cvtpk(s[2 * s2 + 1][0], s[2 * s2 + 1][1]); w.w = cvtpk(s[2 * s2 + 1][2], s[2 * s2 + 1][3]);
                    pf[s2] = __builtin_bit_cast(bf16x8, w); }
#pragma unroll
                for (int dt = 0; dt < 4; ++dt)
#pragma unroll
                    for (int s2 = 0; s2 < 2; ++s2) o[qg][dt] = mfma16(vfr[dt][s2], pf[s2], o[qg][dt]);
            }
            if (QG > 1) asm volatile("" ::: "memory");
        }
        if (MODE & 4) {
            const int srcl = (lane + 48) & 63;
#pragma unroll
            for (int kt = 0; kt < 4; ++kt) { const float pb = (kt == 0) ? carryB : impB[kt == 0 ? 0 : kt - 1];
                const float x0 = __shfl(pb, srcl), x1 = __shfl(impB[kt], srcl); const float add = (g == 0) ? x0 : x1;
                const int J = 4 * ((k0 >> 4) + kt) + g; const float prevv = imp_acc ? impw[i16 * 128 + J] : 0.f; impw[i16 * 128 + J] = prevv + impA[kt] + add; }
            carryB = impB[3];
        }
    }
}

template <int QG, int MODE>
__device__ __forceinline__ void flash_run(LAS unsigned char* lds, const Src S, const int ntiles, const bf16x8 (&qf)[QG][2], f32x4 (&o)[QG][4], float (&m)[QG], float (&l)[QG],
                                          const int qc, const int qcw_min, const int qcw_max, const int maxrel, const LAS unsigned* selp, const LAS unsigned* wunp,
                                          const float (&invl)[QG], LAS float* impw, const bool imp_acc, const int lutslot, const int lane, const int tid) {
    const LAS int* tl = (const LAS int*)(lds + L_TL);
    const LAS float* lut = (const LAS float*)(lds + L_LUT) + lutslot * LUTN;
    const int srow = tid >> 3, sch = tid & 7;
    u32x4 kr0 = {0, 0, 0, 0}, vr0 = {0, 0, 0, 0}, kr1 = {0, 0, 0, 0}, vr1 = {0, 0, 0, 0};
    float carryB = 0.f;
#define FL_ISSUE(i, KR, VR) do { int c_ = __builtin_amdgcn_readfirstlane(tl[2 * (i)]) + srow; c_ = c_ < 0 ? 0 : c_; const size_t off_ = (size_t)(c_ * S.dil + S.roff) * S.stride + sch * 8; \
        KR = *(const u32x4*)(S.kb + off_); if (!(MODE & 2)) VR = *(const u32x4*)(S.vb + off_); } while (0)
#define FL_COMMIT(b, KR, VR) do { *(LAS u32x4*)(lds + ((b) ? L_K1 : L_K0) + srow * KP + sch * 16) = KR; if (!(MODE & 2)) *(LAS u32x4*)(lds + ((b) ? L_V1 : L_V0) + srow * KP + sch * 16) = VR; } while (0)
#define FL_TILE(i, b) flash_tile<QG, MODE>(lds, b, __builtin_amdgcn_readfirstlane(tl[2 * (i)]), __builtin_amdgcn_readfirstlane(tl[2 * (i) + 1]), S.dil, qf, o, m, l, qc, qcw_min, qcw_max, maxrel, selp, wunp, invl, impw, imp_acc, lut, carryB, lane)
    LDS_BARRIER();
    if (ntiles > 0) { FL_ISSUE(0, kr0, vr0); if (ntiles > 1) FL_ISSUE(1, kr1, vr1); FL_COMMIT(0, kr0, vr0); }
    LDS_BARRIER();
    for (int i = 0; i < ntiles; i += 2) {
        if (i + 2 < ntiles) FL_ISSUE(i + 2, kr0, vr0);
        FL_TILE(i, 0);
        if (i + 1 < ntiles) FL_COMMIT(1, kr1, vr1);
        LDS_BARRIER();
        if (i + 1 >= ntiles) break;
        if (i + 3 < ntiles) FL_ISSUE(i + 3, kr1, vr1);
        FL_TILE(i + 1, 1);
        if (i + 2 < ntiles) FL_COMMIT(0, kr0, vr0);
        LDS_BARRIER();
    }
#undef FL_ISSUE
#undef FL_COMMIT
#undef FL_TILE
}

template <int QG> __device__ __forceinline__ void flash_init(f32x4 (&o)[QG][4], float (&m)[QG], float (&l)[QG]) {
#pragma unroll
    for (int q = 0; q < QG; ++q) { m[q] = -1e30f; l[q] = 0.f;
#pragma unroll
        for (int d = 0; d < 4; ++d) o[q][d] = (f32x4){0.f, 0.f, 0.f, 0.f}; }
}
template <int NH>
__device__ __forceinline__ void load_lut(LAS unsigned char* lds, const float* glut, int head0, int tid) {
    LAS float* lut = (LAS float*)(lds + L_LUT); const float* src = glut + (size_t)head0 * LUTN;
    float v[NH * 3];
#pragma unroll
    for (int i = 0; i < NH * 3; ++i) v[i] = src[tid + NTHREADS * i];
    __builtin_amdgcn_sched_barrier(0);
#pragma unroll
    for (int i = 0; i < NH * 3; ++i) lut[tid + NTHREADS * i] = v[i];
}
__device__ __forceinline__ int next_unit(unsigned* ctr, LAS unsigned char* lds, int tid) {
    LAS int* slot = (LAS int*)(lds + L_MISC);
    __syncthreads();
    if (tid == 0) *slot = (int)atomicAdd(ctr, 1u);
    __syncthreads();
    return *slot;
}

__device__ __forceinline__ void unit_mixA(const Params& P, LAS unsigned char* lds, int uid, int tid, int lane, int wave) {
    unsigned char* ws = P.ws; const bf16_t* proj = (const bf16_t*)(ws + WS_PROJ);
    const int b = uid / 768; int rem = uid % 768; const int gi = rem / 256; rem %= 256; const int hs = rem / 64, idx = rem % 64;
    const int d = gi == 0 ? 1 : (gi == 1 ? 4 : 16); const int rc = idx % d, nb = idx / d;
    const int g = lane >> 4, i16 = lane & 15;
    load_lut<1>(lds, (const float*)(ws + WS_GLUT), gi * 4 + hs, tid);
    const int ntiles = nb == 0 ? 2 : 4;
    if (tid < 4) { LAS int* tl = (LAS int*)(lds + L_TL); const int i = tid + (nb == 0 ? 2 : 0); if (i < 4) { tl[2 * tid] = nb * 128 - 128 + 64 * i; tl[2 * tid + 1] = -1; } }
    const int qi = nb * 128 + 16 * wave + i16; const int tok = qi * d + rc; const size_t row = (size_t)b * SEQ + tok;
    const int colq = A_OFF + gi * 768 + hs * 64;
    bf16x8 qf[1][2];
#pragma unroll
    for (int ks = 0; ks < 2; ++ks) qf[0][ks] = *(const bf16x8*)(proj + row * INP + colq + ks * 32 + g * 8);
    f32x4 o[1][4]; float m[1], l[1]; flash_init<1>(o, m, l);
    const float il[1] = {0.f};
    Src S{proj + (size_t)b * SEQ * INP + colq + 256, proj + (size_t)b * SEQ * INP + colq + 512, INP, d, rc};
    flash_run<1, 1>(lds, S, ntiles, qf, o, m, l, qi, nb * 128 + 16 * wave, nb * 128 + 16 * wave + 15, 128, nullptr, nullptr, il, nullptr, false, 0, lane, tid);
    const float inv = l[0] > 0.f ? 1.f / l[0] : 0.f;
    bf16_t* O = (bf16_t*)(ws + WS_O) + row * 2048 + gi * 256 + hs * 64;
#pragma unroll
    for (int dt = 0; dt < 4; ++dt) { u32x2 w; w.x = cvtpk(o[0][dt][0] * inv, o[0][dt][1] * inv); w.y = cvtpk(o[0][dt][2] * inv, o[0][dt][3] * inv); *(u32x2*)(O + 16 * dt + 4 * g) = w; }
    if (g == 0) ((float*)(ws + WS_LSE))[row * 12 + gi * 4 + hs] = (m[0] + __log2f(fmaxf(l[0], 1e-30f))) * LN2;
}

__device__ __forceinline__ void unit_moba(const Params& P, LAS unsigned char* lds, int b, int h, int c, int tid, int lane, int wave) {
    unsigned char* ws = P.ws; const bf16_t* proj = (const bf16_t*)(ws + WS_PROJ);
    const int g = lane >> 4, i16 = lane & 15;
    const int t0 = c * 128, ob = t0 >> 8;
    load_lut<1>(lds, (const float*)(ws + WS_GLUT), 12 + h, tid);
    LAS float* km = (LAS float*)(lds + L_IMP);
    LAS unsigned char* qS = lds + L_IMP + 8192;
    { const float* src = (const float*)(ws + WS_KMEAN) + (size_t)(b * 8 + h) * 2048; float kv4[4]; u32x4 qv[2];
#pragma unroll
      for (int i = 0; i < 4; ++i) kv4[i] = src[tid + NTHREADS * i];
#pragma unroll
      for (int i = 0; i < 2; ++i) { const int e = tid + NTHREADS * i; qv[i] = *(const u32x4*)(proj + ((size_t)b * SEQ + t0 + (e >> 3)) * INP + B_OFF + h * 64 + (e & 7) * 8); }
      __builtin_amdgcn_sched_barrier(0);
#pragma unroll
      for (int i = 0; i < 4; ++i) km[tid + NTHREADS * i] = kv4[i];
#pragma unroll
      for (int i = 0; i < 2; ++i) { const int e = tid + NTHREADS * i; *(LAS u32x4*)(qS + (e >> 3) * 128 + (e & 7) * 16) = qv[i]; } }
    LAS unsigned* misc = (LAS unsigned*)(lds + L_MISC);
    if (tid == 0) misc[1] = 0u;
    __syncthreads();
    const int tok = t0 + 16 * wave + i16; const size_t row = (size_t)b * SEQ + tok;
    const int colq = B_OFF + h * 64;
    bf16x8 qf[1][2];
#pragma unroll
    for (int ks = 0; ks < 2; ++ks) qf[0][ks] = *(const bf16x8*)(proj + row * INP + colq + ks * 32 + g * 8);
    unsigned sel = 0u;
    if (ob > 0) {
        float gt[8];
#pragma unroll
        for (int k = 0; k < 8; ++k) gt[k] = 0.f;
#pragma unroll 1
        for (int dc = 0; dc < 8; ++dc) { const u32x4 qw = *(const LAS u32x4*)(qS + (16 * wave + i16) * 128 + dc * 16);
            const float q0 = bflo(qw.x), q1 = bfhi(qw.x), q2 = bflo(qw.y), q3 = bfhi(qw.y), q4 = bflo(qw.z), q5 = bfhi(qw.z), q6 = bflo(qw.w), q7 = bfhi(qw.w);
#pragma unroll
            for (int k = 0; k < 8; ++k) { const LAS f32x4* kr = (const LAS f32x4*)(km + (8 * g + k) * 64 + dc * 8); const f32x4 a = kr[0], bq = kr[1];
                gt[k] += (q0 * a[0] + q1 * a[1]) + (q2 * a[2] + q3 * a[3]) + (q4 * bq[0] + q5 * bq[1]) + (q6 * bq[2] + q7 * bq[3]); } }
#pragma unroll
        for (int k = 0; k < 8; ++k) if (8 * g + k >= ob) gt[k] = -INFINITY;
#pragma unroll
        for (int it = 0; it < 3; ++it) {
            float best = -INFINITY; int bi = 99;
#pragma unroll
            for (int k = 0; k < 8; ++k) if (gt[k] > best) { best = gt[k]; bi = 8 * g + k; }
#pragma unroll
            for (int off = 16; off <= 32; off <<= 1) { const float ob_ = __shfl_xor(best, off); const int oi = __shfl_xor(bi, off); if (ob_ > best || (ob_ == best && oi < bi)) { best = ob_; bi = oi; } }
            if (bi < 32) { sel |= 1u << bi;
#pragma unroll
                for (int k = 0; k < 8; ++k) if (8 * g + k == bi) gt[k] = -INFINITY; }
        }
    }
    unsigned wu = sel;
#pragma unroll
    for (int off = 1; off < 16; off <<= 1) wu |= (unsigned)__shfl_xor((int)wu, off);
    wu = (unsigned)__builtin_amdgcn_readfirstlane((int)wu);
    LAS unsigned* selS = (LAS unsigned*)(lds + L_SEL); LAS unsigned* wunS = (LAS unsigned*)(lds + L_WUN) + wave * 4;
    if (g == 0) selS[(16 * wave + i16) * 4] = sel;
    if (lane == 0) wunS[0] = wu;
    __syncthreads();
    unsigned um = 0u;
#pragma unroll
    for (int w8 = 0; w8 < 8; ++w8) um |= ((const LAS unsigned*)(lds + L_WUN))[w8 * 4];
    if (tid == 0) { LAS int* tl = (LAS int*)(lds + L_TL); int n = 0;
        for (int blk = 0; blk < ob; ++blk) if ((um >> blk) & 1u) for (int s4 = 0; s4 < 4; ++s4) { tl[2 * n] = blk * 256 + 64 * s4; tl[2 * n + 1] = blk; ++n; }
        for (int k0 = ob * 256; k0 < t0 + 128; k0 += 64) { tl[2 * n] = k0; tl[2 * n + 1] = -1; ++n; }
        misc[2] = (unsigned)n; }
    __syncthreads();
    const int ntiles = (int)misc[2];
    f32x4 o[1][4]; float m[1], l[1]; flash_init<1>(o, m, l);
    const float il[1] = {0.f};
    Src S{proj + (size_t)b * SEQ * INP + colq + 512, proj + (size_t)b * SEQ * INP + colq + 1024, INP, 1, 0};
    flash_run<1, 1>(lds, S, ntiles, qf, o, m, l, tok, t0 + 16 * wave, t0 + 16 * wave + 15, 0x7fffffff, selS + (16 * wave + i16) * 4, wunS, il, nullptr, false, 0, lane, tid);
    const float inv = l[0] > 0.f ? 1.f / l[0] : 0.f;
    bf16_t* O = (bf16_t*)(ws + WS_O) + row * 2048 + 768 + h * 64;
#pragma unroll
    for (int dt = 0; dt < 4; ++dt) { u32x2 w; w.x = cvtpk(o[0][dt][0] * inv, o[0][dt][1] * inv); w.y = cvtpk(o[0][dt][2] * inv, o[0][dt][3] * inv); *(u32x2*)(O + 16 * dt + 4 * g) = w; }
}

__device__ __forceinline__ float sigmoidf_(float x) { return 1.f / (1.f + __expf(-x)); }
#ifndef NSA_QG
#define NSA_QG 2
#endif
__device__ __forceinline__ void unit_nsa(const Params& P, LAS unsigned char* lds, int b, int kv, int c, int tid, int lane, int wave) {
    unsigned char* ws = P.ws; const bf16_t* proj = (const bf16_t*)(ws + WS_PROJ);
    const int g = lane >> 4, i16 = lane & 15;
    const int t0 = c * 128;
    const int tok = t0 + 16 * wave + i16; const size_t row = (size_t)b * SEQ + tok;
    load_lut<4>(lds, (const float*)(ws + WS_GLUT), 20 + kv * 4, tid);
    LAS int* tl = (LAS int*)(lds + L_TL);
    LAS unsigned* misc = (LAS unsigned*)(lds + L_MISC);
    LAS unsigned* selS = (LAS unsigned*)(lds + L_SEL);
    LAS float* impw = (LAS float*)(lds + L_IMP) + wave * 2048;
    const int ntc = ((t0 + 96) >> 4) / 64 + 1;
    if (tid < ntc) { tl[2 * tid] = 64 * tid; tl[2 * tid + 1] = -1; }
    if (tid < 4) misc[4 + tid] = 0u;
    LAS unsigned* wunS = (LAS unsigned*)(lds + L_WUN) + wave * 4;
    float* tot = (float*)(ws + WS_TOT) + row * 768 + (kv * 4) * 64;
    const bf16_t* gatep = proj + row * INP + CG_OFF + (kv * 4) * 3;
    const int qcc = (tok - 31) >> 4;
    const int qcw0 = (t0 + 16 * wave - 31) >> 4, qcw1 = (t0 + 16 * wave + 15 - 31) >> 4;
#pragma unroll 1
    for (int hp = 0; hp < 4 / NSA_QG; ++hp) {
        bf16x8 qf[NSA_QG][2];
#pragma unroll
        for (int q = 0; q < NSA_QG; ++q)
#pragma unroll
            for (int ks = 0; ks < 2; ++ks) qf[q][ks] = *(const bf16x8*)(proj + row * INP + CQ_OFF + (kv * 4 + hp * NSA_QG + q) * 64 + ks * 32 + g * 8);
        f32x4 o[NSA_QG][4]; float m[NSA_QG], l[NSA_QG]; flash_init<NSA_QG>(o, m, l);
        float il[NSA_QG]; for (int q_ = 0; q_ < NSA_QG; ++q_) il[q_] = 0.f;
#ifdef NSA_CMP_FAKEKV
        Src S{proj + (size_t)b * SEQ * INP + CKV_OFF + 4 * 192 + kv * 64, proj + (size_t)b * SEQ * INP + CKV_OFF + 5 * 192 + kv * 64, INP, 1, 0};
#else
        Src S{(const bf16_t*)(ws + WS_KC) + (size_t)(b * 3 + kv) * 512 * 64, (const bf16_t*)(ws + WS_VC) + (size_t)(b * 3 + kv) * 512 * 64, 64, 1, 0};
#endif
#ifdef NSA_CMP_SINGLE
        flash_run<NSA_QG, 0>(lds, S, ntc, qf, o, m, l, qcc, qcw0, qcw1, 0x7fffffff, nullptr, nullptr, il, nullptr, false, 0, lane, tid);
#pragma unroll
        for (int q = 0; q < NSA_QG; ++q) il[q] = l[q] > 0.f ? 1.f / l[q] : 0.f;
        (void)impw;
#elif !defined(NSA_NO_CMP)
        flash_run<NSA_QG, 2>(lds, S, ntc, qf, o, m, l, qcc, qcw0, qcw1, 0x7fffffff, nullptr, nullptr, il, nullptr, false, 0, lane, tid);
#pragma unroll
        for (int q = 0; q < NSA_QG; ++q) { il[q] = l[q] > 0.f ? 1.f / l[q] : 0.f; l[q] = 0.f; }
        flash_run<NSA_QG, 4>(lds, S, ntc, qf, o, m, l, qcc, qcw0, qcw1, 0x7fffffff, nullptr, nullptr, il, impw, hp != 0, 0, lane, tid);
#else
        (void)S; (void)impw;
#endif
#pragma unroll
        for (int q = 0; q < NSA_QG; ++q) { const float gt = sigmoidf_(bf2f(gatep[(hp * NSA_QG + q) * 3 + 0])); const float sc = il[q] * gt;
#pragma unroll
            for (int dt = 0; dt < 4; ++dt) *(f32x4*)(tot + (hp * NSA_QG + q) * 64 + 16 * dt + 4 * g) = o[q][dt] * sc; }
    }
#ifndef NSA_NO_TOPK
    lds_wait();
    unsigned wun0 = 0u, wun1 = 0u, wun2 = 0u, wun3 = 0u;
#pragma unroll 1
    for (int q = 0; q < 16; ++q) {
        const int t = t0 + 16 * wave + q, own = t >> 6;
        const int ncand = own - 2 > 0 ? own - 2 : 0; const int nforced = own >= 2 ? 3 : own + 1; const int K = 16 - nforced;
        const int j0 = lane, j1 = lane + 64;
        const bool c0 = (j0 >= 1) && (j0 <= own - 2), c1 = (j1 <= own - 2);
        const unsigned k0 = c0 ? (__float_as_uint(impw[q * 128 + j0]) + 1u) : 0u, k1 = c1 ? (__float_as_uint(impw[q * 128 + j1]) + 1u) : 0u;
        bool s0 = c0, s1 = c1;
        if (ncand > K) {
            unsigned T = 0u;
            for (int bit = 31; bit >= 0; --bit) { const unsigned Tn = T | (1u << bit);
                const int cnt = __popcll(__ballot(k0 >= Tn)) + __popcll(__ballot(k1 >= Tn)); if (cnt >= K) T = Tn; }
            const bool g0 = k0 > T, g1 = k1 > T; const int ng = __popcll(__ballot(g0)) + __popcll(__ballot(g1)); const int need = K - ng;
            const unsigned long long e0 = __ballot(k0 == T), e1 = __ballot(k1 == T); const unsigned long long lt = (1ull << lane) - 1ull;
            const int r0 = __popcll(e0 & lt), r1 = __popcll(e0) + __popcll(e1 & lt);
            s0 = g0 || (k0 == T && r0 < need); s1 = g1 || (k1 == T && r1 < need);
        }
        s0 = s0 || (j0 == 0) || (j0 == own) || (j0 == own - 1); s1 = s1 || (j1 == own) || (j1 == own - 1);
        const unsigned long long m0 = __ballot(s0), m1 = __ballot(s1);
        const unsigned w0 = (unsigned)m0, w1 = (unsigned)(m0 >> 32), w2 = (unsigned)m1, w3 = (unsigned)(m1 >> 32);
        if (lane == 0) { selS[(16 * wave + q) * 4 + 0] = w0; selS[(16 * wave + q) * 4 + 1] = w1; selS[(16 * wave + q) * 4 + 2] = w2; selS[(16 * wave + q) * 4 + 3] = w3; }
        wun0 |= w0; wun1 |= w1; wun2 |= w2; wun3 |= w3;
    }
    if (lane == 0) { wunS[0] = wun0; wunS[1] = wun1; wunS[2] = wun2; wunS[3] = wun3; }
    __syncthreads();
    if (tid < 4) { unsigned u_ = 0u; for (int w8 = 0; w8 < 8; ++w8) u_ |= ((const LAS unsigned*)(lds + L_WUN))[w8 * 4 + tid]; misc[4 + tid] = u_; }
    __syncthreads();
    const LAS unsigned* selp = selS + (16 * wave + i16) * 4;
    const int ownmax = (t0 + 127) >> 6;
    if (tid == 0) { int n = 0; for (int j = 0; j <= ownmax; ++j) if ((misc[4 + (j >> 5)] >> (j & 31)) & 1u) { tl[2 * n] = 64 * j; tl[2 * n + 1] = j; ++n; } misc[2] = (unsigned)n; }
    __syncthreads();
    const int nts = (int)misc[2];
#else
    const int ownmax = (t0 + 127) >> 6; const int nts = 0; const LAS unsigned* selp = nullptr; (void)selS; (void)wunS;
#endif
    const int kfirst = t0 - 512 > 0 ? t0 - 512 : 0; const int ntw = (t0 + 128 - kfirst) / 64;
#ifdef NSA_PACK4
    __syncthreads();
    if (tid == 0) { int n = 0; for (int j = 0; j <= ownmax; ++j) if ((misc[4 + (j >> 5)] >> (j & 31)) & 1u) { tl[2 * n] = 64 * j; tl[2 * n + 1] = j; ++n; } }
#pragma unroll 1
    for (int ps = 0; ps < 4; ++ps) {
        const int tli = 32 * ps + 4 * wave + (i16 >> 2), hd = i16 & 3;
        const int tokp = t0 + tli; const size_t rowp = (size_t)b * SEQ + tokp;
        bf16x8 qf[1][2];
#pragma unroll
        for (int ks = 0; ks < 2; ++ks) qf[0][ks] = *(const bf16x8*)(proj + rowp * INP + CQ_OFF + (kv * 4 + hd) * 64 + ks * 32 + g * 8);
        if (lane < 4) { unsigned w_ = 0u;
#pragma unroll
            for (int k = 0; k < 4; ++k) w_ |= selS[(32 * ps + 4 * wave + k) * 4 + lane];
            wunS[lane] = w_; }
        lds_wait();
        f32x4 o[1][4]; float m[1], l[1]; flash_init<1>(o, m, l);
        const float il[1] = {0.f};
        Src S{proj + (size_t)b * SEQ * INP + CKV_OFF + 2 * 192 + kv * 64, proj + (size_t)b * SEQ * INP + CKV_OFF + 3 * 192 + kv * 64, INP, 1, 0};
        flash_run<1, 1>(lds, S, nts, qf, o, m, l, tokp, t0 + 32 * ps + 4 * wave, t0 + 32 * ps + 4 * wave + 3, 0x7fffffff, selS + tli * 4, wunS, il, nullptr, false, hd, lane, tid);
        const float gt = sigmoidf_(bf2f(proj[rowp * INP + CG_OFF + (kv * 4 + hd) * 3 + 1])); const float sc = (l[0] > 0.f ? 1.f / l[0] : 0.f) * gt;
        float* tp0 = (float*)(ws + WS_TOT) + rowp * 768 + (kv * 4 + hd) * 64;
#pragma unroll
        for (int dt = 0; dt < 4; ++dt) { float* tp = tp0 + 16 * dt + 4 * g; *(f32x4*)tp = *(const f32x4*)tp + o[0][dt] * sc; }
    }
    __syncthreads();
#pragma unroll 1
    for (int hp = 0; hp < 2; ++hp) {
        bf16x8 qf[2][2];
#pragma unroll
        for (int q = 0; q < 2; ++q)
#pragma unroll
            for (int ks = 0; ks < 2; ++ks) qf[q][ks] = *(const bf16x8*)(proj + row * INP + CQ_OFF + (kv * 4 + hp * 2 + q) * 64 + ks * 32 + g * 8);
        f32x4 o[2][4]; float m[2], l[2];
        float il[2] = {0.f, 0.f};
        __syncthreads();
        if (tid < ntw) { tl[2 * tid] = kfirst + 64 * tid; tl[2 * tid + 1] = -1; }
        flash_init<2>(o, m, l);
        Src S{proj + (size_t)b * SEQ * INP + CKV_OFF + 4 * 192 + kv * 64, proj + (size_t)b * SEQ * INP + CKV_OFF + 5 * 192 + kv * 64, INP, 1, 0};
        flash_run<2, 1>(lds, S, ntw, qf, o, m, l, tok, t0 + 16 * wave, t0 + 16 * wave + 15, 511, nullptr, nullptr, il, nullptr, false, hp * 2, lane, tid);
        bf16_t* O = (bf16_t*)(ws + WS_O) + row * 2048 + 1280 + (kv * 4) * 64;
#pragma unroll
        for (int q = 0; q < 2; ++q) { const float gt = sigmoidf_(bf2f(gatep[(hp * 2 + q) * 3 + 2])); const float sc = (l[q] > 0.f ? 1.f / l[q] : 0.f) * gt;
#pragma unroll
            for (int dt = 0; dt < 4; ++dt) { const f32x4 v = *(const f32x4*)(tot + (hp * 2 + q) * 64 + 16 * dt + 4 * g) + o[q][dt] * sc;
                u32x2 w; w.x = cvtpk(v[0], v[1]); w.y = cvtpk(v[2], v[3]); *(u32x2*)(O + (hp * 2 + q) * 64 + 16 * dt + 4 * g) = w; } }
    }
}
#else
#pragma unroll 1
    for (int hp = 0; hp < 4 / NSA_QG; ++hp) {
        bf16x8 qf[NSA_QG][2];
#pragma unroll
        for (int q = 0; q < NSA_QG; ++q)
#pragma unroll
            for (int ks = 0; ks < 2; ++ks) qf[q][ks] = *(const bf16x8*)(proj + row * INP + CQ_OFF + (kv * 4 + hp * NSA_QG + q) * 64 + ks * 32 + g * 8);
        f32x4 o[NSA_QG][4]; float m[NSA_QG], l[NSA_QG];
        float il[NSA_QG]; for (int q_ = 0; q_ < NSA_QG; ++q_) il[q_] = 0.f;
        __syncthreads();
        if (tid == 0) { int n = 0; for (int j = 0; j <= ownmax; ++j) if ((misc[4 + (j >> 5)] >> (j & 31)) & 1u) { tl[2 * n] = 64 * j; tl[2 * n + 1] = j; ++n; } }
#ifndef NSA_NO_SLC
        { flash_init<NSA_QG>(o, m, l);
          Src S{proj + (size_t)b * SEQ * INP + CKV_OFF + 2 * 192 + kv * 64, proj + (size_t)b * SEQ * INP + CKV_OFF + 3 * 192 + kv * 64, INP, 1, 0};
          flash_run<NSA_QG, 1>(lds, S, nts, qf, o, m, l, tok, t0 + 16 * wave, t0 + 16 * wave + 15, 0x7fffffff, selp, wunS, il, nullptr, false, hp * NSA_QG, lane, tid);
#pragma unroll
          for (int q = 0; q < NSA_QG; ++q) { const float gt = sigmoidf_(bf2f(gatep[(hp * NSA_QG + q) * 3 + 1])); const float sc = (l[q] > 0.f ? 1.f / l[q] : 0.f) * gt;
#pragma unroll
              for (int dt = 0; dt < 4; ++dt) { float* tp = tot + (hp * NSA_QG + q) * 64 + 16 * dt + 4 * g; *(f32x4*)tp = *(const f32x4*)tp + o[q][dt] * sc; } }
        }
#endif
        if (tid < ntw) { tl[2 * tid] = kfirst + 64 * tid; tl[2 * tid + 1] = -1; }
        { flash_init<NSA_QG>(o, m, l);
          Src S{proj + (size_t)b * SEQ * INP + CKV_OFF + 4 * 192 + kv * 64, proj + (size_t)b * SEQ * INP + CKV_OFF + 5 * 192 + kv * 64, INP, 1, 0};
#ifndef NSA_NO_WIN
          flash_run<NSA_QG, 1>(lds, S, ntw, qf, o, m, l, tok, t0 + 16 * wave, t0 + 16 * wave + 15, 511, nullptr, nullptr, il, nullptr, false, hp * NSA_QG, lane, tid);
#else
          (void)S;
#endif
          bf16_t* O = (bf16_t*)(ws + WS_O) + row * 2048 + 1280 + (kv * 4) * 64;
#pragma unroll
          for (int q = 0; q < NSA_QG; ++q) { const float gt = sigmoidf_(bf2f(gatep[(hp * NSA_QG + q) * 3 + 2])); const float sc = (l[q] > 0.f ? 1.f / l[q] : 0.f) * gt;
#pragma unroll
              for (int dt = 0; dt < 4; ++dt) { const f32x4 v = *(const f32x4*)(tot + (hp * NSA_QG + q) * 64 + 16 * dt + 4 * g) + o[q][dt] * sc;
                  u32x2 w; w.x = cvtpk(v[0], v[1]); w.y = cvtpk(v[2], v[3]); *(u32x2*)(O + (hp * NSA_QG + q) * 64 + 16 * dt + 4 * g) = w; } }
        }
    }
}

#endif

__device__ __forceinline__ float gelu_tanh(float x) { const float u = 0.7978845608028654f * (x + 0.044715f * x * x * x); const float e = __expf(2.f * u); const float th = 1.f - 2.f / (1.f + e); return 0.5f * x * (1.f + th); }
__device__ __forceinline__ void item_compress(const Params& P, int layer, int it, int lane) {
    unsigned char* ws = P.ws; const bf16_t* proj = (const bf16_t*)(ws + WS_PROJ);
    const int nt = it & 31; int r = it >> 5; const int which = r & 1; r >>= 1; const int kv = r % 3, b = r / 3;
    const int g = lane >> 4, i16 = lane & 15;
    int n = 16 * nt + i16; const int nld = n > 510 ? 510 : n;
    const bf16_t* w1t = (const bf16_t*)(ws + WS_W1T) + (size_t)(layer * 2 + which) * 128 * 2048;
    const bf16_t* w2t = (const bf16_t*)(ws + WS_W2T) + (size_t)(layer * 2 + which) * 64 * 128;
    const float* cpe = (const float*)(ws + WS_CPE) + (layer * 2 + which) * 128;
    const bf16_t* src = proj + ((size_t)b * SEQ + 16 * nld) * INP + CKV_OFF + which * 192 + kv * 64 + 8 * g;
    f32x4 acc[8];
#pragma unroll
    for (int h = 0; h < 8; ++h) acc[h] = (f32x4){0.f, 0.f, 0.f, 0.f};
    const bf16_t* w1l = w1t + (size_t)i16 * 2048 + 8 * g;
#pragma unroll 1
    for (int ks = 0; ks < 64; ks += 4) {
        bf16x8 bq[4], af[4][8];
#pragma unroll
        for (int u = 0; u < 4; ++u) { bq[u] = *(const bf16x8*)(src + (size_t)((ks + u) >> 1) * INP + (u & 1) * 32);
#pragma unroll
            for (int h = 0; h < 8; ++h) af[u][h] = *(const bf16x8*)(w1l + (size_t)(16 * h) * 2048 + 32 * (ks + u)); }
        __builtin_amdgcn_sched_barrier(0);
#pragma unroll
        for (int u = 0; u < 4; ++u)
#pragma unroll
            for (int h = 0; h < 8; ++h) acc[h] = mfma16(af[u][h], bq[u], acc[h]);
    }
    bf16x8 pf[4];
#pragma unroll
    for (int s = 0; s < 4; ++s) { float hv[8];
#pragma unroll
        for (int r2 = 0; r2 < 4; ++r2) { hv[r2] = gelu_tanh(acc[2 * s][r2] + cpe[32 * s + 4 * g + r2]); hv[4 + r2] = gelu_tanh(acc[2 * s + 1][r2] + cpe[32 * s + 16 + 4 * g + r2]); }
        u32x4 w; w.x = cvtpk(hv[0], hv[1]); w.y = cvtpk(hv[2], hv[3]); w.z = cvtpk(hv[4], hv[5]); w.w = cvtpk(hv[6], hv[7]); pf[s] = __builtin_bit_cast(bf16x8, w); }
    bf16_t* dst = (bf16_t*)(ws + (which ? WS_VC : WS_KC)) + ((size_t)(b * 3 + kv) * 512 + n) * 64;
#pragma unroll
    for (int et = 0; et < 4; ++et) { f32x4 oc = {0.f, 0.f, 0.f, 0.f};
#pragma unroll
        for (int s = 0; s < 4; ++s) { const bf16_t* wp = w2t + (size_t)(16 * et + i16) * 128 + 32 * s + 4 * g; const u32x2 lo = *(const u32x2*)wp, hi = *(const u32x2*)(wp + 16);
            u32x4 w; w.x = lo.x; w.y = lo.y; w.z = hi.x; w.w = hi.y; oc = mfma16(__builtin_bit_cast(bf16x8, w), pf[s], oc); }
#ifdef PROBE_CLAMP
#pragma unroll
        for (int r2 = 0; r2 < 4; ++r2) oc[r2] = fminf(fmaxf(oc[r2], -100.f), 100.f);
#endif
        u32x2 w; w.x = cvtpk(oc[0], oc[1]); w.y = cvtpk(oc[2], oc[3]); *(u32x2*)(dst + 16 * et + 4 * g) = w; }
}
__device__ __forceinline__ void item_kmean(const Params& P, int it, int lane) {
    unsigned char* ws = P.ws; const bf16_t* proj = (const bf16_t*)(ws + WS_PROJ);
    const int blk = it & 31, h = (it >> 5) & 7, b = it >> 8;
    const int rg = lane >> 3, dch = lane & 7;
    const bf16_t* src = proj + ((size_t)b * SEQ + blk * 256 + rg) * INP + B_OFF + 512 + h * 64 + dch * 8;
    u32x4 v[32];
#pragma unroll
    for (int i = 0; i < 32; ++i) v[i] = *(const u32x4*)(src + (size_t)(8 * i) * INP);
    __builtin_amdgcn_sched_barrier(0);
    float sm[8];
#pragma unroll
    for (int e = 0; e < 8; ++e) sm[e] = 0.f;
#pragma unroll
    for (int i = 0; i < 32; ++i)
#pragma unroll
        for (int w = 0; w < 4; ++w) { sm[2 * w] += bflo(v[i][w]); sm[2 * w + 1] += bfhi(v[i][w]); }
#pragma unroll
    for (int e = 0; e < 8; ++e) { sm[e] += __shfl_xor(sm[e], 8); sm[e] += __shfl_xor(sm[e], 16); sm[e] += __shfl_xor(sm[e], 32); }
    if (rg == 0) { float* dst = (float*)(ws + WS_KMEAN) + (size_t)it * 64 + dch * 8;
        *(f32x4*)dst = (f32x4){sm[0], sm[1], sm[2], sm[3]} * (1.f / 256.f); *(f32x4*)(dst + 4) = (f32x4){sm[4], sm[5], sm[6], sm[7]} * (1.f / 256.f); }
}
__device__ __forceinline__ void item_combineA(const Params& P, int row, int lane) {
    unsigned char* ws = P.ws; const float* lse = (const float*)(ws + WS_LSE) + (size_t)row * 12; bf16_t* O = (bf16_t*)(ws + WS_O) + (size_t)row * 2048;
#pragma unroll
    for (int k = 0; k < 3; ++k) { const int chunk = lane + 64 * k; const int col = 4 * chunk; const int gi = col >> 8, hs = (col >> 6) & 3;
        const float a0 = lse[hs], a1 = lse[4 + hs], a2 = lse[8 + hs]; const float mx = fmaxf(a0, fmaxf(a1, a2));
        const float e0 = __expf(a0 - mx), e1 = __expf(a1 - mx), e2 = __expf(a2 - mx); const float al = (gi == 0 ? e0 : (gi == 1 ? e1 : e2)) / (e0 + e1 + e2);
        const u32x2 w = *(const u32x2*)(O + col); u32x2 r; r.x = cvtpk(bflo(w.x) * al, bfhi(w.x) * al); r.y = cvtpk(bflo(w.y) * al, bfhi(w.y) * al); *(u32x2*)(O + col) = r; }
}

__device__ __forceinline__ void phase_conv(const Params& P, int layer, int tid) {
    unsigned char* ws = P.ws; const bf16_t* U = (const bf16_t*)(ws + WS_U); bf16_t* ACT = (bf16_t*)(ws + WS_ACT);
    const float* cw = P.conv_w + (size_t)layer * 3 * UPW; const float* cb = P.conv_b + (size_t)layer * UPW;
    constexpr int NCH = DFF / 8, TB = 8, NTB = MROWS / TB;
    for (int it = blockIdx.x * NTHREADS + tid; it < NCH * NTB; it += gridDim.x * NTHREADS) {
        const int ch = it % NCH, tb = it / NCH; const int c = ch * 8; const int ua = 256 * (c >> 7) + (c & 127);
        const int row0 = tb * TB; const bool first = (row0 % SEQ) == 0;
        u32x4 pa[TB + 2], pg[TB + 2];
#pragma unroll
        for (int t = 0; t < TB + 2; ++t) { const int r = row0 - 2 + t; const size_t off = (size_t)(r < 0 ? 0 : r) * UPW + ua; pa[t] = *(const u32x4*)(U + off); pg[t] = *(const u32x4*)(U + off + 128); }
        f32x4 wa4[3][2], wg4[3][2], ba4[2], bg4[2];
#pragma unroll
        for (int j = 0; j < 3; ++j)
#pragma unroll
            for (int h = 0; h < 2; ++h) { wa4[j][h] = *(const f32x4*)(cw + (size_t)j * UPW + c + 4 * h); wg4[j][h] = *(const f32x4*)(cw + (size_t)j * UPW + DFF + c + 4 * h); }
#pragma unroll
        for (int h = 0; h < 2; ++h) { ba4[h] = *(const f32x4*)(cb + c + 4 * h); bg4[h] = *(const f32x4*)(cb + DFF + c + 4 * h); }
        __builtin_amdgcn_sched_barrier(0);
        if (first) { pa[0] = (u32x4){0, 0, 0, 0}; pa[1] = pa[0]; pg[0] = pa[0]; pg[1] = pa[0]; }
#pragma unroll
        for (int t = 0; t < TB; ++t) {
            float r[8];
#pragma unroll
            for (int e = 0; e < 8; ++e) { const int w_ = e >> 1; const int h = e >> 2, x = e & 3;
                const float a0 = (e & 1) ? bfhi(pa[t + 2][w_]) : bflo(pa[t + 2][w_]), a1 = (e & 1) ? bfhi(pa[t + 1][w_]) : bflo(pa[t + 1][w_]), a2 = (e & 1) ? bfhi(pa[t][w_]) : bflo(pa[t][w_]);
                const float g0 = (e & 1) ? bfhi(pg[t + 2][w_]) : bflo(pg[t + 2][w_]), g1 = (e & 1) ? bfhi(pg[t + 1][w_]) : bflo(pg[t + 1][w_]), g2 = (e & 1) ? bfhi(pg[t][w_]) : bflo(pg[t][w_]);
                const float ya = ba4[h][x] + wa4[0][h][x] * a0 + wa4[1][h][x] * a1 + wa4[2][h][x] * a2;
                const float yg = bg4[h][x] + wg4[0][h][x] * g0 + wg4[1][h][x] * g1 + wg4[2][h][x] * g2;
                r[e] = ya * yg / (1.f + __expf(-yg)); }
            u32x4 w; w.x = cvtpk(r[0], r[1]); w.y = cvtpk(r[2], r[3]); w.z = cvtpk(r[4], r[5]); w.w = cvtpk(r[6], r[7]);
            *(u32x4*)(ACT + (size_t)(row0 + t) * DFF + c) = w;
        }
    }
}

__device__ __forceinline__ void phase_convfix(const Params& P, int layer, int tid) {
    unsigned char* ws = P.ws; const bf16_t* UB = (const bf16_t*)(ws + WS_UB); bf16_t* ACT = (bf16_t*)(ws + WS_ACT);
    const float* cw = P.conv_w + (size_t)layer * 3 * UPW; const float* cb = P.conv_b + (size_t)layer * UPW;
    constexpr int NCH = DFF / 8, NS = MROWS / 64;
    for (int it = blockIdx.x * NTHREADS + tid; it < NCH * 2 * NS; it += gridDim.x * NTHREADS) {
        const int ch = it % NCH, lr = (it / NCH) & 1, sl = it / (2 * NCH); const int c = ch * 8; const int ua = 256 * (c >> 7) + (c & 127);
        const bool first = (sl % (SEQ / 64)) == 0;
        const int slp = sl > 0 ? sl - 1 : 0;
        const bf16_t* r0 = UB + ((size_t)sl * 4 + lr) * UPW + ua;
        const bf16_t* r1 = lr == 0 ? UB + ((size_t)slp * 4 + 3) * UPW + ua : UB + ((size_t)sl * 4 + 0) * UPW + ua;
        const bf16_t* r2 = lr == 0 ? UB + ((size_t)slp * 4 + 2) * UPW + ua : UB + ((size_t)slp * 4 + 3) * UPW + ua;
        u32x4 a0 = *(const u32x4*)r0, g0 = *(const u32x4*)(r0 + 128), a1 = *(const u32x4*)r1, g1 = *(const u32x4*)(r1 + 128), a2 = *(const u32x4*)r2, g2 = *(const u32x4*)(r2 + 128);
        const u32x4 z = {0, 0, 0, 0};
        if (first && lr == 0) { a1 = z; g1 = z; }
        if (first) { a2 = z; g2 = z; }
        float r[8];
#pragma unroll
        for (int e = 0; e < 8; ++e) { const int w_ = e >> 1;
            const float x0 = (e & 1) ? bfhi(a0[w_]) : bflo(a0[w_]), x1 = (e & 1) ? bfhi(a1[w_]) : bflo(a1[w_]), x2 = (e & 1) ? bfhi(a2[w_]) : bflo(a2[w_]);
            const float y0 = (e & 1) ? bfhi(g0[w_]) : bflo(g0[w_]), y1 = (e & 1) ? bfhi(g1[w_]) : bflo(g1[w_]), y2 = (e & 1) ? bfhi(g2[w_]) : bflo(g2[w_]);
            const float ya = cb[c + e] + cw[c + e] * x0 + cw[UPW + c + e] * x1 + cw[2 * UPW + c + e] * x2;
            const float yg = cb[DFF + c + e] + cw[DFF + c + e] * y0 + cw[UPW + DFF + c + e] * y1 + cw[2 * UPW + DFF + c + e] * y2;
            r[e] = ya * yg / (1.f + __expf(-yg)); }
        u32x4 w; w.x = cvtpk(r[0], r[1]); w.y = cvtpk(r[2], r[3]); w.z = cvtpk(r[4], r[5]); w.w = cvtpk(r[6], r[7]);
        *(u32x4*)(ACT + (size_t)(sl * 64 + lr) * DFF + c) = w;
    }
}

#define XB_TMO      128
#define XB_XCNT(j)  (256  + 64 * (j))
#define XB_XSUB(j)  (1280 + 64 * (j))
#define XB_XGEN(j)  (2304 + 64 * (j))
#define XB_TOP      3328
#define XB_TOPGEN   3392
#define XCD_BAR_WORDS 3456
#define XB_SPIN_CAP (1u << 27)

__device__ __forceinline__ unsigned xb_ld(unsigned* p)              { return __hip_atomic_load(p, __ATOMIC_RELAXED, __HIP_MEMORY_SCOPE_AGENT); }
__device__ __forceinline__ unsigned xb_add(unsigned* p, unsigned v) { return __hip_atomic_fetch_add(p, v, __ATOMIC_RELAXED, __HIP_MEMORY_SCOPE_AGENT); }
__device__ __forceinline__ unsigned xb_xcc_id() { return (unsigned)__builtin_amdgcn_s_getreg((3 << 11) | 20) & 0xFu; }
#define XB_SPIN(cond, bar) do { unsigned _sp = 0; while (cond) { __builtin_amdgcn_s_sleep(1); \
    if ((++_sp & 255u) == 0u) { if (xb_ld(&(bar)[XB_TMO])) break; if (_sp > XB_SPIN_CAP) { atomicAdd(&(bar)[XB_TMO], 1u); break; } } } } while (0)

struct XcdBarrier {
    unsigned* bar; unsigned x;
    volatile LAS unsigned* st;
};

__device__ __forceinline__ XcdBarrier xcd_barrier_post(unsigned* bar, volatile LAS unsigned* st) {
    XcdBarrier b; b.bar = bar; b.x = xb_xcc_id(); b.st = st;
    if (threadIdx.x == 0) (void)xb_add(&bar[XB_XCNT(b.x)], 1u);
    return b;
}
__device__ __forceinline__ void xcd_barrier_complete(unsigned* bar, unsigned x, unsigned& nloc, unsigned& nx) {
    const unsigned G = gridDim.x * gridDim.y * gridDim.z;
    unsigned sum, cnt, mine, sp = 0u;
    for (;;) {
        sum = 0u; cnt = 0u; mine = 0u;
#pragma unroll
        for (unsigned j = 0; j < 16; ++j) { const unsigned c = xb_ld(&bar[XB_XCNT(j)]); sum += c; cnt += (c > 0u) ? 1u : 0u; mine = (j == x) ? c : mine; }
        if (sum == G) break;
        __builtin_amdgcn_s_sleep(1);
        if ((++sp & 255u) == 0u) { if (xb_ld(&bar[XB_TMO])) break; if (sp > XB_SPIN_CAP) { atomicAdd(&bar[XB_TMO], 1u); break; } }
    }
    nloc = mine > 0u ? mine : 1u; nx = cnt > 0u ? cnt : 1u;
}

__device__ __forceinline__ void xcd_barrier(const XcdBarrier& b) {
    asm volatile("s_waitcnt vmcnt(0)" ::: "memory");
    __syncthreads();
    if (threadIdx.x == 0) {
        unsigned* bar = b.bar;
        __builtin_amdgcn_s_waitcnt(0);
        unsigned nloc = b.st[0], nx = b.st[1];
        if (nloc == 0u) { xcd_barrier_complete(bar, b.x, nloc, nx); b.st[0] = nloc; b.st[1] = nx; }
        const unsigned old = xb_add(&bar[XB_XSUB(b.x)], 1u);
        const unsigned gen = old / nloc;
        if (old + 1u == (gen + 1u) * nloc) {
            __builtin_amdgcn_fence(__ATOMIC_RELEASE, "agent");
            asm volatile("s_waitcnt vmcnt(0)" ::: "memory");
            const unsigned og = xb_add(&bar[XB_TOP], 1u);
            const unsigned tg = og / nx;
            if (og + 1u == (tg + 1u) * nx) xb_add(&bar[XB_TOPGEN], 1u);
            else XB_SPIN(xb_ld(&bar[XB_TOPGEN]) == tg, bar);
            __builtin_amdgcn_fence(__ATOMIC_ACQUIRE, "agent");
            xb_add(&bar[XB_XGEN(b.x)], 1u);
            asm volatile("s_waitcnt vmcnt(0)" ::: "memory");
        } else {
            XB_SPIN(xb_ld(&bar[XB_XGEN(b.x)]) == gen, bar);
            __builtin_amdgcn_fence(__ATOMIC_ACQUIRE, "agent");
            asm volatile("s_waitcnt vmcnt(0)" ::: "memory");
        }
    }
    __syncthreads();
}

__global__ void __launch_bounds__(NTHREADS) fwd_megakernel(Params P) {
    extern __shared__ __attribute__((aligned(16))) unsigned char lds_raw[];
    LAS unsigned char* lds = (LAS unsigned char*)lds_raw;
    int wave0 = __builtin_amdgcn_readfirstlane((int)threadIdx.x >> 6);
    unsigned char* ws0 = P.ws;
    volatile LAS unsigned* bst = (volatile LAS unsigned*)(lds + LDS_BYTES - 64);
    if (threadIdx.x < 2) bst[threadIdx.x] = 0u;
    __syncthreads();
    (void)xcd_barrier_post((unsigned*)(P.ws + WS_CTL) + 4096, bst);
#define GRID_BAR() do { XcdBarrier b_; b_.bar = (unsigned*)(ws0 + WS_CTL) + 4096; b_.x = xb_xcc_id(); b_.st = (volatile LAS unsigned*)(lds + LDS_BYTES - 64); xcd_barrier(b_); } while (0)
    { const int wave = wave0, lane = lane_id_opaque(), tid = wave * 64 + lane;

#ifndef SKIP_P0
    p0_prologue(P, lds, tid, lane, wave);
#ifdef DUP_P0
    p0_prologue(P, lds, tid, lane, wave);
#endif
#endif
    }
    GRID_BAR();

#pragma unroll 1
    for (int layer = 0; layer < DEPTH; ++layer) {
        asm volatile("" : "+s"(wave0), "+s"(ws0));
        const int wave = wave0, lane = lane_id_opaque(), tid = wave * 64 + lane;
        const int G = gridDim.x, gw = blockIdx.x * NWAVES + wave, NGW = G * NWAVES;
        unsigned char* ws = ws0;
        unsigned* ctl = (unsigned*)(ws + WS_CTL);
#ifdef PROBE_ZERO_O
        for (size_t i = (size_t)blockIdx.x * NTHREADS + tid; i < (size_t)MROWS * 2048 / 8; i += (size_t)G * NTHREADS) ((u32x4*)(ws + WS_O))[i] = (u32x4){0u, 0u, 0u, 0u};
#endif
        { pg8::Gemm gm{(const pg8::bf16_t*)(ws + WS_XB), (const pg8::bf16_t*)(ws + WS_WIN + layer * SZ_WIN), MROWS, INP, DM};
          pg8::StaticOrder S; S.init(MROWS, INP, G, (int)blockIdx.x);
          pg8::EpiScaleBf16 E{(pg8::bf16_t*)(ws + WS_PROJ), INP, (const float*)(ws + WS_SSP)};
          pg8::gemm_phase<pg8::EpiScaleBf16, pg8::StaticOrder, true, true>(lds, gm, S, E, wave); }
        GRID_BAR();
#ifndef SKIP_CMP
        for (int it = wave * G + (int)blockIdx.x; it < 384 + 512; it += NGW) { if (it < 384) item_compress(P, layer, it, lane); else item_kmean(P, it - 384, lane); }
#ifdef DUP_CMP
        for (int it = wave * G + (int)blockIdx.x; it < 384 + 512; it += NGW) { if (it < 384) item_compress(P, layer, it, lane); else item_kmean(P, it - 384, lane); }
#endif
#endif
#ifndef SKIP_MIXA
#ifdef DUP_P2A
        for (int rep_ = 0; rep_ < 2; ++rep_)
        for (;;) { const int u = next_unit(ctl + 64 * (layer * 2 + 0 + 8 * rep_), lds, tid); if (u >= 1536) break; const int ln_ = lane_id_opaque(); unit_mixA(P, lds, u, wave * 64 + ln_, ln_, wave); }
#else
        for (;;) { const int u = next_unit(ctl + 64 * (layer * 2 + 0), lds, tid); if (u >= 1536) break; const int ln_ = lane_id_opaque(); unit_mixA(P, lds, u, wave * 64 + ln_, ln_, wave); }
#endif
#endif
        GRID_BAR();
        for (int r = gw; r < MROWS; r += NGW) item_combineA(P, r, lane);
#ifdef DUP_P2B
        for (int rep_ = 0; rep_ < 2; ++rep_)
        for (;;) { const int u = next_unit(ctl + 64 * (layer * 2 + 1 + 8 * rep_), lds, tid); if (u >= 384 + 1024) break;
#ifdef DUP_NSA_ONLY
            if (rep_ == 1 && u >= 384) continue;
#endif
#else
        const int n_units_b = 384 + 1024 + ((P0_LAYERS == 1 && layer + 1 < DEPTH) ? N_CONV_UNITS : 0);
        for (;;) { const int u = next_unit(ctl + 64 * (layer * 2 + 1), lds, tid); if (u >= n_units_b) break;
            if (u >= 384 + 1024) {
                LAS float* scr = (LAS float*)(lds + wave * 16384); const int ln_ = lane_id_opaque();
                for (int k = 0; k < CONV_UNIT_ITEMS / NWAVES; ++k) { const int r = (u - 384 - 1024) * CONV_UNIT_ITEMS + wave * (CONV_UNIT_ITEMS / NWAVES) + k; if (r < I_LAYER) p0_layer_item(P, scr, layer + 1, r, ln_); }
                continue; }
#endif
            if (u < 384) {
#ifndef SKIP_NSA
                { const int ln_ = lane_id_opaque(); unit_nsa(P, lds, (u % 6) / 3, (u % 6) % 3, 63 - u / 6, wave * 64 + ln_, ln_, wave); }
#endif
            } else { const int v = u - 384;
#ifndef SKIP_MOBA
                { const int ln_ = lane_id_opaque(); unit_moba(P, lds, (v % 16) / 8, (v % 16) % 8, 63 - v / 16, wave * 64 + ln_, ln_, wave); }
#endif
            } }
        GRID_BAR();
        { pg8::Gemm gm{(const pg8::bf16_t*)(ws + WS_O), (const pg8::bf16_t*)(ws + WS_WOUT + layer * SZ_WOUT), MROWS, DM, DM};
          pg8::StaticOrder S; S.init(MROWS, DM, G, (int)blockIdx.x);
          pg8::EpiResid E{(pg8::bf16_t*)(ws + WS_XB), (float*)(ws + WS_SSP)};
          pg8::gemm_phase<pg8::EpiResid, pg8::StaticOrder, true, true>(lds, gm, S, E, wave); }
        GRID_BAR();
#ifdef FUSE_CONV
        { pg8::Gemm gm{(const pg8::bf16_t*)(ws + WS_XB), (const pg8::bf16_t*)(ws + WS_WUP + layer * SZ_WUP), MROWS, UPW, DM};
          pg8::StaticOrder S; S.init(MROWS, UPW, G, (int)blockIdx.x);
          pg8::EpiConvGate E{(pg8::bf16_t*)(ws + WS_ACT), (pg8::bf16_t*)(ws + WS_UB), (const float*)(ws + WS_SSP), P.conv_w + (size_t)layer * 3 * UPW, P.conv_b + (size_t)layer * UPW, DFF};
          pg8::gemm_phase<pg8::EpiConvGate, pg8::StaticOrder, true, true>(lds, gm, S, E, wave); }
        GRID_BAR();
        phase_convfix(P, layer, tid);
        GRID_BAR();
#else
        { pg8::Gemm gm{(const pg8::bf16_t*)(ws + WS_XB), (const pg8::bf16_t*)(ws + WS_WUP + layer * SZ_WUP), MROWS, UPW, DM};
          pg8::StaticOrder S; S.init(MROWS, UPW, G, (int)blockIdx.x);
          pg8::EpiScaleBf16 E{(pg8::bf16_t*)(ws + WS_U), UPW, (const float*)(ws + WS_SSP)};
#ifdef DUP_G3
          pg8::gemm_phase<pg8::EpiScaleBf16, pg8::StaticOrder, true, true>(lds, gm, S, E, wave);
#endif
          pg8::gemm_phase<pg8::EpiScaleBf16, pg8::StaticOrder, true, true>(lds, gm, S, E, wave); }
        GRID_BAR();
#ifndef SKIP_CONV
        phase_conv(P, layer, tid);
#ifdef DUP_CONV
        phase_conv(P, layer, tid);
#endif
#endif
        GRID_BAR();
#endif
        { pg8::Gemm gm{(const pg8::bf16_t*)(ws + WS_ACT), (const pg8::bf16_t*)(ws + WS_WDN + layer * SZ_WDN), MROWS, DM, DFF};
          pg8::StaticOrder S; S.init(MROWS, DM, G, (int)blockIdx.x);
          pg8::EpiResid E{(pg8::bf16_t*)(ws + WS_XB), (float*)(ws + WS_SSP)};
          pg8::gemm_phase<pg8::EpiResid, pg8::StaticOrder, true, true>(lds, gm, S, E, wave); }
        GRID_BAR();
    }
    const int wave = wave0, lane = lane_id_opaque();
    const int G = gridDim.x, gw = blockIdx.x * NWAVES + wave, NGW = G * NWAVES;
    unsigned char* ws = ws0; (void)G;
    for (int mrow = gw; mrow < MROWS; mrow += NGW) {
        const u32x2* xr = (const u32x2*)((const bf16_t*)(ws + WS_XB) + (size_t)mrow * DM) + lane; const f32x4* gr = (const f32x4*)P.norm_final + lane;
        f32x4 v[8]; float s = 0.f;
#pragma unroll
        for (int j = 0; j < 8; ++j) { const u32x2 w = xr[64 * j]; v[j] = (f32x4){bflo(w.x), bfhi(w.x), bflo(w.y), bfhi(w.y)}; s += (v[j][0] * v[j][0] + v[j][1] * v[j][1]) + (v[j][2] * v[j][2] + v[j][3] * v[j][3]); }
#pragma unroll
        for (int o = 1; o < 64; o <<= 1) s += __shfl_xor(s, o);
        const float rs = 1.0f / sqrtf(s * (1.0f / DM) + 1e-6f);
        f32x4* orow = (f32x4*)(P.out + (size_t)mrow * DM) + lane;
#pragma unroll
        for (int j = 0; j < 8; ++j) orow[64 * j] = v[j] * rs * gr[64 * j];
    }
}

extern "C" void kernel_launch(void* const* d_in, const int* in_sizes, int n_in, void* d_out, int out_size, void* d_ws, size_t ws_size, hipStream_t stream) {
    static int grid = 0;
    if (grid == 0) {
        if (n_in != 14 || ws_size < WS_END) { fprintf(stderr, "kernel_launch: unexpected n_in %d or workspace %zu < %zu\n", n_in, ws_size, (size_t)WS_END); grid = -1; return; }
        int dev = 0, cus = 0, per_cu = 0;
        hipGetDevice(&dev); hipDeviceGetAttribute(&cus, hipDeviceAttributeMultiprocessorCount, dev);
        if (hipFuncSetAttribute((const void*)fwd_megakernel, hipFuncAttributeMaxDynamicSharedMemorySize, LDS_BYTES) != hipSuccess) { fprintf(stderr, "kernel_launch: hipFuncSetAttribute failed\n"); grid = -1; return; }
        if (hipOccupancyMaxActiveBlocksPerMultiprocessor(&per_cu, (const void*)fwd_megakernel, NTHREADS, LDS_BYTES) != hipSuccess || per_cu < 1) { fprintf(stderr, "kernel_launch: occupancy query says %d\n", per_cu); per_cu = 1; }
        (void)hipGetLastError();
        grid = cus * 1;
    }
    if (grid < 0) return;
    hipMemsetAsync((char*)d_ws + WS_CTL, 0, CTL_BYTES, stream);
    Params p{};
    p.x = (const float*)d_in[0]; p.rel = (const float*)d_in[1]; p.w_in = (const float*)d_in[2]; p.w_out = (const float*)d_in[3]; p.cmp_w1 = (const float*)d_in[4]; p.cmp_w2 = (const float*)d_in[5];
    p.cmp_pe = (const float*)d_in[6]; p.norm_attn = (const float*)d_in[7]; p.norm_mlp = (const float*)d_in[8]; p.w_up = (const float*)d_in[9]; p.conv_w = (const float*)d_in[10]; p.conv_b = (const float*)d_in[11];
    p.w_down = (const float*)d_in[12]; p.norm_final = (const float*)d_in[13]; p.out = (float*)d_out; p.ws = (unsigned char*)d_ws;
    void* args[] = {&p};
    hipError_t e = hipLaunchCooperativeKernel((const void*)fwd_megakernel, dim3(grid), dim3(NTHREADS), args, LDS_BYTES, stream);
    if (e != hipSuccess) fprintf(stderr, "kernel_launch: cooperative launch failed: %s (grid %d)\n", hipGetErrorString(e), grid);
}
```

```cpp
#define FUSE_CONV
#define CONV_DPP
#include <hip/hip_runtime.h>
#include <hip/hip_cooperative_groups.h>
#include <cstdio>
#include <cstdint>
namespace cg = cooperative_groups;
namespace pg8 {
#define PG8_LAS __attribute__((address_space(3)))
typedef unsigned short bf16_t;
typedef short bf16x8 __attribute__((ext_vector_type(8)));
typedef float f32x4 __attribute__((ext_vector_type(4)));
typedef unsigned u32x4 __attribute__((ext_vector_type(4)));
constexpr int BM = 256, BK = 64, HALF = 128, HTB = HALF * BK * 2  , STAGE_BYTES = 8 * HTB, NXCD = 8, WGM = 8;

__host__ __device__ __forceinline__ int lds_byte(int r, int c) { const int st = (r >> 4) * 2 + (c >> 5), rr = r & 15, cc = c & 31, ob = rr * 64 + cc * 2; return st * 1024 + (ob ^ (((ob >> 9) & 1) << 5)); }
__host__ __device__ __forceinline__ void stage_rc(int b, int& R, int& C) { const int st = b / 1024, sb = b % 1024, swz = sb ^ (((sb >> 9) & 1) << 5); R = (st >> 1) * 16 + swz / 64; C = (st & 1) * 32 + (swz % 64) / 2; }
__host__ __device__ __forceinline__ int perm32(int rho) { const int n = rho >> 4, i = rho & 15; return 8 * (i >> 2) + 4 * n + (i & 3); }

struct Unit { int pm, pn; };
struct Gemm { const bf16_t* A; const bf16_t* Bt; int M, N, K; };

struct StaticOrder {
    int nM, nN, nwg, G, c;
    __host__ __device__ void init(int M, int N, int G_, int c_) { nM = M / BM; nN = N / BM; nwg = nM * nN; G = G_; c = c_; }
    __host__ __device__ bool next(int i, Unit& u) const {
        const long L = (long)i * G + c; if (L >= nwg) return false;
        int wgid = (int)L; { const int q = nwg / NXCD, r = nwg % NXCD, xcd = wgid % NXCD, off = wgid / NXCD; wgid = (xcd < r ? xcd * (q + 1) : r * (q + 1) + (xcd - r) * q) + off; }
        const int nig = WGM * nN, gid = wgid / nig, fm = gid * WGM, gsz = (nM - fm) < WGM ? (nM - fm) : WGM;
        u.pm = fm + ((wgid % nig) % gsz); u.pn = (wgid % nig) / gsz; return true;
    }
    __device__ __forceinline__ void a_ready(const Unit&) const {}
    __device__ __forceinline__ void done(const Unit&) const {}
};
typedef float f32x2 __attribute__((ext_vector_type(2)));
typedef __bf16 bf16x2_pk __attribute__((ext_vector_type(2)));
__device__ __forceinline__ unsigned cvt_pk_bf16(float lo, float hi) { f32x2 v = {lo, hi}; bf16x2_pk b = __builtin_convertvector(v, bf16x2_pk); return __builtin_bit_cast(unsigned, b); }
__device__ __forceinline__ float row_rstd(const float* ssp, int row) {
    const f32x4* p = (const f32x4*)(ssp + (size_t)row * 32); float s = 0.f;
#pragma unroll
    for (int i = 0; i < 8; ++i) { const f32x4 v = p[i]; s += (v[0] + v[1]) + (v[2] + v[3]); }
    return 1.0f / sqrtf(s * (1.0f / 2048.0f) + 1e-6f);
}
struct EpiScaleBf16 {
    static constexpr bool PERM = true, AFTER_DRAIN = false;
    bf16_t* O; int ldc; const float* ssp;
    __device__ __forceinline__ void operator()(const f32x4 (&acc)[2][2][4][2], const Unit& u, int wr, int wc, int fr, int fq) const {
        const int lane = fq * 16 + fr;
        const int rbase = u.pm * BM + wr * 64;
        f32x4 t[2][8];
#pragma unroll
        for (int j = 0; j < 2; ++j) { const int q = 2 * lane + j; const int row = rbase + (q >> 6) * HALF + (q & 63);
            const f32x4* p = (const f32x4*)(ssp + (size_t)row * 32);
#pragma unroll
            for (int i = 0; i < 8; ++i) t[j][i] = p[i]; }
        __builtin_amdgcn_sched_barrier(0);
        float rsv[2];
#pragma unroll
        for (int j = 0; j < 2; ++j) { float sm = 0.f;
#pragma unroll
            for (int i = 0; i < 8; ++i) sm += (t[j][i][0] + t[j][i][1]) + (t[j][i][2] + t[j][i][3]);
            rsv[j] = 1.0f / sqrtf(sm * (1.0f / 2048.0f) + 1e-6f); }
        const int row0 = rbase + fr; const int col0 = u.pn * BM + wc * 32 + 8 * fq;
#pragma unroll
        for (int ai = 0; ai < 2; ++ai)
#pragma unroll
            for (int m = 0; m < 4; ++m) { const int q = ai * 64 + m * 16 + fr; const float v0 = __shfl(rsv[0], q >> 1), v1 = __shfl(rsv[1], q >> 1); const float rs = (q & 1) ? v1 : v0;
                bf16_t* rowp = O + (size_t)(row0 + ai * HALF + m * 16) * ldc + col0;
#pragma unroll
                for (int bj = 0; bj < 2; ++bj) { const f32x4 v0_ = acc[ai][bj][m][0] * rs, v1_ = acc[ai][bj][m][1] * rs; u32x4 w;
                    w.x = cvt_pk_bf16(v0_[0], v0_[1]); w.y = cvt_pk_bf16(v0_[2], v0_[3]); w.z = cvt_pk_bf16(v1_[0], v1_[1]); w.w = cvt_pk_bf16(v1_[2], v1_[3]);
                    *(u32x4*)(rowp + bj * HALF) = w; } }
    }
};
struct EpiResid {
    static constexpr bool PERM = false, AFTER_DRAIN = false;
    bf16_t* XB; float* ssp;
    __device__ __forceinline__ void operator()(const f32x4 (&acc)[2][2][4][2], const Unit& u, int wr, int wc, int fr, int fq) const {
        typedef unsigned u32x2v __attribute__((ext_vector_type(2)));
        const int row0 = u.pm * BM + wr * 64 + fr; const int col0 = u.pn * BM + wc * 32 + 4 * fq;
#pragma unroll
        for (int ai = 0; ai < 2; ++ai) {
            u32x2v bs[4][2][2];
#pragma unroll
            for (int m = 0; m < 4; ++m)
#pragma unroll
                for (int bj = 0; bj < 2; ++bj)
#pragma unroll
                    for (int n = 0; n < 2; ++n) bs[m][bj][n] = *(const u32x2v*)(XB + (size_t)(row0 + ai * HALF + m * 16) * 2048 + col0 + bj * HALF + n * 16);
            __builtin_amdgcn_sched_barrier(0);
#pragma unroll
            for (int m = 0; m < 4; ++m) { const int row = row0 + ai * HALF + m * 16; const size_t off = (size_t)row * 2048 + col0; float ss = 0.f;
#pragma unroll
                for (int bj = 0; bj < 2; ++bj)
#pragma unroll
                    for (int n = 0; n < 2; ++n) { const size_t o2 = off + bj * HALF + n * 16; const u32x2v b2 = bs[m][bj][n];
                        const f32x4 bv = {__uint_as_float(b2.x << 16), __uint_as_float(b2.x & 0xffff0000u), __uint_as_float(b2.y << 16), __uint_as_float(b2.y & 0xffff0000u)};
                        const f32x4 v = bv + acc[ai][bj][m][n];
                        u32x2v w; w.x = cvt_pk_bf16(v[0], v[1]); w.y = cvt_pk_bf16(v[2], v[3]); *(u32x2v*)(XB + o2) = w;
                        ss += (v[0] * v[0] + v[1] * v[1]) + (v[2] * v[2] + v[3] * v[3]); }
                ss += __shfl_xor(ss, 16); ss += __shfl_xor(ss, 32);
                if (fq == 0) ssp[(size_t)row * 32 + u.pn * 4 + wc] = ss; }
            asm volatile("" ::: "memory");
        }
    }
};
template <int CTRL> __device__ __forceinline__ float dpp_f(float v) { return __builtin_bit_cast(float, __builtin_amdgcn_update_dpp(0, __builtin_bit_cast(int, v), CTRL, 0xf, 0xf, false)); }
#ifdef CONV_DPP
#define ROWM1(v) dpp_f<0x121>(v)
#define ROWM2(v) dpp_f<0x122>(v)
#else
#define ROWM1(v) __shfl(v, src1)
#define ROWM2(v) __shfl(v, src2)
#endif
struct EpiConvGate {
    static constexpr bool PERM = true, AFTER_DRAIN = false;
    bf16_t* ACT; bf16_t* UB; const float* ssp; const float* cw; const float* cb; int dff;
    __device__ __forceinline__ void operator()(const f32x4 (&acc)[2][2][4][2], const Unit& u, int wr, int wc, int fr, int fq) const {
        typedef unsigned u32x2v __attribute__((ext_vector_type(2)));
        const int lane = fq * 16 + fr;
        const int rbase = u.pm * BM + wr * 64;
        const int upw = 2 * dff;
        float rsv[2];
        { f32x4 t[2][8];
#pragma unroll
          for (int j = 0; j < 2; ++j) { const int q = 2 * lane + j; const int row = rbase + (q >> 6) * HALF + (q & 63);
              const f32x4* p = (const f32x4*)(ssp + (size_t)row * 32);
#pragma unroll
              for (int i = 0; i < 8; ++i) t[j][i] = p[i]; }
          __builtin_amdgcn_sched_barrier(0);
#pragma unroll
          for (int j = 0; j < 2; ++j) { float sm = 0.f;
#pragma unroll
              for (int i = 0; i < 8; ++i) sm += (t[j][i][0] + t[j][i][1]) + (t[j][i][2] + t[j][i][3]);
              rsv[j] = 1.0f / sqrtf(sm * (1.0f / 2048.0f) + 1e-6f); } }
        const int src1 = fq * 16 + ((fr + 15) & 15), src2 = fq * 16 + ((fr + 14) & 15); (void)src1; (void)src2;
        const int chb = u.pn * HALF + wc * 32 + 8 * fq;
        const int ucb = u.pn * BM + wc * 32 + 8 * fq;
#pragma unroll
        for (int n = 0; n < 2; ++n) {
            const int ch = chb + 4 * n;
            const f32x4 wa0 = *(const f32x4*)(cw + ch), wa1 = *(const f32x4*)(cw + upw + ch), wa2 = *(const f32x4*)(cw + 2 * upw + ch);
            const f32x4 wg0 = *(const f32x4*)(cw + dff + ch), wg1 = *(const f32x4*)(cw + upw + dff + ch), wg2 = *(const f32x4*)(cw + 2 * upw + dff + ch);
            const f32x4 ba = *(const f32x4*)(cb + ch), bg = *(const f32x4*)(cb + dff + ch);
            __builtin_amdgcn_sched_barrier(0);
#pragma unroll
            for (int ai = 0; ai < 2; ++ai) {
                f32x4 pa = {0.f, 0.f, 0.f, 0.f}, pg = {0.f, 0.f, 0.f, 0.f};
#pragma unroll
                for (int m = 0; m < 4; ++m) {
                    const int q = ai * 64 + m * 16 + fr; const float rv0 = __shfl(rsv[0], q >> 1), rv1 = __shfl(rsv[1], q >> 1); const float rsm = (q & 1) ? rv1 : rv0;
                    const f32x4 va = acc[ai][0][m][n] * rsm, vg = acc[ai][1][m][n] * rsm;
                    f32x4 a1, a2, g1, g2;
#pragma unroll
                    for (int x = 0; x < 4; ++x) {
                        const float c1 = ROWM1(va[x]), c2 = ROWM2(va[x]), e1 = ROWM1(vg[x]), e2 = ROWM2(vg[x]);
                        float d1 = 0.f, d2 = 0.f, f1 = 0.f, f2 = 0.f;
                        if (m > 0) { d1 = ROWM1(pa[x]); d2 = ROWM2(pa[x]); f1 = ROWM1(pg[x]); f2 = ROWM2(pg[x]); }
                        a1[x] = fr >= 1 ? c1 : d1; a2[x] = fr >= 2 ? c2 : d2; g1[x] = fr >= 1 ? e1 : f1; g2[x] = fr >= 2 ? e2 : f2; }
                    const f32x4 ya = ba + wa0 * va + wa1 * a1 + wa2 * a2, yg = bg + wg0 * vg + wg1 * g1 + wg2 * g2;
                    float r4[4];
#pragma unroll
                    for (int x = 0; x < 4; ++x) r4[x] = ya[x] * yg[x] / (1.f + __expf(-yg[x]));
                    const int row = rbase + ai * HALF + m * 16 + fr;
                    if (m > 0 || fr >= 2) { u32x2v w; w.x = cvt_pk_bf16(r4[0], r4[1]); w.y = cvt_pk_bf16(r4[2], r4[3]); *(u32x2v*)(ACT + (size_t)row * dff + ch) = w; }
                    if ((m == 0 && fr < 2) || (m == 3 && fr >= 14)) { const int k = (m == 0) ? fr : fr - 12; bf16_t* ub = UB + ((size_t)(row >> 6) * 4 + k) * upw + ucb + 4 * n;
                        u32x2v w; w.x = cvt_pk_bf16(va[0], va[1]); w.y = cvt_pk_bf16(va[2], va[3]); *(u32x2v*)ub = w;
                        w.x = cvt_pk_bf16(vg[0], vg[1]); w.y = cvt_pk_bf16(vg[2], vg[3]); *(u32x2v*)(ub + HALF) = w; }
                    pa = va; pg = vg;
                }
                asm volatile("" ::: "memory");
            }
        }
    }
};
template <class Epi, class Sched, bool ALIGN_EPI = false, bool SP2 = false>
__device__ __forceinline__ void gemm_phase(PG8_LAS unsigned char* lds, const Gemm g, const Sched& S, const Epi& E, const int wid_in) {
    int lane_; asm volatile("v_mbcnt_lo_u32_b32 %0, -1, 0\n\tv_mbcnt_hi_u32_b32 %0, -1, %0" : "=v"(lane_)); const int wid = wid_in, lane = lane_, tid = wid * 64 + lane, wr = wid >> 2, wc = wid & 3, fr = lane & 15, fq = lane >> 4;
    const int K = g.K, nt = K / BK;
    unsigned voffA[2], voffB[2];
#pragma unroll
    for (int i = 0; i < 2; ++i) { int R, C; stage_rc(tid * 16 + i * 8192, R, C); const int Rb = Epi::PERM ? ((R & ~31) + perm32(R & 31)) : R;
        voffA[i] = (unsigned)(R * K + C) * 2u; voffB[i] = (unsigned)(Rb * K + C) * 2u; }
    const size_t kstep = (size_t)(BK * 2);
    const size_t hstep = (size_t)HALF * K * 2;
    const size_t tstep = 2 * hstep;
    const unsigned ldsw = (unsigned)wid * 1024u;
    const int aoff = lds_byte(wr * 64 + fr, fq * 8), boff = lds_byte(wc * 32 + fr, fq * 8);
#define PG8_SA(b, h) (((b) * 2 + (h)) * HTB)
#define PG8_SB(b, h) ((4 + (b) * 2 + (h)) * HTB)
#define PG8_STAGE(bufoff, gbase, voff) do { _Pragma("unroll") for (int _i = 0; _i < 2; ++_i) \
        __builtin_amdgcn_global_load_lds((const unsigned*)((const char*)(gbase) + (voff)[_i]), (PG8_LAS unsigned*)(lds + (bufoff) + ldsw + _i * 8192), 16, 0, 0); } while (0)
#define PG8_LDA(dst, b, h) do { _Pragma("unroll") for (int m = 0; m < 4; ++m) _Pragma("unroll") for (int k = 0; k < 2; ++k) dst[m][k] = *(const PG8_LAS bf16x8*)(lds + PG8_SA(b, h) + aoff + m * 2048 + k * 1024); } while (0)
#define PG8_LDB(dst, b, h) do { _Pragma("unroll") for (int n = 0; n < 2; ++n) _Pragma("unroll") for (int k = 0; k < 2; ++k) dst[n][k] = *(const PG8_LAS bf16x8*)(lds + PG8_SB(b, h) + boff + n * 2048 + k * 1024); } while (0)
#define PG8_MMA(ai, bj, At, Bt) do { __builtin_amdgcn_s_setprio(1); _Pragma("unroll") for (int m = 0; m < 4; ++m) _Pragma("unroll") for (int n = 0; n < 2; ++n) _Pragma("unroll") for (int k = 0; k < 2; ++k) \
        acc[ai][bj][m][n] = __builtin_amdgcn_mfma_f32_16x16x32_bf16(Bt[n][k], At[m][k], acc[ai][bj][m][n], 0, 0, 0); __builtin_amdgcn_s_setprio(0); } while (0)
#define PG8_WAIT_V(n) asm volatile("s_waitcnt vmcnt(" #n ")" ::: "memory")
#define PG8_WAIT_L(n) asm volatile("s_waitcnt lgkmcnt(" #n ")" ::: "memory")
#define PG8_BAR __builtin_amdgcn_s_barrier()
#define PG8_SCHED __builtin_amdgcn_sched_barrier(0)
    Unit cur, nxt; int ui = 0;
    if (!S.next(0, cur)) return;
    f32x4 acc[2][2][4][2];
#pragma unroll
    for (int a = 0; a < 2; ++a)
#pragma unroll
        for (int b = 0; b < 2; ++b)
#pragma unroll
            for (int m = 0; m < 4; ++m)
#pragma unroll
                for (int n = 0; n < 2; ++n) acc[a][b][m][n] = (f32x4){0.f, 0.f, 0.f, 0.f};
    bf16x8 At[4][2], B0[2][2], B1[2][2];
    const char* cA = (const char*)g.A + (size_t)cur.pm * tstep; const char* cB = (const char*)g.Bt + (size_t)cur.pn * tstep;
    S.a_ready(cur);
    if constexpr (SP2) {
        PG8_STAGE(PG8_SB(0, 0), cB, voffB); PG8_STAGE(PG8_SB(0, 1), cB + hstep, voffB); PG8_STAGE(PG8_SA(0, 0), cA, voffA); PG8_STAGE(PG8_SA(0, 1), cA + hstep, voffA);
        if (wr == 1) PG8_BAR;
        PG8_WAIT_V(2); PG8_BAR;
        PG8_STAGE(PG8_SB(1, 0), cB + kstep, voffB); PG8_STAGE(PG8_SA(1, 0), cA + kstep, voffA); PG8_STAGE(PG8_SB(1, 1), cB + hstep + kstep, voffB);
        PG8_WAIT_V(6); PG8_BAR;
    } else {
        PG8_STAGE(PG8_SB(0, 0), cB, voffB); PG8_STAGE(PG8_SA(0, 0), cA, voffA); PG8_STAGE(PG8_SB(0, 1), cB + hstep, voffB); PG8_STAGE(PG8_SA(0, 1), cA + hstep, voffA);
        if (wr == 1) PG8_BAR;
        PG8_WAIT_V(4); PG8_BAR;
        PG8_STAGE(PG8_SB(1, 0), cB + kstep, voffB); PG8_STAGE(PG8_SA(1, 0), cA + kstep, voffA); PG8_STAGE(PG8_SB(1, 1), cB + hstep + kstep, voffB);
        PG8_WAIT_V(6); PG8_BAR;
    }
    for (;;) {
        const bool has_next = S.next(ui + 1, nxt);
        const char* nA = has_next ? (const char*)g.A + (size_t)nxt.pm * tstep : cA; const char* nB = has_next ? (const char*)g.Bt + (size_t)nxt.pn * tstep : cB;
        for (int t = 0; t < nt; t += 2) {
            const bool last = (t == nt - 2);
            const char* a1 = cA + (size_t)(t + 1) * kstep;
            const char* a2 = last ? nA : cA + (size_t)(t + 2) * kstep; const char* b2 = last ? nB : cB + (size_t)(t + 2) * kstep;
            const char* a3 = a2 + kstep; const char* b3 = b2 + kstep;
            if (last && has_next) S.a_ready(nxt);
            if constexpr (SP2) {
            PG8_LDB(B0, 0, 0); PG8_LDB(B1, 0, 1); PG8_SCHED; PG8_LDA(At, 0, 0); PG8_STAGE(PG8_SA(1, 1), a1 + hstep, voffA);
            PG8_WAIT_V(8); PG8_WAIT_L(0); PG8_BAR; PG8_MMA(0, 0, At, B0); PG8_MMA(0, 1, At, B1); PG8_BAR; PG8_SCHED;
            PG8_LDA(At, 0, 1); PG8_STAGE(PG8_SB(0, 0), b2, voffB); PG8_STAGE(PG8_SB(0, 1), b2 + hstep, voffB); PG8_STAGE(PG8_SA(0, 0), a2, voffA);
            PG8_WAIT_V(8); PG8_WAIT_L(0); PG8_BAR; PG8_MMA(1, 0, At, B0); PG8_MMA(1, 1, At, B1); PG8_BAR; PG8_SCHED;
            PG8_LDB(B0, 1, 0); PG8_LDB(B1, 1, 1); PG8_SCHED; PG8_LDA(At, 1, 0); PG8_STAGE(PG8_SA(0, 1), a2 + hstep, voffA);
            PG8_WAIT_V(8); PG8_WAIT_L(0); PG8_BAR; PG8_MMA(0, 0, At, B0); PG8_MMA(0, 1, At, B1); PG8_BAR; PG8_SCHED;
            PG8_LDA(At, 1, 1); PG8_STAGE(PG8_SB(1, 0), b3, voffB); PG8_STAGE(PG8_SB(1, 1), b3 + hstep, voffB); PG8_STAGE(PG8_SA(1, 0), a3, voffA);
            PG8_WAIT_V(8); PG8_WAIT_L(0); PG8_BAR; PG8_MMA(1, 0, At, B0); PG8_MMA(1, 1, At, B1); PG8_BAR; PG8_SCHED;
            } else {
            PG8_LDB(B0, 0, 0); PG8_SCHED; PG8_LDA(At, 0, 0); PG8_STAGE(PG8_SA(1, 1), a1 + hstep, voffA);
            PG8_WAIT_L(8); PG8_BAR; PG8_WAIT_L(0); PG8_MMA(0, 0, At, B0); PG8_BAR; PG8_SCHED;
            PG8_LDB(B1, 0, 1); PG8_STAGE(PG8_SB(0, 0), b2, voffB);
            PG8_BAR; PG8_WAIT_L(0); PG8_MMA(0, 1, At, B1); PG8_BAR;
            PG8_LDA(At, 0, 1); PG8_STAGE(PG8_SA(0, 0), a2, voffA);
            PG8_BAR; PG8_WAIT_L(0); PG8_MMA(1, 0, At, B0); PG8_BAR; PG8_SCHED;
            PG8_STAGE(PG8_SB(0, 1), b2 + hstep, voffB);
            PG8_WAIT_V(6); PG8_BAR; PG8_MMA(1, 1, At, B1); PG8_BAR;
            PG8_LDB(B0, 1, 0); PG8_SCHED; PG8_LDA(At, 1, 0); PG8_STAGE(PG8_SA(0, 1), a2 + hstep, voffA);
            PG8_WAIT_L(8); PG8_BAR; PG8_WAIT_L(0); PG8_MMA(0, 0, At, B0); PG8_BAR; PG8_SCHED;
            PG8_LDB(B1, 1, 1); PG8_STAGE(PG8_SB(1, 0), b3, voffB);
            PG8_BAR; PG8_WAIT_L(0); PG8_MMA(0, 1, At, B1); PG8_BAR;
            PG8_LDA(At, 1, 1); PG8_STAGE(PG8_SA(1, 0), a3, voffA);
            PG8_BAR; PG8_WAIT_L(0); PG8_MMA(1, 0, At, B0); PG8_BAR; PG8_SCHED;
            PG8_STAGE(PG8_SB(1, 1), b3 + hstep, voffB);
            PG8_WAIT_V(6); PG8_BAR; PG8_MMA(1, 1, At, B1); PG8_BAR;
            }
        }
        if constexpr (ALIGN_EPI) { if (wr == 0) PG8_BAR; }
        if constexpr (!Epi::AFTER_DRAIN) { E(acc, cur, wr, wc, fr, fq); S.done(cur); }
        if (!has_next) break;
#pragma unroll
        for (int a = 0; a < 2; ++a)
#pragma unroll
            for (int b = 0; b < 2; ++b)
#pragma unroll
                for (int m = 0; m < 4; ++m)
#pragma unroll
                    for (int n = 0; n < 2; ++n) acc[a][b][m][n] = (f32x4){0.f, 0.f, 0.f, 0.f};
        cur = nxt; cA = nA; cB = nB; ++ui;
        if constexpr (ALIGN_EPI) { if (wr == 1) PG8_BAR; }
    }
    PG8_WAIT_V(0);
    if constexpr (!ALIGN_EPI) { if (wr == 0) PG8_BAR; }
    PG8_BAR;
    if constexpr (Epi::AFTER_DRAIN) { E.fused(acc, cur, wr, wc, fr, fq, lds, wid, lane); S.done(cur); }
#undef PG8_SA
#undef PG8_SB
#undef PG8_STAGE
#undef PG8_LDA
#undef PG8_LDB
#undef PG8_MMA
#undef PG8_WAIT_V
#undef PG8_WAIT_L
#undef PG8_BAR
#undef PG8_SCHED
}
}

#define GAS __attribute__((address_space(1)))
#define LAS __attribute__((address_space(3)))
typedef unsigned short bf16_t;
typedef short bf16x8 __attribute__((ext_vector_type(8)));
typedef float f32x4 __attribute__((ext_vector_type(4)));
typedef unsigned u32x4 __attribute__((ext_vector_type(4)));
typedef unsigned u32x2 __attribute__((ext_vector_type(2)));
typedef short s16x4 __attribute__((ext_vector_type(4)));

constexpr int BATCH = 2, SEQ = 8192, DM = 2048, DEPTH = 4, MROWS = BATCH * SEQ;
constexpr int INW = 5796, INP = 5888, DFF = 5632, UPW = 2 * DFF;
constexpr int A_OFF = 0, B_OFF = 2304, CQ_OFF = 3840, CKV_OFF = 4608, CG_OFF = 5760;
constexpr int LUTN = 1536;
constexpr float LOG2E = 1.4426950408889634f, LN2 = 0.6931471805599453f;
constexpr int NTHREADS = 512, NWAVES = 8;

constexpr size_t al256(size_t x) { return (x + 255) & ~(size_t)255; }
constexpr size_t WS_CTL = 0, CTL_BYTES = 1u << 20;
constexpr size_t SZ_WIN = (size_t)INP * DM * 2, SZ_WOUT = (size_t)DM * DM * 2, SZ_WUP = (size_t)UPW * DM * 2, SZ_WDN = (size_t)DM * DFF * 2;
constexpr size_t WS_WIN = CTL_BYTES;
constexpr size_t WS_WOUT = WS_WIN + DEPTH * SZ_WIN;
constexpr size_t WS_WUP = WS_WOUT + DEPTH * SZ_WOUT;
constexpr size_t WS_WDN = WS_WUP + DEPTH * SZ_WUP;
constexpr size_t WS_W1T = WS_WDN + DEPTH * SZ_WDN;
constexpr size_t WS_W2T = WS_W1T + (size_t)DEPTH * 2 * 128 * 2048 * 2;
constexpr size_t WS_CPE = WS_W2T + (size_t)DEPTH * 2 * 64 * 128 * 2;
constexpr size_t WS_GLUT = al256(WS_CPE + (size_t)DEPTH * 2 * 128 * 4);
constexpr size_t WS_X = al256(WS_GLUT + (size_t)32 * LUTN * 4);
constexpr size_t WS_XB = WS_X + (size_t)MROWS * DM * 4;
constexpr size_t WS_SSP = WS_XB + (size_t)MROWS * DM * 2;
constexpr size_t WS_R1 = WS_SSP + (size_t)MROWS * 32 * 4;
constexpr size_t WS_PROJ = WS_R1;
constexpr size_t WS_O = WS_R1 + (size_t)MROWS * INP * 2;
constexpr size_t WS_U = WS_R1;
constexpr size_t SZ_R1 = (size_t)MROWS * UPW * 2;
static_assert((size_t)MROWS * INP * 2 + (size_t)MROWS * DM * 2 <= SZ_R1, "overlay");
constexpr size_t WS_ACT = WS_R1 + SZ_R1;
constexpr size_t WS_TOT = WS_ACT + (size_t)MROWS * DFF * 2;
constexpr size_t WS_LSE = WS_TOT + (size_t)MROWS * 768 * 4;
constexpr size_t WS_KC = WS_LSE + (size_t)MROWS * 12 * 4;
constexpr size_t WS_VC = WS_KC + (size_t)BATCH * 3 * 512 * 64 * 2;
constexpr size_t WS_KMEAN = WS_VC + (size_t)BATCH * 3 * 512 * 64 * 2;
constexpr size_t WS_UB = WS_KMEAN + (size_t)BATCH * 8 * 32 * 64 * 4;
constexpr size_t WS_END = WS_UB + (size_t)(MROWS / 64) * 4 * UPW * 2;

constexpr int KP = 160;
constexpr int TILE_B = 64 * KP;
constexpr int L_K0 = 0, L_V0 = TILE_B, L_K1 = 2 * TILE_B, L_V1 = 3 * TILE_B;
constexpr int L_LUT = 4 * TILE_B;
constexpr int L_IMP = L_LUT + 4 * LUTN * 4;
constexpr int L_SEL = L_IMP + 65536;
constexpr int L_TL = L_SEL + 2048;
constexpr int L_MISC = L_TL + 2048;
constexpr int L_WUN = L_MISC + 64;
constexpr int LDS_BYTES = 147456;
static_assert(L_MISC + 256 <= LDS_BYTES, "lds map");

struct Params {
    const float* x; const float* rel; const float* w_in; const float* w_out; const float* cmp_w1; const float* cmp_w2; const float* cmp_pe;
    const float* norm_attn; const float* norm_mlp; const float* w_up; const float* conv_w; const float* conv_b; const float* w_down; const float* norm_final;
    float* out; unsigned char* ws;
};

typedef float f32x2_t __attribute__((ext_vector_type(2))); typedef __bf16 bf16x2_t __attribute__((ext_vector_type(2)));
__device__ __forceinline__ unsigned cvtpk(float lo, float hi) { f32x2_t v = {lo, hi}; bf16x2_t b = __builtin_convertvector(v, bf16x2_t); return __builtin_bit_cast(unsigned, b); }
__device__ __forceinline__ float bf2f(unsigned short b) { return __uint_as_float(((unsigned)b) << 16); }
__device__ __forceinline__ float bflo(unsigned w) { return __uint_as_float(w << 16); }
__device__ __forceinline__ float bfhi(unsigned w) { return __uint_as_float(w & 0xffff0000u); }
__device__ __forceinline__ float fexp2(float x) { return __builtin_amdgcn_exp2f(x); }
__device__ __forceinline__ int lane_id_opaque() { int l_; asm volatile("v_mbcnt_lo_u32_b32 %0, -1, 0\n\tv_mbcnt_hi_u32_b32 %0, -1, %0" : "=v"(l_)); return l_; }
#define LDS_BARRIER() do { asm volatile("s_waitcnt lgkmcnt(0)" ::: "memory"); __builtin_amdgcn_s_barrier(); asm volatile("" ::: "memory"); } while (0)
__device__ __forceinline__ float fma_1(float a, float b, float c) { float r; asm("v_fma_f32 %0, %1, %2, %3" : "=v"(r) : "v"(a), "v"(b), "v"(c)); return r; }
__device__ __forceinline__ float xrow16_max(float x) {
  auto s_ = __builtin_amdgcn_permlane16_swap(__float_as_uint(x), __float_as_uint(x), false, false);
  x = fmaxf(__uint_as_float(s_[0]), __uint_as_float(s_[1]));
  auto t_ = __builtin_amdgcn_permlane32_swap(__float_as_uint(x), __float_as_uint(x), false, false);
  return fmaxf(__uint_as_float(t_[0]), __uint_as_float(t_[1]));
}
__device__ __forceinline__ float xrow16_sum(float x) {
  auto s_ = __builtin_amdgcn_permlane16_swap(__float_as_uint(x), __float_as_uint(x), false, false);
  x = __uint_as_float(s_[0]) + __uint_as_float(s_[1]);
  auto t_ = __builtin_amdgcn_permlane32_swap(__float_as_uint(x), __float_as_uint(x), false, false);
  return __uint_as_float(t_[0]) + __uint_as_float(t_[1]);
}
__device__ __forceinline__ void lds_wait() { asm volatile("s_waitcnt lgkmcnt(0)" ::: "memory"); }
__device__ __forceinline__ s16x4 tr_read(const LAS unsigned char* p) { return __builtin_bit_cast(s16x4, __builtin_amdgcn_ds_read_tr16_b64_v4i16((LAS s16x4*)p)); }
__device__ __forceinline__ f32x4 mfma16(bf16x8 a, bf16x8 b, f32x4 c) { return __builtin_amdgcn_mfma_f32_16x16x32_bf16(a, b, c, 0, 0, 0); }

__device__ __forceinline__ int t5_bucket(int n) {
    if (n < 16) return n < 0 ? 0 : n;
    int b = 16;
    b += n >= 22; b += n >= 30; b += n >= 40; b += n >= 54; b += n >= 73; b += n >= 99; b += n >= 134; b += n >= 182;
    b += n >= 246; b += n >= 332; b += n >= 450; b += n >= 609; b += n >= 825; b += n >= 1117; b += n >= 1513;
    return b;
}
__device__ __forceinline__ bool is_qcol(int n) { return (n < 2304) ? ((n % 768) < 256) : ((n < 2816) || (n >= 3840 && n < 4608)); }

template <int MODE>
__device__ __forceinline__ void p0_item(const float* W, int K, int Nsrc, bf16_t* WT, const float* kscale, LAS float* scr, int kb, int nb, int lane) {
    const int k0 = 64 * kb, n0 = 32 * nb;
    const int nd = n0 + (lane & 31);
    int sc = nd; float cs = 1.f; bool ok = true;
    if (MODE == 0) { ok = nd < INW; if (is_qcol(nd)) cs = 0.125f; }
    if (MODE == 2) { const int pn = nd >> 8, r = nd & 255; sc = (r >= 128 ? DFF : 0) + 128 * pn + (r & 127); }
    float wv[32], kv_[32];
    const float* wp_ = W + (size_t)(k0 + (lane >> 5)) * Nsrc + (ok ? sc : 0);
#pragma unroll
    for (int i = 0; i < 32; ++i) { wv[i] = wp_[(size_t)(2 * i) * Nsrc]; kv_[i] = (MODE != 1) ? kscale[k0 + 2 * i + (lane >> 5)] : 1.f; }
    __builtin_amdgcn_sched_barrier(0);
#pragma unroll
    for (int i = 0; i < 32; ++i) { const int kk = 2 * i + (lane >> 5); scr[kk * 33 + (lane & 31)] = ok ? wv[i] * cs * kv_[i] : 0.f; }
    lds_wait();
    const int c = lane & 7;
#pragma unroll
    for (int j = 0; j < 4; ++j) { const int n = (lane >> 3) + 8 * j; const LAS float* s = scr + (8 * c) * 33 + n;
        u32x4 o; o.x = cvtpk(s[0 * 33], s[1 * 33]); o.y = cvtpk(s[2 * 33], s[3 * 33]); o.z = cvtpk(s[4 * 33], s[5 * 33]); o.w = cvtpk(s[6 * 33], s[7 * 33]);
        *(u32x4*)(WT + (size_t)(n0 + n) * K + k0 + 8 * c) = o; }
    lds_wait();
}

constexpr int I_IN = 32 * (INP / 32), I_OUT = 32 * 64, I_UP = 32 * (UPW / 32), I_DN = (DFF / 64) * 64, I_W1 = 2 * 32 * 4, I_W2 = 2 * 2 * 2;
constexpr int I_LAYER = I_IN + I_OUT + I_UP + I_DN + I_W1 + I_W2;
__device__ __forceinline__ void p0_layer_item(const Params& P, LAS float* scr, int l, int r, int lane) {
    unsigned char* ws = P.ws;
    if (r < I_IN) { p0_item<0>(P.w_in + (size_t)l * DM * INW, DM, INW, (bf16_t*)(ws + WS_WIN + l * SZ_WIN), P.norm_attn + l * DM, scr, r / (INP / 32), r % (INP / 32), lane); return; } r -= I_IN;
    if (r < I_OUT) { p0_item<1>(P.w_out + (size_t)l * DM * DM, DM, DM, (bf16_t*)(ws + WS_WOUT + l * SZ_WOUT), nullptr, scr, r / 64, r % 64, lane); return; } r -= I_OUT;
    if (r < I_UP) { p0_item<2>(P.w_up + (size_t)l * DM * UPW, DM, UPW, (bf16_t*)(ws + WS_WUP + l * SZ_WUP), P.norm_mlp + l * DM, scr, r / (UPW / 32), r % (UPW / 32), lane); return; } r -= I_UP;
    if (r < I_DN) { p0_item<1>(P.w_down + (size_t)l * DFF * DM, DFF, DM, (bf16_t*)(ws + WS_WDN + l * SZ_WDN), nullptr, scr, r / 64, r % 64, lane); return; } r -= I_DN;
    if (r < I_W1) { const int i = r / 128, rr = r % 128; p0_item<1>(P.cmp_w1 + (size_t)(l * 2 + i) * 2048 * 128, 2048, 128, (bf16_t*)(ws + WS_W1T) + (size_t)(l * 2 + i) * 128 * 2048, nullptr, scr, rr / 4, rr % 4, lane); return; } r -= I_W1;
    { const int i = r / 4, rr = r % 4; p0_item<1>(P.cmp_w2 + (size_t)(l * 2 + i) * 128 * 64, 128, 64, (bf16_t*)(ws + WS_W2T) + (size_t)(l * 2 + i) * 64 * 128, nullptr, scr, rr / 2, rr % 2, lane); }
}
#if !defined(BGFILL) && !defined(TAILFILL_P2B)
constexpr int P0_LAYERS = DEPTH;
#else
constexpr int P0_LAYERS = 1;
#endif
constexpr int CONV_UNIT_ITEMS = 64, N_CONV_UNITS = (I_LAYER + CONV_UNIT_ITEMS - 1) / CONV_UNIT_ITEMS;

__device__ __forceinline__ void p0_prologue(const Params& P, LAS unsigned char* lds, int tid, int lane, int wave) {
    unsigned char* ws = P.ws;
    LAS float* scr = (LAS float*)(lds + wave * 16384);
    const int G = gridDim.x, gw = blockIdx.x * NWAVES + wave, NGW = G * NWAVES;
    for (int it = gw; it < P0_LAYERS * I_LAYER; it += NGW) p0_layer_item(P, scr, it / I_LAYER, it % I_LAYER, lane);
    for (int m = gw; m < MROWS; m += NGW) {
        const f32x4* xr = (const f32x4*)(P.x + (size_t)m * DM) + lane; float s = 0.f;
        u32x2* ob = (u32x2*)((bf16_t*)(ws + WS_XB) + (size_t)m * DM) + lane;
#pragma unroll
        for (int j = 0; j < 8; ++j) { const f32x4 v = xr[64 * j]; s += (v[0] * v[0] + v[1] * v[1]) + (v[2] * v[2] + v[3] * v[3]); u32x2 w; w.x = cvtpk(v[0], v[1]); w.y = cvtpk(v[2], v[3]); ob[64 * j] = w; }
#pragma unroll
        for (int o = 1; o < 64; o <<= 1) s += __shfl_xor(s, o);
        if (lane < 32) ((float*)(ws + WS_SSP))[(size_t)m * 32 + lane] = (lane == 0) ? s : 0.f;
    }
    for (int i = blockIdx.x * NTHREADS + tid; i < 32 * LUTN; i += G * NTHREADS) { const int h = i / LUTN, n = i % LUTN; ((float*)(ws + WS_GLUT))[i] = P.rel[h * 32 + t5_bucket(n)] * LOG2E; }
    if (blockIdx.x < DEPTH * 2) {
        __syncthreads();
        const int li = blockIdx.x, kp = tid >> 7, hid = tid & 127; const float* pe = P.cmp_pe + (size_t)li * 2048; const float* w1 = P.cmp_w1 + (size_t)li * 2048 * 128;
        float s = 0.f;
#pragma unroll 8
        for (int k = kp * 512; k < kp * 512 + 512; ++k) s += pe[k] * w1[(size_t)k * 128 + hid];
        LAS float* red = (LAS float*)lds; red[tid] = s; __syncthreads();
        if (tid < 128) ((float*)(ws + WS_CPE))[li * 128 + tid] = (red[tid] + red[tid + 128]) + (red[tid + 256] + red[tid + 384]);
        __syncthreads();
    }
}

struct Src { const bf16_t* kb; const bf16_t* vb; int stride; int dil; int roff; };

template <int QG, int MODE>
__device__ __forceinline__ void flash_tile(LAS unsigned char* lds, const int buf, const int k0, const int tag, const int dil, const bf16x8 (&qf)[QG][2], f32x4 (&o)[QG][4], float (&m)[QG], float (&l)[QG],
                                           const int qc, const int qcw_min, const int qcw_max, const int maxrel, const LAS unsigned* selp, const LAS unsigned* wunp,
                                           const float (&invl)[QG], LAS float* impw, const bool imp_acc, const LAS float* lut, float& carryB, const int lane) {
    const int g = lane >> 4, i16 = lane & 15;
    bool skip = (k0 > qcw_max) || (maxrel != 0x7fffffff && k0 + 63 < qcw_min - maxrel);
    if (tag >= 0) { const unsigned w = (unsigned)__builtin_amdgcn_readfirstlane((int)wunp[tag >> 5]); if (!((w >> (tag & 31)) & 1u)) skip = true; }
    if (MODE & 4) skip = false;
    if (!skip) {
        const LAS unsigned char* Ks = lds + (buf ? L_K1 : L_K0);
        const LAS unsigned char* Vs = lds + (buf ? L_V1 : L_V0);
        bool allowed = true;
        if (tag >= 0) { const unsigned w = selp[tag >> 5]; allowed = ((w >> (tag & 31)) & 1u) != 0u; }
        float impA[4] = {0.f, 0.f, 0.f, 0.f}, impB[4] = {0.f, 0.f, 0.f, 0.f};
        const int dl_ = qcw_min - (k0 + 63), dh_ = qcw_max - k0;
        bool uni = (k0 >= 0) && (dl_ >= 0) && (maxrel == 0x7fffffff || dh_ <= maxrel);
        if (MODE & 1) uni = uni && (dl_ * dil >= 1513);
        const unsigned uni_di = (unsigned)(dl_ * dil) < (unsigned)(LUTN - 1) ? (unsigned)(dl_ * dil) : (unsigned)(LUTN - 1);
        const bool mid = (MODE & 1) && !uni && (dil == 1) && (k0 >= 0) && (dl_ >= 0) && (maxrel == 0x7fffffff || dh_ <= maxrel) && (dh_ <= LUTN - 1);
#pragma unroll
        for (int qg = 0; qg < QG; ++qg) {
            bf16x8 kf[4][2];
#pragma unroll
            for (int kt = 0; kt < 4; ++kt)
#pragma unroll
                for (int ks = 0; ks < 2; ++ks) kf[kt][ks] = *(const LAS bf16x8*)(Ks + (16 * kt + i16) * KP + ks * 64 + g * 16);
            __builtin_amdgcn_sched_barrier(0);
            f32x4 s[4];
#pragma unroll
            for (int kt = 0; kt < 4; ++kt) { s[kt] = (f32x4){0.f, 0.f, 0.f, 0.f};
#pragma unroll
                for (int ks = 0; ks < 2; ++ks) s[kt] = mfma16(kf[kt][ks], qf[qg][ks], s[kt]); }
            bf16x8 vfr[4][2];
            if (!(MODE & 2)) {
#pragma unroll
                for (int dt = 0; dt < 4; ++dt)
#pragma unroll
                    for (int s2 = 0; s2 < 2; ++s2) { const LAS unsigned char* vp = Vs + (32 * s2 + 4 * g + (i16 >> 2)) * KP + (16 * dt + 4 * (i16 & 3)) * 2;
                        const s16x4 lo = tr_read(vp), hi = tr_read(vp + 16 * KP);
                        vfr[dt][s2] = (bf16x8){lo[0], lo[1], lo[2], lo[3], hi[0], hi[1], hi[2], hi[3]}; }
            }
            __builtin_amdgcn_sched_barrier(0);
            float mx = -INFINITY; float lanebias = 0.f;
            if (uni) {
                float lb = 0.f;
                if (MODE & 1) lb = lut[qg * LUTN + uni_di];
                lanebias = allowed ? lb : -INFINITY;
                float mr = -INFINITY;
#pragma unroll
                for (int kt = 0; kt < 4; ++kt)
#pragma unroll
                    for (int r = 0; r < 4; ++r) mr = fmaxf(mr, s[kt][r]);
                mx = allowed ? __builtin_fmaf(mr, LOG2E, lb) : -INFINITY;
            } else if (mid) {
                const LAS float* lp = lut + qg * LUTN + (qc - k0 - 4 * g - 63);
                float bv[4][4];
#pragma unroll
                for (int kt = 0; kt < 4; ++kt)
#pragma unroll
                    for (int r = 0; r < 4; ++r) bv[kt][r] = lp[63 - 16 * kt - r];
                __builtin_amdgcn_sched_barrier(0);
#pragma unroll
                for (int kt = 0; kt < 4; ++kt)
#pragma unroll
                    for (int r = 0; r < 4; ++r) { float sc = __builtin_fmaf(s[kt][r], LOG2E, bv[kt][r]); sc = allowed ? sc : -INFINITY; s[kt][r] = sc; mx = fmaxf(mx, sc); }
            } else {
                float bv[4][4];
#pragma unroll
                for (int kt = 0; kt < 4; ++kt)
#pragma unroll
                    for (int r = 0; r < 4; ++r) { bv[kt][r] = 0.f;
                        if (MODE & 1) { const int rel = qc - (k0 + 16 * kt + 4 * g + r); unsigned di = (unsigned)(rel * dil); di = di < (unsigned)(LUTN - 1) ? di : (unsigned)(LUTN - 1); bv[kt][r] = lut[qg * LUTN + di]; } }
                if (MODE & 1) __builtin_amdgcn_sched_barrier(0);
#pragma unroll
                for (int kt = 0; kt < 4; ++kt)
#pragma unroll
                    for (int r = 0; r < 4; ++r) { const int kc = k0 + 16 * kt + 4 * g + r; const int rel = qc - kc;
                        const bool ok = allowed && ((unsigned)rel <= (unsigned)maxrel) && (kc >= 0);
                        float sc = __builtin_fmaf(s[kt][r], LOG2E, bv[kt][r]);
                        sc = ok ? sc : -INFINITY; s[kt][r] = sc; mx = fmaxf(mx, sc); }
            }
            mx = xrow16_max(mx);
            const float mnew = fmaxf(m[qg], mx); const float alpha = fexp2(m[qg] - mnew); m[qg] = mnew;
            float rs = 0.f;
            if (uni) { const float cb_ = lanebias - mnew;
#pragma unroll
                for (int kt = 0; kt < 4; ++kt)
#pragma unroll
                    for (int r = 0; r < 4; ++r) { const float p = fexp2(__builtin_fmaf(s[kt][r], LOG2E, cb_)); s[kt][r] = p; rs += p; }
            } else {
#pragma unroll
                for (int kt = 0; kt < 4; ++kt)
#pragma unroll
                    for (int r = 0; r < 4; ++r) { const float p = fexp2(s[kt][r] - mnew); s[kt][r] = p; rs += p; }
            }
            if (MODE & 2) { rs = xrow16_sum(rs); l[qg] = l[qg] * alpha + rs; }
            if (MODE & 4) {
#pragma unroll
                for (int kt = 0; kt < 4; ++kt) { impA[kt] += ((s[kt][0] + s[kt][1]) + (s[kt][2] + s[kt][3])) * invl[qg]; impB[kt] += s[kt][3] * invl[qg]; }
            }
            if (!(MODE & 2)) {
#pragma unroll
                for (int dt = 0; dt < 4; ++dt) o[qg][dt] = o[qg][dt] * alpha;
                bf16x8 pf[2];
#pragma unroll
                for (int s2 = 0; s2 < 2; ++s2) { u32x4 w; w.x = cvtpk(s[2 * s2][0], s[2 * s2][1]); w.y = cvtpk(s[2 * s2][2], s[2 * s2][3]); w.z = cvtpk(s[2 * s2 + 1][0], s[2 * s2 + 1][1]); w.w = cvtpk(s[2 * s2 + 1][2], s[2 * s2 + 1][3]);
                    pf[s2] = __builtin_bit_cast(bf16x8, w); }
                { const bf16x8 ones = {16256, 16256, 16256, 16256, 16256, 16256, 16256, 16256};
                  f32x4 rsv = {0.f, 0.f, 0.f, 0.f};
                  rsv = mfma16(ones, pf[0], rsv); rsv = mfma16(ones, pf[1], rsv);
                  l[qg] = l[qg] * alpha + rsv[0]; }
#pragma unroll
                for (int dt = 0; dt < 4; ++dt)
#pragma unroll
                    for (int s2 = 0; s2 < 2; ++s2) o[qg][dt] = mfma16(vfr[dt][s2], pf[s2], o[qg][dt]);
            }
            if (QG > 1) asm volatile("" ::: "memory");
        }
        if (MODE & 4) {
            const int srcl = (lane + 48) & 63;
#pragma unroll
            for (int kt = 0; kt < 4; ++kt) { const float pb = (kt == 0) ? carryB : impB[kt == 0 ? 0 : kt - 1];
                const float x0 = __shfl(pb, srcl), x1 = __shfl(impB[kt], srcl); const float add = (g == 0) ? x0 : x1;
                const int J = 4 * ((k0 >> 4) + kt) + g; const float prevv = imp_acc ? impw[i16 * 128 + J] : 0.f; impw[i16 * 128 + J] = prevv + impA[kt] + add; }
            carryB = impB[3];
        }
    }
}

template <int QG, int MODE>
__device__ __forceinline__ void flash_run(LAS unsigned char* lds, const Src S, const int ntiles, const bf16x8 (&qf)[QG][2], f32x4 (&o)[QG][4], float (&m)[QG], float (&l)[QG],
                                          const int qc, const int qcw_min, const int qcw_max, const int maxrel, const LAS unsigned* selp, const LAS unsigned* wunp,
                                          const float (&invl)[QG], LAS float* impw, const bool imp_acc, const int lutslot, const int lane, const int tid) {
    const LAS int* tl = (const LAS int*)(lds + L_TL);
    const LAS float* lut = (const LAS float*)(lds + L_LUT) + lutslot * LUTN;
    const int srow = tid >> 3, sch = tid & 7;
    u32x4 kr0 = {0, 0, 0, 0}, vr0 = {0, 0, 0, 0}, kr1 = {0, 0, 0, 0}, vr1 = {0, 0, 0, 0};
    float carryB = 0.f;
#define FL_ISSUE(i, KR, VR) do { int c_ = __builtin_amdgcn_readfirstlane(tl[2 * (i)]) + srow; c_ = c_ < 0 ? 0 : c_; const size_t off_ = (size_t)(c_ * S.dil + S.roff) * S.stride + sch * 8; \
        KR = *(const u32x4*)(S.kb + off_); if (!(MODE & 2)) VR = *(const u32x4*)(S.vb + off_); } while (0)
#define FL_COMMIT(b, KR, VR) do { *(LAS u32x4*)(lds + ((b) ? L_K1 : L_K0) + srow * KP + sch * 16) = KR; if (!(MODE & 2)) *(LAS u32x4*)(lds + ((b) ? L_V1 : L_V0) + srow * KP + sch * 16) = VR; } while (0)
#define FL_TILE(i, b) flash_tile<QG, MODE>(lds, b, __builtin_amdgcn_readfirstlane(tl[2 * (i)]), __builtin_amdgcn_readfirstlane(tl[2 * (i) + 1]), S.dil, qf, o, m, l, qc, qcw_min, qcw_max, maxrel, selp, wunp, invl, impw, imp_acc, lut, carryB, lane)
    LDS_BARRIER();
    if (ntiles > 0) { FL_ISSUE(0, kr0, vr0); if (ntiles > 1) FL_ISSUE(1, kr1, vr1); FL_COMMIT(0, kr0, vr0); }
    LDS_BARRIER();
    for (int i = 0; i < ntiles; i += 2) {
        if (i + 2 < ntiles) FL_ISSUE(i + 2, kr0, vr0);
        FL_TILE(i, 0);
        if (i + 1 < ntiles) FL_COMMIT(1, kr1, vr1);
        LDS_BARRIER();
        if (i + 1 >= ntiles) break;
        if (i + 3 < ntiles) FL_ISSUE(i + 3, kr1, vr1);
        FL_TILE(i + 1, 1);
        if (i + 2 < ntiles) FL_COMMIT(0, kr0, vr0);
        LDS_BARRIER();
    }
#undef FL_ISSUE
#undef FL_COMMIT
#undef FL_TILE
}

template <int QG> __device__ __forceinline__ void flash_init(f32x4 (&o)[QG][4], float (&m)[QG], float (&l)[QG]) {
#pragma unroll
    for (int q = 0; q < QG; ++q) { m[q] = -1e30f; l[q] = 0.f;
#pragma unroll
        for (int d = 0; d < 4; ++d) o[q][d] = (f32x4){0.f, 0.f, 0.f, 0.f}; }
}
template <int NH>
__device__ __forceinline__ void load_lut(LAS unsigned char* lds, const float* glut, int head0, int tid) {
    LAS float* lut = (LAS float*)(lds + L_LUT); const float* src = glut + (size_t)head0 * LUTN;
    float v[NH * 3];
#pragma unroll
    for (int i = 0; i < NH * 3; ++i) v[i] = src[tid + NTHREADS * i];
    __builtin_amdgcn_sched_barrier(0);
#pragma unroll
    for (int i = 0; i < NH * 3; ++i) lut[tid + NTHREADS * i] = v[i];
}
__device__ __forceinline__ int next_unit(unsigned* ctr, LAS unsigned char* lds, int tid) {
    LAS int* slot = (LAS int*)(lds + L_MISC);
    __syncthreads();
    if (tid == 0) *slot = (int)atomicAdd(ctr, 1u);
    __syncthreads();
    return *slot;
}

__device__ __forceinline__ void unit_mixA(const Params& P, LAS unsigned char* lds, int uid, int tid, int lane, int wave) {
    unsigned char* ws = P.ws; const bf16_t* proj = (const bf16_t*)(ws + WS_PROJ);
    const int b = uid / 768; int rem = uid % 768; const int gi = rem / 256; rem %= 256; const int hs = rem / 64, idx = rem % 64;
    const int d = gi == 0 ? 1 : (gi == 1 ? 4 : 16); const int rc = idx % d, nb = idx / d;
    const int g = lane >> 4, i16 = lane & 15;
    load_lut<1>(lds, (const float*)(ws + WS_GLUT), gi * 4 + hs, tid);
    const int ntiles = nb == 0 ? 2 : 4;
    if (tid < 4) { LAS int* tl = (LAS int*)(lds + L_TL); const int i = tid + (nb == 0 ? 2 : 0); if (i < 4) { tl[2 * tid] = nb * 128 - 128 + 64 * i; tl[2 * tid + 1] = -1; } }
    const int qi = nb * 128 + 16 * wave + i16; const int tok = qi * d + rc; const size_t row = (size_t)b * SEQ + tok;
    const int colq = A_OFF + gi * 768 + hs * 64;
    bf16x8 qf[1][2];
#pragma unroll
    for (int ks = 0; ks < 2; ++ks) qf[0][ks] = *(const bf16x8*)(proj + row * INP + colq + ks * 32 + g * 8);
    f32x4 o[1][4]; float m[1], l[1]; flash_init<1>(o, m, l);
    const float il[1] = {0.f};
    Src S{proj + (size_t)b * SEQ * INP + colq + 256, proj + (size_t)b * SEQ * INP + colq + 512, INP, d, rc};
    flash_run<1, 1>(lds, S, ntiles, qf, o, m, l, qi, nb * 128 + 16 * wave, nb * 128 + 16 * wave + 15, 128, nullptr, nullptr, il, nullptr, false, 0, lane, tid);
    const float inv = l[0] > 0.f ? 1.f / l[0] : 0.f;
    bf16_t* O = (bf16_t*)(ws + WS_O) + row * 2048 + gi * 256 + hs * 64;
#pragma unroll
    for (int dt = 0; dt < 4; ++dt) { u32x2 w; w.x = cvtpk(o[0][dt][0] * inv, o[0][dt][1] * inv); w.y = cvtpk(o[0][dt][2] * inv, o[0][dt][3] * inv); *(u32x2*)(O + 16 * dt + 4 * g) = w; }
    if (g == 0) ((float*)(ws + WS_LSE))[row * 12 + gi * 4 + hs] = (m[0] + __log2f(fmaxf(l[0], 1e-30f))) * LN2;
}

__device__ __forceinline__ void unit_moba(const Params& P, LAS unsigned char* lds, int b, int h, int c, int tid, int lane, int wave) {
    unsigned char* ws = P.ws; const bf16_t* proj = (const bf16_t*)(ws + WS_PROJ);
    const int g = lane >> 4, i16 = lane & 15;
    const int t0 = c * 128, ob = t0 >> 8;
    load_lut<1>(lds, (const float*)(ws + WS_GLUT), 12 + h, tid);
    LAS float* km = (LAS float*)(lds + L_IMP);
    LAS unsigned char* qS = lds + L_IMP + 8192;
    { const float* src = (const float*)(ws + WS_KMEAN) + (size_t)(b * 8 + h) * 2048; float kv4[4]; u32x4 qv[2];
#pragma unroll
      for (int i = 0; i < 4; ++i) kv4[i] = src[tid + NTHREADS * i];
#pragma unroll
      for (int i = 0; i < 2; ++i) { const int e = tid + NTHREADS * i; qv[i] = *(const u32x4*)(proj + ((size_t)b * SEQ + t0 + (e >> 3)) * INP + B_OFF + h * 64 + (e & 7) * 8); }
      __builtin_amdgcn_sched_barrier(0);
#pragma unroll
      for (int i = 0; i < 4; ++i) km[tid + NTHREADS * i] = kv4[i];
#pragma unroll
      for (int i = 0; i < 2; ++i) { const int e = tid + NTHREADS * i; *(LAS u32x4*)(qS + (e >> 3) * 128 + (e & 7) * 16) = qv[i]; } }
    LAS unsigned* misc = (LAS unsigned*)(lds + L_MISC);
    if (tid == 0) misc[1] = 0u;
    __syncthreads();
    const int tok = t0 + 16 * wave + i16; const size_t row = (size_t)b * SEQ + tok;
    const int colq = B_OFF + h * 64;
    bf16x8 qf[1][2];
#pragma unroll
    for (int ks = 0; ks < 2; ++ks) qf[0][ks] = *(const bf16x8*)(proj + row * INP + colq + ks * 32 + g * 8);
    unsigned sel = 0u;
    if (ob > 0) {
        float gt[8];
#pragma unroll
        for (int k = 0; k < 8; ++k) gt[k] = 0.f;
#pragma unroll 1
        for (int dc = 0; dc < 8; ++dc) { const u32x4 qw = *(const LAS u32x4*)(qS + (16 * wave + i16) * 128 + dc * 16);
            const float q0 = bflo(qw.x), q1 = bfhi(qw.x), q2 = bflo(qw.y), q3 = bfhi(qw.y), q4 = bflo(qw.z), q5 = bfhi(qw.z), q6 = bflo(qw.w), q7 = bfhi(qw.w);
#pragma unroll
            for (int k = 0; k < 8; ++k) { const LAS f32x4* kr = (const LAS f32x4*)(km + (8 * g + k) * 64 + dc * 8); const f32x4 a = kr[0], bq = kr[1];
                gt[k] += (q0 * a[0] + q1 * a[1]) + (q2 * a[2] + q3 * a[3]) + (q4 * bq[0] + q5 * bq[1]) + (q6 * bq[2] + q7 * bq[3]); } }
#pragma unroll
        for (int k = 0; k < 8; ++k) if (8 * g + k >= ob) gt[k] = -INFINITY;
#pragma unroll
        for (int it = 0; it < 3; ++it) {
            float best = -INFINITY; int bi = 99;
#pragma unroll
            for (int k = 0; k < 8; ++k) if (gt[k] > best) { best = gt[k]; bi = 8 * g + k; }
#pragma unroll
            for (int off = 16; off <= 32; off <<= 1) { const float ob_ = __shfl_xor(best, off); const int oi = __shfl_xor(bi, off); if (ob_ > best || (ob_ == best && oi < bi)) { best = ob_; bi = oi; } }
            if (bi < 32) { sel |= 1u << bi;
#pragma unroll
                for (int k = 0; k < 8; ++k) if (8 * g + k == bi) gt[k] = -INFINITY; }
        }
    }
    unsigned wu = sel;
#pragma unroll
    for (int off = 1; off < 16; off <<= 1) wu |= (unsigned)__shfl_xor((int)wu, off);
    wu = (unsigned)__builtin_amdgcn_readfirstlane((int)wu);
    LAS unsigned* selS = (LAS unsigned*)(lds + L_SEL); LAS unsigned* wunS = (LAS unsigned*)(lds + L_WUN) + wave * 4;
    if (g == 0) selS[(16 * wave + i16) * 4] = sel;
    if (lane == 0) wunS[0] = wu;
    __syncthreads();
    unsigned um = 0u;
#pragma unroll
    for (int w8 = 0; w8 < 8; ++w8) um |= ((const LAS unsigned*)(lds + L_WUN))[w8 * 4];
    if (tid == 0) { LAS int* tl = (LAS int*)(lds + L_TL); int n = 0;
        for (int blk = 0; blk < ob; ++blk) if ((um >> blk) & 1u) for (int s4 = 0; s4 < 4; ++s4) { tl[2 * n] = blk * 256 + 64 * s4; tl[2 * n + 1] = blk; ++n; }
        for (int k0 = ob * 256; k0 < t0 + 128; k0 += 64) { tl[2 * n] = k0; tl[2 * n + 1] = -1; ++n; }
        misc[2] = (unsigned)n; }
    __syncthreads();
    const int ntiles = (int)misc[2];
    f32x4 o[1][4]; float m[1], l[1]; flash_init<1>(o, m, l);
    const float il[1] = {0.f};
    Src S{proj + (size_t)b * SEQ * INP + colq + 512, proj + (size_t)b * SEQ * INP + colq + 1024, INP, 1, 0};
    flash_run<1, 1>(lds, S, ntiles, qf, o, m, l, tok, t0 + 16 * wave, t0 + 16 * wave + 15, 0x7fffffff, selS + (16 * wave + i16) * 4, wunS, il, nullptr, false, 0, lane, tid);
    const float inv = l[0] > 0.f ? 1.f / l[0] : 0.f;
    bf16_t* O = (bf16_t*)(ws + WS_O) + row * 2048 + 768 + h * 64;
#pragma unroll
    for (int dt = 0; dt < 4; ++dt) { u32x2 w; w.x = cvtpk(o[0][dt][0] * inv, o[0][dt][1] * inv); w.y = cvtpk(o[0][dt][2] * inv, o[0][dt][3] * inv); *(u32x2*)(O + 16 * dt + 4 * g) = w; }
}

__device__ __forceinline__ float sigmoidf_(float x) { return 1.f / (1.f + __expf(-x)); }
#ifndef NSA_QG
#define NSA_QG 2
#endif
__device__ __forceinline__ void unit_nsa(const Params& P, LAS unsigned char* lds, int b, int kv, int c, int tid, int lane, int wave) {
    unsigned char* ws = P.ws; const bf16_t* proj = (const bf16_t*)(ws + WS_PROJ);
    const int g = lane >> 4, i16 = lane & 15;
    const int t0 = c * 128;
    const int tok = t0 + 16 * wave + i16; const size_t row = (size_t)b * SEQ + tok;
    load_lut<4>(lds, (const float*)(ws + WS_GLUT), 20 + kv * 4, tid);
    LAS int* tl = (LAS int*)(lds + L_TL);
    LAS unsigned* misc = (LAS unsigned*)(lds + L_MISC);
    LAS unsigned* selS = (LAS unsigned*)(lds + L_SEL);
    LAS float* impw = (LAS float*)(lds + L_IMP) + wave * 2048;
    const int ntc = ((t0 + 96) >> 4) / 64 + 1;
    if (tid < ntc) { tl[2 * tid] = 64 * tid; tl[2 * tid + 1] = -1; }
    if (tid < 4) misc[4 + tid] = 0u;
    LAS unsigned* wunS = (LAS unsigned*)(lds + L_WUN) + wave * 4;
    float* tot = (float*)(ws + WS_TOT) + row * 768 + (kv * 4) * 64;
    const bf16_t* gatep = proj + row * INP + CG_OFF + (kv * 4) * 3;
    const int qcc = (tok - 31) >> 4;
    const int qcw0 = (t0 + 16 * wave - 31) >> 4, qcw1 = (t0 + 16 * wave + 15 - 31) >> 4;
#pragma unroll 1
    for (int hp = 0; hp < 4 / NSA_QG; ++hp) {
        bf16x8 qf[NSA_QG][2];
#pragma unroll
        for (int q = 0; q < NSA_QG; ++q)
#pragma unroll
            for (int ks = 0; ks < 2; ++ks) qf[q][ks] = *(const bf16x8*)(proj + row * INP + CQ_OFF + (kv * 4 + hp * NSA_QG + q) * 64 + ks * 32 + g * 8);
        f32x4 o[NSA_QG][4]; float m[NSA_QG], l[NSA_QG]; flash_init<NSA_QG>(o, m, l);
        float il[NSA_QG]; for (int q_ = 0; q_ < NSA_QG; ++q_) il[q_] = 0.f;
#ifdef NSA_CMP_FAKEKV
        Src S{proj + (size_t)b * SEQ * INP + CKV_OFF + 4 * 192 + kv * 64, proj + (size_t)b * SEQ * INP + CKV_OFF + 5 * 192 + kv * 64, INP, 1, 0};
#else
        Src S{(const bf16_t*)(ws + WS_KC) + (size_t)(b * 3 + kv) * 512 * 64, (const bf16_t*)(ws + WS_VC) + (size_t)(b * 3 + kv) * 512 * 64, 64, 1, 0};
#endif
#ifdef NSA_CMP_SINGLE
        flash_run<NSA_QG, 0>(lds, S, ntc, qf, o, m, l, qcc, qcw0, qcw1, 0x7fffffff, nullptr, nullptr, il, nullptr, false, 0, lane, tid);
#pragma unroll
        for (int q = 0; q < NSA_QG; ++q) il[q] = l[q] > 0.f ? 1.f / l[q] : 0.f;
        (void)impw;
#elif !defined(NSA_NO_CMP)
        flash_run<NSA_QG, 2>(lds, S, ntc, qf, o, m, l, qcc, qcw0, qcw1, 0x7fffffff, nullptr, nullptr, il, nullptr, false, 0, lane, tid);
#pragma unroll
        for (int q = 0; q < NSA_QG; ++q) { il[q] = l[q] > 0.f ? 1.f / l[q] : 0.f; l[q] = 0.f; }
        flash_run<NSA_QG, 4>(lds, S, ntc, qf, o, m, l, qcc, qcw0, qcw1, 0x7fffffff, nullptr, nullptr, il, impw, hp != 0, 0, lane, tid);
#else
        (void)S; (void)impw;
#endif
#pragma unroll
        for (int q = 0; q < NSA_QG; ++q) { const float gt = sigmoidf_(bf2f(gatep[(hp * NSA_QG + q) * 3 + 0])); const float sc = il[q] * gt;
#pragma unroll
            for (int dt = 0; dt < 4; ++dt) *(f32x4*)(tot + (hp * NSA_QG + q) * 64 + 16 * dt + 4 * g) = o[q][dt] * sc; }
    }
#ifndef NSA_NO_TOPK
    lds_wait();
    unsigned wun0 = 0u, wun1 = 0u, wun2 = 0u, wun3 = 0u;
#pragma unroll 1
    for (int q = 0; q < 16; ++q) {
        const int t = t0 + 16 * wave + q, own = t >> 6;
        const int ncand = own - 2 > 0 ? own - 2 : 0; const int nforced = own >= 2 ? 3 : own + 1; const int K = 16 - nforced;
        const int j0 = lane, j1 = lane + 64;
        const bool c0 = (j0 >= 1) && (j0 <= own - 2), c1 = (j1 <= own - 2);
        const unsigned k0 = c0 ? (__float_as_uint(impw[q * 128 + j0]) + 1u) : 0u, k1 = c1 ? (__float_as_uint(impw[q * 128 + j1]) + 1u) : 0u;
        bool s0 = c0, s1 = c1;
        if (ncand > K) {
            unsigned T = 0u;
            for (int bit = 31; bit >= 0; --bit) { const unsigned Tn = T | (1u << bit);
                const int cnt = __popcll(__ballot(k0 >= Tn)) + __popcll(__ballot(k1 >= Tn)); if (cnt >= K) T = Tn; }
            const bool g0 = k0 > T, g1 = k1 > T; const int ng = __popcll(__ballot(g0)) + __popcll(__ballot(g1)); const int need = K - ng;
            const unsigned long long e0 = __ballot(k0 == T), e1 = __ballot(k1 == T); const unsigned long long lt = (1ull << lane) - 1ull;
            const int r0 = __popcll(e0 & lt), r1 = __popcll(e0) + __popcll(e1 & lt);
            s0 = g0 || (k0 == T && r0 < need); s1 = g1 || (k1 == T && r1 < need);
        }
        s0 = s0 || (j0 == 0) || (j0 == own) || (j0 == own - 1); s1 = s1 || (j1 == own) || (j1 == own - 1);
        const unsigned long long m0 = __ballot(s0), m1 = __ballot(s1);
        const unsigned w0 = (unsigned)m0, w1 = (unsigned)(m0 >> 32), w2 = (unsigned)m1, w3 = (unsigned)(m1 >> 32);
        if (lane == 0) { selS[(16 * wave + q) * 4 + 0] = w0; selS[(16 * wave + q) * 4 + 1] = w1; selS[(16 * wave + q) * 4 + 2] = w2; selS[(16 * wave + q) * 4 + 3] = w3; }
        wun0 |= w0; wun1 |= w1; wun2 |= w2; wun3 |= w3;
    }
    if (lane == 0) { wunS[0] = wun0; wunS[1] = wun1; wunS[2] = wun2; wunS[3] = wun3; }
    __syncthreads();
    if (tid < 4) { unsigned u_ = 0u; for (int w8 = 0; w8 < 8; ++w8) u_ |= ((const LAS unsigned*)(lds + L_WUN))[w8 * 4 + tid]; misc[4 + tid] = u_; }
    __syncthreads();
    const LAS unsigned* selp = selS + (16 * wave + i16) * 4;
    const int ownmax = (t0 + 127) >> 6;
    if (tid == 0) { int n = 0; for (int j = 0; j <= ownmax; ++j) if ((misc[4 + (j >> 5)] >> (j & 31)) & 1u) { tl[2 * n] = 64 * j; tl[2 * n + 1] = j; ++n; } misc[2] = (unsigned)n; }
    __syncthreads();
    const int nts = (int)misc[2];
#else
    const int ownmax = (t0 + 127) >> 6; const int nts = 0; const LAS unsigned* selp = nullptr; (void)selS; (void)wunS;
#endif
    const int kfirst = t0 - 512 > 0 ? t0 - 512 : 0; const int ntw = (t0 + 128 - kfirst) / 64;
#ifdef NSA_PACK4
    __syncthreads();
    if (tid == 0) { int n = 0; for (int j = 0; j <= ownmax; ++j) if ((misc[4 + (j >> 5)] >> (j & 31)) & 1u) { tl[2 * n] = 64 * j; tl[2 * n + 1] = j; ++n; } }
#pragma unroll 1
    for (int ps = 0; ps < 4; ++ps) {
        const int tli = 32 * ps + 4 * wave + (i16 >> 2), hd = i16 & 3;
        const int tokp = t0 + tli; const size_t rowp = (size_t)b * SEQ + tokp;
        bf16x8 qf[1][2];
#pragma unroll
        for (int ks = 0; ks < 2; ++ks) qf[0][ks] = *(const bf16x8*)(proj + rowp * INP + CQ_OFF + (kv * 4 + hd) * 64 + ks * 32 + g * 8);
        if (lane < 4) { unsigned w_ = 0u;
#pragma unroll
            for (int k = 0; k < 4; ++k) w_ |= selS[(32 * ps + 4 * wave + k) * 4 + lane];
            wunS[lane] = w_; }
        lds_wait();
        f32x4 o[1][4]; float m[1], l[1]; flash_init<1>(o, m, l);
        const float il[1] = {0.f};
        Src S{proj + (size_t)b * SEQ * INP + CKV_OFF + 2 * 192 + kv * 64, proj + (size_t)b * SEQ * INP + CKV_OFF + 3 * 192 + kv * 64, INP, 1, 0};
        flash_run<1, 1>(lds, S, nts, qf, o, m, l, tokp, t0 + 32 * ps + 4 * wave, t0 + 32 * ps + 4 * wave + 3, 0x7fffffff, selS + tli * 4, wunS, il, nullptr, false, hd, lane, tid);
        const float gt = sigmoidf_(bf2f(proj[rowp * INP + CG_OFF + (kv * 4 + hd) * 3 + 1])); const float sc = (l[0] > 0.f ? 1.f / l[0] : 0.f) * gt;
        float* tp0 = (float*)(ws + WS_TOT) + rowp * 768 + (kv * 4 + hd) * 64;
#pragma unroll
        for (int dt = 0; dt < 4; ++dt) { float* tp = tp0 + 16 * dt + 4 * g; *(f32x4*)tp = *(const f32x4*)tp + o[0][dt] * sc; }
    }
    __syncthreads();
#pragma unroll 1
    for (int hp = 0; hp < 2; ++hp) {
        bf16x8 qf[2][2];
#pragma unroll
        for (int q = 0; q < 2; ++q)
#pragma unroll
            for (int ks = 0; ks < 2; ++ks) qf[q][ks] = *(const bf16x8*)(proj + row * INP + CQ_OFF + (kv * 4 + hp * 2 + q) * 64 + ks * 32 + g * 8);
        f32x4 o[2][4]; float m[2], l[2];
        float il[2] = {0.f, 0.f};
        __syncthreads();
        if (tid < ntw) { tl[2 * tid] = kfirst + 64 * tid; tl[2 * tid + 1] = -1; }
        flash_init<2>(o, m, l);
        Src S{proj + (size_t)b * SEQ * INP + CKV_OFF + 4 * 192 + kv * 64, proj + (size_t)b * SEQ * INP + CKV_OFF + 5 * 192 + kv * 64, INP, 1, 0};
        flash_run<2, 1>(lds, S, ntw, qf, o, m, l, tok, t0 + 16 * wave, t0 + 16 * wave + 15, 511, nullptr, nullptr, il, nullptr, false, hp * 2, lane, tid);
        bf16_t* O = (bf16_t*)(ws + WS_O) + row * 2048 + 1280 + (kv * 4) * 64;
#pragma unroll
        for (int q = 0; q < 2; ++q) { const float gt = sigmoidf_(bf2f(gatep[(hp * 2 + q) * 3 + 2])); const float sc = (l[q] > 0.f ? 1.f / l[q] : 0.f) * gt;
#pragma unroll
            for (int dt = 0; dt < 4; ++dt) { const f32x4 v = *(const f32x4*)(tot + (hp * 2 + q) * 64 + 16 * dt + 4 * g) + o[q][dt] * sc;
                u32x2 w; w.x = cvtpk(v[0], v[1]); w.y = cvtpk(v[2], v[3]); *(u32x2*)(O + (hp * 2 + q) * 64 + 16 * dt + 4 * g) = w; } }
    }
}
#else
#pragma unroll 1
    for (int hp = 0; hp < 4 / NSA_QG; ++hp) {
        bf16x8 qf[NSA_QG][2];
#pragma unroll
        for (int q = 0; q < NSA_QG; ++q)
#pragma unroll
            for (int ks = 0; ks < 2; ++ks) qf[q][ks] = *(const bf16x8*)(proj + row * INP + CQ_OFF + (kv * 4 + hp * NSA_QG + q) * 64 + ks * 32 + g * 8);
        f32x4 o[NSA_QG][4]; float m[NSA_QG], l[NSA_QG];
        float il[NSA_QG]; for (int q_ = 0; q_ < NSA_QG; ++q_) il[q_] = 0.f;
        __syncthreads();
        if (tid == 0) { int n = 0; for (int j = 0; j <= ownmax; ++j) if ((misc[4 + (j >> 5)] >> (j & 31)) & 1u) { tl[2 * n] = 64 * j; tl[2 * n + 1] = j; ++n; } }
#ifndef NSA_NO_SLC
        { flash_init<NSA_QG>(o, m, l);
          Src S{proj + (size_t)b * SEQ * INP + CKV_OFF + 2 * 192 + kv * 64, proj + (size_t)b * SEQ * INP + CKV_OFF + 3 * 192 + kv * 64, INP, 1, 0};
          flash_run<NSA_QG, 1>(lds, S, nts, qf, o, m, l, tok, t0 + 16 * wave, t0 + 16 * wave + 15, 0x7fffffff, selp, wunS, il, nullptr, false, hp * NSA_QG, lane, tid);
#pragma unroll
          for (int q = 0; q < NSA_QG; ++q) { const float gt = sigmoidf_(bf2f(gatep[(hp * NSA_QG + q) * 3 + 1])); const float sc = (l[q] > 0.f ? 1.f / l[q] : 0.f) * gt;
#pragma unroll
              for (int dt = 0; dt < 4; ++dt) { float* tp = tot + (hp * NSA_QG + q) * 64 + 16 * dt + 4 * g; *(f32x4*)tp = *(const f32x4*)tp + o[q][dt] * sc; } }
        }
#endif
        if (tid < ntw) { tl[2 * tid] = kfirst + 64 * tid; tl[2 * tid + 1] = -1; }
        { flash_init<NSA_QG>(o, m, l);
          Src S{proj + (size_t)b * SEQ * INP + CKV_OFF + 4 * 192 + kv * 64, proj + (size_t)b * SEQ * INP + CKV_OFF + 5 * 192 + kv * 64, INP, 1, 0};
#ifndef NSA_NO_WIN
          flash_run<NSA_QG, 1>(lds, S, ntw, qf, o, m, l, tok, t0 + 16 * wave, t0 + 16 * wave + 15, 511, nullptr, nullptr, il, nullptr, false, hp * NSA_QG, lane, tid);
#else
          (void)S;
#endif
          bf16_t* O = (bf16_t*)(ws + WS_O) + row * 2048 + 1280 + (kv * 4) * 64;
#pragma unroll
          for (int q = 0; q < NSA_QG; ++q) { const float gt = sigmoidf_(bf2f(gatep[(hp * NSA_QG + q) * 3 + 2])); const float sc = (l[q] > 0.f ? 1.f / l[q] : 0.f) * gt;
#pragma unroll
              for (int dt = 0; dt < 4; ++dt) { const f32x4 v = *(const f32x4*)(tot + (hp * NSA_QG + q) * 64 + 16 * dt + 4 * g) + o[q][dt] * sc;
                  u32x2 w; w.x = cvtpk(v[0], v[1]); w.y = cvtpk(v[2], v[3]); *(u32x2*)(O + (hp * NSA_QG + q) * 64 + 16 * dt + 4 * g) = w; } }
        }
    }
}

#endif

__device__ __forceinline__ float gelu_tanh(float x) { const float u = 0.7978845608028654f * (x + 0.044715f * x * x * x); const float e = __expf(2.f * u); const float th = 1.f - 2.f / (1.f + e); return 0.5f * x * (1.f + th); }
__device__ __forceinline__ void item_compress(const Params& P, int layer, int it, int lane) {
    unsigned char* ws = P.ws; const bf16_t* proj = (const bf16_t*)(ws + WS_PROJ);
    const int nt = it & 31; int r = it >> 5; const int which = r & 1; r >>= 1; const int kv = r % 3, b = r / 3;
    const int g = lane >> 4, i16 = lane & 15;
    int n = 16 * nt + i16; const int nld = n > 510 ? 510 : n;
    const bf16_t* w1t = (const bf16_t*)(ws + WS_W1T) + (size_t)(layer * 2 + which) * 128 * 2048;
    const bf16_t* w2t = (const bf16_t*)(ws + WS_W2T) + (size_t)(layer * 2 + which) * 64 * 128;
    const float* cpe = (const float*)(ws + WS_CPE) + (layer * 2 + which) * 128;
    const bf16_t* src = proj + ((size_t)b * SEQ + 16 * nld) * INP + CKV_OFF + which * 192 + kv * 64 + 8 * g;
    f32x4 acc[8];
#pragma unroll
    for (int h = 0; h < 8; ++h) acc[h] = (f32x4){0.f, 0.f, 0.f, 0.f};
    const bf16_t* w1l = w1t + (size_t)i16 * 2048 + 8 * g;
#pragma unroll 1
    for (int ks = 0; ks < 64; ks += 4) {
        bf16x8 bq[4], af[4][8];
#pragma unroll
        for (int u = 0; u < 4; ++u) { bq[u] = *(const bf16x8*)(src + (size_t)((ks + u) >> 1) * INP + (u & 1) * 32);
#pragma unroll
            for (int h = 0; h < 8; ++h) af[u][h] = *(const bf16x8*)(w1l + (size_t)(16 * h) * 2048 + 32 * (ks + u)); }
        __builtin_amdgcn_sched_barrier(0);
#pragma unroll
        for (int u = 0; u < 4; ++u)
#pragma unroll
            for (int h = 0; h < 8; ++h) acc[h] = mfma16(af[u][h], bq[u], acc[h]);
    }
    bf16x8 pf[4];
#pragma unroll
    for (int s = 0; s < 4; ++s) { float hv[8];
#pragma unroll
        for (int r2 = 0; r2 < 4; ++r2) { hv[r2] = gelu_tanh(acc[2 * s][r2] + cpe[32 * s + 4 * g + r2]); hv[4 + r2] = gelu_tanh(acc[2 * s + 1][r2] + cpe[32 * s + 16 + 4 * g + r2]); }
        u32x4 w; w.x = cvtpk(hv[0], hv[1]); w.y = cvtpk(hv[2], hv[3]); w.z = cvtpk(hv[4], hv[5]); w.w = cvtpk(hv[6], hv[7]); pf[s] = __builtin_bit_cast(bf16x8, w); }
    bf16_t* dst = (bf16_t*)(ws + (which ? WS_VC : WS_KC)) + ((size_t)(b * 3 + kv) * 512 + n) * 64;
#pragma unroll
    for (int et = 0; et < 4; ++et) { f32x4 oc = {0.f, 0.f, 0.f, 0.f};
#pragma unroll
        for (int s = 0; s < 4; ++s) { const bf16_t* wp = w2t + (size_t)(16 * et + i16) * 128 + 32 * s + 4 * g; const u32x2 lo = *(const u32x2*)wp, hi = *(const u32x2*)(wp + 16);
            u32x4 w; w.x = lo.x; w.y = lo.y; w.z = hi.x; w.w = hi.y; oc = mfma16(__builtin_bit_cast(bf16x8, w), pf[s], oc); }
#ifdef PROBE_CLAMP
#pragma unroll
        for (int r2 = 0; r2 < 4; ++r2) oc[r2] = fminf(fmaxf(oc[r2], -100.f), 100.f);
#endif
        u32x2 w; w.x = cvtpk(oc[0], oc[1]); w.y = cvtpk(oc[2], oc[3]); *(u32x2*)(dst + 16 * et + 4 * g) = w; }
}
__device__ __forceinline__ void item_kmean(const Params& P, int it, int lane) {
    unsigned char* ws = P.ws; const bf16_t* proj = (const bf16_t*)(ws + WS_PROJ);
    const int blk = it & 31, h = (it >> 5) & 7, b = it >> 8;
    const int rg = lane >> 3, dch = lane & 7;
    const bf16_t* src = proj + ((size_t)b * SEQ + blk * 256 + rg) * INP + B_OFF + 512 + h * 64 + dch * 8;
    u32x4 v[32];
#pragma unroll
    for (int i = 0; i < 32; ++i) v[i] = *(const u32x4*)(src + (size_t)(8 * i) * INP);
    __builtin_amdgcn_sched_barrier(0);
    float sm[8];
#pragma unroll
    for (int e = 0; e < 8; ++e) sm[e] = 0.f;
#pragma unroll
    for (int i = 0; i < 32; ++i)
#pragma unroll
        for (int w = 0; w < 4; ++w) { sm[2 * w] += bflo(v[i][w]); sm[2 * w + 1] += bfhi(v[i][w]); }
#pragma unroll
    for (int e = 0; e < 8; ++e) { sm[e] += __shfl_xor(sm[e], 8); sm[e] += __shfl_xor(sm[e], 16); sm[e] += __shfl_xor(sm[e], 32); }
    if (rg == 0) { float* dst = (float*)(ws + WS_KMEAN) + (size_t)it * 64 + dch * 8;
        *(f32x4*)dst = (f32x4){sm[0], sm[1], sm[2], sm[3]} * (1.f / 256.f); *(f32x4*)(dst + 4) = (f32x4){sm[4], sm[5], sm[6], sm[7]} * (1.f / 256.f); }
}
__device__ __forceinline__ void item_combineA(const Params& P, int row, int lane) {
    unsigned char* ws = P.ws; const float* lse = (const float*)(ws + WS_LSE) + (size_t)row * 12; bf16_t* O = (bf16_t*)(ws + WS_O) + (size_t)row * 2048;
#pragma unroll
    for (int k = 0; k < 3; ++k) { const int chunk = lane + 64 * k; const int col = 4 * chunk; const int gi = col >> 8, hs = (col >> 6) & 3;
        const float a0 = lse[hs], a1 = lse[4 + hs], a2 = lse[8 + hs]; const float mx = fmaxf(a0, fmaxf(a1, a2));
        const float e0 = __expf(a0 - mx), e1 = __expf(a1 - mx), e2 = __expf(a2 - mx); const float al = (gi == 0 ? e0 : (gi == 1 ? e1 : e2)) / (e0 + e1 + e2);
        const u32x2 w = *(const u32x2*)(O + col); u32x2 r; r.x = cvtpk(bflo(w.x) * al, bfhi(w.x) * al); r.y = cvtpk(bflo(w.y) * al, bfhi(w.y) * al); *(u32x2*)(O + col) = r; }
}

__device__ __forceinline__ void phase_conv(const Params& P, int layer, int tid) {
    unsigned char* ws = P.ws; const bf16_t* U = (const bf16_t*)(ws + WS_U); bf16_t* ACT = (bf16_t*)(ws + WS_ACT);
    const float* cw = P.conv_w + (size_t)layer * 3 * UPW; const float* cb = P.conv_b + (size_t)layer * UPW;
    constexpr int NCH = DFF / 8, TB = 8, NTB = MROWS / TB;
    for (int it = blockIdx.x * NTHREADS + tid; it < NCH * NTB; it += gridDim.x * NTHREADS) {
        const int ch = it % NCH, tb = it / NCH; const int c = ch * 8; const int ua = 256 * (c >> 7) + (c & 127);
        const int row0 = tb * TB; const bool first = (row0 % SEQ) == 0;
        u32x4 pa[TB + 2], pg[TB + 2];
#pragma unroll
        for (int t = 0; t < TB + 2; ++t) { const int r = row0 - 2 + t; const size_t off = (size_t)(r < 0 ? 0 : r) * UPW + ua; pa[t] = *(const u32x4*)(U + off); pg[t] = *(const u32x4*)(U + off + 128); }
        f32x4 wa4[3][2], wg4[3][2], ba4[2], bg4[2];
#pragma unroll
        for (int j = 0; j < 3; ++j)
#pragma unroll
            for (int h = 0; h < 2; ++h) { wa4[j][h] = *(const f32x4*)(cw + (size_t)j * UPW + c + 4 * h); wg4[j][h] = *(const f32x4*)(cw + (size_t)j * UPW + DFF + c + 4 * h); }
#pragma unroll
        for (int h = 0; h < 2; ++h) { ba4[h] = *(const f32x4*)(cb + c + 4 * h); bg4[h] = *(const f32x4*)(cb + DFF + c + 4 * h); }
        __builtin_amdgcn_sched_barrier(0);
        if (first) { pa[0] = (u32x4){0, 0, 0, 0}; pa[1] = pa[0]; pg[0] = pa[0]; pg[1] = pa[0]; }
#pragma unroll
        for (int t = 0; t < TB; ++t) {
            float r[8];
#pragma unroll
            for (int e = 0; e < 8; ++e) { const int w_ = e >> 1; const int h = e >> 2, x = e & 3;
                const float a0 = (e & 1) ? bfhi(pa[t + 2][w_]) : bflo(pa[t + 2][w_]), a1 = (e & 1) ? bfhi(pa[t + 1][w_]) : bflo(pa[t + 1][w_]), a2 = (e & 1) ? bfhi(pa[t][w_]) : bflo(pa[t][w_]);
                const float g0 = (e & 1) ? bfhi(pg[t + 2][w_]) : bflo(pg[t + 2][w_]), g1 = (e & 1) ? bfhi(pg[t + 1][w_]) : bflo(pg[t + 1][w_]), g2 = (e & 1) ? bfhi(pg[t][w_]) : bflo(pg[t][w_]);
                const float ya = ba4[h][x] + wa4[0][h][x] * a0 + wa4[1][h][x] * a1 + wa4[2][h][x] * a2;
                const float yg = bg4[h][x] + wg4[0][h][x] * g0 + wg4[1][h][x] * g1 + wg4[2][h][x] * g2;
                r[e] = ya * yg / (1.f + __expf(-yg)); }
            u32x4 w; w.x = cvtpk(r[0], r[1]); w.y = cvtpk(r[2], r[3]); w.z = cvtpk(r[4], r[5]); w.w = cvtpk(r[6], r[7]);
            *(u32x4*)(ACT + (size_t)(row0 + t) * DFF + c) = w;
        }
    }
}

__device__ __forceinline__ void phase_convfix(const Params& P, int layer, int tid) {
    unsigned char* ws = P.ws; const bf16_t* UB = (const bf16_t*)(ws + WS_UB); bf16_t* ACT = (bf16_t*)(ws + WS_ACT);
    const float* cw = P.conv_w + (size_t)layer * 3 * UPW; const float* cb = P.conv_b + (size_t)layer * UPW;
    constexpr int NCH = DFF / 8, NS = MROWS / 64;
    for (int it = blockIdx.x * NTHREADS + tid; it < NCH * 2 * NS; it += gridDim.x * NTHREADS) {
        const int ch = it % NCH, lr = (it / NCH) & 1, sl = it / (2 * NCH); const int c = ch * 8; const int ua = 256 * (c >> 7) + (c & 127);
        const bool first = (sl % (SEQ / 64)) == 0;
        const int slp = sl > 0 ? sl - 1 : 0;
        const bf16_t* r0 = UB + ((size_t)sl * 4 + lr) * UPW + ua;
        const bf16_t* r1 = lr == 0 ? UB + ((size_t)slp * 4 + 3) * UPW + ua : UB + ((size_t)sl * 4 + 0) * UPW + ua;
        const bf16_t* r2 = lr == 0 ? UB + ((size_t)slp * 4 + 2) * UPW + ua : UB + ((size_t)slp * 4 + 3) * UPW + ua;
        u32x4 a0 = *(const u32x4*)r0, g0 = *(const u32x4*)(r0 + 128), a1 = *(const u32x4*)r1, g1 = *(const u32x4*)(r1 + 128), a2 = *(const u32x4*)r2, g2 = *(const u32x4*)(r2 + 128);
        const u32x4 z = {0, 0, 0, 0};
        if (first && lr == 0) { a1 = z; g1 = z; }
        if (first) { a2 = z; g2 = z; }
        float r[8];
#pragma unroll
        for (int e = 0; e < 8; ++e) { const int w_ = e >> 1;
            const float x0 = (e & 1) ? bfhi(a0[w_]) : bflo(a0[w_]), x1 = (e & 1) ? bfhi(a1[w_]) : bflo(a1[w_]), x2 = (e & 1) ? bfhi(a2[w_]) : bflo(a2[w_]);
            const float y0 = (e & 1) ? bfhi(g0[w_]) : bflo(g0[w_]), y1 = (e & 1) ? bfhi(g1[w_]) : bflo(g1[w_]), y2 = (e & 1) ? bfhi(g2[w_]) : bflo(g2[w_]);
            const float ya = cb[c + e] + cw[c + e] * x0 + cw[UPW + c + e] * x1 + cw[2 * UPW + c + e] * x2;
            const float yg = cb[DFF + c + e] + cw[DFF + c + e] * y0 + cw[UPW + DFF + c + e] * y1 + cw[2 * UPW + DFF + c + e] * y2;
            r[e] = ya * yg / (1.f + __expf(-yg)); }
        u32x4 w; w.x = cvtpk(r[0], r[1]); w.y = cvtpk(r[2], r[3]); w.z = cvtpk(r[4], r[5]); w.w = cvtpk(r[6], r[7]);
        *(u32x4*)(ACT + (size_t)(sl * 64 + lr) * DFF + c) = w;
    }
}

#define XB_TMO      128
#define XB_XCNT(j)  (256  + 64 * (j))
#define XB_XSUB(j)  (1280 + 64 * (j))
#define XB_XGEN(j)  (2304 + 64 * (j))
#define XB_TOP      3328
#define XB_TOPGEN   3392
#define XCD_BAR_WORDS 3456
#define XB_SPIN_CAP (1u << 27)

__device__ __forceinline__ unsigned xb_ld(unsigned* p)              { return __hip_atomic_load(p, __ATOMIC_RELAXED, __HIP_MEMORY_SCOPE_AGENT); }
__device__ __forceinline__ unsigned xb_add(unsigned* p, unsigned v) { return __hip_atomic_fetch_add(p, v, __ATOMIC_RELAXED, __HIP_MEMORY_SCOPE_AGENT); }
__device__ __forceinline__ unsigned xb_xcc_id() { return (unsigned)__builtin_amdgcn_s_getreg((3 << 11) | 20) & 0xFu; }
#define XB_SPIN(cond, bar) do { unsigned _sp = 0; while (cond) { __builtin_amdgcn_s_sleep(1); \
    if ((++_sp & 255u) == 0u) { if (xb_ld(&(bar)[XB_TMO])) break; if (_sp > XB_SPIN_CAP) { atomicAdd(&(bar)[XB_TMO], 1u); break; } } } } while (0)

struct XcdBarrier {
    unsigned* bar; unsigned x;
    volatile LAS unsigned* st;
};

__device__ __forceinline__ XcdBarrier xcd_barrier_post(unsigned* bar, volatile LAS unsigned* st) {
    XcdBarrier b; b.bar = bar; b.x = xb_xcc_id(); b.st = st;
    if (threadIdx.x == 0) (void)xb_add(&bar[XB_XCNT(b.x)], 1u);
    return b;
}
__device__ __forceinline__ void xcd_barrier_complete(unsigned* bar, unsigned x, unsigned& nloc, unsigned& nx) {
    const unsigned G = gridDim.x * gridDim.y * gridDim.z;
    unsigned sum, cnt, mine, sp = 0u;
    for (;;) {
        sum = 0u; cnt = 0u; mine = 0u;
#pragma unroll
        for (unsigned j = 0; j < 16; ++j) { const unsigned c = xb_ld(&bar[XB_XCNT(j)]); sum += c; cnt += (c > 0u) ? 1u : 0u; mine = (j == x) ? c : mine; }
        if (sum == G) break;
        __builtin_amdgcn_s_sleep(1);
        if ((++sp & 255u) == 0u) { if (xb_ld(&bar[XB_TMO])) break; if (sp > XB_SPIN_CAP) { atomicAdd(&bar[XB_TMO], 1u); break; } }
    }
    nloc = mine > 0u ? mine : 1u; nx = cnt > 0u ? cnt : 1u;
}

__device__ __forceinline__ void xcd_barrier(const XcdBarrier& b) {
    asm volatile("s_waitcnt vmcnt(0)" ::: "memory");
    __syncthreads();
    if (threadIdx.x == 0) {
        unsigned* bar = b.bar;
        __builtin_amdgcn_s_waitcnt(0);
        unsigned nloc = b.st[0], nx = b.st[1];
        if (nloc == 0u) { xcd_barrier_complete(bar, b.x, nloc, nx); b.st[0] = nloc; b.st[1] = nx; }
        const unsigned old = xb_add(&bar[XB_XSUB(b.x)], 1u);
        const unsigned gen = old / nloc;
        if (old + 1u == (gen + 1u) * nloc) {
            __builtin_amdgcn_fence(__ATOMIC_RELEASE, "agent");
            asm volatile("s_waitcnt vmcnt(0)" ::: "memory");
            const unsigned og = xb_add(&bar[XB_TOP], 1u);
            const unsigned tg = og / nx;
            if (og + 1u == (tg + 1u) * nx) xb_add(&bar[XB_TOPGEN], 1u);
            else XB_SPIN(xb_ld(&bar[XB_TOPGEN]) == tg, bar);
            __builtin_amdgcn_fence(__ATOMIC_ACQUIRE, "agent");
            xb_add(&bar[XB_XGEN(b.x)], 1u);
            asm volatile("s_waitcnt vmcnt(0)" ::: "memory");
        } else {
            XB_SPIN(xb_ld(&bar[XB_XGEN(b.x)]) == gen, bar);
            __builtin_amdgcn_fence(__ATOMIC_ACQUIRE, "agent");
            asm volatile("s_waitcnt vmcnt(0)" ::: "memory");
        }
    }
    __syncthreads();
}

constexpr int BG_ITEMS = 16, BG_UNITS_LAYER = (I_LAYER + BG_ITEMS - 1) / BG_ITEMS, BG_TOTAL = (DEPTH - 1) * BG_UNITS_LAYER;
__device__ __forceinline__ void bg_unit(const Params& P, LAS unsigned char* lds, int u, int wave) {
    const int l = 1 + u / BG_UNITS_LAYER, r0 = (u % BG_UNITS_LAYER) * BG_ITEMS + wave * (BG_ITEMS / NWAVES);
    LAS float* scr = (LAS float*)(lds + wave * 16384); const int ln = lane_id_opaque();
    for (int k = 0; k < BG_ITEMS / NWAVES; ++k) { const int r = r0 + k; if (r < I_LAYER) p0_layer_item(P, scr, l, r, ln); }
}
__device__ __forceinline__ void bg_fill(const Params& P, LAS unsigned char* lds, unsigned* ctl, int bar_idx, int must_upto, int tid, int wave) {
    unsigned* done = ctl + 2560 + 16 * bar_idx; unsigned* nxt = ctl + 64 * 39;
    LAS int* slot = (LAS int*)(lds + L_MISC) + 3;
    const unsigned thresh = (gridDim.x * 13u) / 16u;
    __syncthreads();
    if (tid == 0) atomicAdd(done, 1u);
    for (;;) {
        if (tid == 0) { int u = -1; const unsigned cur = __hip_atomic_load(nxt, __ATOMIC_RELAXED, __HIP_MEMORY_SCOPE_AGENT);
            bool want = cur < (unsigned)must_upto;
            if (!want && cur < (unsigned)BG_TOTAL) want = __hip_atomic_load(done, __ATOMIC_RELAXED, __HIP_MEMORY_SCOPE_AGENT) < thresh;
            if (want) { u = (int)atomicAdd(nxt, 1u); if (u >= BG_TOTAL) u = -1; }
            *slot = u; }
        __syncthreads();
        const int u = *slot;
        __syncthreads();
        if (u < 0) break;
        bg_unit(P, lds, u, wave);
    }
}

__global__ void __launch_bounds__(NTHREADS) fwd_megakernel(Params P) {
    extern __shared__ __attribute__((aligned(16))) unsigned char lds_raw[];
    LAS unsigned char* lds = (LAS unsigned char*)lds_raw;
    int wave0 = __builtin_amdgcn_readfirstlane((int)threadIdx.x >> 6);
    unsigned char* ws0 = P.ws;
    volatile LAS unsigned* bst = (volatile LAS unsigned*)(lds + LDS_BYTES - 64);
    if (threadIdx.x < 2) bst[threadIdx.x] = 0u;
    __syncthreads();
    (void)xcd_barrier_post((unsigned*)(P.ws + WS_CTL) + 4096, bst);
#define GRID_BAR() do { XcdBarrier b_; b_.bar = (unsigned*)(ws0 + WS_CTL) + 4096; b_.x = xb_xcc_id(); b_.st = (volatile LAS unsigned*)(lds + LDS_BYTES - 64); xcd_barrier(b_); } while (0)
    { const int wave = wave0, lane = lane_id_opaque(), tid = wave * 64 + lane;

#ifndef SKIP_P0
    p0_prologue(P, lds, tid, lane, wave);
#ifdef DUP_P0
    p0_prologue(P, lds, tid, lane, wave);
#endif
#endif
    }
    GRID_BAR();

#pragma unroll 1
    for (int layer = 0; layer < DEPTH; ++layer) {
        asm volatile("" : "+s"(wave0), "+s"(ws0));
        const int wave = wave0, lane = lane_id_opaque(), tid = wave * 64 + lane;
        const int G = gridDim.x, gw = blockIdx.x * NWAVES + wave, NGW = G * NWAVES;
        unsigned char* ws = ws0;
        unsigned* ctl = (unsigned*)(ws + WS_CTL);
#ifdef PROBE_ZERO_O
        for (size_t i = (size_t)blockIdx.x * NTHREADS + tid; i < (size_t)MROWS * 2048 / 8; i += (size_t)G * NTHREADS) ((u32x4*)(ws + WS_O))[i] = (u32x4){0u, 0u, 0u, 0u};
#endif
        { pg8::Gemm gm{(const pg8::bf16_t*)(ws + WS_XB), (const pg8::bf16_t*)(ws + WS_WIN + layer * SZ_WIN), MROWS, INP, DM};
          pg8::StaticOrder S; S.init(MROWS, INP, G, (int)blockIdx.x);
          pg8::EpiScaleBf16 E{(pg8::bf16_t*)(ws + WS_PROJ), INP, (const float*)(ws + WS_SSP)};
          pg8::gemm_phase<pg8::EpiScaleBf16, pg8::StaticOrder, true, true>(lds, gm, S, E, wave); }
#ifdef BGFILL
        bg_fill(P, lds, ctl, layer * 10 + 0, BG_UNITS_LAYER * (layer + 0), tid, wave);
#endif
        GRID_BAR();
#ifndef SKIP_CMP
        for (int it = wave * G + (int)blockIdx.x; it < 384 + 512; it += NGW) { if (it < 384) item_compress(P, layer, it, lane); else item_kmean(P, it - 384, lane); }
#ifdef DUP_CMP
        for (int it = wave * G + (int)blockIdx.x; it < 384 + 512; it += NGW) { if (it < 384) item_compress(P, layer, it, lane); else item_kmean(P, it - 384, lane); }
#endif
#endif
#ifndef SKIP_MIXA
#ifdef DUP_P2A
        for (int rep_ = 0; rep_ < 2; ++rep_)
        for (;;) { const int u = next_unit(ctl + 64 * (layer * 2 + 0 + 8 * rep_), lds, tid); if (u >= 1536) break; const int ln_ = lane_id_opaque(); unit_mixA(P, lds, u, wave * 64 + ln_, ln_, wave); }
#else
        for (;;) { const int u = next_unit(ctl + 64 * (layer * 2 + 0), lds, tid); if (u >= 1536) break; const int ln_ = lane_id_opaque(); unit_mixA(P, lds, u, wave * 64 + ln_, ln_, wave); }
#endif
#endif
        GRID_BAR();
        for (int r = gw; r < MROWS; r += NGW) item_combineA(P, r, lane);
#ifdef DUP_P2B
        for (int rep_ = 0; rep_ < 2; ++rep_)
        for (;;) { const int u = next_unit(ctl + 64 * (layer * 2 + 1 + 8 * rep_), lds, tid); if (u >= 384 + 1024) break;
#ifdef DUP_NSA_ONLY
            if (rep_ == 1 && u >= 384) continue;
#endif
#else
#ifdef TAILFILL_P2B
        const int n_units_b = 384 + 1024 + ((layer + 1 < DEPTH) ? N_CONV_UNITS : 0);
#else
        const int n_units_b = 384 + 1024;
#endif
        for (;;) { const int u = next_unit(ctl + 64 * (layer * 2 + 1), lds, tid); if (u >= n_units_b) break;
            if (u >= 384 + 1024) {
                LAS float* scr = (LAS float*)(lds + wave * 16384); const int ln_ = lane_id_opaque();
                for (int k = 0; k < CONV_UNIT_ITEMS / NWAVES; ++k) { const int r = (u - 384 - 1024) * CONV_UNIT_ITEMS + wave * (CONV_UNIT_ITEMS / NWAVES) + k; if (r < I_LAYER) p0_layer_item(P, scr, layer + 1, r, ln_); }
                continue; }
#endif
            if (u < 384) {
#ifndef SKIP_NSA
                { const int ln_ = lane_id_opaque(); unit_nsa(P, lds, (u % 6) / 3, (u % 6) % 3, 63 - u / 6, wave * 64 + ln_, ln_, wave); }
#endif
            } else { const int v = u - 384;
#ifndef SKIP_MOBA
                { const int ln_ = lane_id_opaque(); unit_moba(P, lds, (v % 16) / 8, (v % 16) % 8, 63 - v / 16, wave * 64 + ln_, ln_, wave); }
#endif
            } }
        GRID_BAR();
        { pg8::Gemm gm{(const pg8::bf16_t*)(ws + WS_O), (const pg8::bf16_t*)(ws + WS_WOUT + layer * SZ_WOUT), MROWS, DM, DM};
          pg8::StaticOrder S; S.init(MROWS, DM, G, (int)blockIdx.x);
          pg8::EpiResid E{(pg8::bf16_t*)(ws + WS_XB), (float*)(ws + WS_SSP)};
          pg8::gemm_phase<pg8::EpiResid, pg8::StaticOrder, true, true>(lds, gm, S, E, wave); }
        GRID_BAR();
#ifdef FUSE_CONV
        { pg8::Gemm gm{(const pg8::bf16_t*)(ws + WS_XB), (const pg8::bf16_t*)(ws + WS_WUP + layer * SZ_WUP), MROWS, UPW, DM};
          pg8::StaticOrder S; S.init(MROWS, UPW, G, (int)blockIdx.x);
          pg8::EpiConvGate E{(pg8::bf16_t*)(ws + WS_ACT), (pg8::bf16_t*)(ws + WS_UB), (const float*)(ws + WS_SSP), P.conv_w + (size_t)layer * 3 * UPW, P.conv_b + (size_t)layer * UPW, DFF};
          pg8::gemm_phase<pg8::EpiConvGate, pg8::StaticOrder, true, true>(lds, gm, S, E, wave); }
#ifdef BGFILL
        bg_fill(P, lds, ctl, layer * 10 + 4, BG_UNITS_LAYER * (layer + 0), tid, wave);
#endif
        GRID_BAR();
        phase_convfix(P, layer, tid);
        GRID_BAR();
#else
        { pg8::Gemm gm{(const pg8::bf16_t*)(ws + WS_XB), (const pg8::bf16_t*)(ws + WS_WUP + layer * SZ_WUP), MROWS, UPW, DM};
          pg8::StaticOrder S; S.init(MROWS, UPW, G, (int)blockIdx.x);
          pg8::EpiScaleBf16 E{(pg8::bf16_t*)(ws + WS_U), UPW, (const float*)(ws + WS_SSP)};
#ifdef DUP_G3
          pg8::gemm_phase<pg8::EpiScaleBf16, pg8::StaticOrder, true, true>(lds, gm, S, E, wave);
#endif
          pg8::gemm_phase<pg8::EpiScaleBf16, pg8::StaticOrder, true, true>(lds, gm, S, E, wave); }
        GRID_BAR();
#ifndef SKIP_CONV
        phase_conv(P, layer, tid);
#ifdef DUP_CONV
        phase_conv(P, layer, tid);
#endif
#endif
        GRID_BAR();
#endif
        { pg8::Gemm gm{(const pg8::bf16_t*)(ws + WS_ACT), (const pg8::bf16_t*)(ws + WS_WDN + layer * SZ_WDN), MROWS, DM, DFF};
          pg8::StaticOrder S; S.init(MROWS, DM, G, (int)blockIdx.x);
          pg8::EpiResid E{(pg8::bf16_t*)(ws + WS_XB), (float*)(ws + WS_SSP)};
          pg8::gemm_phase<pg8::EpiResid, pg8::StaticOrder, true, true>(lds, gm, S, E, wave); }
#ifdef BGFILL
        bg_fill(P, lds, ctl, layer * 10 + 8, BG_UNITS_LAYER * (layer + 1), tid, wave);
#endif
        GRID_BAR();
    }
    const int wave = wave0, lane = lane_id_opaque();
    const int G = gridDim.x, gw = blockIdx.x * NWAVES + wave, NGW = G * NWAVES;
    unsigned char* ws = ws0; (void)G;
    for (int mrow = gw; mrow < MROWS; mrow += NGW) {
        const u32x2* xr = (const u32x2*)((const bf16_t*)(ws + WS_XB) + (size_t)mrow * DM) + lane; const f32x4* gr = (const f32x4*)P.norm_final + lane;
        f32x4 v[8]; float s = 0.f;
#pragma unroll
        for (int j = 0; j < 8; ++j) { const u32x2 w = xr[64 * j]; v[j] = (f32x4){bflo(w.x), bfhi(w.x), bflo(w.y), bfhi(w.y)}; s += (v[j][0] * v[j][0] + v[j][1] * v[j][1]) + (v[j][2] * v[j][2] + v[j][3] * v[j][3]); }
#pragma unroll
        for (int o = 1; o < 64; o <<= 1) s += __shfl_xor(s, o);
        const float rs = 1.0f / sqrtf(s * (1.0f / DM) + 1e-6f);
        f32x4* orow = (f32x4*)(P.out + (size_t)mrow * DM) + lane;
#pragma unroll
        for (int j = 0; j < 8; ++j) orow[64 * j] = v[j] * rs * gr[64 * j];
    }
}

extern "C" void kernel_launch(void* const* d_in, const int* in_sizes, int n_in, void* d_out, int out_size, void* d_ws, size_t ws_size, hipStream_t stream) {
    static int grid = 0;
    if (grid == 0) {
        if (n_in != 14 || ws_size < WS_END) { fprintf(stderr, "kernel_launch: unexpected n_in %d or workspace %zu < %zu\n", n_in, ws_size, (size_t)WS_END); grid = -1; return; }
        int dev = 0, cus = 0, per_cu = 0;
        hipGetDevice(&dev); hipDeviceGetAttribute(&cus, hipDeviceAttributeMultiprocessorCount, dev);
        if (hipFuncSetAttribute((const void*)fwd_megakernel, hipFuncAttributeMaxDynamicSharedMemorySize, LDS_BYTES) != hipSuccess) { fprintf(stderr, "kernel_launch: hipFuncSetAttribute failed\n"); grid = -1; return; }
        if (hipOccupancyMaxActiveBlocksPerMultiprocessor(&per_cu, (const void*)fwd_megakernel, NTHREADS, LDS_BYTES) != hipSuccess || per_cu < 1) { fprintf(stderr, "kernel_launch: occupancy query says %d\n", per_cu); per_cu = 1; }
        (void)hipGetLastError();
        grid = cus * 1;
    }
    if (grid < 0) return;
    hipMemsetAsync((char*)d_ws + WS_CTL, 0, CTL_BYTES, stream);
    Params p{};
    p.x = (const float*)d_in[0]; p.rel = (const float*)d_in[1]; p.w_in = (const float*)d_in[2]; p.w_out = (const float*)d_in[3]; p.cmp_w1 = (const float*)d_in[4]; p.cmp_w2 = (const float*)d_in[5];
    p.cmp_pe = (const float*)d_in[6]; p.norm_attn = (const float*)d_in[7]; p.norm_mlp = (const float*)d_in[8]; p.w_up = (const float*)d_in[9]; p.conv_w = (const float*)d_in[10]; p.conv_b = (const float*)d_in[11];
    p.w_down = (const float*)d_in[12]; p.norm_final = (const float*)d_in[13]; p.out = (float*)d_out; p.ws = (unsigned char*)d_ws;
    void* args[] = {&p};
    hipError_t e = hipLaunchCooperativeKernel((const void*)fwd_megakernel, dim3(grid), dim3(NTHREADS), args, LDS_BYTES, stream);
    if (e != hipSuccess) fprintf(stderr, "kernel_launch: cooperative launch failed: %s (grid %d)\n", hipGetErrorString(e), grid);
}
```

```cpp
#define FUSE_CONV
#define CONV_DPP
#include <hip/hip_runtime.h>
#include <hip/hip_cooperative_groups.h>
#include <cstdio>
#include <cstdint>
namespace cg = cooperative_groups;
namespace pg8 {
#define PG8_LAS __attribute__((address_space(3)))
typedef unsigned short bf16_t;
typedef short bf16x8 __attribute__((ext_vector_type(8)));
typedef float f32x4 __attribute__((ext_vector_type(4)));
typedef unsigned u32x4 __attribute__((ext_vector_type(4)));
constexpr int BM = 256, BK = 64, HALF = 128, HTB = HALF * BK * 2  , STAGE_BYTES = 8 * HTB, NXCD = 8, WGM = 8;

__host__ __device__ __forceinline__ int lds_byte(int r, int c) { const int st = (r >> 4) * 2 + (c >> 5), rr = r & 15, cc = c & 31, ob = rr * 64 + cc * 2; return st * 1024 + (ob ^ (((ob >> 9) & 1) << 5)); }
__host__ __device__ __forceinline__ void stage_rc(int b, int& R, int& C) { const int st = b / 1024, sb = b % 1024, swz = sb ^ (((sb >> 9) & 1) << 5); R = (st >> 1) * 16 + swz / 64; C = (st & 1) * 32 + (swz % 64) / 2; }
__host__ __device__ __forceinline__ int perm32(int rho) { const int n = rho >> 4, i = rho & 15; return 8 * (i >> 2) + 4 * n + (i & 3); }

struct Unit { int pm, pn; };
struct Gemm { const bf16_t* A; const bf16_t* Bt; int M, N, K; };

struct StaticOrder {
    int nM, nN, nwg, G, c;
    __host__ __device__ void init(int M, int N, int G_, int c_) { nM = M / BM; nN = N / BM; nwg = nM * nN; G = G_; c = c_; }
    __host__ __device__ bool next(int i, Unit& u) const {
        const long L = (long)i * G + c; if (L >= nwg) return false;
        int wgid = (int)L; { const int q = nwg / NXCD, r = nwg % NXCD, xcd = wgid % NXCD, off = wgid / NXCD; wgid = (xcd < r ? xcd * (q + 1) : r * (q + 1) + (xcd - r) * q) + off; }
        const int nig = WGM * nN, gid = wgid / nig, fm = gid * WGM, gsz = (nM - fm) < WGM ? (nM - fm) : WGM;
        u.pm = fm + ((wgid % nig) % gsz); u.pn = (wgid % nig) / gsz; return true;
    }
    __device__ __forceinline__ void a_ready(const Unit&) const {}
    __device__ __forceinline__ void done(const Unit&) const {}
};
typedef float f32x2 __attribute__((ext_vector_type(2)));
typedef __bf16 bf16x2_pk __attribute__((ext_vector_type(2)));
__device__ __forceinline__ unsigned cvt_pk_bf16(float lo, float hi) { f32x2 v = {lo, hi}; bf16x2_pk b = __builtin_convertvector(v, bf16x2_pk); return __builtin_bit_cast(unsigned, b); }
__device__ __forceinline__ float row_rstd(const float* ssp, int row) {
    const f32x4* p = (const f32x4*)(ssp + (size_t)row * 32); float s = 0.f;
#pragma unroll
    for (int i = 0; i < 8; ++i) { const f32x4 v = p[i]; s += (v[0] + v[1]) + (v[2] + v[3]); }
    return 1.0f / sqrtf(s * (1.0f / 2048.0f) + 1e-6f);
}
struct EpiScaleBf16 {
    static constexpr bool PERM = true, AFTER_DRAIN = false;
    bf16_t* O; int ldc; const float* ssp;
    __device__ __forceinline__ void operator()(const f32x4 (&acc)[2][2][4][2], const Unit& u, int wr, int wc, int fr, int fq) const {
        const int lane = fq * 16 + fr;
        const int rbase = u.pm * BM + wr * 64;
        f32x4 t[2][8];
#pragma unroll
        for (int j = 0; j < 2; ++j) { const int q = 2 * lane + j; const int row = rbase + (q >> 6) * HALF + (q & 63);
            const f32x4* p = (const f32x4*)(ssp + (size_t)row * 32);
#pragma unroll
            for (int i = 0; i < 8; ++i) t[j][i] = p[i]; }
        __builtin_amdgcn_sched_barrier(0);
        float rsv[2];
#pragma unroll
        for (int j = 0; j < 2; ++j) { float sm = 0.f;
#pragma unroll
            for (int i = 0; i < 8; ++i) sm += (t[j][i][0] + t[j][i][1]) + (t[j][i][2] + t[j][i][3]);
            rsv[j] = 1.0f / sqrtf(sm * (1.0f / 2048.0f) + 1e-6f); }
        const int row0 = rbase + fr; const int col0 = u.pn * BM + wc * 32 + 8 * fq;
#pragma unroll
        for (int ai = 0; ai < 2; ++ai)
#pragma unroll
            for (int m = 0; m < 4; ++m) { const int q = ai * 64 + m * 16 + fr; const float v0 = __shfl(rsv[0], q >> 1), v1 = __shfl(rsv[1], q >> 1); const float rs = (q & 1) ? v1 : v0;
                bf16_t* rowp = O + (size_t)(row0 + ai * HALF + m * 16) * ldc + col0;
#pragma unroll
                for (int bj = 0; bj < 2; ++bj) { const f32x4 v0_ = acc[ai][bj][m][0] * rs, v1_ = acc[ai][bj][m][1] * rs; u32x4 w;
                    w.x = cvt_pk_bf16(v0_[0], v0_[1]); w.y = cvt_pk_bf16(v0_[2], v0_[3]); w.z = cvt_pk_bf16(v1_[0], v1_[1]); w.w = cvt_pk_bf16(v1_[2], v1_[3]);
                    *(u32x4*)(rowp + bj * HALF) = w; } }
    }
};
struct EpiResid {
    static constexpr bool PERM = false, AFTER_DRAIN = false;
    bf16_t* XB; float* ssp;
    __device__ __forceinline__ void operator()(const f32x4 (&acc)[2][2][4][2], const Unit& u, int wr, int wc, int fr, int fq) const {
        typedef unsigned u32x2v __attribute__((ext_vector_type(2)));
        const int row0 = u.pm * BM + wr * 64 + fr; const int col0 = u.pn * BM + wc * 32 + 4 * fq;
#pragma unroll
        for (int ai = 0; ai < 2; ++ai) {
            u32x2v bs[4][2][2];
#pragma unroll
            for (int m = 0; m < 4; ++m)
#pragma unroll
                for (int bj = 0; bj < 2; ++bj)
#pragma unroll
                    for (int n = 0; n < 2; ++n) bs[m][bj][n] = *(const u32x2v*)(XB + (size_t)(row0 + ai * HALF + m * 16) * 2048 + col0 + bj * HALF + n * 16);
            __builtin_amdgcn_sched_barrier(0);
#pragma unroll
            for (int m = 0; m < 4; ++m) { const int row = row0 + ai * HALF + m * 16; const size_t off = (size_t)row * 2048 + col0; float ss = 0.f;
#pragma unroll
                for (int bj = 0; bj < 2; ++bj)
#pragma unroll
                    for (int n = 0; n < 2; ++n) { const size_t o2 = off + bj * HALF + n * 16; const u32x2v b2 = bs[m][bj][n];
                        const f32x4 bv = {__uint_as_float(b2.x << 16), __uint_as_float(b2.x & 0xffff0000u), __uint_as_float(b2.y << 16), __uint_as_float(b2.y & 0xffff0000u)};
                        const f32x4 v = bv + acc[ai][bj][m][n];
                        u32x2v w; w.x = cvt_pk_bf16(v[0], v[1]); w.y = cvt_pk_bf16(v[2], v[3]); *(u32x2v*)(XB + o2) = w;
                        ss += (v[0] * v[0] + v[1] * v[1]) + (v[2] * v[2] + v[3] * v[3]); }
                ss += __shfl_xor(ss, 16); ss += __shfl_xor(ss, 32);
                if (fq == 0) ssp[(size_t)row * 32 + u.pn * 4 + wc] = ss; }
            asm volatile("" ::: "memory");
        }
    }
};
template <int CTRL> __device__ __forceinline__ float dpp_f(float v) { return __builtin_bit_cast(float, __builtin_amdgcn_update_dpp(0, __builtin_bit_cast(int, v), CTRL, 0xf, 0xf, false)); }
#ifdef CONV_DPP
#define ROWM1(v) dpp_f<0x121>(v)
#define ROWM2(v) dpp_f<0x122>(v)
#else
#define ROWM1(v) __shfl(v, src1)
#define ROWM2(v) __shfl(v, src2)
#endif
struct EpiConvGate {
    static constexpr bool PERM = true, AFTER_DRAIN = false;
    bf16_t* ACT; bf16_t* UB; const float* ssp; const float* cw; const float* cb; int dff;
    __device__ __forceinline__ void operator()(const f32x4 (&acc)[2][2][4][2], const Unit& u, int wr, int wc, int fr, int fq) const {
        typedef unsigned u32x2v __attribute__((ext_vector_type(2)));
        const int lane = fq * 16 + fr;
        const int rbase = u.pm * BM + wr * 64;
        const int upw = 2 * dff;
        float rsv[2];
        { f32x4 t[2][8];
#pragma unroll
          for (int j = 0; j < 2; ++j) { const int q = 2 * lane + j; const int row = rbase + (q >> 6) * HALF + (q & 63);
              const f32x4* p = (const f32x4*)(ssp + (size_t)row * 32);
#pragma unroll
              for (int i = 0; i < 8; ++i) t[j][i] = p[i]; }
          __builtin_amdgcn_sched_barrier(0);
#pragma unroll
          for (int j = 0; j < 2; ++j) { float sm = 0.f;
#pragma unroll
              for (int i = 0; i < 8; ++i) sm += (t[j][i][0] + t[j][i][1]) + (t[j][i][2] + t[j][i][3]);
              rsv[j] = 1.0f / sqrtf(sm * (1.0f / 2048.0f) + 1e-6f); } }
        const int src1 = fq * 16 + ((fr + 15) & 15), src2 = fq * 16 + ((fr + 14) & 15); (void)src1; (void)src2;
        const int chb = u.pn * HALF + wc * 32 + 8 * fq;
        const int ucb = u.pn * BM + wc * 32 + 8 * fq;
#pragma unroll
        for (int n = 0; n < 2; ++n) {
            const int ch = chb + 4 * n;
            const f32x4 wa0 = *(const f32x4*)(cw + ch), wa1 = *(const f32x4*)(cw + upw + ch), wa2 = *(const f32x4*)(cw + 2 * upw + ch);
            const f32x4 wg0 = *(const f32x4*)(cw + dff + ch), wg1 = *(const f32x4*)(cw + upw + dff + ch), wg2 = *(const f32x4*)(cw + 2 * upw + dff + ch);
            const f32x4 ba = *(const f32x4*)(cb + ch), bg = *(const f32x4*)(cb + dff + ch);
            __builtin_amdgcn_sched_barrier(0);
#pragma unroll
            for (int ai = 0; ai < 2; ++ai) {
                f32x4 pa = {0.f, 0.f, 0.f, 0.f}, pg = {0.f, 0.f, 0.f, 0.f};
#pragma unroll
                for (int m = 0; m < 4; ++m) {
                    const int q = ai * 64 + m * 16 + fr; const float rv0 = __shfl(rsv[0], q >> 1), rv1 = __shfl(rsv[1], q >> 1); const float rsm = (q & 1) ? rv1 : rv0;
                    const f32x4 va = acc[ai][0][m][n] * rsm, vg = acc[ai][1][m][n] * rsm;
                    f32x4 a1, a2, g1, g2;
#pragma unroll
                    for (int x = 0; x < 4; ++x) {
                        const float c1 = ROWM1(va[x]), c2 = ROWM2(va[x]), e1 = ROWM1(vg[x]), e2 = ROWM2(vg[x]);
                        float d1 = 0.f, d2 = 0.f, f1 = 0.f, f2 = 0.f;
                        if (m > 0) { d1 = ROWM1(pa[x]); d2 = ROWM2(pa[x]); f1 = ROWM1(pg[x]); f2 = ROWM2(pg[x]); }
                        a1[x] = fr >= 1 ? c1 : d1; a2[x] = fr >= 2 ? c2 : d2; g1[x] = fr >= 1 ? e1 : f1; g2[x] = fr >= 2 ? e2 : f2; }
                    const f32x4 ya = ba + wa0 * va + wa1 * a1 + wa2 * a2, yg = bg + wg0 * vg + wg1 * g1 + wg2 * g2;
                    float r4[4];
#pragma unroll
                    for (int x = 0; x < 4; ++x) r4[x] = ya[x] * yg[x] / (1.f + __expf(-yg[x]));
                    const int row = rbase + ai * HALF + m * 16 + fr;
                    if (m > 0 || fr >= 2) { u32x2v w; w.x = cvt_pk_bf16(r4[0], r4[1]); w.y = cvt_pk_bf16(r4[2], r4[3]); *(u32x2v*)(ACT + (size_t)row * dff + ch) = w; }
                    if ((m == 0 && fr < 2) || (m == 3 && fr >= 14)) { const int k = (m == 0) ? fr : fr - 12; bf16_t* ub = UB + ((size_t)(row >> 6) * 4 + k) * upw + ucb + 4 * n;
                        u32x2v w; w.x = cvt_pk_bf16(va[0], va[1]); w.y = cvt_pk_bf16(va[2], va[3]); *(u32x2v*)ub = w;
                        w.x = cvt_pk_bf16(vg[0], vg[1]); w.y = cvt_pk_bf16(vg[2], vg[3]); *(u32x2v*)(ub + HALF) = w; }
                    pa = va; pg = vg;
                }
                asm volatile("" ::: "memory");
            }
        }
    }
};
template <class Epi, class Sched, bool ALIGN_EPI = false, bool SP2 = false>
__device__ __forceinline__ void gemm_phase(PG8_LAS unsigned char* lds, const Gemm g, const Sched& S, const Epi& E, const int wid_in) {
    int lane_; asm volatile("v_mbcnt_lo_u32_b32 %0, -1, 0\n\tv_mbcnt_hi_u32_b32 %0, -1, %0" : "=v"(lane_)); const int wid = wid_in, lane = lane_, tid = wid * 64 + lane, wr = wid >> 2, wc = wid & 3, fr = lane & 15, fq = lane >> 4;
    const int K = g.K, nt = K / BK;
    unsigned voffA[2], voffB[2];
#pragma unroll
    for (int i = 0; i < 2; ++i) { int R, C; stage_rc(tid * 16 + i * 8192, R, C); const int Rb = Epi::PERM ? ((R & ~31) + perm32(R & 31)) : R;
        voffA[i] = (unsigned)(R * K + C) * 2u; voffB[i] = (unsigned)(Rb * K + C) * 2u; }
    const size_t kstep = (size_t)(BK * 2);
    const size_t hstep = (size_t)HALF * K * 2;
    const size_t tstep = 2 * hstep;
    const unsigned ldsw = (unsigned)wid * 1024u;
    const int aoff = lds_byte(wr * 64 + fr, fq * 8), boff = lds_byte(wc * 32 + fr, fq * 8);
#define PG8_SA(b, h) (((b) * 2 + (h)) * HTB)
#define PG8_SB(b, h) ((4 + (b) * 2 + (h)) * HTB)
#define PG8_STAGE(bufoff, gbase, voff) do { _Pragma("unroll") for (int _i = 0; _i < 2; ++_i) \
        __builtin_amdgcn_global_load_lds((const unsigned*)((const char*)(gbase) + (voff)[_i]), (PG8_LAS unsigned*)(lds + (bufoff) + ldsw + _i * 8192), 16, 0, 0); } while (0)
#define PG8_LDA(dst, b, h) do { _Pragma("unroll") for (int m = 0; m < 4; ++m) _Pragma("unroll") for (int k = 0; k < 2; ++k) dst[m][k] = *(const PG8_LAS bf16x8*)(lds + PG8_SA(b, h) + aoff + m * 2048 + k * 1024); } while (0)
#define PG8_LDB(dst, b, h) do { _Pragma("unroll") for (int n = 0; n < 2; ++n) _Pragma("unroll") for (int k = 0; k < 2; ++k) dst[n][k] = *(const PG8_LAS bf16x8*)(lds + PG8_SB(b, h) + boff + n * 2048 + k * 1024); } while (0)
#define PG8_MMA(ai, bj, At, Bt) do { __builtin_amdgcn_s_setprio(1); _Pragma("unroll") for (int m = 0; m < 4; ++m) _Pragma("unroll") for (int n = 0; n < 2; ++n) _Pragma("unroll") for (int k = 0; k < 2; ++k) \
        acc[ai][bj][m][n] = __builtin_amdgcn_mfma_f32_16x16x32_bf16(Bt[n][k], At[m][k], acc[ai][bj][m][n], 0, 0, 0); __builtin_amdgcn_s_setprio(0); } while (0)
#define PG8_WAIT_V(n) asm volatile("s_waitcnt vmcnt(" #n ")" ::: "memory")
#define PG8_WAIT_L(n) asm volatile("s_waitcnt lgkmcnt(" #n ")" ::: "memory")
#define PG8_BAR __builtin_amdgcn_s_barrier()
#define PG8_SCHED __builtin_amdgcn_sched_barrier(0)
    Unit cur, nxt; int ui = 0;
    if (!S.next(0, cur)) return;
    f32x4 acc[2][2][4][2];
#pragma unroll
    for (int a = 0; a < 2; ++a)
#pragma unroll
        for (int b = 0; b < 2; ++b)
#pragma unroll
            for (int m = 0; m < 4; ++m)
#pragma unroll
                for (int n = 0; n < 2; ++n) acc[a][b][m][n] = (f32x4){0.f, 0.f, 0.f, 0.f};
    bf16x8 At[4][2], B0[2][2], B1[2][2];
    const char* cA = (const char*)g.A + (size_t)cur.pm * tstep; const char* cB = (const char*)g.Bt + (size_t)cur.pn * tstep;
    S.a_ready(cur);
    if constexpr (SP2) {
        PG8_STAGE(PG8_SB(0, 0), cB, voffB); PG8_STAGE(PG8_SB(0, 1), cB + hstep, voffB); PG8_STAGE(PG8_SA(0, 0), cA, voffA); PG8_STAGE(PG8_SA(0, 1), cA + hstep, voffA);
        if (wr == 1) PG8_BAR;
        PG8_WAIT_V(2); PG8_BAR;
        PG8_STAGE(PG8_SB(1, 0), cB + kstep, voffB); PG8_STAGE(PG8_SA(1, 0), cA + kstep, voffA); PG8_STAGE(PG8_SB(1, 1), cB + hstep + kstep, voffB);
        PG8_WAIT_V(6); PG8_BAR;
    } else {
        PG8_STAGE(PG8_SB(0, 0), cB, voffB); PG8_STAGE(PG8_SA(0, 0), cA, voffA); PG8_STAGE(PG8_SB(0, 1), cB + hstep, voffB); PG8_STAGE(PG8_SA(0, 1), cA + hstep, voffA);
        if (wr == 1) PG8_BAR;
        PG8_WAIT_V(4); PG8_BAR;
        PG8_STAGE(PG8_SB(1, 0), cB + kstep, voffB); PG8_STAGE(PG8_SA(1, 0), cA + kstep, voffA); PG8_STAGE(PG8_SB(1, 1), cB + hstep + kstep, voffB);
        PG8_WAIT_V(6); PG8_BAR;
    }
    for (;;) {
        const bool has_next = S.next(ui + 1, nxt);
        const char* nA = has_next ? (const char*)g.A + (size_t)nxt.pm * tstep : cA; const char* nB = has_next ? (const char*)g.Bt + (size_t)nxt.pn * tstep : cB;
        for (int t = 0; t < nt; t += 2) {
            const bool last = (t == nt - 2);
            const char* a1 = cA + (size_t)(t + 1) * kstep;
            const char* a2 = last ? nA : cA + (size_t)(t + 2) * kstep; const char* b2 = last ? nB : cB + (size_t)(t + 2) * kstep;
            const char* a3 = a2 + kstep; const char* b3 = b2 + kstep;
            if (last && has_next) S.a_ready(nxt);
            if constexpr (SP2) {
            PG8_LDB(B0, 0, 0); PG8_LDB(B1, 0, 1); PG8_SCHED; PG8_LDA(At, 0, 0); PG8_STAGE(PG8_SA(1, 1), a1 + hstep, voffA);
            PG8_WAIT_V(8); PG8_WAIT_L(0); PG8_BAR; PG8_MMA(0, 0, At, B0); PG8_MMA(0, 1, At, B1); PG8_BAR; PG8_SCHED;
            PG8_LDA(At, 0, 1); PG8_STAGE(PG8_SB(0, 0), b2, voffB); PG8_STAGE(PG8_SB(0, 1), b2 + hstep, voffB); PG8_STAGE(PG8_SA(0, 0), a2, voffA);
            PG8_WAIT_V(8); PG8_WAIT_L(0); PG8_BAR; PG8_MMA(1, 0, At, B0); PG8_MMA(1, 1, At, B1); PG8_BAR; PG8_SCHED;
            PG8_LDB(B0, 1, 0); PG8_LDB(B1, 1, 1); PG8_SCHED; PG8_LDA(At, 1, 0); PG8_STAGE(PG8_SA(0, 1), a2 + hstep, voffA);
            PG8_WAIT_V(8); PG8_WAIT_L(0); PG8_BAR; PG8_MMA(0, 0, At, B0); PG8_MMA(0, 1, At, B1); PG8_BAR; PG8_SCHED;
            PG8_LDA(At, 1, 1); PG8_STAGE(PG8_SB(1, 0), b3, voffB); PG8_STAGE(PG8_SB(1, 1), b3 + hstep, voffB); PG8_STAGE(PG8_SA(1, 0), a3, voffA);
            PG8_WAIT_V(8); PG8_WAIT_L(0); PG8_BAR; PG8_MMA(1, 0, At, B0); PG8_MMA(1, 1, At, B1); PG8_BAR; PG8_SCHED;
            } else {
            PG8_LDB(B0, 0, 0); PG8_SCHED; PG8_LDA(At, 0, 0); PG8_STAGE(PG8_SA(1, 1), a1 + hstep, voffA);
            PG8_WAIT_L(8); PG8_BAR; PG8_WAIT_L(0); PG8_MMA(0, 0, At, B0); PG8_BAR; PG8_SCHED;
            PG8_LDB(B1, 0, 1); PG8_STAGE(PG8_SB(0, 0), b2, voffB);
            PG8_BAR; PG8_WAIT_L(0); PG8_MMA(0, 1, At, B1); PG8_BAR;
            PG8_LDA(At, 0, 1); PG8_STAGE(PG8_SA(0, 0), a2, voffA);
            PG8_BAR; PG8_WAIT_L(0); PG8_MMA(1, 0, At, B0); PG8_BAR; PG8_SCHED;
            PG8_STAGE(PG8_SB(0, 1), b2 + hstep, voffB);
            PG8_WAIT_V(6); PG8_BAR; PG8_MMA(1, 1, At, B1); PG8_BAR;
            PG8_LDB(B0, 1, 0); PG8_SCHED; PG8_LDA(At, 1, 0); PG8_STAGE(PG8_SA(0, 1), a2 + hstep, voffA);
            PG8_WAIT_L(8); PG8_BAR; PG8_WAIT_L(0); PG8_MMA(0, 0, At, B0); PG8_BAR; PG8_SCHED;
            PG8_LDB(B1, 1, 1); PG8_STAGE(PG8_SB(1, 0), b3, voffB);
            PG8_BAR; PG8_WAIT_L(0); PG8_MMA(0, 1, At, B1); PG8_BAR;
            PG8_LDA(At, 1, 1); PG8_STAGE(PG8_SA(1, 0), a3, voffA);
            PG8_BAR; PG8_WAIT_L(0); PG8_MMA(1, 0, At, B0); PG8_BAR; PG8_SCHED;
            PG8_STAGE(PG8_SB(1, 1), b3 + hstep, voffB);
            PG8_WAIT_V(6); PG8_BAR; PG8_MMA(1, 1, At, B1); PG8_BAR;
            }
        }
        if constexpr (ALIGN_EPI) { if (wr == 0) PG8_BAR; }
        if constexpr (!Epi::AFTER_DRAIN) { E(acc, cur, wr, wc, fr, fq); S.done(cur); }
        if (!has_next) break;
#pragma unroll
        for (int a = 0; a < 2; ++a)
#pragma unroll
            for (int b = 0; b < 2; ++b)
#pragma unroll
                for (int m = 0; m < 4; ++m)
#pragma unroll
                    for (int n = 0; n < 2; ++n) acc[a][b][m][n] = (f32x4){0.f, 0.f, 0.f, 0.f};
        cur = nxt; cA = nA; cB = nB; ++ui;
        if constexpr (ALIGN_EPI) { if (wr == 1) PG8_BAR; }
    }
    PG8_WAIT_V(0);
    if constexpr (!ALIGN_EPI) { if (wr == 0) PG8_BAR; }
    PG8_BAR;
    if constexpr (Epi::AFTER_DRAIN) { E.fused(acc, cur, wr, wc, fr, fq, lds, wid, lane); S.done(cur); }
#undef PG8_SA
#undef PG8_SB
#undef PG8_STAGE
#undef PG8_LDA
#undef PG8_LDB
#undef PG8_MMA
#undef PG8_WAIT_V
#undef PG8_WAIT_L
#undef PG8_BAR
#undef PG8_SCHED
}
}

#define GAS __attribute__((address_space(1)))
#define LAS __attribute__((address_space(3)))
typedef unsigned short bf16_t;
typedef short bf16x8 __attribute__((ext_vector_type(8)));
typedef float f32x4 __attribute__((ext_vector_type(4)));
typedef unsigned u32x4 __attribute__((ext_vector_type(4)));
typedef unsigned u32x2 __attribute__((ext_vector_type(2)));
typedef short s16x4 __attribute__((ext_vector_type(4)));

constexpr int BATCH = 2, SEQ = 8192, DM = 2048, DEPTH = 4, MROWS = BATCH * SEQ;
constexpr int INW = 5796, INP = 5888, DFF = 5632, UPW = 2 * DFF;
constexpr int A_OFF = 0, B_OFF = 2304, CQ_OFF = 3840, CKV_OFF = 4608, CG_OFF = 5760;
constexpr int LUTN = 1536;
constexpr float LOG2E = 1.4426950408889634f, LN2 = 0.6931471805599453f;
constexpr int NTHREADS = 512, NWAVES = 8;

constexpr size_t al256(size_t x) { return (x + 255) & ~(size_t)255; }
constexpr size_t WS_CTL = 0, CTL_BYTES = 1u << 20;
constexpr size_t SZ_WIN = (size_t)INP * DM * 2, SZ_WOUT = (size_t)DM * DM * 2, SZ_WUP = (size_t)UPW * DM * 2, SZ_WDN = (size_t)DM * DFF * 2;
constexpr size_t WS_WIN = CTL_BYTES;
constexpr size_t WS_WOUT = WS_WIN + DEPTH * SZ_WIN;
constexpr size_t WS_WUP = WS_WOUT + DEPTH * SZ_WOUT;
constexpr size_t WS_WDN = WS_WUP + DEPTH * SZ_WUP;
constexpr size_t WS_W1T = WS_WDN + DEPTH * SZ_WDN;
constexpr size_t WS_W2T = WS_W1T + (size_t)DEPTH * 2 * 128 * 2048 * 2;
constexpr size_t WS_CPE = WS_W2T + (size_t)DEPTH * 2 * 64 * 128 * 2;
constexpr size_t WS_GLUT = al256(WS_CPE + (size_t)DEPTH * 2 * 128 * 4);
constexpr size_t WS_X = al256(WS_GLUT + (size_t)32 * LUTN * 4);
constexpr size_t WS_XB = WS_X + (size_t)MROWS * DM * 4;
constexpr size_t WS_SSP = WS_XB + (size_t)MROWS * DM * 2;
constexpr size_t WS_R1 = WS_SSP + (size_t)MROWS * 32 * 4;
constexpr size_t WS_PROJ = WS_R1;
constexpr size_t WS_O = WS_R1 + (size_t)MROWS * INP * 2;
constexpr size_t WS_U = WS_R1;
constexpr size_t SZ_R1 = (size_t)MROWS * UPW * 2;
static_assert((size_t)MROWS * INP * 2 + (size_t)MROWS * DM * 2 <= SZ_R1, "overlay");
constexpr size_t WS_ACT = WS_R1 + SZ_R1;
constexpr size_t WS_TOT = WS_ACT + (size_t)MROWS * DFF * 2;
constexpr size_t WS_LSE = WS_TOT + (size_t)MROWS * 768 * 4;
constexpr size_t WS_KC = WS_LSE + (size_t)MROWS * 12 * 4;
constexpr size_t WS_VC = WS_KC + (size_t)BATCH * 3 * 512 * 64 * 2;
constexpr size_t WS_KMEAN = WS_VC + (size_t)BATCH * 3 * 512 * 64 * 2;
constexpr size_t WS_UB = WS_KMEAN + (size_t)BATCH * 8 * 32 * 64 * 4;
constexpr size_t WS_END = WS_UB + (size_t)(MROWS / 64) * 4 * UPW * 2;

constexpr int KP = 160;
constexpr int TILE_B = 64 * KP;
constexpr int L_K0 = 0, L_V0 = TILE_B, L_K1 = 2 * TILE_B, L_V1 = 3 * TILE_B;
constexpr int L_LUT = 4 * TILE_B;
constexpr int L_IMP = L_LUT + 4 * LUTN * 4;
constexpr int L_SEL = L_IMP + 65536;
constexpr int L_TL = L_SEL + 2048;
constexpr int L_MISC = L_TL + 2048;
constexpr int L_WUN = L_MISC + 64;
constexpr int LDS_BYTES = 147456;
static_assert(L_MISC + 256 <= LDS_BYTES, "lds map");

struct Params {
    const float* x; const float* rel; const float* w_in; const float* w_out; const float* cmp_w1; const float* cmp_w2; const float* cmp_pe;
    const float* norm_attn; const float* norm_mlp; const float* w_up; const float* conv_w; const float* conv_b; const float* w_down; const float* norm_final;
    float* out; unsigned char* ws;
};

typedef float f32x2_t __attribute__((ext_vector_type(2))); typedef __bf16 bf16x2_t __attribute__((ext_vector_type(2)));
__device__ __forceinline__ unsigned cvtpk(float lo, float hi) { f32x2_t v = {lo, hi}; bf16x2_t b = __builtin_convertvector(v, bf16x2_t); return __builtin_bit_cast(unsigned, b); }
__device__ __forceinline__ float bf2f(unsigned short b) { return __uint_as_float(((unsigned)b) << 16); }
__device__ __forceinline__ float bflo(unsigned w) { return __uint_as_float(w << 16); }
__device__ __forceinline__ float bfhi(unsigned w) { return __uint_as_float(w & 0xffff0000u); }
__device__ __forceinline__ float fexp2(float x) { return __builtin_amdgcn_exp2f(x); }
__device__ __forceinline__ int lane_id_opaque() { int l_; asm volatile("v_mbcnt_lo_u32_b32 %0, -1, 0\n\tv_mbcnt_hi_u32_b32 %0, -1, %0" : "=v"(l_)); return l_; }
#define LDS_BARRIER() do { asm volatile("s_waitcnt lgkmcnt(0)" ::: "memory"); __builtin_amdgcn_s_barrier(); asm volatile("" ::: "memory"); } while (0)
__device__ __forceinline__ float fma_1(float a, float b, float c) { float r; asm("v_fma_f32 %0, %1, %2, %3" : "=v"(r) : "v"(a), "v"(b), "v"(c)); return r; }
__device__ __forceinline__ float xrow16_max(float x) {
  auto s_ = __builtin_amdgcn_permlane16_swap(__float_as_uint(x), __float_as_uint(x), false, false);
  x = fmaxf(__uint_as_float(s_[0]), __uint_as_float(s_[1]));
  auto t_ = __builtin_amdgcn_permlane32_swap(__float_as_uint(x), __float_as_uint(x), false, false);
  return fmaxf(__uint_as_float(t_[0]), __uint_as_float(t_[1]));
}
__device__ __forceinline__ float xrow16_sum(float x) {
  auto s_ = __builtin_amdgcn_permlane16_swap(__float_as_uint(x), __float_as_uint(x), false, false);
  x = __uint_as_float(s_[0]) + __uint_as_float(s_[1]);
  auto t_ = __builtin_amdgcn_permlane32_swap(__float_as_uint(x), __float_as_uint(x), false, false);
  return __uint_as_float(t_[0]) + __uint_as_float(t_[1]);
}
__device__ __forceinline__ void lds_wait() { asm volatile("s_waitcnt lgkmcnt(0)" ::: "memory"); }
__device__ __forceinline__ s16x4 tr_read(const LAS unsigned char* p) { return __builtin_bit_cast(s16x4, __builtin_amdgcn_ds_read_tr16_b64_v4i16((LAS s16x4*)p)); }
__device__ __forceinline__ f32x4 mfma16(bf16x8 a, bf16x8 b, f32x4 c) { return __builtin_amdgcn_mfma_f32_16x16x32_bf16(a, b, c, 0, 0, 0); }

__device__ __forceinline__ int t5_bucket(int n) {
    if (n < 16) return n < 0 ? 0 : n;
    int b = 16;
    b += n >= 22; b += n >= 30; b += n >= 40; b += n >= 54; b += n >= 73; b += n >= 99; b += n >= 134; b += n >= 182;
    b += n >= 246; b += n >= 332; b += n >= 450; b += n >= 609; b += n >= 825; b += n >= 1117; b += n >= 1513;
    return b;
}
__device__ __forceinline__ bool is_qcol(int n) { return (n < 2304) ? ((n % 768) < 256) : ((n < 2816) || (n >= 3840 && n < 4608)); }

template <int MODE>
__device__ __forceinline__ void p0_item(const float* W, int K, int Nsrc, bf16_t* WT, const float* kscale, LAS float* scr, int kb, int nb, int lane) {
    const int k0 = 64 * kb, n0 = 32 * nb;
    const int nd = n0 + (lane & 31);
    int sc = nd; float cs = 1.f; bool ok = true;
    if (MODE == 0) { ok = nd < INW; if (is_qcol(nd)) cs = 0.125f; }
    if (MODE == 2) { const int pn = nd >> 8, r = nd & 255; sc = (r >= 128 ? DFF : 0) + 128 * pn + (r & 127); }
    float wv[32], kv_[32];
    const float* wp_ = W + (size_t)(k0 + (lane >> 5)) * Nsrc + (ok ? sc : 0);
#pragma unroll
    for (int i = 0; i < 32; ++i) { wv[i] = wp_[(size_t)(2 * i) * Nsrc]; kv_[i] = (MODE != 1) ? kscale[k0 + 2 * i + (lane >> 5)] : 1.f; }
    __builtin_amdgcn_sched_barrier(0);
#pragma unroll
    for (int i = 0; i < 32; ++i) { const int kk = 2 * i + (lane >> 5); scr[kk * 33 + (lane & 31)] = ok ? wv[i] * cs * kv_[i] : 0.f; }
    lds_wait();
    const int c = lane & 7;
#pragma unroll
    for (int j = 0; j < 4; ++j) { const int n = (lane >> 3) + 8 * j; const LAS float* s = scr + (8 * c) * 33 + n;
        u32x4 o; o.x = cvtpk(s[0 * 33], s[1 * 33]); o.y = cvtpk(s[2 * 33], s[3 * 33]); o.z = cvtpk(s[4 * 33], s[5 * 33]); o.w = cvtpk(s[6 * 33], s[7 * 33]);
        *(u32x4*)(WT + (size_t)(n0 + n) * K + k0 + 8 * c) = o; }
    lds_wait();
}

constexpr int I_IN = 32 * (INP / 32), I_OUT = 32 * 64, I_UP = 32 * (UPW / 32), I_DN = (DFF / 64) * 64, I_W1 = 2 * 32 * 4, I_W2 = 2 * 2 * 2;
constexpr int I_LAYER = I_IN + I_OUT + I_UP + I_DN + I_W1 + I_W2;
__device__ __forceinline__ void p0_layer_item(const Params& P, LAS float* scr, int l, int r, int lane) {
    unsigned char* ws = P.ws;
    if (r < I_IN) { p0_item<0>(P.w_in + (size_t)l * DM * INW, DM, INW, (bf16_t*)(ws + WS_WIN + l * SZ_WIN), P.norm_attn + l * DM, scr, r / (INP / 32), r % (INP / 32), lane); return; } r -= I_IN;
    if (r < I_OUT) { p0_item<1>(P.w_out + (size_t)l * DM * DM, DM, DM, (bf16_t*)(ws + WS_WOUT + l * SZ_WOUT), nullptr, scr, r / 64, r % 64, lane); return; } r -= I_OUT;
    if (r < I_UP) { p0_item<2>(P.w_up + (size_t)l * DM * UPW, DM, UPW, (bf16_t*)(ws + WS_WUP + l * SZ_WUP), P.norm_mlp + l * DM, scr, r / (UPW / 32), r % (UPW / 32), lane); return; } r -= I_UP;
    if (r < I_DN) { p0_item<1>(P.w_down + (size_t)l * DFF * DM, DFF, DM, (bf16_t*)(ws + WS_WDN + l * SZ_WDN), nullptr, scr, r / 64, r % 64, lane); return; } r -= I_DN;
    if (r < I_W1) { const int i = r / 128, rr = r % 128; p0_item<1>(P.cmp_w1 + (size_t)(l * 2 + i) * 2048 * 128, 2048, 128, (bf16_t*)(ws + WS_W1T) + (size_t)(l * 2 + i) * 128 * 2048, nullptr, scr, rr / 4, rr % 4, lane); return; } r -= I_W1;
    { const int i = r / 4, rr = r % 4; p0_item<1>(P.cmp_w2 + (size_t)(l * 2 + i) * 128 * 64, 128, 64, (bf16_t*)(ws + WS_W2T) + (size_t)(l * 2 + i) * 64 * 128, nullptr, scr, rr / 2, rr % 2, lane); }
}
#if !defined(BGFILL) && !defined(TAILFILL_P2B)
constexpr int P0_LAYERS = DEPTH;
#else
constexpr int P0_LAYERS = 1;
#endif
constexpr int CONV_UNIT_ITEMS = 64, N_CONV_UNITS = (I_LAYER + CONV_UNIT_ITEMS - 1) / CONV_UNIT_ITEMS;

__device__ __forceinline__ void p0_prologue(const Params& P, LAS unsigned char* lds, int tid, int lane, int wave) {
    unsigned char* ws = P.ws;
    LAS float* scr = (LAS float*)(lds + wave * 16384);
    const int G = gridDim.x, gw = blockIdx.x * NWAVES + wave, NGW = G * NWAVES;
    for (int it = gw; it < P0_LAYERS * I_LAYER; it += NGW) p0_layer_item(P, scr, it / I_LAYER, it % I_LAYER, lane);
    for (int m = gw; m < MROWS; m += NGW) {
        const f32x4* xr = (const f32x4*)(P.x + (size_t)m * DM) + lane; float s = 0.f;
        u32x2* ob = (u32x2*)((bf16_t*)(ws + WS_XB) + (size_t)m * DM) + lane;
#pragma unroll
        for (int j = 0; j < 8; ++j) { const f32x4 v = xr[64 * j]; s += (v[0] * v[0] + v[1] * v[1]) + (v[2] * v[2] + v[3] * v[3]); u32x2 w; w.x = cvtpk(v[0], v[1]); w.y = cvtpk(v[2], v[3]); ob[64 * j] = w; }
#pragma unroll
        for (int o = 1; o < 64; o <<= 1) s += __shfl_xor(s, o);
        if (lane < 32) ((float*)(ws + WS_SSP))[(size_t)m * 32 + lane] = (lane == 0) ? s : 0.f;
    }
    for (int i = blockIdx.x * NTHREADS + tid; i < 32 * LUTN; i += G * NTHREADS) { const int h = i / LUTN, n = i % LUTN; ((float*)(ws + WS_GLUT))[i] = P.rel[h * 32 + t5_bucket(n)] * LOG2E; }
    if (blockIdx.x < DEPTH * 2) {
        __syncthreads();
        const int li = blockIdx.x, kp = tid >> 7, hid = tid & 127; const float* pe = P.cmp_pe + (size_t)li * 2048; const float* w1 = P.cmp_w1 + (size_t)li * 2048 * 128;
        float s = 0.f;
#pragma unroll 8
        for (int k = kp * 512; k < kp * 512 + 512; ++k) s += pe[k] * w1[(size_t)k * 128 + hid];
        LAS float* red = (LAS float*)lds; red[tid] = s; __syncthreads();
        if (tid < 128) ((float*)(ws + WS_CPE))[li * 128 + tid] = (red[tid] + red[tid + 128]) + (red[tid + 256] + red[tid + 384]);
        __syncthreads();
    }
}

struct Src { const bf16_t* kb; const bf16_t* vb; int stride; int dil; int roff; };

template <int QG, int MODE>
__device__ __forceinline__ void flash_tile(LAS unsigned char* lds, const int buf, const int k0, const int tag, const int dil, const bf16x8 (&qf)[QG][2], f32x4 (&o)[QG][4], float (&m)[QG], float (&l)[QG],
                                           const int qc, const int qcw_min, const int qcw_max, const int maxrel, const LAS unsigned* selp, const LAS unsigned* wunp,
                                           const float (&invl)[QG], LAS float* impw, const bool imp_acc, const LAS float* lut, float& carryB, const int lane) {
    const int g = lane >> 4, i16 = lane & 15;
    bool skip = (k0 > qcw_max) || (maxrel != 0x7fffffff && k0 + 63 < qcw_min - maxrel);
    if (tag >= 0) { const unsigned w = (unsigned)__builtin_amdgcn_readfirstlane((int)wunp[tag >> 5]); if (!((w >> (tag & 31)) & 1u)) skip = true; }
    if (MODE & 4) skip = false;
    if (!skip) {
        const LAS unsigned char* Ks = lds + (buf ? L_K1 : L_K0);
        const LAS unsigned char* Vs = lds + (buf ? L_V1 : L_V0);
        bool allowed = true;
        if (tag >= 0) { const unsigned w = selp[tag >> 5]; allowed = ((w >> (tag & 31)) & 1u) != 0u; }
        float impA[4] = {0.f, 0.f, 0.f, 0.f}, impB[4] = {0.f, 0.f, 0.f, 0.f};
        const int dl_ = qcw_min - (k0 + 63), dh_ = qcw_max - k0;
        bool uni = (k0 >= 0) && (dl_ >= 0) && (maxrel == 0x7fffffff || dh_ <= maxrel);
        if (MODE & 1) uni = uni && (dl_ * dil >= 1513);
        const unsigned uni_di = (unsigned)(dl_ * dil) < (unsigned)(LUTN - 1) ? (unsigned)(dl_ * dil) : (unsigned)(LUTN - 1);
        const bool mid = (MODE & 1) && !uni && (dil == 1) && (k0 >= 0) && (dl_ >= 0) && (maxrel == 0x7fffffff || dh_ <= maxrel) && (dh_ <= LUTN - 1);
#pragma unroll
        for (int qg = 0; qg < QG; ++qg) {
            bf16x8 kf[4][2];
#pragma unroll
            for (int kt = 0; kt < 4; ++kt)
#pragma unroll
                for (int ks = 0; ks < 2; ++ks) kf[kt][ks] = *(const LAS bf16x8*)(Ks + (16 * kt + i16) * KP + ks * 64 + g * 16);
            __builtin_amdgcn_sched_barrier(0);
            f32x4 s[4];
#pragma unroll
            for (int kt = 0; kt < 4; ++kt) { s[kt] = (f32x4){0.f, 0.f, 0.f, 0.f};
#pragma unroll
                for (int ks = 0; ks < 2; ++ks) s[kt] = mfma16(kf[kt][ks], qf[qg][ks], s[kt]); }
            bf16x8 vfr[4][2];
            if (!(MODE & 2)) {
#pragma unroll
                for (int dt = 0; dt < 4; ++dt)
#pragma unroll
                    for (int s2 = 0; s2 < 2; ++s2) { const LAS unsigned char* vp = Vs + (32 * s2 + 4 * g + (i16 >> 2)) * KP + (16 * dt + 4 * (i16 & 3)) * 2;
                        const s16x4 lo = tr_read(vp), hi = tr_read(vp + 16 * KP);
                        vfr[dt][s2] = (bf16x8){lo[0], lo[1], lo[2], lo[3], hi[0], hi[1], hi[2], hi[3]}; }
            }
            __builtin_amdgcn_sched_barrier(0);
            float mx = -INFINITY; float lanebias = 0.f;
            if (uni) {
                float lb = 0.f;
                if (MODE & 1) lb = lut[qg * LUTN + uni_di];
                lanebias = allowed ? lb : -INFINITY;
                float mr = -INFINITY;
#pragma unroll
                for (int kt = 0; kt < 4; ++kt)
#pragma unroll
                    for (int r = 0; r < 4; ++r) mr = fmaxf(mr, s[kt][r]);
                mx = allowed ? __builtin_fmaf(mr, LOG2E, lb) : -INFINITY;
            } else if (mid) {
                const LAS float* lp = lut + qg * LUTN + (qc - k0 - 4 * g - 63);
                float bv[4][4];
#pragma unroll
                for (int kt = 0; kt < 4; ++kt)
#pragma unroll
                    for (int r = 0; r < 4; ++r) bv[kt][r] = lp[63 - 16 * kt - r];
                __builtin_amdgcn_sched_barrier(0);
#pragma unroll
                for (int kt = 0; kt < 4; ++kt)
#pragma unroll
                    for (int r = 0; r < 4; ++r) { float sc = __builtin_fmaf(s[kt][r], LOG2E, bv[kt][r]); sc = allowed ? sc : -INFINITY; s[kt][r] = sc; mx = fmaxf(mx, sc); }
            } else {
                float bv[4][4];
#pragma unroll
                for (int kt = 0; kt < 4; ++kt)
#pragma unroll
                    for (int r = 0; r < 4; ++r) { bv[kt][r] = 0.f;
                        if (MODE & 1) { const int rel = qc - (k0 + 16 * kt + 4 * g + r); unsigned di = (unsigned)(rel * dil); di = di < (unsigned)(LUTN - 1) ? di : (unsigned)(LUTN - 1); bv[kt][r] = lut[qg * LUTN + di]; } }
                if (MODE & 1) __builtin_amdgcn_sched_barrier(0);
#pragma unroll
                for (int kt = 0; kt < 4; ++kt)
#pragma unroll
                    for (int r = 0; r < 4; ++r) { const int kc = k0 + 16 * kt + 4 * g + r; const int rel = qc - kc;
                        const bool ok = allowed && ((unsigned)rel <= (unsigned)maxrel) && (kc >= 0);
                        float sc = __builtin_fmaf(s[kt][r], LOG2E, bv[kt][r]);
                        sc = ok ? sc : -INFINITY; s[kt][r] = sc; mx = fmaxf(mx, sc); }
            }
            mx = xrow16_max(mx);
            const float mnew = fmaxf(m[qg], mx); const float alpha = fexp2(m[qg] - mnew); m[qg] = mnew;
            float rs = 0.f;
            if (uni) { const float cb_ = lanebias - mnew;
#pragma unroll
                for (int kt = 0; kt < 4; ++kt)
#pragma unroll
                    for (int r = 0; r < 4; ++r) { const float p = fexp2(__builtin_fmaf(s[kt][r], LOG2E, cb_)); s[kt][r] = p; rs += p; }
            } else {
#pragma unroll
                for (int kt = 0; kt < 4; ++kt)
#pragma unroll
                    for (int r = 0; r < 4; ++r) { const float p = fexp2(s[kt][r] - mnew); s[kt][r] = p; rs += p; }
            }
            if (MODE & 2) { rs = xrow16_sum(rs); l[qg] = l[qg] * alpha + rs; }
            if (MODE & 4) {
#pragma unroll
                for (int kt = 0; kt < 4; ++kt) { impA[kt] += ((s[kt][0] + s[kt][1]) + (s[kt][2] + s[kt][3])) * invl[qg]; impB[kt] += s[kt][3] * invl[qg]; }
            }
            if (!(MODE & 2)) {
#pragma unroll
                for (int dt = 0; dt < 4; ++dt) o[qg][dt] = o[qg][dt] * alpha;
                bf16x8 pf[2];
#pragma unroll
                for (int s2 = 0; s2 < 2; ++s2) { u32x4 w; w.x = cvtpk(s[2 * s2][0], s[2 * s2][1]); w.y = cvtpk(s[2 * s2][2], s[2 * s2][3]); w.z = cvtpk(s[2 * s2 + 1][0], s[2 * s2 + 1][1]); w.w = cvtpk(s[2 * s2 + 1][2], s[2 * s2 + 1][3]);
                    pf[s2] = __builtin_bit_cast(bf16x8, w); }
                { const bf16x8 ones = {16256, 16256, 16256, 16256, 16256, 16256, 16256, 16256};
                  f32x4 rsv = {0.f, 0.f, 0.f, 0.f};
                  rsv = mfma16(ones, pf[0], rsv); rsv = mfma16(ones, pf[1], rsv);
                  l[qg] = l[qg] * alpha + rsv[0]; }
#pragma unroll
                for (int dt = 0; dt < 4; ++dt)
#pragma unroll
                    for (int s2 = 0; s2 < 2; ++s2) o[qg][dt] = mfma16(vfr[dt][s2], pf[s2], o[qg][dt]);
            }
            if (QG > 1) asm volatile("" ::: "memory");
        }
        if (MODE & 4) {
            const int srcl = (lane + 48) & 63;
#pragma unroll
            for (int kt = 0; kt < 4; ++kt) { const float pb = (kt == 0) ? carryB : impB[kt == 0 ? 0 : kt - 1];
                const float x0 = __shfl(pb, srcl), x1 = __shfl(impB[kt], srcl); const float add = (g == 0) ? x0 : x1;
                const int J = 4 * ((k0 >> 4) + kt) + g; const float prevv = imp_acc ? impw[i16 * 128 + J] : 0.f; impw[i16 * 128 + J] = prevv + impA[kt] + add; }
            carryB = impB[3];
        }
    }
}

template <int QG, int MODE>
__device__ __forceinline__ void flash_run(LAS unsigned char* lds, const Src S, const int ntiles, const bf16x8 (&qf)[QG][2], f32x4 (&o)[QG][4], float (&m)[QG], float (&l)[QG],
                                          const int qc, const int qcw_min, const int qcw_max, const int maxrel, const LAS unsigned* selp, const LAS unsigned* wunp,
                                          const float (&invl)[QG], LAS float* impw, const bool imp_acc, const int lutslot, const int lane, const int tid) {
    const LAS int* tl = (const LAS int*)(lds + L_TL);
    const LAS float* lut = (const LAS float*)(lds + L_LUT) + lutslot * LUTN;
    const int srow = tid >> 3, sch = tid & 7;
    u32x4 kr0 = {0, 0, 0, 0}, vr0 = {0, 0, 0, 0}, kr1 = {0, 0, 0, 0}, vr1 = {0, 0, 0, 0};
    float carryB = 0.f;
#define FL_ISSUE(i, KR, VR) do { int c_ = __builtin_amdgcn_readfirstlane(tl[2 * (i)]) + srow; c_ = c_ < 0 ? 0 : c_; const size_t off_ = (size_t)(c_ * S.dil + S.roff) * S.stride + sch * 8; \
        KR = *(const u32x4*)(S.kb + off_); if (!(MODE & 2)) VR = *(const u32x4*)(S.vb + off_); } while (0)
#define FL_COMMIT(b, KR, VR) do { *(LAS u32x4*)(lds + ((b) ? L_K1 : L_K0) + srow * KP + sch * 16) = KR; if (!(MODE & 2)) *(LAS u32x4*)(lds + ((b) ? L_V1 : L_V0) + srow * KP + sch * 16) = VR; } while (0)
#define FL_TILE(i, b) flash_tile<QG, MODE>(lds, b, __builtin_amdgcn_readfirstlane(tl[2 * (i)]), __builtin_amdgcn_readfirstlane(tl[2 * (i) + 1]), S.dil, qf, o, m, l, qc, qcw_min, qcw_max, maxrel, selp, wunp, invl, impw, imp_acc, lut, carryB, lane)
    LDS_BARRIER();
    if (ntiles > 0) { FL_ISSUE(0, kr0, vr0); if (ntiles > 1) FL_ISSUE(1, kr1, vr1); FL_COMMIT(0, kr0, vr0); }
    LDS_BARRIER();
    for (int i = 0; i < ntiles; i += 2) {
        if (i + 2 < ntiles) FL_ISSUE(i + 2, kr0, vr0);
        FL_TILE(i, 0);
        if (i + 1 < ntiles) FL_COMMIT(1, kr1, vr1);
        LDS_BARRIER();
        if (i + 1 >= ntiles) break;
        if (i + 3 < ntiles) FL_ISSUE(i + 3, kr1, vr1);
        FL_TILE(i + 1, 1);
        if (i + 2 < ntiles) FL_COMMIT(0, kr0, vr0);
        LDS_BARRIER();
    }
#undef FL_ISSUE
#undef FL_COMMIT
#undef FL_TILE
}

template <int QG> __device__ __forceinline__ void flash_init(f32x4 (&o)[QG][4], float (&m)[QG], float (&l)[QG]) {
#pragma unroll
    for (int q = 0; q < QG; ++q) { m[q] = -1e30f; l[q] = 0.f;
#pragma unroll
        for (int d = 0; d < 4; ++d) o[q][d] = (f32x4){0.f, 0.f, 0.f, 0.f}; }
}
template <int NH>
__device__ __forceinline__ void load_lut(LAS unsigned char* lds, const float* glut, int head0, int tid) {
    LAS float* lut = (LAS float*)(lds + L_LUT); const float* src = glut + (size_t)head0 * LUTN;
    float v[NH * 3];
#pragma unroll
    for (int i = 0; i < NH * 3; ++i) v[i] = src[tid + NTHREADS * i];
    __builtin_amdgcn_sched_barrier(0);
#pragma unroll
    for (int i = 0; i < NH * 3; ++i) lut[tid + NTHREADS * i] = v[i];
}
__device__ __forceinline__ int next_unit(unsigned* ctr, LAS unsigned char* lds, int tid) {
    LAS int* slot = (LAS int*)(lds + L_MISC);
    __syncthreads();
    if (tid == 0) *slot = (int)atomicAdd(ctr, 1u);
    __syncthreads();
    return *slot;
}

__device__ __forceinline__ void unit_mixA(const Params& P, LAS unsigned char* lds, int uid, int tid, int lane, int wave) {
    unsigned char* ws = P.ws; const bf16_t* proj = (const bf16_t*)(ws + WS_PROJ);
    const int b = uid / 768; int rem = uid % 768; const int gi = rem / 256; rem %= 256; const int hs = rem / 64, idx = rem % 64;
    const int d = gi == 0 ? 1 : (gi == 1 ? 4 : 16); const int rc = idx % d, nb = idx / d;
    const int g = lane >> 4, i16 = lane & 15;
    load_lut<1>(lds, (const float*)(ws + WS_GLUT), gi * 4 + hs, tid);
    const int ntiles = nb == 0 ? 2 : 4;
    if (tid < 4) { LAS int* tl = (LAS int*)(lds + L_TL); const int i = tid + (nb == 0 ? 2 : 0); if (i < 4) { tl[2 * tid] = nb * 128 - 128 + 64 * i; tl[2 * tid + 1] = -1; } }
    const int qi = nb * 128 + 16 * wave + i16; const int tok = qi * d + rc; const size_t row = (size_t)b * SEQ + tok;
    const int colq = A_OFF + gi * 768 + hs * 64;
    bf16x8 qf[1][2];
#pragma unroll
    for (int ks = 0; ks < 2; ++ks) qf[0][ks] = *(const bf16x8*)(proj + row * INP + colq + ks * 32 + g * 8);
    f32x4 o[1][4]; float m[1], l[1]; flash_init<1>(o, m, l);
    const float il[1] = {0.f};
    Src S{proj + (size_t)b * SEQ * INP + colq + 256, proj + (size_t)b * SEQ * INP + colq + 512, INP, d, rc};
    flash_run<1, 1>(lds, S, ntiles, qf, o, m, l, qi, nb * 128 + 16 * wave, nb * 128 + 16 * wave + 15, 128, nullptr, nullptr, il, nullptr, false, 0, lane, tid);
    const float inv = l[0] > 0.f ? 1.f / l[0] : 0.f;
    bf16_t* O = (bf16_t*)(ws + WS_O) + row * 2048 + gi * 256 + hs * 64;
#pragma unroll
    for (int dt = 0; dt < 4; ++dt) { u32x2 w; w.x = cvtpk(o[0][dt][0] * inv, o[0][dt][1] * inv); w.y = cvtpk(o[0][dt][2] * inv, o[0][dt][3] * inv); *(u32x2*)(O + 16 * dt + 4 * g) = w; }
    if (g == 0) ((float*)(ws + WS_LSE))[row * 12 + gi * 4 + hs] = (m[0] + __log2f(fmaxf(l[0], 1e-30f))) * LN2;
}

__device__ __forceinline__ void unit_moba(const Params& P, LAS unsigned char* lds, int b, int h, int c, int tid, int lane, int wave) {
    unsigned char* ws = P.ws; const bf16_t* proj = (const bf16_t*)(ws + WS_PROJ);
    const int g = lane >> 4, i16 = lane & 15;
    const int t0 = c * 128, ob = t0 >> 8;
    load_lut<1>(lds, (const float*)(ws + WS_GLUT), 12 + h, tid);
    LAS float* km = (LAS float*)(lds + L_IMP);
    LAS unsigned char* qS = lds + L_IMP + 8192;
    { const float* src = (const float*)(ws + WS_KMEAN) + (size_t)(b * 8 + h) * 2048; float kv4[4]; u32x4 qv[2];
#pragma unroll
      for (int i = 0; i < 4; ++i) kv4[i] = src[tid + NTHREADS * i];
#pragma unroll
      for (int i = 0; i < 2; ++i) { const int e = tid + NTHREADS * i; qv[i] = *(const u32x4*)(proj + ((size_t)b * SEQ + t0 + (e >> 3)) * INP + B_OFF + h * 64 + (e & 7) * 8); }
      __builtin_amdgcn_sched_barrier(0);
#pragma unroll
      for (int i = 0; i < 4; ++i) km[tid + NTHREADS * i] = kv4[i];
#pragma unroll
      for (int i = 0; i < 2; ++i) { const int e = tid + NTHREADS * i; *(LAS u32x4*)(qS + (e >> 3) * 128 + (e & 7) * 16) = qv[i]; } }
    LAS unsigned* misc = (LAS unsigned*)(lds + L_MISC);
    if (tid == 0) misc[1] = 0u;
    __syncthreads();
    const int tok = t0 + 16 * wave + i16; const size_t row = (size_t)b * SEQ + tok;
    const int colq = B_OFF + h * 64;
    bf16x8 qf[1][2];
#pragma unroll
    for (int ks = 0; ks < 2; ++ks) qf[0][ks] = *(const bf16x8*)(proj + row * INP + colq + ks * 32 + g * 8);
    unsigned sel = 0u;
    if (ob > 0) {
        float gt[8];
#pragma unroll
        for (int k = 0; k < 8; ++k) gt[k] = 0.f;
#pragma unroll 1
        for (int dc = 0; dc < 8; ++dc) { const u32x4 qw = *(const LAS u32x4*)(qS + (16 * wave + i16) * 128 + dc * 16);
            const float q0 = bflo(qw.x), q1 = bfhi(qw.x), q2 = bflo(qw.y), q3 = bfhi(qw.y), q4 = bflo(qw.z), q5 = bfhi(qw.z), q6 = bflo(qw.w), q7 = bfhi(qw.w);
#pragma unroll
            for (int k = 0; k < 8; ++k) { const LAS f32x4* kr = (const LAS f32x4*)(km + (8 * g + k) * 64 + dc * 8); const f32x4 a = kr[0], bq = kr[1];
                gt[k] += (q0 * a[0] + q1 * a[1]) + (q2 * a[2] + q3 * a[3]) + (q4 * bq[0] + q5 * bq[1]) + (q6 * bq[2] + q7 * bq[3]); } }
#pragma unroll
        for (int k = 0; k < 8; ++k) if (8 * g + k >= ob) gt[k] = -INFINITY;
#pragma unroll
        for (int it = 0; it < 3; ++it) {
            float best = -INFINITY; int bi = 99;
#pragma unroll
            for (int k = 0; k < 8; ++k) if (gt[k] > best) { best = gt[k]; bi = 8 * g + k; }
#pragma unroll
            for (int off = 16; off <= 32; off <<= 1) { const float ob_ = __shfl_xor(best, off); const int oi = __shfl_xor(bi, off); if (ob_ > best || (ob_ == best && oi < bi)) { best = ob_; bi = oi; } }
            if (bi < 32) { sel |= 1u << bi;
#pragma unroll
                for (int k = 0; k < 8; ++k) if (8 * g + k == bi) gt[k] = -INFINITY; }
        }
    }
    unsigned wu = sel;
#pragma unroll
    for (int off = 1; off < 16; off <<= 1) wu |= (unsigned)__shfl_xor((int)wu, off);
    wu = (unsigned)__builtin_amdgcn_readfirstlane((int)wu);
    LAS unsigned* selS = (LAS unsigned*)(lds + L_SEL); LAS unsigned* wunS = (LAS unsigned*)(lds + L_WUN) + wave * 4;
    if (g == 0) selS[(16 * wave + i16) * 4] = sel;
    if (lane == 0) wunS[0] = wu;
    __syncthreads();
    unsigned um = 0u;
#pragma unroll
    for (int w8 = 0; w8 < 8; ++w8) um |= ((const LAS unsigned*)(lds + L_WUN))[w8 * 4];
    if (tid == 0) { LAS int* tl = (LAS int*)(lds + L_TL); int n = 0;
        for (int blk = 0; blk < ob; ++blk) if ((um >> blk) & 1u) for (int s4 = 0; s4 < 4; ++s4) { tl[2 * n] = blk * 256 + 64 * s4; tl[2 * n + 1] = blk; ++n; }
        for (int k0 = ob * 256; k0 < t0 + 128; k0 += 64) { tl[2 * n] = k0; tl[2 * n + 1] = -1; ++n; }
        misc[2] = (unsigned)n; }
    __syncthreads();
    const int ntiles = (int)misc[2];
    f32x4 o[1][4]; float m[1], l[1]; flash_init<1>(o, m, l);
    const float il[1] = {0.f};
    Src S{proj + (size_t)b * SEQ * INP + colq + 512, proj + (size_t)b * SEQ * INP + colq + 1024, INP, 1, 0};
    flash_run<1, 1>(lds, S, ntiles, qf, o, m, l, tok, t0 + 16 * wave, t0 + 16 * wave + 15, 0x7fffffff, selS + (16 * wave + i16) * 4, wunS, il, nullptr, false, 0, lane, tid);
    const float inv = l[0] > 0.f ? 1.f / l[0] : 0.f;
    bf16_t* O = (bf16_t*)(ws + WS_O) + row * 2048 + 768 + h * 64;
#pragma unroll
    for (int dt = 0; dt < 4; ++dt) { u32x2 w; w.x = cvtpk(o[0][dt][0] * inv, o[0][dt][1] * inv); w.y = cvtpk(o[0][dt][2] * inv, o[0][dt][3] * inv); *(u32x2*)(O + 16 * dt + 4 * g) = w; }
}

__device__ __forceinline__ float sigmoidf_(float x) { return 1.f / (1.f + __expf(-x)); }
#ifndef NSA_QG
#define NSA_QG 2
#endif
__device__ __forceinline__ void unit_nsa(const Params& P, LAS unsigned char* lds, int b, int kv, int c, int tid, int lane, int wave) {
    unsigned char* ws = P.ws; const bf16_t* proj = (const bf16_t*)(ws + WS_PROJ);
    const int g = lane >> 4, i16 = lane & 15;
    const int t0 = c * 128;
    const int tok = t0 + 16 * wave + i16; const size_t row = (size_t)b * SEQ + tok;
    load_lut<4>(lds, (const float*)(ws + WS_GLUT), 20 + kv * 4, tid);
    LAS int* tl = (LAS int*)(lds + L_TL);
    LAS unsigned* misc = (LAS unsigned*)(lds + L_MISC);
    LAS unsigned* selS = (LAS unsigned*)(lds + L_SEL);
    LAS float* impw = (LAS float*)(lds + L_IMP) + wave * 2048;
    const int ntc = ((t0 + 96) >> 4) / 64 + 1;
    if (tid < ntc) { tl[2 * tid] = 64 * tid; tl[2 * tid + 1] = -1; }
    if (tid < 4) misc[4 + tid] = 0u;
    LAS unsigned* wunS = (LAS unsigned*)(lds + L_WUN) + wave * 4;
    float* tot = (float*)(ws + WS_TOT) + row * 768 + (kv * 4) * 64;
    const bf16_t* gatep = proj + row * INP + CG_OFF + (kv * 4) * 3;
    const int qcc = (tok - 31) >> 4;
    const int qcw0 = (t0 + 16 * wave - 31) >> 4, qcw1 = (t0 + 16 * wave + 15 - 31) >> 4;
#pragma unroll 1
    for (int hp = 0; hp < 4 / NSA_QG; ++hp) {
        bf16x8 qf[NSA_QG][2];
#pragma unroll
        for (int q = 0; q < NSA_QG; ++q)
#pragma unroll
            for (int ks = 0; ks < 2; ++ks) qf[q][ks] = *(const bf16x8*)(proj + row * INP + CQ_OFF + (kv * 4 + hp * NSA_QG + q) * 64 + ks * 32 + g * 8);
        f32x4 o[NSA_QG][4]; float m[NSA_QG], l[NSA_QG]; flash_init<NSA_QG>(o, m, l);
        float il[NSA_QG]; for (int q_ = 0; q_ < NSA_QG; ++q_) il[q_] = 0.f;
#ifdef NSA_CMP_FAKEKV
        Src S{proj + (size_t)b * SEQ * INP + CKV_OFF + 4 * 192 + kv * 64, proj + (size_t)b * SEQ * INP + CKV_OFF + 5 * 192 + kv * 64, INP, 1, 0};
#else
        Src S{(const bf16_t*)(ws + WS_KC) + (size_t)(b * 3 + kv) * 512 * 64, (const bf16_t*)(ws + WS_VC) + (size_t)(b * 3 + kv) * 512 * 64, 64, 1, 0};
#endif
#ifdef NSA_CMP_SINGLE
        flash_run<NSA_QG, 0>(lds, S, ntc, qf, o, m, l, qcc, qcw0, qcw1, 0x7fffffff, nullptr, nullptr, il, nullptr, false, 0, lane, tid);
#pragma unroll
        for (int q = 0; q < NSA_QG; ++q) il[q] = l[q] > 0.f ? 1.f / l[q] : 0.f;
        (void)impw;
#elif !defined(NSA_NO_CMP)
        flash_run<NSA_QG, 2>(lds, S, ntc, qf, o, m, l, qcc, qcw0, qcw1, 0x7fffffff, nullptr, nullptr, il, nullptr, false, 0, lane, tid);
#pragma unroll
        for (int q = 0; q < NSA_QG; ++q) { il[q] = l[q] > 0.f ? 1.f / l[q] : 0.f; l[q] = 0.f; }
        flash_run<NSA_QG, 4>(lds, S, ntc, qf, o, m, l, qcc, qcw0, qcw1, 0x7fffffff, nullptr, nullptr, il, impw, hp != 0, 0, lane, tid);
#else
        (void)S; (void)impw;
#endif
#pragma unroll
        for (int q = 0; q < NSA_QG; ++q) { const float gt = sigmoidf_(bf2f(gatep[(hp * NSA_QG + q) * 3 + 0])); const float sc = il[q] * gt;
#pragma unroll
            for (int dt = 0; dt < 4; ++dt) *(f32x4*)(tot + (hp * NSA_QG + q) * 64 + 16 * dt + 4 * g) = o[q][dt] * sc; }
    }
#ifndef NSA_NO_TOPK
    lds_wait();
    unsigned wun0 = 0u, wun1 = 0u, wun2 = 0u, wun3 = 0u;
#pragma unroll 1
    for (int q = 0; q < 16; ++q) {
        const int t = t0 + 16 * wave + q, own = t >> 6;
        const int ncand = own - 2 > 0 ? own - 2 : 0; const int nforced = own >= 2 ? 3 : own + 1; const int K = 16 - nforced;
        const int j0 = lane, j1 = lane + 64;
        const bool c0 = (j0 >= 1) && (j0 <= own - 2), c1 = (j1 <= own - 2);
        const unsigned k0 = c0 ? (__float_as_uint(impw[q * 128 + j0]) + 1u) : 0u, k1 = c1 ? (__float_as_uint(impw[q * 128 + j1]) + 1u) : 0u;
        bool s0 = c0, s1 = c1;
        if (ncand > K) {
            unsigned T = 0u;
            for (int bit = 31; bit >= 0; --bit) { const unsigned Tn = T | (1u << bit);
                const int cnt = __popcll(__ballot(k0 >= Tn)) + __popcll(__ballot(k1 >= Tn)); if (cnt >= K) T = Tn; }
            const bool g0 = k0 > T, g1 = k1 > T; const int ng = __popcll(__ballot(g0)) + __popcll(__ballot(g1)); const int need = K - ng;
            const unsigned long long e0 = __ballot(k0 == T), e1 = __ballot(k1 == T); const unsigned long long lt = (1ull << lane) - 1ull;
            const int r0 = __popcll(e0 & lt), r1 = __popcll(e0) + __popcll(e1 & lt);
            s0 = g0 || (k0 == T && r0 < need); s1 = g1 || (k1 == T && r1 < need);
        }
        s0 = s0 || (j0 == 0) || (j0 == own) || (j0 == own - 1); s1 = s1 || (j1 == own) || (j1 == own - 1);
        const unsigned long long m0 = __ballot(s0), m1 = __ballot(s1);
        const unsigned w0 = (unsigned)m0, w1 = (unsigned)(m0 >> 32), w2 = (unsigned)m1, w3 = (unsigned)(m1 >> 32);
        if (lane == 0) { selS[(16 * wave + q) * 4 + 0] = w0; selS[(16 * wave + q) * 4 + 1] = w1; selS[(16 * wave + q) * 4 + 2] = w2; selS[(16 * wave + q) * 4 + 3] = w3; }
        wun0 |= w0; wun1 |= w1; wun2 |= w2; wun3 |= w3;
    }
    if (lane == 0) { wunS[0] = wun0; wunS[1] = wun1; wunS[2] = wun2; wunS[3] = wun3; }
    __syncthreads();
    if (tid < 4) { unsigned u_ = 0u; for (int w8 = 0; w8 < 8; ++w8) u_ |= ((const LAS unsigned*)(lds + L_WUN))[w8 * 4 + tid]; misc[4 + tid] = u_; }
    __syncthreads();
    const LAS unsigned* selp = selS + (16 * wave + i16) * 4;
    const int ownmax = (t0 + 127) >> 6;
    if (tid == 0) { int n = 0; for (int j = 0; j <= ownmax; ++j) if ((misc[4 + (j >> 5)] >> (j & 31)) & 1u) { tl[2 * n] = 64 * j; tl[2 * n + 1] = j; ++n; } misc[2] = (unsigned)n; }
    __syncthreads();
    const int nts = (int)misc[2];
#else
    const int ownmax = (t0 + 127) >> 6; const int nts = 0; const LAS unsigned* selp = nullptr; (void)selS; (void)wunS;
#endif
    const int kfirst = t0 - 512 > 0 ? t0 - 512 : 0; const int ntw = (t0 + 128 - kfirst) / 64;
#ifdef NSA_PACK4
    __syncthreads();
    if (tid == 0) { int n = 0; for (int j = 0; j <= ownmax; ++j) if ((misc[4 + (j >> 5)] >> (j & 31)) & 1u) { tl[2 * n] = 64 * j; tl[2 * n + 1] = j; ++n; } }
#pragma unroll 1
    for (int ps = 0; ps < 4; ++ps) {
        const int tli = 32 * ps + 4 * wave + (i16 >> 2), hd = i16 & 3;
        const int tokp = t0 + tli; const size_t rowp = (size_t)b * SEQ + tokp;
        bf16x8 qf[1][2];
#pragma unroll
        for (int ks = 0; ks < 2; ++ks) qf[0][ks] = *(const bf16x8*)(proj + rowp * INP + CQ_OFF + (kv * 4 + hd) * 64 + ks * 32 + g * 8);
        if (lane < 4) { unsigned w_ = 0u;
#pragma unroll
            for (int k = 0; k < 4; ++k) w_ |= selS[(32 * ps + 4 * wave + k) * 4 + lane];
            wunS[lane] = w_; }
        lds_wait();
        f32x4 o[1][4]; float m[1], l[1]; flash_init<1>(o, m, l);
        const float il[1] = {0.f};
        Src S{proj + (size_t)b * SEQ * INP + CKV_OFF + 2 * 192 + kv * 64, proj + (size_t)b * SEQ * INP + CKV_OFF + 3 * 192 + kv * 64, INP, 1, 0};
        flash_run<1, 1>(lds, S, nts, qf, o, m, l, tokp, t0 + 32 * ps + 4 * wave, t0 + 32 * ps + 4 * wave + 3, 0x7fffffff, selS + tli * 4, wunS, il, nullptr, false, hd, lane, tid);
        const float gt = sigmoidf_(bf2f(proj[rowp * INP + CG_OFF + (kv * 4 + hd) * 3 + 1])); const float sc = (l[0] > 0.f ? 1.f / l[0] : 0.f) * gt;
        float* tp0 = (float*)(ws + WS_TOT) + rowp * 768 + (kv * 4 + hd) * 64;
#pragma unroll
        for (int dt = 0; dt < 4; ++dt) { float* tp = tp0 + 16 * dt + 4 * g; *(f32x4*)tp = *(const f32x4*)tp + o[0][dt] * sc; }
    }
    __syncthreads();
#pragma unroll 1
    for (int hp = 0; hp < 2; ++hp) {
        bf16x8 qf[2][2];
#pragma unroll
        for (int q = 0; q < 2; ++q)
#pragma unroll
            for (int ks = 0; ks < 2; ++ks) qf[q][ks] = *(const bf16x8*)(proj + row * INP + CQ_OFF + (kv * 4 + hp * 2 + q) * 64 + ks * 32 + g * 8);
        f32x4 o[2][4]; float m[2], l[2];
        float il[2] = {0.f, 0.f};
        __syncthreads();
        if (tid < ntw) { tl[2 * tid] = kfirst + 64 * tid; tl[2 * tid + 1] = -1; }
        flash_init<2>(o, m, l);
        Src S{proj + (size_t)b * SEQ * INP + CKV_OFF + 4 * 192 + kv * 64, proj + (size_t)b * SEQ * INP + CKV_OFF + 5 * 192 + kv * 64, INP, 1, 0};
        flash_run<2, 1>(lds, S, ntw, qf, o, m, l, tok, t0 + 16 * wave, t0 + 16 * wave + 15, 511, nullptr, nullptr, il, nullptr, false, hp * 2, lane, tid);
        bf16_t* O = (bf16_t*)(ws + WS_O) + row * 2048 + 1280 + (kv * 4) * 64;
#pragma unroll
        for (int q = 0; q < 2; ++q) { const float gt = sigmoidf_(bf2f(gatep[(hp * 2 + q) * 3 + 2])); const float sc = (l[q] > 0.f ? 1.f / l[q] : 0.f) * gt;
#pragma unroll
            for (int dt = 0; dt < 4; ++dt) { const f32x4 v = *(const f32x4*)(tot + (hp * 2 + q) * 64 + 16 * dt + 4 * g) + o[q][dt] * sc;
                u32x2 w; w.x = cvtpk(v[0], v[1]); w.y = cvtpk(v[2], v[3]); *(u32x2*)(O + (hp * 2 + q) * 64 + 16 * dt + 4 * g) = w; } }
    }
}
#else
#pragma unroll 1
    for (int hp = 0; hp < 4 / NSA_QG; ++hp) {
        bf16x8 qf[NSA_QG][2];
#pragma unroll
        for (int q = 0; q < NSA_QG; ++q)
#pragma unroll
            for (int ks = 0; ks < 2; ++ks) qf[q][ks] = *(const bf16x8*)(proj + row * INP + CQ_OFF + (kv * 4 + hp * NSA_QG + q) * 64 + ks * 32 + g * 8);
        f32x4 o[NSA_QG][4]; float m[NSA_QG], l[NSA_QG];
        float il[NSA_QG]; for (int q_ = 0; q_ < NSA_QG; ++q_) il[q_] = 0.f;
        __syncthreads();
        if (tid == 0) { int n = 0; for (int j = 0; j <= ownmax; ++j) if ((misc[4 + (j >> 5)] >> (j & 31)) & 1u) { tl[2 * n] = 64 * j; tl[2 * n + 1] = j; ++n; } }
#ifndef NSA_NO_SLC
        { flash_init<NSA_QG>(o, m, l);
          Src S{proj + (size_t)b * SEQ * INP + CKV_OFF + 2 * 192 + kv * 64, proj + (size_t)b * SEQ * INP + CKV_OFF + 3 * 192 + kv * 64, INP, 1, 0};
          flash_run<NSA_QG, 1>(lds, S, nts, qf, o, m, l, tok, t0 + 16 * wave, t0 + 16 * wave + 15, 0x7fffffff, selp, wunS, il, nullptr, false, hp * NSA_QG, lane, tid);
#pragma unroll
          for (int q = 0; q < NSA_QG; ++q) { const float gt = sigmoidf_(bf2f(gatep[(hp * NSA_QG + q) * 3 + 1])); const float sc = (l[q] > 0.f ? 1.f / l[q] : 0.f) * gt;
#pragma unroll
              for (int dt = 0; dt < 4; ++dt) { float* tp = tot + (hp * NSA_QG + q) * 64 + 16 * dt + 4 * g; *(f32x4*)tp = *(const f32x4*)tp + o[q][dt] * sc; } }
        }
#endif
        if (tid < ntw) { tl[2 * tid] = kfirst + 64 * tid; tl[2 * tid + 1] = -1; }
        { flash_init<NSA_QG>(o, m, l);
          Src S{proj + (size_t)b * SEQ * INP + CKV_OFF + 4 * 192 + kv * 64, proj + (size_t)b * SEQ * INP + CKV_OFF + 5 * 192 + kv * 64, INP, 1, 0};
#ifndef NSA_NO_WIN
          flash_run<NSA_QG, 1>(lds, S, ntw, qf, o, m, l, tok, t0 + 16 * wave, t0 + 16 * wave + 15, 511, nullptr, nullptr, il, nullptr, false, hp * NSA_QG, lane, tid);
#else
          (void)S;
#endif
          bf16_t* O = (bf16_t*)(ws + WS_O) + row * 2048 + 1280 + (kv * 4) * 64;
#pragma unroll
          for (int q = 0; q < NSA_QG; ++q) { const float gt = sigmoidf_(bf2f(gatep[(hp * NSA_QG + q) * 3 + 2])); const float sc = (l[q] > 0.f ? 1.f / l[q] : 0.f) * gt;
#pragma unroll
              for (int dt = 0; dt < 4; ++dt) { const f32x4 v = *(const f32x4*)(tot + (hp * NSA_QG + q) * 64 + 16 * dt + 4 * g) + o[q][dt] * sc;
                  u32x2 w; w.x = cvtpk(v[0], v[1]); w.y = cvtpk(v[2], v[3]); *(u32x2*)(O + (hp * NSA_QG + q) * 64 + 16 * dt + 4 * g) = w; } }
        }
    }
}

#endif

__device__ __forceinline__ float gelu_tanh(float x) { const float u = 0.7978845608028654f * (x + 0.044715f * x * x * x); const float e = __expf(2.f * u); const float th = 1.f - 2.f / (1.f + e); return 0.5f * x * (1.f + th); }
__device__ __forceinline__ void item_compress(const Params& P, int layer, int it, int lane) {
    unsigned char* ws = P.ws; const bf16_t* proj = (const bf16_t*)(ws + WS_PROJ);
    const int nt = it & 31; int r = it >> 5; const int which = r & 1; r >>= 1; const int kv = r % 3, b = r / 3;
    const int g = lane >> 4, i16 = lane & 15;
    int n = 16 * nt + i16; const int nld = n > 510 ? 510 : n;
    const bf16_t* w1t = (const bf16_t*)(ws + WS_W1T) + (size_t)(layer * 2 + which) * 128 * 2048;
    const bf16_t* w2t = (const bf16_t*)(ws + WS_W2T) + (size_t)(layer * 2 + which) * 64 * 128;
    const float* cpe = (const float*)(ws + WS_CPE) + (layer * 2 + which) * 128;
    const bf16_t* src = proj + ((size_t)b * SEQ + 16 * nld) * INP + CKV_OFF + which * 192 + kv * 64 + 8 * g;
    f32x4 acc[8];
#pragma unroll
    for (int h = 0; h < 8; ++h) acc[h] = (f32x4){0.f, 0.f, 0.f, 0.f};
    const bf16_t* w1l = w1t + (size_t)i16 * 2048 + 8 * g;
#pragma unroll 1
    for (int ks = 0; ks < 64; ks += 4) {
        bf16x8 bq[4], af[4][8];
#pragma unroll
        for (int u = 0; u < 4; ++u) { bq[u] = *(const bf16x8*)(src + (size_t)((ks + u) >> 1) * INP + (u & 1) * 32);
#pragma unroll
            for (int h = 0; h < 8; ++h) af[u][h] = *(const bf16x8*)(w1l + (size_t)(16 * h) * 2048 + 32 * (ks + u)); }
        __builtin_amdgcn_sched_barrier(0);
#pragma unroll
        for (int u = 0; u < 4; ++u)
#pragma unroll
            for (int h = 0; h < 8; ++h) acc[h] = mfma16(af[u][h], bq[u], acc[h]);
    }
    bf16x8 pf[4];
#pragma unroll
    for (int s = 0; s < 4; ++s) { float hv[8];
#pragma unroll
        for (int r2 = 0; r2 < 4; ++r2) { hv[r2] = gelu_tanh(acc[2 * s][r2] + cpe[32 * s + 4 * g + r2]); hv[4 + r2] = gelu_tanh(acc[2 * s + 1][r2] + cpe[32 * s + 16 + 4 * g + r2]); }
        u32x4 w; w.x = cvtpk(hv[0], hv[1]); w.y = cvtpk(hv[2], hv[3]); w.z = cvtpk(hv[4], hv[5]); w.w = cvtpk(hv[6], hv[7]); pf[s] = __builtin_bit_cast(bf16x8, w); }
    bf16_t* dst = (bf16_t*)(ws + (which ? WS_VC : WS_KC)) + ((size_t)(b * 3 + kv) * 512 + n) * 64;
#pragma unroll
    for (int et = 0; et < 4; ++et) { f32x4 oc = {0.f, 0.f, 0.f, 0.f};
#pragma unroll
        for (int s = 0; s < 4; ++s) { const bf16_t* wp = w2t + (size_t)(16 * et + i16) * 128 + 32 * s + 4 * g; const u32x2 lo = *(const u32x2*)wp, hi = *(const u32x2*)(wp + 16);
            u32x4 w; w.x = lo.x; w.y = lo.y; w.z = hi.x; w.w = hi.y; oc = mfma16(__builtin_bit_cast(bf16x8, w), pf[s], oc); }
#ifdef PROBE_CLAMP
#pragma unroll
        for (int r2 = 0; r2 < 4; ++r2) oc[r2] = fminf(fmaxf(oc[r2], -100.f), 100.f);
#endif
        u32x2 w; w.x = cvtpk(oc[0], oc[1]); w.y = cvtpk(oc[2], oc[3]); *(u32x2*)(dst + 16 * et + 4 * g) = w; }
}
__device__ __forceinline__ void item_kmean(const Params& P, int it, int lane) {
    unsigned char* ws = P.ws; const bf16_t* proj = (const bf16_t*)(ws + WS_PROJ);
    const int blk = it & 31, h = (it >> 5) & 7, b = it >> 8;
    const int rg = lane >> 3, dch = lane & 7;
    const bf16_t* src = proj + ((size_t)b * SEQ + blk * 256 + rg) * INP + B_OFF + 512 + h * 64 + dch * 8;
    u32x4 v[32];
#pragma unroll
    for (int i = 0; i < 32; ++i) v[i] = *(const u32x4*)(src + (size_t)(8 * i) * INP);
    __builtin_amdgcn_sched_barrier(0);
    float sm[8];
#pragma unroll
    for (int e = 0; e < 8; ++e) sm[e] = 0.f;
#pragma unroll
    for (int i = 0; i < 32; ++i)
#pragma unroll
        for (int w = 0; w < 4; ++w) { sm[2 * w] += bflo(v[i][w]); sm[2 * w + 1] += bfhi(v[i][w]); }
#pragma unroll
    for (int e = 0; e < 8; ++e) { sm[e] += __shfl_xor(sm[e], 8); sm[e] += __shfl_xor(sm[e], 16); sm[e] += __shfl_xor(sm[e], 32); }
    if (rg == 0) { float* dst = (float*)(ws + WS_KMEAN) + (size_t)it * 64 + dch * 8;
        *(f32x4*)dst = (f32x4){sm[0], sm[1], sm[2], sm[3]} * (1.f / 256.f); *(f32x4*)(dst + 4) = (f32x4){sm[4], sm[5], sm[6], sm[7]} * (1.f / 256.f); }
}
__device__ __forceinline__ void item_combineA4(const Params& P, int row0, int rstride, int lane) {
    unsigned char* ws = P.ws;
    float a0[4][3], a1[4][3], a2[4][3]; u32x2 w[4][3];
#pragma unroll
    for (int k = 0; k < 4; ++k) { const int rowu = row0 + k * rstride; const int row = rowu < MROWS ? rowu : MROWS - 1; const float* lse = (const float*)(ws + WS_LSE) + (size_t)row * 12; const bf16_t* O = (const bf16_t*)(ws + WS_O) + (size_t)row * 2048;
#pragma unroll
        for (int c = 0; c < 3; ++c) { const int col = 4 * (lane + 64 * c); const int hs = (col >> 6) & 3; a0[k][c] = lse[hs]; a1[k][c] = lse[4 + hs]; a2[k][c] = lse[8 + hs]; w[k][c] = *(const u32x2*)(O + col); } }
    __builtin_amdgcn_sched_barrier(0);
#pragma unroll
    for (int k = 0; k < 4; ++k) { const int row = row0 + k * rstride; if (row >= MROWS) break; bf16_t* O = (bf16_t*)(ws + WS_O) + (size_t)row * 2048;
#pragma unroll
        for (int c = 0; c < 3; ++c) { const int col = 4 * (lane + 64 * c); const int gi = col >> 8;
            const float mx = fmaxf(a0[k][c], fmaxf(a1[k][c], a2[k][c]));
            const float e0 = __expf(a0[k][c] - mx), e1 = __expf(a1[k][c] - mx), e2 = __expf(a2[k][c] - mx); const float al = (gi == 0 ? e0 : (gi == 1 ? e1 : e2)) / (e0 + e1 + e2);
            u32x2 r; r.x = cvtpk(bflo(w[k][c].x) * al, bfhi(w[k][c].x) * al); r.y = cvtpk(bflo(w[k][c].y) * al, bfhi(w[k][c].y) * al); *(u32x2*)(O + col) = r; } }
}

__device__ __forceinline__ void phase_conv(const Params& P, int layer, int tid) {
    unsigned char* ws = P.ws; const bf16_t* U = (const bf16_t*)(ws + WS_U); bf16_t* ACT = (bf16_t*)(ws + WS_ACT);
    const float* cw = P.conv_w + (size_t)layer * 3 * UPW; const float* cb = P.conv_b + (size_t)layer * UPW;
    constexpr int NCH = DFF / 8, TB = 8, NTB = MROWS / TB;
    for (int it = blockIdx.x * NTHREADS + tid; it < NCH * NTB; it += gridDim.x * NTHREADS) {
        const int ch = it % NCH, tb = it / NCH; const int c = ch * 8; const int ua = 256 * (c >> 7) + (c & 127);
        const int row0 = tb * TB; const bool first = (row0 % SEQ) == 0;
        u32x4 pa[TB + 2], pg[TB + 2];
#pragma unroll
        for (int t = 0; t < TB + 2; ++t) { const int r = row0 - 2 + t; const size_t off = (size_t)(r < 0 ? 0 : r) * UPW + ua; pa[t] = *(const u32x4*)(U + off); pg[t] = *(const u32x4*)(U + off + 128); }
        f32x4 wa4[3][2], wg4[3][2], ba4[2], bg4[2];
#pragma unroll
        for (int j = 0; j < 3; ++j)
#pragma unroll
            for (int h = 0; h < 2; ++h) { wa4[j][h] = *(const f32x4*)(cw + (size_t)j * UPW + c + 4 * h); wg4[j][h] = *(const f32x4*)(cw + (size_t)j * UPW + DFF + c + 4 * h); }
#pragma unroll
        for (int h = 0; h < 2; ++h) { ba4[h] = *(const f32x4*)(cb + c + 4 * h); bg4[h] = *(const f32x4*)(cb + DFF + c + 4 * h); }
        __builtin_amdgcn_sched_barrier(0);
        if (first) { pa[0] = (u32x4){0, 0, 0, 0}; pa[1] = pa[0]; pg[0] = pa[0]; pg[1] = pa[0]; }
#pragma unroll
        for (int t = 0; t < TB; ++t) {
            float r[8];
#pragma unroll
            for (int e = 0; e < 8; ++e) { const int w_ = e >> 1; const int h = e >> 2, x = e & 3;
                const float a0 = (e & 1) ? bfhi(pa[t + 2][w_]) : bflo(pa[t + 2][w_]), a1 = (e & 1) ? bfhi(pa[t + 1][w_]) : bflo(pa[t + 1][w_]), a2 = (e & 1) ? bfhi(pa[t][w_]) : bflo(pa[t][w_]);
                const float g0 = (e & 1) ? bfhi(pg[t + 2][w_]) : bflo(pg[t + 2][w_]), g1 = (e & 1) ? bfhi(pg[t + 1][w_]) : bflo(pg[t + 1][w_]), g2 = (e & 1) ? bfhi(pg[t][w_]) : bflo(pg[t][w_]);
                const float ya = ba4[h][x] + wa4[0][h][x] * a0 + wa4[1][h][x] * a1 + wa4[2][h][x] * a2;
                const float yg = bg4[h][x] + wg4[0][h][x] * g0 + wg4[1][h][x] * g1 + wg4[2][h][x] * g2;
                r[e] = ya * yg / (1.f + __expf(-yg)); }
            u32x4 w; w.x = cvtpk(r[0], r[1]); w.y = cvtpk(r[2], r[3]); w.z = cvtpk(r[4], r[5]); w.w = cvtpk(r[6], r[7]);
            *(u32x4*)(ACT + (size_t)(row0 + t) * DFF + c) = w;
        }
    }
}

__device__ __forceinline__ void phase_convfix(const Params& P, int layer, int tid) {
    unsigned char* ws = P.ws; const bf16_t* UB = (const bf16_t*)(ws + WS_UB); bf16_t* ACT = (bf16_t*)(ws + WS_ACT);
    const float* cw = P.conv_w + (size_t)layer * 3 * UPW; const float* cb = P.conv_b + (size_t)layer * UPW;
    constexpr int NCH = DFF / 8, NS = MROWS / 64;
    for (int it = blockIdx.x * NTHREADS + tid; it < NCH * 2 * NS; it += gridDim.x * NTHREADS) {
        const int ch = it % NCH, lr = (it / NCH) & 1, sl = it / (2 * NCH); const int c = ch * 8; const int ua = 256 * (c >> 7) + (c & 127);
        const bool first = (sl % (SEQ / 64)) == 0;
        const int slp = sl > 0 ? sl - 1 : 0;
        const bf16_t* r0 = UB + ((size_t)sl * 4 + lr) * UPW + ua;
        const bf16_t* r1 = lr == 0 ? UB + ((size_t)slp * 4 + 3) * UPW + ua : UB + ((size_t)sl * 4 + 0) * UPW + ua;
        const bf16_t* r2 = lr == 0 ? UB + ((size_t)slp * 4 + 2) * UPW + ua : UB + ((size_t)slp * 4 + 3) * UPW + ua;
        u32x4 a0 = *(const u32x4*)r0, g0 = *(const u32x4*)(r0 + 128), a1 = *(const u32x4*)r1, g1 = *(const u32x4*)(r1 + 128), a2 = *(const u32x4*)r2, g2 = *(const u32x4*)(r2 + 128);
        const u32x4 z = {0, 0, 0, 0};
        if (first && lr == 0) { a1 = z; g1 = z; }
        if (first) { a2 = z; g2 = z; }
        f32x4 wa[3][2], wg[3][2], ba[2], bg[2];
#pragma unroll
        for (int h = 0; h < 2; ++h) { ba[h] = *(const f32x4*)(cb + c + 4 * h); bg[h] = *(const f32x4*)(cb + DFF + c + 4 * h);
#pragma unroll
            for (int j = 0; j < 3; ++j) { wa[j][h] = *(const f32x4*)(cw + (size_t)j * UPW + c + 4 * h); wg[j][h] = *(const f32x4*)(cw + (size_t)j * UPW + DFF + c + 4 * h); } }
        float r[8];
#pragma unroll
        for (int e = 0; e < 8; ++e) { const int w_ = e >> 1, h = e >> 2, x = e & 3;
            const float x0 = (e & 1) ? bfhi(a0[w_]) : bflo(a0[w_]), x1 = (e & 1) ? bfhi(a1[w_]) : bflo(a1[w_]), x2 = (e & 1) ? bfhi(a2[w_]) : bflo(a2[w_]);
            const float y0 = (e & 1) ? bfhi(g0[w_]) : bflo(g0[w_]), y1 = (e & 1) ? bfhi(g1[w_]) : bflo(g1[w_]), y2 = (e & 1) ? bfhi(g2[w_]) : bflo(g2[w_]);
            const float ya = ba[h][x] + wa[0][h][x] * x0 + wa[1][h][x] * x1 + wa[2][h][x] * x2;
            const float yg = bg[h][x] + wg[0][h][x] * y0 + wg[1][h][x] * y1 + wg[2][h][x] * y2;
            r[e] = ya * yg / (1.f + __expf(-yg)); }
        u32x4 w; w.x = cvtpk(r[0], r[1]); w.y = cvtpk(r[2], r[3]); w.z = cvtpk(r[4], r[5]); w.w = cvtpk(r[6], r[7]);
        *(u32x4*)(ACT + (size_t)(sl * 64 + lr) * DFF + c) = w;
    }
}

#define XB_TMO      128
#define XB_XCNT(j)  (256  + 64 * (j))
#define XB_XSUB(j)  (1280 + 64 * (j))
#define XB_XGEN(j)  (2304 + 64 * (j))
#define XB_TOP      3328
#define XB_TOPGEN   3392
#define XCD_BAR_WORDS 3456
#define XB_SPIN_CAP (1u << 27)

__device__ __forceinline__ unsigned xb_ld(unsigned* p)              { return __hip_atomic_load(p, __ATOMIC_RELAXED, __HIP_MEMORY_SCOPE_AGENT); }
__device__ __forceinline__ unsigned xb_add(unsigned* p, unsigned v) { return __hip_atomic_fetch_add(p, v, __ATOMIC_RELAXED, __HIP_MEMORY_SCOPE_AGENT); }
__device__ __forceinline__ unsigned xb_xcc_id() { return (unsigned)__builtin_amdgcn_s_getreg((3 << 11) | 20) & 0xFu; }
#define XB_SPIN(cond, bar) do { unsigned _sp = 0; while (cond) { __builtin_amdgcn_s_sleep(1); \
    if ((++_sp & 255u) == 0u) { if (xb_ld(&(bar)[XB_TMO])) break; if (_sp > XB_SPIN_CAP) { atomicAdd(&(bar)[XB_TMO], 1u); break; } } } } while (0)

struct XcdBarrier {
    unsigned* bar; unsigned x;
    volatile LAS unsigned* st;
};

__device__ __forceinline__ XcdBarrier xcd_barrier_post(unsigned* bar, volatile LAS unsigned* st) {
    XcdBarrier b; b.bar = bar; b.x = xb_xcc_id(); b.st = st;
    if (threadIdx.x == 0) (void)xb_add(&bar[XB_XCNT(b.x)], 1u);
    return b;
}
__device__ __forceinline__ void xcd_barrier_complete(unsigned* bar, unsigned x, unsigned& nloc, unsigned& nx) {
    const unsigned G = gridDim.x * gridDim.y * gridDim.z;
    unsigned sum, cnt, mine, sp = 0u;
    for (;;) {
        sum = 0u; cnt = 0u; mine = 0u;
#pragma unroll
        for (unsigned j = 0; j < 16; ++j) { const unsigned c = xb_ld(&bar[XB_XCNT(j)]); sum += c; cnt += (c > 0u) ? 1u : 0u; mine = (j == x) ? c : mine; }
        if (sum == G) break;
        __builtin_amdgcn_s_sleep(1);
        if ((++sp & 255u) == 0u) { if (xb_ld(&bar[XB_TMO])) break; if (sp > XB_SPIN_CAP) { atomicAdd(&bar[XB_TMO], 1u); break; } }
    }
    nloc = mine > 0u ? mine : 1u; nx = cnt > 0u ? cnt : 1u;
}

__device__ __forceinline__ void xcd_barrier(const XcdBarrier& b) {
    asm volatile("s_waitcnt vmcnt(0)" ::: "memory");
    __syncthreads();
    if (threadIdx.x == 0) {
        unsigned* bar = b.bar;
        __builtin_amdgcn_s_waitcnt(0);
        unsigned nloc = b.st[0], nx = b.st[1];
        if (nloc == 0u) { xcd_barrier_complete(bar, b.x, nloc, nx); b.st[0] = nloc; b.st[1] = nx; }
        const unsigned old = xb_add(&bar[XB_XSUB(b.x)], 1u);
        const unsigned gen = old / nloc;
        if (old + 1u == (gen + 1u) * nloc) {
            __builtin_amdgcn_fence(__ATOMIC_RELEASE, "agent");
            asm volatile("s_waitcnt vmcnt(0)" ::: "memory");
            const unsigned og = xb_add(&bar[XB_TOP], 1u);
            const unsigned tg = og / nx;
            if (og + 1u == (tg + 1u) * nx) xb_add(&bar[XB_TOPGEN], 1u);
            else XB_SPIN(xb_ld(&bar[XB_TOPGEN]) == tg, bar);
            __builtin_amdgcn_fence(__ATOMIC_ACQUIRE, "agent");
            xb_add(&bar[XB_XGEN(b.x)], 1u);
            asm volatile("s_waitcnt vmcnt(0)" ::: "memory");
        } else {
            XB_SPIN(xb_ld(&bar[XB_XGEN(b.x)]) == gen, bar);
            __builtin_amdgcn_fence(__ATOMIC_ACQUIRE, "agent");
            asm volatile("s_waitcnt vmcnt(0)" ::: "memory");
        }
    }
    __syncthreads();
}

constexpr int BG_ITEMS = 16, BG_UNITS_LAYER = (I_LAYER + BG_ITEMS - 1) / BG_ITEMS, BG_TOTAL = (DEPTH - 1) * BG_UNITS_LAYER;
__device__ __forceinline__ void bg_unit(const Params& P, LAS unsigned char* lds, int u, int wave) {
    const int l = 1 + u / BG_UNITS_LAYER, r0 = (u % BG_UNITS_LAYER) * BG_ITEMS + wave * (BG_ITEMS / NWAVES);
    LAS float* scr = (LAS float*)(lds + wave * 16384); const int ln = lane_id_opaque();
    for (int k = 0; k < BG_ITEMS / NWAVES; ++k) { const int r = r0 + k; if (r < I_LAYER) p0_layer_item(P, scr, l, r, ln); }
}
__device__ __forceinline__ void bg_fill(const Params& P, LAS unsigned char* lds, unsigned* ctl, int bar_idx, int must_upto, int tid, int wave) {
    unsigned* done = ctl + 2560 + 16 * bar_idx; unsigned* nxt = ctl + 64 * 39;
    LAS int* slot = (LAS int*)(lds + L_MISC) + 3;
    const unsigned thresh = (gridDim.x * 13u) / 16u;
    __syncthreads();
    if (tid == 0) atomicAdd(done, 1u);
    for (;;) {
        if (tid == 0) { int u = -1; const unsigned cur = __hip_atomic_load(nxt, __ATOMIC_RELAXED, __HIP_MEMORY_SCOPE_AGENT);
            bool want = cur < (unsigned)must_upto;
            if (!want && cur < (unsigned)BG_TOTAL) want = __hip_atomic_load(done, __ATOMIC_RELAXED, __HIP_MEMORY_SCOPE_AGENT) < thresh;
            if (want) { u = (int)atomicAdd(nxt, 1u); if (u >= BG_TOTAL) u = -1; }
            *slot = u; }
        __syncthreads();
        const int u = *slot;
        __syncthreads();
        if (u < 0) break;
        bg_unit(P, lds, u, wave);
    }
}

__global__ void __launch_bounds__(NTHREADS) fwd_megakernel(Params P) {
    extern __shared__ __attribute__((aligned(16))) unsigned char lds_raw[];
    LAS unsigned char* lds = (LAS unsigned char*)lds_raw;
    int wave0 = __builtin_amdgcn_readfirstlane((int)threadIdx.x >> 6);
    unsigned char* ws0 = P.ws;
    volatile LAS unsigned* bst = (volatile LAS unsigned*)(lds + LDS_BYTES - 64);
    if (threadIdx.x < 2) bst[threadIdx.x] = 0u;
    __syncthreads();
    (void)xcd_barrier_post((unsigned*)(P.ws + WS_CTL) + 4096, bst);
#define GRID_BAR() do { XcdBarrier b_; b_.bar = (unsigned*)(ws0 + WS_CTL) + 4096; b_.x = xb_xcc_id(); b_.st = (volatile LAS unsigned*)(lds + LDS_BYTES - 64); xcd_barrier(b_); } while (0)
    { const int wave = wave0, lane = lane_id_opaque(), tid = wave * 64 + lane;

#ifndef SKIP_P0
    p0_prologue(P, lds, tid, lane, wave);
#ifdef DUP_P0
    p0_prologue(P, lds, tid, lane, wave);
#endif
#endif
    }
    GRID_BAR();

#pragma unroll 1
    for (int layer = 0; layer < DEPTH; ++layer) {
        asm volatile("" : "+s"(wave0), "+s"(ws0));
        const int wave = wave0, lane = lane_id_opaque(), tid = wave * 64 + lane;
        const int G = gridDim.x, gw = blockIdx.x * NWAVES + wave, NGW = G * NWAVES;
        unsigned char* ws = ws0;
        unsigned* ctl = (unsigned*)(ws + WS_CTL);
#ifdef PROBE_ZERO_O
        for (size_t i = (size_t)blockIdx.x * NTHREADS + tid; i < (size_t)MROWS * 2048 / 8; i += (size_t)G * NTHREADS) ((u32x4*)(ws + WS_O))[i] = (u32x4){0u, 0u, 0u, 0u};
#endif
        { pg8::Gemm gm{(const pg8::bf16_t*)(ws + WS_XB), (const pg8::bf16_t*)(ws + WS_WIN + layer * SZ_WIN), MROWS, INP, DM};
          pg8::StaticOrder S; S.init(MROWS, INP, G, (int)blockIdx.x);
          pg8::EpiScaleBf16 E{(pg8::bf16_t*)(ws + WS_PROJ), INP, (const float*)(ws + WS_SSP)};
          pg8::gemm_phase<pg8::EpiScaleBf16, pg8::StaticOrder, true, true>(lds, gm, S, E, wave); }
#ifdef BGFILL
        bg_fill(P, lds, ctl, layer * 10 + 0, BG_UNITS_LAYER * (layer + 0), tid, wave);
#endif
        GRID_BAR();
#ifndef SKIP_CMP
        for (int it = wave * G + (int)blockIdx.x; it < 384 + 512; it += NGW) { if (it < 384) item_compress(P, layer, it, lane); else item_kmean(P, it - 384, lane); }
#ifdef DUP_CMP
        for (int it = wave * G + (int)blockIdx.x; it < 384 + 512; it += NGW) { if (it < 384) item_compress(P, layer, it, lane); else item_kmean(P, it - 384, lane); }
#endif
#endif
#ifndef SKIP_MIXA
#ifdef DUP_P2A
        for (int rep_ = 0; rep_ < 2; ++rep_)
        for (;;) { const int u = next_unit(ctl + 64 * (layer * 2 + 0 + 8 * rep_), lds, tid); if (u >= 1536) break; const int ln_ = lane_id_opaque(); unit_mixA(P, lds, u, wave * 64 + ln_, ln_, wave); }
#else
        for (;;) { const int u = next_unit(ctl + 64 * (layer * 2 + 0), lds, tid); if (u >= 1536) break; const int ln_ = lane_id_opaque(); unit_mixA(P, lds, u, wave * 64 + ln_, ln_, wave); }
#endif
#endif
        GRID_BAR();
        for (int r = gw; r < MROWS; r += 4 * NGW) item_combineA4(P, r, NGW, lane);
#ifdef DUP_P2B
        for (int rep_ = 0; rep_ < 2; ++rep_)
        for (;;) { const int u = next_unit(ctl + 64 * (layer * 2 + 1 + 8 * rep_), lds, tid); if (u >= 384 + 1024) break;
#ifdef DUP_NSA_ONLY
            if (rep_ == 1 && u >= 384) continue;
#endif
#else
#ifdef TAILFILL_P2B
        const int n_units_b = 384 + 1024 + ((layer + 1 < DEPTH) ? N_CONV_UNITS : 0);
#else
        const int n_units_b = 384 + 1024;
#endif
        for (;;) { const int u = next_unit(ctl + 64 * (layer * 2 + 1), lds, tid); if (u >= n_units_b) break;
            if (u >= 384 + 1024) {
                LAS float* scr = (LAS float*)(lds + wave * 16384); const int ln_ = lane_id_opaque();
                for (int k = 0; k < CONV_UNIT_ITEMS / NWAVES; ++k) { const int r = (u - 384 - 1024) * CONV_UNIT_ITEMS + wave * (CONV_UNIT_ITEMS / NWAVES) + k; if (r < I_LAYER) p0_layer_item(P, scr, layer + 1, r, ln_); }
                continue; }
#endif
            if (u < 384) {
#ifndef SKIP_NSA
                { const int ln_ = lane_id_opaque(); unit_nsa(P, lds, (u % 6) / 3, (u % 6) % 3, 63 - u / 6, wave * 64 + ln_, ln_, wave); }
#endif
            } else { const int v = u - 384;
#ifndef SKIP_MOBA
                { const int ln_ = lane_id_opaque(); unit_moba(P, lds, (v % 16) / 8, (v % 16) % 8, 63 - v / 16, wave * 64 + ln_, ln_, wave); }
#endif
            } }
        GRID_BAR();
        { pg8::Gemm gm{(const pg8::bf16_t*)(ws + WS_O), (const pg8::bf16_t*)(ws + WS_WOUT + layer * SZ_WOUT), MROWS, DM, DM};
          pg8::StaticOrder S; S.init(MROWS, DM, G, (int)blockIdx.x);
          pg8::EpiResid E{(pg8::bf16_t*)(ws + WS_XB), (float*)(ws + WS_SSP)};
          pg8::gemm_phase<pg8::EpiResid, pg8::StaticOrder, true, true>(lds, gm, S, E, wave); }
        GRID_BAR();
#ifdef FUSE_CONV
        { pg8::Gemm gm{(const pg8::bf16_t*)(ws + WS_XB), (const pg8::bf16_t*)(ws + WS_WUP + layer * SZ_WUP), MROWS, UPW, DM};
          pg8::StaticOrder S; S.init(MROWS, UPW, G, (int)blockIdx.x);
          pg8::EpiConvGate E{(pg8::bf16_t*)(ws + WS_ACT), (pg8::bf16_t*)(ws + WS_UB), (const float*)(ws + WS_SSP), P.conv_w + (size_t)layer * 3 * UPW, P.conv_b + (size_t)layer * UPW, DFF};
          pg8::gemm_phase<pg8::EpiConvGate, pg8::StaticOrder, true, true>(lds, gm, S, E, wave); }
#ifdef BGFILL
        bg_fill(P, lds, ctl, layer * 10 + 4, BG_UNITS_LAYER * (layer + 0), tid, wave);
#endif
        GRID_BAR();
        phase_convfix(P, layer, tid);
        GRID_BAR();
#else
        { pg8::Gemm gm{(const pg8::bf16_t*)(ws + WS_XB), (const pg8::bf16_t*)(ws + WS_WUP + layer * SZ_WUP), MROWS, UPW, DM};
          pg8::StaticOrder S; S.init(MROWS, UPW, G, (int)blockIdx.x);
          pg8::EpiScaleBf16 E{(pg8::bf16_t*)(ws + WS_U), UPW, (const float*)(ws + WS_SSP)};
#ifdef DUP_G3
          pg8::gemm_phase<pg8::EpiScaleBf16, pg8::StaticOrder, true, true>(lds, gm, S, E, wave);
#endif
          pg8::gemm_phase<pg8::EpiScaleBf16, pg8::StaticOrder, true, true>(lds, gm, S, E, wave); }
        GRID_BAR();
#ifndef SKIP_CONV
        phase_conv(P, layer, tid);
#ifdef DUP_CONV
        phase_conv(P, layer, tid);
#endif
#endif
        GRID_BAR();
#endif
        { pg8::Gemm gm{(const pg8::bf16_t*)(ws + WS_ACT), (const pg8::bf16_t*)(ws + WS_WDN + layer * SZ_WDN), MROWS, DM, DFF};
          pg8::StaticOrder S; S.init(MROWS, DM, G, (int)blockIdx.x);
          pg8::EpiResid E{(pg8::bf16_t*)(ws + WS_XB), (float*)(ws + WS_SSP)};
          pg8::gemm_phase<pg8::EpiResid, pg8::StaticOrder, true, true>(lds, gm, S, E, wave); }
#ifdef BGFILL
        bg_fill(P, lds, ctl, layer * 10 + 8, BG_UNITS_LAYER * (layer + 1), tid, wave);
#endif
        GRID_BAR();
    }
    const int wave = wave0, lane = lane_id_opaque();
    const int G = gridDim.x, gw = blockIdx.x * NWAVES + wave, NGW = G * NWAVES;
    unsigned char* ws = ws0; (void)G;
    for (int mrow = gw; mrow < MROWS; mrow += NGW) {
        const u32x2* xr = (const u32x2*)((const bf16_t*)(ws + WS_XB) + (size_t)mrow * DM) + lane; const f32x4* gr = (const f32x4*)P.norm_final + lane;
        f32x4 v[8]; float s = 0.f;
#pragma unroll
        for (int j = 0; j < 8; ++j) { const u32x2 w = xr[64 * j]; v[j] = (f32x4){bflo(w.x), bfhi(w.x), bflo(w.y), bfhi(w.y)}; s += (v[j][0] * v[j][0] + v[j][1] * v[j][1]) + (v[j][2] * v[j][2] + v[j][3] * v[j][3]); }
#pragma unroll
        for (int o = 1; o < 64; o <<= 1) s += __shfl_xor(s, o);
        const float rs = 1.0f / sqrtf(s * (1.0f / DM) + 1e-6f);
        f32x4* orow = (f32x4*)(P.out + (size_t)mrow * DM) + lane;
#pragma unroll
        for (int j = 0; j < 8; ++j) orow[64 * j] = v[j] * rs * gr[64 * j];
    }
}

extern "C" void kernel_launch(void* const* d_in, const int* in_sizes, int n_in, void* d_out, int out_size, void* d_ws, size_t ws_size, hipStream_t stream) {
    static int grid = 0;
    if (grid == 0) {
        if (n_in != 14 || ws_size < WS_END) { fprintf(stderr, "kernel_launch: unexpected n_in %d or workspace %zu < %zu\n", n_in, ws_size, (size_t)WS_END); grid = -1; return; }
        int dev = 0, cus = 0, per_cu = 0;
        hipGetDevice(&dev); hipDeviceGetAttribute(&cus, hipDeviceAttributeMultiprocessorCount, dev);
        if (hipFuncSetAttribute((const void*)fwd_megakernel, hipFuncAttributeMaxDynamicSharedMemorySize, LDS_BYTES) != hipSuccess) { fprintf(stderr, "kernel_launch: hipFuncSetAttribute failed\n"); grid = -1; return; }
        if (hipOccupancyMaxActiveBlocksPerMultiprocessor(&per_cu, (const void*)fwd_megakernel, NTHREADS, LDS_BYTES) != hipSuccess || per_cu < 1) { fprintf(stderr, "kernel_launch: occupancy query says %d\n", per_cu); per_cu = 1; }
        (void)hipGetLastError();
        grid = cus * 1;
    }
    if (grid < 0) return;
    hipMemsetAsync((char*)d_ws + WS_CTL, 0, CTL_BYTES, stream);
    Params p{};
    p.x = (const float*)d_in[0]; p.rel = (const float*)d_in[1]; p.w_in = (const float*)d_in[2]; p.w_out = (const float*)d_in[3]; p.cmp_w1 = (const float*)d_in[4]; p.cmp_w2 = (const float*)d_in[5];
    p.cmp_pe = (const float*)d_in[6]; p.norm_attn = (const float*)d_in[7]; p.norm_mlp = (const float*)d_in[8]; p.w_up = (const float*)d_in[9]; p.conv_w = (const float*)d_in[10]; p.conv_b = (const float*)d_in[11];
    p.w_down = (const float*)d_in[12]; p.norm_final = (const float*)d_in[13]; p.out = (float*)d_out; p.ws = (unsigned char*)d_ws;
    void* args[] = {&p};
    hipError_t e = hipLaunchCooperativeKernel((const void*)fwd_megakernel, dim3(grid), dim3(NTHREADS), args, LDS_BYTES, stream);
    if (e != hipSuccess) fprintf(stderr, "kernel_launch: cooperative launch failed: %s (grid %d)\n", hipGetErrorString(e), grid);
}
```

```cpp
#define FUSE_CONV
#define CONV_DPP
#include <hip/hip_runtime.h>
#include <hip/hip_cooperative_groups.h>
#include <cstdio>
#include <cstdint>
namespace cg = cooperative_groups;
namespace pg8 {
#define PG8_LAS __attribute__((address_space(3)))
typedef unsigned short bf16_t;
typedef short bf16x8 __attribute__((ext_vector_type(8)));
typedef float f32x4 __attribute__((ext_vector_type(4)));
typedef unsigned u32x4 __attribute__((ext_vector_type(4)));
constexpr int BM = 256, BK = 64, HALF = 128, HTB = HALF * BK * 2  , STAGE_BYTES = 8 * HTB, NXCD = 8, WGM = 8;

__host__ __device__ __forceinline__ int lds_byte(int r, int c) { const int st = (r >> 4) * 2 + (c >> 5), rr = r & 15, cc = c & 31, ob = rr * 64 + cc * 2; return st * 1024 + (ob ^ (((ob >> 9) & 1) << 5)); }
__host__ __device__ __forceinline__ void stage_rc(int b, int& R, int& C) { const int st = b / 1024, sb = b % 1024, swz = sb ^ (((sb >> 9) & 1) << 5); R = (st >> 1) * 16 + swz / 64; C = (st & 1) * 32 + (swz % 64) / 2; }
__host__ __device__ __forceinline__ int perm32(int rho) { const int n = rho >> 4, i = rho & 15; return 8 * (i >> 2) + 4 * n + (i & 3); }

struct Unit { int pm, pn; };
struct Gemm { const bf16_t* A; const bf16_t* Bt; int M, N, K; };

struct StaticOrder {
    int nM, nN, nwg, G, c;
    __host__ __device__ void init(int M, int N, int G_, int c_) { nM = M / BM; nN = N / BM; nwg = nM * nN; G = G_; c = c_; }
    __host__ __device__ bool next(int i, Unit& u) const {
        const long L = (long)i * G + c; if (L >= nwg) return false;
        int wgid = (int)L; { const int q = nwg / NXCD, r = nwg % NXCD, xcd = wgid % NXCD, off = wgid / NXCD; wgid = (xcd < r ? xcd * (q + 1) : r * (q + 1) + (xcd - r) * q) + off; }
        const int nig = WGM * nN, gid = wgid / nig, fm = gid * WGM, gsz = (nM - fm) < WGM ? (nM - fm) : WGM;
        u.pm = fm + ((wgid % nig) % gsz); u.pn = (wgid % nig) / gsz; return true;
    }
    __device__ __forceinline__ void a_ready(const Unit&) const {}
    __device__ __forceinline__ void done(const Unit&) const {}
};
typedef float f32x2 __attribute__((ext_vector_type(2)));
typedef __bf16 bf16x2_pk __attribute__((ext_vector_type(2)));
__device__ __forceinline__ unsigned cvt_pk_bf16(float lo, float hi) { f32x2 v = {lo, hi}; bf16x2_pk b = __builtin_convertvector(v, bf16x2_pk); return __builtin_bit_cast(unsigned, b); }
__device__ __forceinline__ float row_rstd(const float* ssp, int row) {
    const f32x4* p = (const f32x4*)(ssp + (size_t)row * 32); float s = 0.f;
#pragma unroll
    for (int i = 0; i < 8; ++i) { const f32x4 v = p[i]; s += (v[0] + v[1]) + (v[2] + v[3]); }
    return 1.0f / sqrtf(s * (1.0f / 2048.0f) + 1e-6f);
}
struct EpiScaleBf16 {
    static constexpr bool PERM = true, AFTER_DRAIN = false;
    bf16_t* O; int ldc; const float* ssp;
    __device__ __forceinline__ void operator()(const f32x4 (&acc)[2][2][4][2], const Unit& u, int wr, int wc, int fr, int fq) const {
        const int lane = fq * 16 + fr;
        const int rbase = u.pm * BM + wr * 64;
        f32x4 t[2][8];
#pragma unroll
        for (int j = 0; j < 2; ++j) { const int q = 2 * lane + j; const int row = rbase + (q >> 6) * HALF + (q & 63);
            const f32x4* p = (const f32x4*)(ssp + (size_t)row * 32);
#pragma unroll
            for (int i = 0; i < 8; ++i) t[j][i] = p[i]; }
        __builtin_amdgcn_sched_barrier(0);
        float rsv[2];
#pragma unroll
        for (int j = 0; j < 2; ++j) { float sm = 0.f;
#pragma unroll
            for (int i = 0; i < 8; ++i) sm += (t[j][i][0] + t[j][i][1]) + (t[j][i][2] + t[j][i][3]);
            rsv[j] = 1.0f / sqrtf(sm * (1.0f / 2048.0f) + 1e-6f); }
        const int row0 = rbase + fr; const int col0 = u.pn * BM + wc * 32 + 8 * fq;
#pragma unroll
        for (int ai = 0; ai < 2; ++ai)
#pragma unroll
            for (int m = 0; m < 4; ++m) { const int q = ai * 64 + m * 16 + fr; const float v0 = __shfl(rsv[0], q >> 1), v1 = __shfl(rsv[1], q >> 1); const float rs = (q & 1) ? v1 : v0;
                bf16_t* rowp = O + (size_t)(row0 + ai * HALF + m * 16) * ldc + col0;
#pragma unroll
                for (int bj = 0; bj < 2; ++bj) { const f32x4 v0_ = acc[ai][bj][m][0] * rs, v1_ = acc[ai][bj][m][1] * rs; u32x4 w;
                    w.x = cvt_pk_bf16(v0_[0], v0_[1]); w.y = cvt_pk_bf16(v0_[2], v0_[3]); w.z = cvt_pk_bf16(v1_[0], v1_[1]); w.w = cvt_pk_bf16(v1_[2], v1_[3]);
                    *(u32x4*)(rowp + bj * HALF) = w; } }
    }
};
struct EpiResid {
    static constexpr bool PERM = false, AFTER_DRAIN = false;
    bf16_t* XB; float* ssp;
    __device__ __forceinline__ void operator()(const f32x4 (&acc)[2][2][4][2], const Unit& u, int wr, int wc, int fr, int fq) const {
        typedef unsigned u32x2v __attribute__((ext_vector_type(2)));
        const int row0 = u.pm * BM + wr * 64 + fr; const int col0 = u.pn * BM + wc * 32 + 4 * fq;
#pragma unroll
        for (int ai = 0; ai < 2; ++ai) {
            u32x2v bs[4][2][2];
#pragma unroll
            for (int m = 0; m < 4; ++m)
#pragma unroll
                for (int bj = 0; bj < 2; ++bj)
#pragma unroll
                    for (int n = 0; n < 2; ++n) bs[m][bj][n] = *(const u32x2v*)(XB + (size_t)(row0 + ai * HALF + m * 16) * 2048 + col0 + bj * HALF + n * 16);
            __builtin_amdgcn_sched_barrier(0);
#pragma unroll
            for (int m = 0; m < 4; ++m) { const int row = row0 + ai * HALF + m * 16; const size_t off = (size_t)row * 2048 + col0; float ss = 0.f;
#pragma unroll
                for (int bj = 0; bj < 2; ++bj)
#pragma unroll
                    for (int n = 0; n < 2; ++n) { const size_t o2 = off + bj * HALF + n * 16; const u32x2v b2 = bs[m][bj][n];
                        const f32x4 bv = {__uint_as_float(b2.x << 16), __uint_as_float(b2.x & 0xffff0000u), __uint_as_float(b2.y << 16), __uint_as_float(b2.y & 0xffff0000u)};
                        const f32x4 v = bv + acc[ai][bj][m][n];
                        u32x2v w; w.x = cvt_pk_bf16(v[0], v[1]); w.y = cvt_pk_bf16(v[2], v[3]); *(u32x2v*)(XB + o2) = w;
                        ss += (v[0] * v[0] + v[1] * v[1]) + (v[2] * v[2] + v[3] * v[3]); }
                ss += __shfl_xor(ss, 16); ss += __shfl_xor(ss, 32);
                if (fq == 0) ssp[(size_t)row * 32 + u.pn * 4 + wc] = ss; }
            asm volatile("" ::: "memory");
        }
    }
};
template <int CTRL> __device__ __forceinline__ float dpp_f(float v) { return __builtin_bit_cast(float, __builtin_amdgcn_update_dpp(0, __builtin_bit_cast(int, v), CTRL, 0xf, 0xf, false)); }
#ifdef CONV_DPP
#define ROWM1(v) dpp_f<0x121>(v)
#define ROWM2(v) dpp_f<0x122>(v)
#else
#define ROWM1(v) __shfl(v, src1)
#define ROWM2(v) __shfl(v, src2)
#endif
struct EpiConvGate {
    static constexpr bool PERM = true, AFTER_DRAIN = false;
    bf16_t* ACT; bf16_t* UB; const float* ssp; const float* cw; const float* cb; int dff;
    __device__ __forceinline__ void operator()(const f32x4 (&acc)[2][2][4][2], const Unit& u, int wr, int wc, int fr, int fq) const {
        typedef unsigned u32x2v __attribute__((ext_vector_type(2)));
        const int lane = fq * 16 + fr;
        const int rbase = u.pm * BM + wr * 64;
        const int upw = 2 * dff;
        float rsv[2];
        { f32x4 t[2][8];
#pragma unroll
          for (int j = 0; j < 2; ++j) { const int q = 2 * lane + j; const int row = rbase + (q >> 6) * HALF + (q & 63);
              const f32x4* p = (const f32x4*)(ssp + (size_t)row * 32);
#pragma unroll
              for (int i = 0; i < 8; ++i) t[j][i] = p[i]; }
          __builtin_amdgcn_sched_barrier(0);
#pragma unroll
          for (int j = 0; j < 2; ++j) { float sm = 0.f;
#pragma unroll
              for (int i = 0; i < 8; ++i) sm += (t[j][i][0] + t[j][i][1]) + (t[j][i][2] + t[j][i][3]);
              rsv[j] = 1.0f / sqrtf(sm * (1.0f / 2048.0f) + 1e-6f); } }
        const int src1 = fq * 16 + ((fr + 15) & 15), src2 = fq * 16 + ((fr + 14) & 15); (void)src1; (void)src2;
        const int chb = u.pn * HALF + wc * 32 + 8 * fq;
        const int ucb = u.pn * BM + wc * 32 + 8 * fq;
#pragma unroll
        for (int n = 0; n < 2; ++n) {
            const int ch = chb + 4 * n;
            const f32x4 wa0 = *(const f32x4*)(cw + ch), wa1 = *(const f32x4*)(cw + upw + ch), wa2 = *(const f32x4*)(cw + 2 * upw + ch);
            const f32x4 wg0 = *(const f32x4*)(cw + dff + ch), wg1 = *(const f32x4*)(cw + upw + dff + ch), wg2 = *(const f32x4*)(cw + 2 * upw + dff + ch);
            const f32x4 ba = *(const f32x4*)(cb + ch), bg = *(const f32x4*)(cb + dff + ch);
            __builtin_amdgcn_sched_barrier(0);
#pragma unroll
            for (int ai = 0; ai < 2; ++ai) {
                f32x4 pa = {0.f, 0.f, 0.f, 0.f}, pg = {0.f, 0.f, 0.f, 0.f};
#pragma unroll
                for (int m = 0; m < 4; ++m) {
                    const int q = ai * 64 + m * 16 + fr; const float rv0 = __shfl(rsv[0], q >> 1), rv1 = __shfl(rsv[1], q >> 1); const float rsm = (q & 1) ? rv1 : rv0;
                    const f32x4 va = acc[ai][0][m][n] * rsm, vg = acc[ai][1][m][n] * rsm;
                    f32x4 a1, a2, g1, g2;
#pragma unroll
                    for (int x = 0; x < 4; ++x) {
                        const float c1 = ROWM1(va[x]), c2 = ROWM2(va[x]), e1 = ROWM1(vg[x]), e2 = ROWM2(vg[x]);
                        float d1 = 0.f, d2 = 0.f, f1 = 0.f, f2 = 0.f;
                        if (m > 0) { d1 = ROWM1(pa[x]); d2 = ROWM2(pa[x]); f1 = ROWM1(pg[x]); f2 = ROWM2(pg[x]); }
                        a1[x] = fr >= 1 ? c1 : d1; a2[x] = fr >= 2 ? c2 : d2; g1[x] = fr >= 1 ? e1 : f1; g2[x] = fr >= 2 ? e2 : f2; }
                    const f32x4 ya = ba + wa0 * va + wa1 * a1 + wa2 * a2, yg = bg + wg0 * vg + wg1 * g1 + wg2 * g2;
                    float r4[4];
#pragma unroll
                    for (int x = 0; x < 4; ++x) r4[x] = ya[x] * yg[x] / (1.f + __expf(-yg[x]));
                    const int row = rbase + ai * HALF + m * 16 + fr;
                    if (m > 0 || fr >= 2) { u32x2v w; w.x = cvt_pk_bf16(r4[0], r4[1]); w.y = cvt_pk_bf16(r4[2], r4[3]); *(u32x2v*)(ACT + (size_t)row * dff + ch) = w; }
                    if ((m == 0 && fr < 2) || (m == 3 && fr >= 14)) { const int k = (m == 0) ? fr : fr - 12; bf16_t* ub = UB + ((size_t)(row >> 6) * 4 + k) * upw + ucb + 4 * n;
                        u32x2v w; w.x = cvt_pk_bf16(va[0], va[1]); w.y = cvt_pk_bf16(va[2], va[3]); *(u32x2v*)ub = w;
                        w.x = cvt_pk_bf16(vg[0], vg[1]); w.y = cvt_pk_bf16(vg[2], vg[3]); *(u32x2v*)(ub + HALF) = w; }
                    pa = va; pg = vg;
                }
                asm volatile("" ::: "memory");
            }
        }
    }
};
template <class Epi, class Sched, bool ALIGN_EPI = false, bool SP2 = false>
__device__ __forceinline__ void gemm_phase(PG8_LAS unsigned char* lds, const Gemm g, const Sched& S, const Epi& E, const int wid_in) {
    int lane_; asm volatile("v_mbcnt_lo_u32_b32 %0, -1, 0\n\tv_mbcnt_hi_u32_b32 %0, -1, %0" : "=v"(lane_)); const int wid = wid_in, lane = lane_, tid = wid * 64 + lane, wr = wid >> 2, wc = wid & 3, fr = lane & 15, fq = lane >> 4;
    const int K = g.K, nt = K / BK;
    unsigned voffA[2], voffB[2];
#pragma unroll
    for (int i = 0; i < 2; ++i) { int R, C; stage_rc(tid * 16 + i * 8192, R, C); const int Rb = Epi::PERM ? ((R & ~31) + perm32(R & 31)) : R;
        voffA[i] = (unsigned)(R * K + C) * 2u; voffB[i] = (unsigned)(Rb * K + C) * 2u; }
    const size_t kstep = (size_t)(BK * 2);
    const size_t hstep = (size_t)HALF * K * 2;
    const size_t tstep = 2 * hstep;
    const unsigned ldsw = (unsigned)wid * 1024u;
    const int aoff = lds_byte(wr * 64 + fr, fq * 8), boff = lds_byte(wc * 32 + fr, fq * 8);
#define PG8_SA(b, h) (((b) * 2 + (h)) * HTB)
#define PG8_SB(b, h) ((4 + (b) * 2 + (h)) * HTB)
#define PG8_STAGE(bufoff, gbase, voff) do { _Pragma("unroll") for (int _i = 0; _i < 2; ++_i) \
        __builtin_amdgcn_global_load_lds((const unsigned*)((const char*)(gbase) + (voff)[_i]), (PG8_LAS unsigned*)(lds + (bufoff) + ldsw + _i * 8192), 16, 0, 0); } while (0)
#define PG8_LDA(dst, b, h) do { _Pragma("unroll") for (int m = 0; m < 4; ++m) _Pragma("unroll") for (int k = 0; k < 2; ++k) dst[m][k] = *(const PG8_LAS bf16x8*)(lds + PG8_SA(b, h) + aoff + m * 2048 + k * 1024); } while (0)
#define PG8_LDB(dst, b, h) do { _Pragma("unroll") for (int n = 0; n < 2; ++n) _Pragma("unroll") for (int k = 0; k < 2; ++k) dst[n][k] = *(const PG8_LAS bf16x8*)(lds + PG8_SB(b, h) + boff + n * 2048 + k * 1024); } while (0)
#define PG8_MMA(ai, bj, At, Bt) do { __builtin_amdgcn_s_setprio(1); _Pragma("unroll") for (int m = 0; m < 4; ++m) _Pragma("unroll") for (int n = 0; n < 2; ++n) _Pragma("unroll") for (int k = 0; k < 2; ++k) \
        acc[ai][bj][m][n] = __builtin_amdgcn_mfma_f32_16x16x32_bf16(Bt[n][k], At[m][k], acc[ai][bj][m][n], 0, 0, 0); __builtin_amdgcn_s_setprio(0); } while (0)
#define PG8_WAIT_V(n) asm volatile("s_waitcnt vmcnt(" #n ")" ::: "memory")
#define PG8_WAIT_L(n) asm volatile("s_waitcnt lgkmcnt(" #n ")" ::: "memory")
#define PG8_BAR __builtin_amdgcn_s_barrier()
#define PG8_SCHED __builtin_amdgcn_sched_barrier(0)
    Unit cur, nxt; int ui = 0;
    if (!S.next(0, cur)) return;
    f32x4 acc[2][2][4][2];
#pragma unroll
    for (int a = 0; a < 2; ++a)
#pragma unroll
        for (int b = 0; b < 2; ++b)
#pragma unroll
            for (int m = 0; m < 4; ++m)
#pragma unroll
                for (int n = 0; n < 2; ++n) acc[a][b][m][n] = (f32x4){0.f, 0.f, 0.f, 0.f};
    bf16x8 At[4][2], B0[2][2], B1[2][2];
    const char* cA = (const char*)g.A + (size_t)cur.pm * tstep; const char* cB = (const char*)g.Bt + (size_t)cur.pn * tstep;
    S.a_ready(cur);
    if constexpr (SP2) {
        PG8_STAGE(PG8_SB(0, 0), cB, voffB); PG8_STAGE(PG8_SB(0, 1), cB + hstep, voffB); PG8_STAGE(PG8_SA(0, 0), cA, voffA); PG8_STAGE(PG8_SA(0, 1), cA + hstep, voffA);
        if (wr == 1) PG8_BAR;
        PG8_WAIT_V(2); PG8_BAR;
        PG8_STAGE(PG8_SB(1, 0), cB + kstep, voffB); PG8_STAGE(PG8_SA(1, 0), cA + kstep, voffA); PG8_STAGE(PG8_SB(1, 1), cB + hstep + kstep, voffB);
        PG8_WAIT_V(6); PG8_BAR;
    } else {
        PG8_STAGE(PG8_SB(0, 0), cB, voffB); PG8_STAGE(PG8_SA(0, 0), cA, voffA); PG8_STAGE(PG8_SB(0, 1), cB + hstep, voffB); PG8_STAGE(PG8_SA(0, 1), cA + hstep, voffA);
        if (wr == 1) PG8_BAR;
        PG8_WAIT_V(4); PG8_BAR;
        PG8_STAGE(PG8_SB(1, 0), cB + kstep, voffB); PG8_STAGE(PG8_SA(1, 0), cA + kstep, voffA); PG8_STAGE(PG8_SB(1, 1), cB + hstep + kstep, voffB);
        PG8_WAIT_V(6); PG8_BAR;
    }
    for (;;) {
        const bool has_next = S.next(ui + 1, nxt);
        const char* nA = has_next ? (const char*)g.A + (size_t)nxt.pm * tstep : cA; const char* nB = has_next ? (const char*)g.Bt + (size_t)nxt.pn * tstep : cB;
        for (int t = 0; t < nt; t += 2) {
            const bool last = (t == nt - 2);
            const char* a1 = cA + (size_t)(t + 1) * kstep;
            const char* a2 = last ? nA : cA + (size_t)(t + 2) * kstep; const char* b2 = last ? nB : cB + (size_t)(t + 2) * kstep;
            const char* a3 = a2 + kstep; const char* b3 = b2 + kstep;
            if (last && has_next) S.a_ready(nxt);
            if constexpr (SP2) {
            PG8_LDB(B0, 0, 0); PG8_LDB(B1, 0, 1); PG8_SCHED; PG8_LDA(At, 0, 0); PG8_STAGE(PG8_SA(1, 1), a1 + hstep, voffA);
            PG8_WAIT_V(8); PG8_WAIT_L(0); PG8_BAR; PG8_MMA(0, 0, At, B0); PG8_MMA(0, 1, At, B1); PG8_BAR; PG8_SCHED;
            PG8_LDA(At, 0, 1); PG8_STAGE(PG8_SB(0, 0), b2, voffB); PG8_STAGE(PG8_SB(0, 1), b2 + hstep, voffB); PG8_STAGE(PG8_SA(0, 0), a2, voffA);
            PG8_WAIT_V(8); PG8_WAIT_L(0); PG8_BAR; PG8_MMA(1, 0, At, B0); PG8_MMA(1, 1, At, B1); PG8_BAR; PG8_SCHED;
            PG8_LDB(B0, 1, 0); PG8_LDB(B1, 1, 1); PG8_SCHED; PG8_LDA(At, 1, 0); PG8_STAGE(PG8_SA(0, 1), a2 + hstep, voffA);
            PG8_WAIT_V(8); PG8_WAIT_L(0); PG8_BAR; PG8_MMA(0, 0, At, B0); PG8_MMA(0, 1, At, B1); PG8_BAR; PG8_SCHED;
            PG8_LDA(At, 1, 1); PG8_STAGE(PG8_SB(1, 0), b3, voffB); PG8_STAGE(PG8_SB(1, 1), b3 + hstep, voffB); PG8_STAGE(PG8_SA(1, 0), a3, voffA);
            PG8_WAIT_V(8); PG8_WAIT_L(0); PG8_BAR; PG8_MMA(1, 0, At, B0); PG8_MMA(1, 1, At, B1); PG8_BAR; PG8_SCHED;
            } else {
            PG8_LDB(B0, 0, 0); PG8_SCHED; PG8_LDA(At, 0, 0); PG8_STAGE(PG8_SA(1, 1), a1 + hstep, voffA);
            PG8_WAIT_L(8); PG8_BAR; PG8_WAIT_L(0); PG8_MMA(0, 0, At, B0); PG8_BAR; PG8_SCHED;
            PG8_LDB(B1, 0, 1); PG8_STAGE(PG8_SB(0, 0), b2, voffB);
            PG8_BAR; PG8_WAIT_L(0); PG8_MMA(0, 1, At, B1); PG8_BAR;
            PG8_LDA(At, 0, 1); PG8_STAGE(PG8_SA(0, 0), a2, voffA);
            PG8_BAR; PG8_WAIT_L(0); PG8_MMA(1, 0, At, B0); PG8_BAR; PG8_SCHED;
            PG8_STAGE(PG8_SB(0, 1), b2 + hstep, voffB);
            PG8_WAIT_V(6); PG8_BAR; PG8_MMA(1, 1, At, B1); PG8_BAR;
            PG8_LDB(B0, 1, 0); PG8_SCHED; PG8_LDA(At, 1, 0); PG8_STAGE(PG8_SA(0, 1), a2 + hstep, voffA);
            PG8_WAIT_L(8); PG8_BAR; PG8_WAIT_L(0); PG8_MMA(0, 0, At, B0); PG8_BAR; PG8_SCHED;
            PG8_LDB(B1, 1, 1); PG8_STAGE(PG8_SB(1, 0), b3, voffB);
            PG8_BAR; PG8_WAIT_L(0); PG8_MMA(0, 1, At, B1); PG8_BAR;
            PG8_LDA(At, 1, 1); PG8_STAGE(PG8_SA(1, 0), a3, voffA);
            PG8_BAR; PG8_WAIT_L(0); PG8_MMA(1, 0, At, B0); PG8_BAR; PG8_SCHED;
            PG8_STAGE(PG8_SB(1, 1), b3 + hstep, voffB);
            PG8_WAIT_V(6); PG8_BAR; PG8_MMA(1, 1, At, B1); PG8_BAR;
            }
        }
        if constexpr (ALIGN_EPI) { if (wr == 0) PG8_BAR; }
        if constexpr (!Epi::AFTER_DRAIN) { E(acc, cur, wr, wc, fr, fq); S.done(cur); }
        if (!has_next) break;
#pragma unroll
        for (int a = 0; a < 2; ++a)
#pragma unroll
            for (int b = 0; b < 2; ++b)
#pragma unroll
                for (int m = 0; m < 4; ++m)
#pragma unroll
                    for (int n = 0; n < 2; ++n) acc[a][b][m][n] = (f32x4){0.f, 0.f, 0.f, 0.f};
        cur = nxt; cA = nA; cB = nB; ++ui;
        if constexpr (ALIGN_EPI) { if (wr == 1) PG8_BAR; }
    }
    PG8_WAIT_V(0);
    if constexpr (!ALIGN_EPI) { if (wr == 0) PG8_BAR; }
    PG8_BAR;
    if constexpr (Epi::AFTER_DRAIN) { E.fused(acc, cur, wr, wc, fr, fq, lds, wid, lane); S.done(cur); }
#undef PG8_SA
#undef PG8_SB
#undef PG8_STAGE
#undef PG8_LDA
#undef PG8_LDB
#undef PG8_MMA
#undef PG8_WAIT_V
#undef PG8_WAIT_L
#undef PG8_BAR
#undef PG8_SCHED
}
}

#define GAS __attribute__((address_space(1)))
#define LAS __attribute__((address_space(3)))
typedef unsigned short bf16_t;
typedef short bf16x8 __attribute__((ext_vector_type(8)));
typedef float f32x4 __attribute__((ext_vector_type(4)));
typedef unsigned u32x4 __attribute__((ext_vector_type(4)));
typedef unsigned u32x2 __attribute__((ext_vector_type(2)));
typedef short s16x4 __attribute__((ext_vector_type(4)));

constexpr int BATCH = 2, SEQ = 8192, DM = 2048, DEPTH = 4, MROWS = BATCH * SEQ;
constexpr int INW = 5796, INP = 5888, DFF = 5632, UPW = 2 * DFF;
constexpr int A_OFF = 0, B_OFF = 2304, CQ_OFF = 3840, CKV_OFF = 4608, CG_OFF = 5760;
constexpr int LUTN = 1536;
constexpr float LOG2E = 1.4426950408889634f, LN2 = 0.6931471805599453f;
constexpr int NTHREADS = 512, NWAVES = 8;

constexpr size_t al256(size_t x) { return (x + 255) & ~(size_t)255; }
constexpr size_t WS_CTL = 0, CTL_BYTES = 1u << 20;
constexpr size_t SZ_WIN = (size_t)INP * DM * 2, SZ_WOUT = (size_t)DM * DM * 2, SZ_WUP = (size_t)UPW * DM * 2, SZ_WDN = (size_t)DM * DFF * 2;
constexpr size_t WS_WIN = CTL_BYTES;
constexpr size_t WS_WOUT = WS_WIN + DEPTH * SZ_WIN;
constexpr size_t WS_WUP = WS_WOUT + DEPTH * SZ_WOUT;
constexpr size_t WS_WDN = WS_WUP + DEPTH * SZ_WUP;
constexpr size_t WS_W1T = WS_WDN + DEPTH * SZ_WDN;
constexpr size_t WS_W2T = WS_W1T + (size_t)DEPTH * 2 * 128 * 2048 * 2;
constexpr size_t WS_CPE = WS_W2T + (size_t)DEPTH * 2 * 64 * 128 * 2;
constexpr size_t WS_GLUT = al256(WS_CPE + (size_t)DEPTH * 2 * 128 * 4);
constexpr size_t WS_X = al256(WS_GLUT + (size_t)32 * LUTN * 4);
constexpr size_t WS_XB = WS_X + (size_t)MROWS * DM * 4;
constexpr size_t WS_SSP = WS_XB + (size_t)MROWS * DM * 2;
constexpr size_t WS_R1 = WS_SSP + (size_t)MROWS * 32 * 4;
constexpr size_t WS_PROJ = WS_R1;
constexpr size_t WS_O = WS_R1 + (size_t)MROWS * INP * 2;
constexpr size_t WS_U = WS_R1;
constexpr size_t SZ_R1 = (size_t)MROWS * UPW * 2;
static_assert((size_t)MROWS * INP * 2 + (size_t)MROWS * DM * 2 <= SZ_R1, "overlay");
constexpr size_t WS_ACT = WS_R1 + SZ_R1;
constexpr size_t WS_TOT = WS_ACT + (size_t)MROWS * DFF * 2;
constexpr size_t WS_LSE = WS_TOT + (size_t)MROWS * 768 * 4;
constexpr size_t WS_KC = WS_LSE + (size_t)MROWS * 12 * 4;
constexpr size_t WS_VC = WS_KC + (size_t)BATCH * 3 * 512 * 64 * 2;
constexpr size_t WS_KMEAN = WS_VC + (size_t)BATCH * 3 * 512 * 64 * 2;
constexpr size_t WS_UB = WS_KMEAN + (size_t)BATCH * 8 * 32 * 64 * 4;
constexpr size_t WS_END = WS_UB + (size_t)(MROWS / 64) * 4 * UPW * 2;

constexpr int KP = 160;
constexpr int TILE_B = 64 * KP;
constexpr int L_K0 = 0, L_V0 = TILE_B, L_K1 = 2 * TILE_B, L_V1 = 3 * TILE_B;
constexpr int L_LUT = 4 * TILE_B;
constexpr int L_IMP = L_LUT + 4 * LUTN * 4;
constexpr int L_SEL = L_IMP + 65536;
constexpr int L_TL = L_SEL + 2048;
constexpr int L_MISC = L_TL + 2048;
constexpr int L_WUN = L_MISC + 64;
constexpr int LDS_BYTES = 147456;
static_assert(L_MISC + 256 <= LDS_BYTES, "lds map");

struct Params {
    const float* x; const float* rel; const float* w_in; const float* w_out; const float* cmp_w1; const float* cmp_w2; const float* cmp_pe;
    const float* norm_attn; const float* norm_mlp; const float* w_up; const float* conv_w; const float* conv_b; const float* w_down; const float* norm_final;
    float* out; unsigned char* ws;
};

typedef float f32x2_t __attribute__((ext_vector_type(2))); typedef __bf16 bf16x2_t __attribute__((ext_vector_type(2)));
__device__ __forceinline__ unsigned cvtpk(float lo, float hi) { f32x2_t v = {lo, hi}; bf16x2_t b = __builtin_convertvector(v, bf16x2_t); return __builtin_bit_cast(unsigned, b); }
__device__ __forceinline__ float bf2f(unsigned short b) { return __uint_as_float(((unsigned)b) << 16); }
__device__ __forceinline__ float bflo(unsigned w) { return __uint_as_float(w << 16); }
__device__ __forceinline__ float bfhi(unsigned w) { return __uint_as_float(w & 0xffff0000u); }
__device__ __forceinline__ float fexp2(float x) { return __builtin_amdgcn_exp2f(x); }
__device__ __forceinline__ int lane_id_opaque() { int l_; asm volatile("v_mbcnt_lo_u32_b32 %0, -1, 0\n\tv_mbcnt_hi_u32_b32 %0, -1, %0" : "=v"(l_)); return l_; }
#define LDS_BARRIER() do { asm volatile("s_waitcnt lgkmcnt(0)" ::: "memory"); __builtin_amdgcn_s_barrier(); asm volatile("" ::: "memory"); } while (0)
__device__ __forceinline__ float fma_1(float a, float b, float c) { float r; asm("v_fma_f32 %0, %1, %2, %3" : "=v"(r) : "v"(a), "v"(b), "v"(c)); return r; }
__device__ __forceinline__ float xrow16_max(float x) {
  auto s_ = __builtin_amdgcn_permlane16_swap(__float_as_uint(x), __float_as_uint(x), false, false);
  x = fmaxf(__uint_as_float(s_[0]), __uint_as_float(s_[1]));
  auto t_ = __builtin_amdgcn_permlane32_swap(__float_as_uint(x), __float_as_uint(x), false, false);
  return fmaxf(__uint_as_float(t_[0]), __uint_as_float(t_[1]));
}
__device__ __forceinline__ float xrow16_sum(float x) {
  auto s_ = __builtin_amdgcn_permlane16_swap(__float_as_uint(x), __float_as_uint(x), false, false);
  x = __uint_as_float(s_[0]) + __uint_as_float(s_[1]);
  auto t_ = __builtin_amdgcn_permlane32_swap(__float_as_uint(x), __float_as_uint(x), false, false);
  return __uint_as_float(t_[0]) + __uint_as_float(t_[1]);
}
__device__ __forceinline__ void lds_wait() { asm volatile("s_waitcnt lgkmcnt(0)" ::: "memory"); }
__device__ __forceinline__ s16x4 tr_read(const LAS unsigned char* p) { return __builtin_bit_cast(s16x4, __builtin_amdgcn_ds_read_tr16_b64_v4i16((LAS s16x4*)p)); }
__device__ __forceinline__ f32x4 mfma16(bf16x8 a, bf16x8 b, f32x4 c) { return __builtin_amdgcn_mfma_f32_16x16x32_bf16(a, b, c, 0, 0, 0); }

__device__ __forceinline__ int t5_bucket(int n) {
    if (n < 16) return n < 0 ? 0 : n;
    int b = 16;
    b += n >= 22; b += n >= 30; b += n >= 40; b += n >= 54; b += n >= 73; b += n >= 99; b += n >= 134; b += n >= 182;
    b += n >= 246; b += n >= 332; b += n >= 450; b += n >= 609; b += n >= 825; b += n >= 1117; b += n >= 1513;
    return b;
}
__device__ __forceinline__ bool is_qcol(int n) { return (n < 2304) ? ((n % 768) < 256) : ((n < 2816) || (n >= 3840 && n < 4608)); }

template <int MODE>
__device__ __forceinline__ void p0_item(const float* W, int K, int Nsrc, bf16_t* WT, const float* kscale, LAS float* scr, int kb, int nb, int lane) {
    const int k0 = 64 * kb, n0 = 32 * nb;
    const int nd = n0 + (lane & 31);
    int sc = nd; float cs = 1.f; bool ok = true;
    if (MODE == 0) { ok = nd < INW; if (is_qcol(nd)) cs = 0.125f; }
    if (MODE == 2) { const int pn = nd >> 8, r = nd & 255; sc = (r >= 128 ? DFF : 0) + 128 * pn + (r & 127); }
    float wv[32], kv_[32];
    const float* wp_ = W + (size_t)(k0 + (lane >> 5)) * Nsrc + (ok ? sc : 0);
#pragma unroll
    for (int i = 0; i < 32; ++i) { wv[i] = wp_[(size_t)(2 * i) * Nsrc]; kv_[i] = (MODE != 1) ? kscale[k0 + 2 * i + (lane >> 5)] : 1.f; }
    __builtin_amdgcn_sched_barrier(0);
#pragma unroll
    for (int i = 0; i < 32; ++i) { const int kk = 2 * i + (lane >> 5); scr[kk * 33 + (lane & 31)] = ok ? wv[i] * cs * kv_[i] : 0.f; }
    lds_wait();
    const int c = lane & 7;
#pragma unroll
    for (int j = 0; j < 4; ++j) { const int n = (lane >> 3) + 8 * j; const LAS float* s = scr + (8 * c) * 33 + n;
        u32x4 o; o.x = cvtpk(s[0 * 33], s[1 * 33]); o.y = cvtpk(s[2 * 33], s[3 * 33]); o.z = cvtpk(s[4 * 33], s[5 * 33]); o.w = cvtpk(s[6 * 33], s[7 * 33]);
        *(u32x4*)(WT + (size_t)(n0 + n) * K + k0 + 8 * c) = o; }
    lds_wait();
}

constexpr int I_IN = 32 * (INP / 32), I_OUT = 32 * 64, I_UP = 32 * (UPW / 32), I_DN = (DFF / 64) * 64, I_W1 = 2 * 32 * 4, I_W2 = 2 * 2 * 2;
constexpr int I_LAYER = I_IN + I_OUT + I_UP + I_DN + I_W1 + I_W2;
__device__ __forceinline__ void p0_layer_item(const Params& P, LAS float* scr, int l, int r, int lane) {
    unsigned char* ws = P.ws;
    if (r < I_IN) { p0_item<0>(P.w_in + (size_t)l * DM * INW, DM, INW, (bf16_t*)(ws + WS_WIN + l * SZ_WIN), P.norm_attn + l * DM, scr, r / (INP / 32), r % (INP / 32), lane); return; } r -= I_IN;
    if (r < I_OUT) { p0_item<1>(P.w_out + (size_t)l * DM * DM, DM, DM, (bf16_t*)(ws + WS_WOUT + l * SZ_WOUT), nullptr, scr, r / 64, r % 64, lane); return; } r -= I_OUT;
    if (r < I_UP) { p0_item<2>(P.w_up + (size_t)l * DM * UPW, DM, UPW, (bf16_t*)(ws + WS_WUP + l * SZ_WUP), P.norm_mlp + l * DM, scr, r / (UPW / 32), r % (UPW / 32), lane); return; } r -= I_UP;
    if (r < I_DN) { p0_item<1>(P.w_down + (size_t)l * DFF * DM, DFF, DM, (bf16_t*)(ws + WS_WDN + l * SZ_WDN), nullptr, scr, r / 64, r % 64, lane); return; } r -= I_DN;
    if (r < I_W1) { const int i = r / 128, rr = r % 128; p0_item<1>(P.cmp_w1 + (size_t)(l * 2 + i) * 2048 * 128, 2048, 128, (bf16_t*)(ws + WS_W1T) + (size_t)(l * 2 + i) * 128 * 2048, nullptr, scr, rr / 4, rr % 4, lane); return; } r -= I_W1;
    { const int i = r / 4, rr = r % 4; p0_item<1>(P.cmp_w2 + (size_t)(l * 2 + i) * 128 * 64, 128, 64, (bf16_t*)(ws + WS_W2T) + (size_t)(l * 2 + i) * 64 * 128, nullptr, scr, rr / 2, rr % 2, lane); }
}
#if !defined(BGFILL) && !defined(TAILFILL_P2B)
constexpr int P0_LAYERS = DEPTH;
#else
constexpr int P0_LAYERS = 1;
#endif
constexpr int CONV_UNIT_ITEMS = 64, N_CONV_UNITS = (I_LAYER + CONV_UNIT_ITEMS - 1) / CONV_UNIT_ITEMS;

__device__ __forceinline__ void p0_prologue(const Params& P, LAS unsigned char* lds, int tid, int lane, int wave) {
    unsigned char* ws = P.ws;
    LAS float* scr = (LAS float*)(lds + wave * 16384);
    const int G = gridDim.x, gw = blockIdx.x * NWAVES + wave, NGW = G * NWAVES;
    for (int it = gw; it < P0_LAYERS * I_LAYER; it += NGW) p0_layer_item(P, scr, it / I_LAYER, it % I_LAYER, lane);
    for (int m = gw; m < MROWS; m += NGW) {
        const f32x4* xr = (const f32x4*)(P.x + (size_t)m * DM) + lane; float s = 0.f;
        u32x2* ob = (u32x2*)((bf16_t*)(ws + WS_XB) + (size_t)m * DM) + lane;
#pragma unroll
        for (int j = 0; j < 8; ++j) { const f32x4 v = xr[64 * j]; s += (v[0] * v[0] + v[1] * v[1]) + (v[2] * v[2] + v[3] * v[3]); u32x2 w; w.x = cvtpk(v[0], v[1]); w.y = cvtpk(v[2], v[3]); ob[64 * j] = w; }
#pragma unroll
        for (int o = 1; o < 64; o <<= 1) s += __shfl_xor(s, o);
        if (lane < 32) ((float*)(ws + WS_SSP))[(size_t)m * 32 + lane] = (lane == 0) ? s : 0.f;
    }
    for (int i = blockIdx.x * NTHREADS + tid; i < 32 * LUTN; i += G * NTHREADS) { const int h = i / LUTN, n = i % LUTN; ((float*)(ws + WS_GLUT))[i] = P.rel[h * 32 + t5_bucket(n)] * LOG2E; }
    if (blockIdx.x < DEPTH * 2) {
        __syncthreads();
        const int li = blockIdx.x, kp = tid >> 7, hid = tid & 127; const float* pe = P.cmp_pe + (size_t)li * 2048; const float* w1 = P.cmp_w1 + (size_t)li * 2048 * 128;
        float s = 0.f;
#pragma unroll 8
        for (int k = kp * 512; k < kp * 512 + 512; ++k) s += pe[k] * w1[(size_t)k * 128 + hid];
        LAS float* red = (LAS float*)lds; red[tid] = s; __syncthreads();
        if (tid < 128) ((float*)(ws + WS_CPE))[li * 128 + tid] = (red[tid] + red[tid + 128]) + (red[tid + 256] + red[tid + 384]);
        __syncthreads();
    }
}

struct Src { const bf16_t* kb; const bf16_t* vb; int stride; int dil; int roff; };

template <int QG, int MODE>
__device__ __forceinline__ void flash_tile(LAS unsigned char* lds, const int buf, const int k0, const int tag, const int dil, const bf16x8 (&qf)[QG][2], f32x4 (&o)[QG][4], float (&m)[QG], float (&l)[QG],
                                           const int qc, const int qcw_min, const int qcw_max, const int maxrel, const LAS unsigned* selp, const LAS unsigned* wunp,
                                           const float (&invl)[QG], LAS float* impw, const bool imp_acc, const LAS float* lut, float& carryB, const int lane) {
    const int g = lane >> 4, i16 = lane & 15;
    bool skip = (k0 > qcw_max) || (maxrel != 0x7fffffff && k0 + 63 < qcw_min - maxrel);
    if (tag >= 0) { const unsigned w = (unsigned)__builtin_amdgcn_readfirstlane((int)wunp[tag >> 5]); if (!((w >> (tag & 31)) & 1u)) skip = true; }
    if (MODE & 4) skip = false;
    if (!skip) {
        const LAS unsigned char* Ks = lds + (buf ? L_K1 : L_K0);
        const LAS unsigned char* Vs = lds + (buf ? L_V1 : L_V0);
        bool allowed = true;
        if (tag >= 0) { const unsigned w = selp[tag >> 5]; allowed = ((w >> (tag & 31)) & 1u) != 0u; }
        float impA[4] = {0.f, 0.f, 0.f, 0.f}, impB[4] = {0.f, 0.f, 0.f, 0.f};
        const int dl_ = qcw_min - (k0 + 63), dh_ = qcw_max - k0;
        bool uni = (k0 >= 0) && (dl_ >= 0) && (maxrel == 0x7fffffff || dh_ <= maxrel);
        if (MODE & 1) uni = uni && (dl_ * dil >= 1513);
        const unsigned uni_di = (unsigned)(dl_ * dil) < (unsigned)(LUTN - 1) ? (unsigned)(dl_ * dil) : (unsigned)(LUTN - 1);
        const bool mid = (MODE & 1) && !uni && (dil == 1) && (k0 >= 0) && (dl_ >= 0) && (maxrel == 0x7fffffff || dh_ <= maxrel) && (dh_ <= LUTN - 1);
#pragma unroll
        for (int qg = 0; qg < QG; ++qg) {
            bf16x8 kf[4][2];
#pragma unroll
            for (int kt = 0; kt < 4; ++kt)
#pragma unroll
                for (int ks = 0; ks < 2; ++ks) kf[kt][ks] = *(const LAS bf16x8*)(Ks + (16 * kt + i16) * KP + ks * 64 + g * 16);
            __builtin_amdgcn_sched_barrier(0);
            f32x4 s[4];
#pragma unroll
            for (int kt = 0; kt < 4; ++kt) { s[kt] = (f32x4){0.f, 0.f, 0.f, 0.f};
#pragma unroll
                for (int ks = 0; ks < 2; ++ks) s[kt] = mfma16(kf[kt][ks], qf[qg][ks], s[kt]); }
            bf16x8 vfr[4][2];
            if (!(MODE & 2)) {
#pragma unroll
                for (int dt = 0; dt < 4; ++dt)
#pragma unroll
                    for (int s2 = 0; s2 < 2; ++s2) { const LAS unsigned char* vp = Vs + (32 * s2 + 4 * g + (i16 >> 2)) * KP + (16 * dt + 4 * (i16 & 3)) * 2;
                        const s16x4 lo = tr_read(vp), hi = tr_read(vp + 16 * KP);
                        vfr[dt][s2] = (bf16x8){lo[0], lo[1], lo[2], lo[3], hi[0], hi[1], hi[2], hi[3]}; }
            }
            __builtin_amdgcn_sched_barrier(0);
            float mx = -INFINITY; float lanebias = 0.f;
            if (uni) {
                float lb = 0.f;
                if (MODE & 1) lb = lut[qg * LUTN + uni_di];
                lanebias = allowed ? lb : -INFINITY;
                float mr = -INFINITY;
#pragma unroll
                for (int kt = 0; kt < 4; ++kt)
#pragma unroll
                    for (int r = 0; r < 4; ++r) mr = fmaxf(mr, s[kt][r]);
                mx = allowed ? __builtin_fmaf(mr, LOG2E, lb) : -INFINITY;
            } else if (mid) {
                const LAS float* lp = lut + qg * LUTN + (qc - k0 - 4 * g - 63);
                float bv[4][4];
#pragma unroll
                for (int kt = 0; kt < 4; ++kt)
#pragma unroll
                    for (int r = 0; r < 4; ++r) bv[kt][r] = lp[63 - 16 * kt - r];
                __builtin_amdgcn_sched_barrier(0);
#pragma unroll
                for (int kt = 0; kt < 4; ++kt)
#pragma unroll
                    for (int r = 0; r < 4; ++r) { float sc = __builtin_fmaf(s[kt][r], LOG2E, bv[kt][r]); sc = allowed ? sc : -INFINITY; s[kt][r] = sc; mx = fmaxf(mx, sc); }
            } else {
                float bv[4][4];
#pragma unroll
                for (int kt = 0; kt < 4; ++kt)
#pragma unroll
                    for (int r = 0; r < 4; ++r) { bv[kt][r] = 0.f;
                        if (MODE & 1) { const int rel = qc - (k0 + 16 * kt + 4 * g + r); unsigned di = (unsigned)(rel * dil); di = di < (unsigned)(LUTN - 1) ? di : (unsigned)(LUTN - 1); bv[kt][r] = lut[qg * LUTN + di]; } }
                if (MODE & 1) __builtin_amdgcn_sched_barrier(0);
#pragma unroll
                for (int kt = 0; kt < 4; ++kt)
#pragma unroll
                    for (int r = 0; r < 4; ++r) { const int kc = k0 + 16 * kt + 4 * g + r; const int rel = qc - kc;
                        const bool ok = allowed && ((unsigned)rel <= (unsigned)maxrel) && (kc >= 0);
                        float sc = __builtin_fmaf(s[kt][r], LOG2E, bv[kt][r]);
                        sc = ok ? sc : -INFINITY; s[kt][r] = sc; mx = fmaxf(mx, sc); }
            }
            mx = xrow16_max(mx);
            const float mnew = fmaxf(m[qg], mx); const float alpha = fexp2(m[qg] - mnew); m[qg] = mnew;
            float rs = 0.f;
            if (uni) { const float cb_ = lanebias - mnew;
#pragma unroll
                for (int kt = 0; kt < 4; ++kt)
#pragma unroll
                    for (int r = 0; r < 4; ++r) { const float p = fexp2(__builtin_fmaf(s[kt][r], LOG2E, cb_)); s[kt][r] = p; rs += p; }
            } else {
#pragma unroll
                for (int kt = 0; kt < 4; ++kt)
#pragma unroll
                    for (int r = 0; r < 4; ++r) { const float p = fexp2(s[kt][r] - mnew); s[kt][r] = p; rs += p; }
            }
            if (MODE & 2) { rs = xrow16_sum(rs); l[qg] = l[qg] * alpha + rs; }
            if (MODE & 4) {
#pragma unroll
                for (int kt = 0; kt < 4; ++kt) { impA[kt] += ((s[kt][0] + s[kt][1]) + (s[kt][2] + s[kt][3])) * invl[qg]; impB[kt] += s[kt][3] * invl[qg]; }
            }
            if (!(MODE & 2)) {
#pragma unroll
                for (int dt = 0; dt < 4; ++dt) o[qg][dt] = o[qg][dt] * alpha;
                bf16x8 pf[2];
#pragma unroll
                for (int s2 = 0; s2 < 2; ++s2) { u32x4 w; w.x = cvtpk(s[2 * s2][0], s[2 * s2][1]); w.y = cvtpk(s[2 * s2][2], s[2 * s2][3]); w.z = cvtpk(s[2 * s2 + 1][0], s[2 * s2 + 1][1]); w.w = cvtpk(s[2 * s2 + 1][2], s[2 * s2 + 1][3]);
                    pf[s2] = __builtin_bit_cast(bf16x8, w); }
                { const bf16x8 ones = {16256, 16256, 16256, 16256, 16256, 16256, 16256, 16256};
                  f32x4 rsv = {0.f, 0.f, 0.f, 0.f};
                  rsv = mfma16(ones, pf[0], rsv); rsv = mfma16(ones, pf[1], rsv);
                  l[qg] = l[qg] * alpha + rsv[0]; }
#pragma unroll
                for (int dt = 0; dt < 4; ++dt)
#pragma unroll
                    for (int s2 = 0; s2 < 2; ++s2) o[qg][dt] = mfma16(vfr[dt][s2], pf[s2], o[qg][dt]);
            }
            if (QG > 1) asm volatile("" ::: "memory");
        }
        if (MODE & 4) {
            const int srcl = (lane + 48) & 63;
#pragma unroll
            for (int kt = 0; kt < 4; ++kt) { const float pb = (kt == 0) ? carryB : impB[kt == 0 ? 0 : kt - 1];
                const float x0 = __shfl(pb, srcl), x1 = __shfl(impB[kt], srcl); const float add = (g == 0) ? x0 : x1;
                const int J = 4 * ((k0 >> 4) + kt) + g; const float prevv = imp_acc ? impw[i16 * 128 + J] : 0.f; impw[i16 * 128 + J] = prevv + impA[kt] + add; }
            carryB = impB[3];
        }
    }
}

template <int QG, int MODE>
__device__ __forceinline__ void flash_run(LAS unsigned char* lds, const Src S, const int ntiles, const bf16x8 (&qf)[QG][2], f32x4 (&o)[QG][4], float (&m)[QG], float (&l)[QG],
                                          const int qc, const int qcw_min, const int qcw_max, const int maxrel, const LAS unsigned* selp, const LAS unsigned* wunp,
                                          const float (&invl)[QG], LAS float* impw, const bool imp_acc, const int lutslot, const int lane, const int tid) {
    const LAS int* tl = (const LAS int*)(lds + L_TL);
    const LAS float* lut = (const LAS float*)(lds + L_LUT) + lutslot * LUTN;
    const int srow = tid >> 3, sch = tid & 7;
    u32x4 kr0 = {0, 0, 0, 0}, vr0 = {0, 0, 0, 0}, kr1 = {0, 0, 0, 0}, vr1 = {0, 0, 0, 0};
    float carryB = 0.f;
#define FL_ISSUE(i, KR, VR) do { int c_ = __builtin_amdgcn_readfirstlane(tl[2 * (i)]) + srow; c_ = c_ < 0 ? 0 : c_; const size_t off_ = (size_t)(c_ * S.dil + S.roff) * S.stride + sch * 8; \
        KR = *(const u32x4*)(S.kb + off_); if (!(MODE & 2)) VR = *(const u32x4*)(S.vb + off_); } while (0)
#define FL_COMMIT(b, KR, VR) do { *(LAS u32x4*)(lds + ((b) ? L_K1 : L_K0) + srow * KP + sch * 16) = KR; if (!(MODE & 2)) *(LAS u32x4*)(lds + ((b) ? L_V1 : L_V0) + srow * KP + sch * 16) = VR; } while (0)
#define FL_TILE(i, b) flash_tile<QG, MODE>(lds, b, __builtin_amdgcn_readfirstlane(tl[2 * (i)]), __builtin_amdgcn_readfirstlane(tl[2 * (i) + 1]), S.dil, qf, o, m, l, qc, qcw_min, qcw_max, maxrel, selp, wunp, invl, impw, imp_acc, lut, carryB, lane)
    LDS_BARRIER();
    if (ntiles > 0) { FL_ISSUE(0, kr0, vr0); if (ntiles > 1) FL_ISSUE(1, kr1, vr1); FL_COMMIT(0, kr0, vr0); }
    LDS_BARRIER();
    for (int i = 0; i < ntiles; i += 2) {
        if (i + 2 < ntiles) FL_ISSUE(i + 2, kr0, vr0);
        FL_TILE(i, 0);
        if (i + 1 < ntiles) FL_COMMIT(1, kr1, vr1);
        LDS_BARRIER();
        if (i + 1 >= ntiles) break;
        if (i + 3 < ntiles) FL_ISSUE(i + 3, kr1, vr1);
        FL_TILE(i + 1, 1);
        if (i + 2 < ntiles) FL_COMMIT(0, kr0, vr0);
        LDS_BARRIER();
    }
#undef FL_ISSUE
#undef FL_COMMIT
#undef FL_TILE
}

template <int QG> __device__ __forceinline__ void flash_init(f32x4 (&o)[QG][4], float (&m)[QG], float (&l)[QG]) {
#pragma unroll
    for (int q = 0; q < QG; ++q) { m[q] = -1e30f; l[q] = 0.f;
#pragma unroll
        for (int d = 0; d < 4; ++d) o[q][d] = (f32x4){0.f, 0.f, 0.f, 0.f}; }
}
template <int NH>
__device__ __forceinline__ void load_lut(LAS unsigned char* lds, const float* glut, int head0, int tid) {
    LAS float* lut = (LAS float*)(lds + L_LUT); const float* src = glut + (size_t)head0 * LUTN;
    float v[NH * 3];
#pragma unroll
    for (int i = 0; i < NH * 3; ++i) v[i] = src[tid + NTHREADS * i];
    __builtin_amdgcn_sched_barrier(0);
#pragma unroll
    for (int i = 0; i < NH * 3; ++i) lut[tid + NTHREADS * i] = v[i];
}
__device__ __forceinline__ int next_unit(unsigned* ctr, LAS unsigned char* lds, int tid) {
    LAS int* slot = (LAS int*)(lds + L_MISC);
    __syncthreads();
    if (tid == 0) *slot = (int)atomicAdd(ctr, 1u);
    __syncthreads();
    return *slot;
}

__device__ __forceinline__ void unit_mixA(const Params& P, LAS unsigned char* lds, int uid, int tid, int lane, int wave) {
    unsigned char* ws = P.ws; const bf16_t* proj = (const bf16_t*)(ws + WS_PROJ);
    const int b = uid / 768; int rem = uid % 768; const int gi = rem / 256; rem %= 256; const int hs = rem / 64, idx = rem % 64;
    const int d = gi == 0 ? 1 : (gi == 1 ? 4 : 16); const int rc = idx % d, nb = idx / d;
    const int g = lane >> 4, i16 = lane & 15;
    load_lut<1>(lds, (const float*)(ws + WS_GLUT), gi * 4 + hs, tid);
    const int ntiles = nb == 0 ? 2 : 4;
    if (tid < 4) { LAS int* tl = (LAS int*)(lds + L_TL); const int i = tid + (nb == 0 ? 2 : 0); if (i < 4) { tl[2 * tid] = nb * 128 - 128 + 64 * i; tl[2 * tid + 1] = -1; } }
    const int qi = nb * 128 + 16 * wave + i16; const int tok = qi * d + rc; const size_t row = (size_t)b * SEQ + tok;
    const int colq = A_OFF + gi * 768 + hs * 64;
    bf16x8 qf[1][2];
#pragma unroll
    for (int ks = 0; ks < 2; ++ks) qf[0][ks] = *(const bf16x8*)(proj + row * INP + colq + ks * 32 + g * 8);
    f32x4 o[1][4]; float m[1], l[1]; flash_init<1>(o, m, l);
    const float il[1] = {0.f};
    Src S{proj + (size_t)b * SEQ * INP + colq + 256, proj + (size_t)b * SEQ * INP + colq + 512, INP, d, rc};
    flash_run<1, 1>(lds, S, ntiles, qf, o, m, l, qi, nb * 128 + 16 * wave, nb * 128 + 16 * wave + 15, 128, nullptr, nullptr, il, nullptr, false, 0, lane, tid);
    const float inv = l[0] > 0.f ? 1.f / l[0] : 0.f;
    bf16_t* O = (bf16_t*)(ws + WS_O) + row * 2048 + gi * 256 + hs * 64;
#pragma unroll
    for (int dt = 0; dt < 4; ++dt) { u32x2 w; w.x = cvtpk(o[0][dt][0] * inv, o[0][dt][1] * inv); w.y = cvtpk(o[0][dt][2] * inv, o[0][dt][3] * inv); *(u32x2*)(O + 16 * dt + 4 * g) = w; }
    if (g == 0) ((float*)(ws + WS_LSE))[row * 12 + gi * 4 + hs] = (m[0] + __log2f(fmaxf(l[0], 1e-30f))) * LN2;
}

__device__ __forceinline__ void unit_moba(const Params& P, LAS unsigned char* lds, int b, int h, int c, int tid, int lane, int wave) {
    unsigned char* ws = P.ws; const bf16_t* proj = (const bf16_t*)(ws + WS_PROJ);
    const int g = lane >> 4, i16 = lane & 15;
    const int t0 = c * 128, ob = t0 >> 8;
    load_lut<1>(lds, (const float*)(ws + WS_GLUT), 12 + h, tid);
    LAS float* km = (LAS float*)(lds + L_IMP);
    LAS unsigned char* qS = lds + L_IMP + 8192;
    { const float* src = (const float*)(ws + WS_KMEAN) + (size_t)(b * 8 + h) * 2048; float kv4[4]; u32x4 qv[2];
#pragma unroll
      for (int i = 0; i < 4; ++i) kv4[i] = src[tid + NTHREADS * i];
#pragma unroll
      for (int i = 0; i < 2; ++i) { const int e = tid + NTHREADS * i; qv[i] = *(const u32x4*)(proj + ((size_t)b * SEQ + t0 + (e >> 3)) * INP + B_OFF + h * 64 + (e & 7) * 8); }
      __builtin_amdgcn_sched_barrier(0);
#pragma unroll
      for (int i = 0; i < 4; ++i) km[tid + NTHREADS * i] = kv4[i];
#pragma unroll
      for (int i = 0; i < 2; ++i) { const int e = tid + NTHREADS * i; *(LAS u32x4*)(qS + (e >> 3) * 128 + (e & 7) * 16) = qv[i]; } }
    LAS unsigned* misc = (LAS unsigned*)(lds + L_MISC);
    if (tid == 0) misc[1] = 0u;
    __syncthreads();
    const int tok = t0 + 16 * wave + i16; const size_t row = (size_t)b * SEQ + tok;
    const int colq = B_OFF + h * 64;
    bf16x8 qf[1][2];
#pragma unroll
    for (int ks = 0; ks < 2; ++ks) qf[0][ks] = *(const bf16x8*)(proj + row * INP + colq + ks * 32 + g * 8);
    unsigned sel = 0u;
    if (ob > 0) {
        float gt[8];
#pragma unroll
        for (int k = 0; k < 8; ++k) gt[k] = 0.f;
#pragma unroll 1
        for (int dc = 0; dc < 8; ++dc) { const u32x4 qw = *(const LAS u32x4*)(qS + (16 * wave + i16) * 128 + dc * 16);
            const float q0 = bflo(qw.x), q1 = bfhi(qw.x), q2 = bflo(qw.y), q3 = bfhi(qw.y), q4 = bflo(qw.z), q5 = bfhi(qw.z), q6 = bflo(qw.w), q7 = bfhi(qw.w);
#pragma unroll
            for (int k = 0; k < 8; ++k) { const LAS f32x4* kr = (const LAS f32x4*)(km + (8 * g + k) * 64 + dc * 8); const f32x4 a = kr[0], bq = kr[1];
                gt[k] += (q0 * a[0] + q1 * a[1]) + (q2 * a[2] + q3 * a[3]) + (q4 * bq[0] + q5 * bq[1]) + (q6 * bq[2] + q7 * bq[3]); } }
#pragma unroll
        for (int k = 0; k < 8; ++k) if (8 * g + k >= ob) gt[k] = -INFINITY;
#pragma unroll
        for (int it = 0; it < 3; ++it) {
            float best = -INFINITY; int bi = 99;
#pragma unroll
            for (int k = 0; k < 8; ++k) if (gt[k] > best) { best = gt[k]; bi = 8 * g + k; }
#pragma unroll
            for (int off = 16; off <= 32; off <<= 1) { const float ob_ = __shfl_xor(best, off); const int oi = __shfl_xor(bi, off); if (ob_ > best || (ob_ == best && oi < bi)) { best = ob_; bi = oi; } }
            if (bi < 32) { sel |= 1u << bi;
#pragma unroll
                for (int k = 0; k < 8; ++k) if (8 * g + k == bi) gt[k] = -INFINITY; }
        }
    }
    unsigned wu = sel;
#pragma unroll
    for (int off = 1; off < 16; off <<= 1) wu |= (unsigned)__shfl_xor((int)wu, off);
    wu = (unsigned)__builtin_amdgcn_readfirstlane((int)wu);
    LAS unsigned* selS = (LAS unsigned*)(lds + L_SEL); LAS unsigned* wunS = (LAS unsigned*)(lds + L_WUN) + wave * 4;
    if (g == 0) selS[(16 * wave + i16) * 4] = sel;
    if (lane == 0) wunS[0] = wu;
    __syncthreads();
    unsigned um = 0u;
#pragma unroll
    for (int w8 = 0; w8 < 8; ++w8) um |= ((const LAS unsigned*)(lds + L_WUN))[w8 * 4];
    if (tid == 0) { LAS int* tl = (LAS int*)(lds + L_TL); int n = 0;
        for (int blk = 0; blk < ob; ++blk) if ((um >> blk) & 1u) for (int s4 = 0; s4 < 4; ++s4) { tl[2 * n] = blk * 256 + 64 * s4; tl[2 * n + 1] = blk; ++n; }
        for (int k0 = ob * 256; k0 < t0 + 128; k0 += 64) { tl[2 * n] = k0; tl[2 * n + 1] = -1; ++n; }
        misc[2] = (unsigned)n; }
    __syncthreads();
    const int ntiles = (int)misc[2];
    f32x4 o[1][4]; float m[1], l[1]; flash_init<1>(o, m, l);
    const float il[1] = {0.f};
    Src S{proj + (size_t)b * SEQ * INP + colq + 512, proj + (size_t)b * SEQ * INP + colq + 1024, INP, 1, 0};
    flash_run<1, 1>(lds, S, ntiles, qf, o, m, l, tok, t0 + 16 * wave, t0 + 16 * wave + 15, 0x7fffffff, selS + (16 * wave + i16) * 4, wunS, il, nullptr, false, 0, lane, tid);
    const float inv = l[0] > 0.f ? 1.f / l[0] : 0.f;
    bf16_t* O = (bf16_t*)(ws + WS_O) + row * 2048 + 768 + h * 64;
#pragma unroll
    for (int dt = 0; dt < 4; ++dt) { u32x2 w; w.x = cvtpk(o[0][dt][0] * inv, o[0][dt][1] * inv); w.y = cvtpk(o[0][dt][2] * inv, o[0][dt][3] * inv); *(u32x2*)(O + 16 * dt + 4 * g) = w; }
}

__device__ __forceinline__ float sigmoidf_(float x) { return 1.f / (1.f + __expf(-x)); }
#ifndef NSA_QG
#define NSA_QG 2
#endif
__device__ __forceinline__ void unit_nsa(const Params& P, LAS unsigned char* lds, int b, int kv, int c, int tid, int lane, int wave) {
    unsigned char* ws = P.ws; const bf16_t* proj = (const bf16_t*)(ws + WS_PROJ);
    const int g = lane >> 4, i16 = lane & 15;
    const int t0 = c * 128;
    const int tok = t0 + 16 * wave + i16; const size_t row = (size_t)b * SEQ + tok;
    load_lut<4>(lds, (const float*)(ws + WS_GLUT), 20 + kv * 4, tid);
    LAS int* tl = (LAS int*)(lds + L_TL);
    LAS unsigned* misc = (LAS unsigned*)(lds + L_MISC);
    LAS unsigned* selS = (LAS unsigned*)(lds + L_SEL);
    LAS float* impw = (LAS float*)(lds + L_IMP) + wave * 2048;
    const int ntc = ((t0 + 96) >> 4) / 64 + 1;
    if (tid < ntc) { tl[2 * tid] = 64 * tid; tl[2 * tid + 1] = -1; }
    if (tid < 4) misc[4 + tid] = 0u;
    LAS unsigned* wunS = (LAS unsigned*)(lds + L_WUN) + wave * 4;
    float* tot = (float*)(ws + WS_TOT) + row * 768 + (kv * 4) * 64;
    const bf16_t* gatep = proj + row * INP + CG_OFF + (kv * 4) * 3;
    const int qcc = (tok - 31) >> 4;
    const int qcw0 = (t0 + 16 * wave - 31) >> 4, qcw1 = (t0 + 16 * wave + 15 - 31) >> 4;
#pragma unroll 1
    for (int hp = 0; hp < 4 / NSA_QG; ++hp) {
        bf16x8 qf[NSA_QG][2];
#pragma unroll
        for (int q = 0; q < NSA_QG; ++q)
#pragma unroll
            for (int ks = 0; ks < 2; ++ks) qf[q][ks] = *(const bf16x8*)(proj + row * INP + CQ_OFF + (kv * 4 + hp * NSA_QG + q) * 64 + ks * 32 + g * 8);
        f32x4 o[NSA_QG][4]; float m[NSA_QG], l[NSA_QG]; flash_init<NSA_QG>(o, m, l);
        float il[NSA_QG]; for (int q_ = 0; q_ < NSA_QG; ++q_) il[q_] = 0.f;
#ifdef NSA_CMP_FAKEKV
        Src S{proj + (size_t)b * SEQ * INP + CKV_OFF + 4 * 192 + kv * 64, proj + (size_t)b * SEQ * INP + CKV_OFF + 5 * 192 + kv * 64, INP, 1, 0};
#else
        Src S{(const bf16_t*)(ws + WS_KC) + (size_t)(b * 3 + kv) * 512 * 64, (const bf16_t*)(ws + WS_VC) + (size_t)(b * 3 + kv) * 512 * 64, 64, 1, 0};
#endif
#ifdef NSA_CMP_SINGLE
        flash_run<NSA_QG, 0>(lds, S, ntc, qf, o, m, l, qcc, qcw0, qcw1, 0x7fffffff, nullptr, nullptr, il, nullptr, false, 0, lane, tid);
#pragma unroll
        for (int q = 0; q < NSA_QG; ++q) il[q] = l[q] > 0.f ? 1.f / l[q] : 0.f;
        (void)impw;
#elif !defined(NSA_NO_CMP)
        flash_run<NSA_QG, 2>(lds, S, ntc, qf, o, m, l, qcc, qcw0, qcw1, 0x7fffffff, nullptr, nullptr, il, nullptr, false, 0, lane, tid);
#pragma unroll
        for (int q = 0; q < NSA_QG; ++q) { il[q] = l[q] > 0.f ? 1.f / l[q] : 0.f; l[q] = 0.f; }
        flash_run<NSA_QG, 4>(lds, S, ntc, qf, o, m, l, qcc, qcw0, qcw1, 0x7fffffff, nullptr, nullptr, il, impw, hp != 0, 0, lane, tid);
#else
        (void)S; (void)impw;
#endif
#pragma unroll
        for (int q = 0; q < NSA_QG; ++q) { const float gt = sigmoidf_(bf2f(gatep[(hp * NSA_QG + q) * 3 + 0])); const float sc = il[q] * gt;
#pragma unroll
            for (int dt = 0; dt < 4; ++dt) *(f32x4*)(tot + (hp * NSA_QG + q) * 64 + 16 * dt + 4 * g) = o[q][dt] * sc; }
    }
#ifndef NSA_NO_TOPK
    lds_wait();
    unsigned wun0 = 0u, wun1 = 0u, wun2 = 0u, wun3 = 0u;
#pragma unroll 1
    for (int q = 0; q < 16; ++q) {
        const int t = t0 + 16 * wave + q, own = t >> 6;
        const int ncand = own - 2 > 0 ? own - 2 : 0; const int nforced = own >= 2 ? 3 : own + 1; const int K = 16 - nforced;
        const int j0 = lane, j1 = lane + 64;
        const bool c0 = (j0 >= 1) && (j0 <= own - 2), c1 = (j1 <= own - 2);
        const unsigned k0 = c0 ? (__float_as_uint(impw[q * 128 + j0]) + 1u) : 0u, k1 = c1 ? (__float_as_uint(impw[q * 128 + j1]) + 1u) : 0u;
        bool s0 = c0, s1 = c1;
        if (ncand > K) {
            unsigned T = 0u;
            for (int bit = 31; bit >= 0; --bit) { const unsigned Tn = T | (1u << bit);
                const int cnt = __popcll(__ballot(k0 >= Tn)) + __popcll(__ballot(k1 >= Tn)); if (cnt >= K) T = Tn; }
            const bool g0 = k0 > T, g1 = k1 > T; const int ng = __popcll(__ballot(g0)) + __popcll(__ballot(g1)); const int need = K - ng;
            const unsigned long long e0 = __ballot(k0 == T), e1 = __ballot(k1 == T); const unsigned long long lt = (1ull << lane) - 1ull;
            const int r0 = __popcll(e0 & lt), r1 = __popcll(e0) + __popcll(e1 & lt);
            s0 = g0 || (k0 == T && r0 < need); s1 = g1 || (k1 == T && r1 < need);
        }
        s0 = s0 || (j0 == 0) || (j0 == own) || (j0 == own - 1); s1 = s1 || (j1 == own) || (j1 == own - 1);
        const unsigned long long m0 = __ballot(s0), m1 = __ballot(s1);
        const unsigned w0 = (unsigned)m0, w1 = (unsigned)(m0 >> 32), w2 = (unsigned)m1, w3 = (unsigned)(m1 >> 32);
        if (lane == 0) { selS[(16 * wave + q) * 4 + 0] = w0; selS[(16 * wave + q) * 4 + 1] = w1; selS[(16 * wave + q) * 4 + 2] = w2; selS[(16 * wave + q) * 4 + 3] = w3; }
        wun0 |= w0; wun1 |= w1; wun2 |= w2; wun3 |= w3;
    }
    if (lane == 0) { wunS[0] = wun0; wunS[1] = wun1; wunS[2] = wun2; wunS[3] = wun3; }
    __syncthreads();
    if (tid < 4) { unsigned u_ = 0u; for (int w8 = 0; w8 < 8; ++w8) u_ |= ((const LAS unsigned*)(lds + L_WUN))[w8 * 4 + tid]; misc[4 + tid] = u_; }
    __syncthreads();
    const LAS unsigned* selp = selS + (16 * wave + i16) * 4;
    const int ownmax = (t0 + 127) >> 6;
    if (tid == 0) { int n = 0; for (int j = 0; j <= ownmax; ++j) if ((misc[4 + (j >> 5)] >> (j & 31)) & 1u) { tl[2 * n] = 64 * j; tl[2 * n + 1] = j; ++n; } misc[2] = (unsigned)n; }
    __syncthreads();
    const int nts = (int)misc[2];
#else
    const int ownmax = (t0 + 127) >> 6; const int nts = 0; const LAS unsigned* selp = nullptr; (void)selS; (void)wunS;
#endif
    const int kfirst = t0 - 512 > 0 ? t0 - 512 : 0; const int ntw = (t0 + 128 - kfirst) / 64;
#ifdef NSA_PACK4
    __syncthreads();
    if (tid == 0) { int n = 0; for (int j = 0; j <= ownmax; ++j) if ((misc[4 + (j >> 5)] >> (j & 31)) & 1u) { tl[2 * n] = 64 * j; tl[2 * n + 1] = j; ++n; } }
#pragma unroll 1
    for (int ps = 0; ps < 4; ++ps) {
        const int tli = 32 * ps + 4 * wave + (i16 >> 2), hd = i16 & 3;
        const int tokp = t0 + tli; const size_t rowp = (size_t)b * SEQ + tokp;
        bf16x8 qf[1][2];
#pragma unroll
        for (int ks = 0; ks < 2; ++ks) qf[0][ks] = *(const bf16x8*)(proj + rowp * INP + CQ_OFF + (kv * 4 + hd) * 64 + ks * 32 + g * 8);
        if (lane < 4) { unsigned w_ = 0u;
#pragma unroll
            for (int k = 0; k < 4; ++k) w_ |= selS[(32 * ps + 4 * wave + k) * 4 + lane];
            wunS[lane] = w_; }
        lds_wait();
        f32x4 o[1][4]; float m[1], l[1]; flash_init<1>(o, m, l);
        const float il[1] = {0.f};
        Src S{proj + (size_t)b * SEQ * INP + CKV_OFF + 2 * 192 + kv * 64, proj + (size_t)b * SEQ * INP + CKV_OFF + 3 * 192 + kv * 64, INP, 1, 0};
        flash_run<1, 1>(lds, S, nts, qf, o, m, l, tokp, t0 + 32 * ps + 4 * wave, t0 + 32 * ps + 4 * wave + 3, 0x7fffffff, selS + tli * 4, wunS, il, nullptr, false, hd, lane, tid);
        const float gt = sigmoidf_(bf2f(proj[rowp * INP + CG_OFF + (kv * 4 + hd) * 3 + 1])); const float sc = (l[0] > 0.f ? 1.f / l[0] : 0.f) * gt;
        float* tp0 = (float*)(ws + WS_TOT) + rowp * 768 + (kv * 4 + hd) * 64;
#pragma unroll
        for (int dt = 0; dt < 4; ++dt) { float* tp = tp0 + 16 * dt + 4 * g; *(f32x4*)tp = *(const f32x4*)tp + o[0][dt] * sc; }
    }
    __syncthreads();
#pragma unroll 1
    for (int hp = 0; hp < 2; ++hp) {
        bf16x8 qf[2][2];
#pragma unroll
        for (int q = 0; q < 2; ++q)
#pragma unroll
            for (int ks = 0; ks < 2; ++ks) qf[q][ks] = *(const bf16x8*)(proj + row * INP + CQ_OFF + (kv * 4 + hp * 2 + q) * 64 + ks * 32 + g * 8);
        f32x4 o[2][4]; float m[2], l[2];
        float il[2] = {0.f, 0.f};
        __syncthreads();
        if (tid < ntw) { tl[2 * tid] = kfirst + 64 * tid; tl[2 * tid + 1] = -1; }
        flash_init<2>(o, m, l);
        Src S{proj + (size_t)b * SEQ * INP + CKV_OFF + 4 * 192 + kv * 64, proj + (size_t)b * SEQ * INP + CKV_OFF + 5 * 192 + kv * 64, INP, 1, 0};
        flash_run<2, 1>(lds, S, ntw, qf, o, m, l, tok, t0 + 16 * wave, t0 + 16 * wave + 15, 511, nullptr, nullptr, il, nullptr, false, hp * 2, lane, tid);
        bf16_t* O = (bf16_t*)(ws + WS_O) + row * 2048 + 1280 + (kv * 4) * 64;
#pragma unroll
        for (int q = 0; q < 2; ++q) { const float gt = sigmoidf_(bf2f(gatep[(hp * 2 + q) * 3 + 2])); const float sc = (l[q] > 0.f ? 1.f / l[q] : 0.f) * gt;
#pragma unroll
            for (int dt = 0; dt < 4; ++dt) { const f32x4 v = *(const f32x4*)(tot + (hp * 2 + q) * 64 + 16 * dt + 4 * g) + o[q][dt] * sc;
                u32x2 w; w.x = cvtpk(v[0], v[1]); w.y = cvtpk(v[2], v[3]); *(u32x2*)(O + (hp * 2 + q) * 64 + 16 * dt + 4 * g) = w; } }
    }
}
#else
#pragma unroll 1
    for (int hp = 0; hp < 4 / NSA_QG; ++hp) {
        bf16x8 qf[NSA_QG][2];
#pragma unroll
        for (int q = 0; q < NSA_QG; ++q)
#pragma unroll
            for (int ks = 0; ks < 2; ++ks) qf[q][ks] = *(const bf16x8*)(proj + row * INP + CQ_OFF + (kv * 4 + hp * NSA_QG + q) * 64 + ks * 32 + g * 8);
        f32x4 o[NSA_QG][4]; float m[NSA_QG], l[NSA_QG];
        float il[NSA_QG]; for (int q_ = 0; q_ < NSA_QG; ++q_) il[q_] = 0.f;
        __syncthreads();
        if (tid == 0) { int n = 0; for (int j = 0; j <= ownmax; ++j) if ((misc[4 + (j >> 5)] >> (j & 31)) & 1u) { tl[2 * n] = 64 * j; tl[2 * n + 1] = j; ++n; } }
#ifndef NSA_NO_SLC
        { flash_init<NSA_QG>(o, m, l);
          Src S{proj + (size_t)b * SEQ * INP + CKV_OFF + 2 * 192 + kv * 64, proj + (size_t)b * SEQ * INP + CKV_OFF + 3 * 192 + kv * 64, INP, 1, 0};
          flash_run<NSA_QG, 1>(lds, S, nts, qf, o, m, l, tok, t0 + 16 * wave, t0 + 16 * wave + 15, 0x7fffffff, selp, wunS, il, nullptr, false, hp * NSA_QG, lane, tid);
#pragma unroll
          for (int q = 0; q < NSA_QG; ++q) { const float gt = sigmoidf_(bf2f(gatep[(hp * NSA_QG + q) * 3 + 1])); const float sc = (l[q] > 0.f ? 1.f / l[q] : 0.f) * gt;
#pragma unroll
              for (int dt = 0; dt < 4; ++dt) { float* tp = tot + (hp * NSA_QG + q) * 64 + 16 * dt + 4 * g; *(f32x4*)tp = *(const f32x4*)tp + o[q][dt] * sc; } }
        }
#endif
        if (tid < ntw) { tl[2 * tid] = kfirst + 64 * tid; tl[2 * tid + 1] = -1; }
        { flash_init<NSA_QG>(o, m, l);
          Src S{proj + (size_t)b * SEQ * INP + CKV_OFF + 4 * 192 + kv * 64, proj + (size_t)b * SEQ * INP + CKV_OFF + 5 * 192 + kv * 64, INP, 1, 0};
#ifndef NSA_NO_WIN
          flash_run<NSA_QG, 1>(lds, S, ntw, qf, o, m, l, tok, t0 + 16 * wave, t0 + 16 * wave + 15, 511, nullptr, nullptr, il, nullptr, false, hp * NSA_QG, lane, tid);
#else
          (void)S;
#endif
          bf16_t* O = (bf16_t*)(ws + WS_O) + row * 2048 + 1280 + (kv * 4) * 64;
#pragma unroll
          for (int q = 0; q < NSA_QG; ++q) { const float gt = sigmoidf_(bf2f(gatep[(hp * NSA_QG + q) * 3 + 2])); const float sc = (l[q] > 0.f ? 1.f / l[q] : 0.f) * gt;
#pragma unroll
              for (int dt = 0; dt < 4; ++dt) { const f32x4 v = *(const f32x4*)(tot + (hp * NSA_QG + q) * 64 + 16 * dt + 4 * g) + o[q][dt] * sc;
                  u32x2 w; w.x = cvtpk(v[0], v[1]); w.y = cvtpk(v[2], v[3]); *(u32x2*)(O + (hp * NSA_QG + q) * 64 + 16 * dt + 4 * g) = w; } }
        }
    }
}

#endif

__device__ __forceinline__ float gelu_tanh(float x) { const float u = 0.7978845608028654f * (x + 0.044715f * x * x * x); const float e = __expf(2.f * u); const float th = 1.f - 2.f / (1.f + e); return 0.5f * x * (1.f + th); }
__device__ __forceinline__ void item_compress(const Params& P, int layer, int it, int lane) {
    unsigned char* ws = P.ws; const bf16_t* proj = (const bf16_t*)(ws + WS_PROJ);
    const int nt = it & 31; int r = it >> 5; const int which = r & 1; r >>= 1; const int kv = r % 3, b = r / 3;
    const int g = lane >> 4, i16 = lane & 15;
    int n = 16 * nt + i16; const int nld = n > 510 ? 510 : n;
    const bf16_t* w1t = (const bf16_t*)(ws + WS_W1T) + (size_t)(layer * 2 + which) * 128 * 2048;
    const bf16_t* w2t = (const bf16_t*)(ws + WS_W2T) + (size_t)(layer * 2 + which) * 64 * 128;
    const float* cpe = (const float*)(ws + WS_CPE) + (layer * 2 + which) * 128;
    const bf16_t* src = proj + ((size_t)b * SEQ + 16 * nld) * INP + CKV_OFF + which * 192 + kv * 64 + 8 * g;
    f32x4 acc[8];
#pragma unroll
    for (int h = 0; h < 8; ++h) acc[h] = (f32x4){0.f, 0.f, 0.f, 0.f};
    const bf16_t* w1l = w1t + (size_t)i16 * 2048 + 8 * g;
#pragma unroll 1
    for (int ks = 0; ks < 64; ks += 4) {
        bf16x8 bq[4], af[4][8];
#pragma unroll
        for (int u = 0; u < 4; ++u) { bq[u] = *(const bf16x8*)(src + (size_t)((ks + u) >> 1) * INP + (u & 1) * 32);
#pragma unroll
            for (int h = 0; h < 8; ++h) af[u][h] = *(const bf16x8*)(w1l + (size_t)(16 * h) * 2048 + 32 * (ks + u)); }
        __builtin_amdgcn_sched_barrier(0);
#pragma unroll
        for (int u = 0; u < 4; ++u)
#pragma unroll
            for (int h = 0; h < 8; ++h) acc[h] = mfma16(af[u][h], bq[u], acc[h]);
    }
    bf16x8 pf[4];
#pragma unroll
    for (int s = 0; s < 4; ++s) { float hv[8];
#pragma unroll
        for (int r2 = 0; r2 < 4; ++r2) { hv[r2] = gelu_tanh(acc[2 * s][r2] + cpe[32 * s + 4 * g + r2]); hv[4 + r2] = gelu_tanh(acc[2 * s + 1][r2] + cpe[32 * s + 16 + 4 * g + r2]); }
        u32x4 w; w.x = cvtpk(hv[0], hv[1]); w.y = cvtpk(hv[2], hv[3]); w.z = cvtpk(hv[4], hv[5]); w.w = cvtpk(hv[6], hv[7]); pf[s] = __builtin_bit_cast(bf16x8, w); }
    bf16_t* dst = (bf16_t*)(ws + (which ? WS_VC : WS_KC)) + ((size_t)(b * 3 + kv) * 512 + n) * 64;
#pragma unroll
    for (int et = 0; et < 4; ++et) { f32x4 oc = {0.f, 0.f, 0.f, 0.f};
#pragma unroll
        for (int s = 0; s < 4; ++s) { const bf16_t* wp = w2t + (size_t)(16 * et + i16) * 128 + 32 * s + 4 * g; const u32x2 lo = *(const u32x2*)wp, hi = *(const u32x2*)(wp + 16);
            u32x4 w; w.x = lo.x; w.y = lo.y; w.z = hi.x; w.w = hi.y; oc = mfma16(__builtin_bit_cast(bf16x8, w), pf[s], oc); }
#ifdef PROBE_CLAMP
#pragma unroll
        for (int r2 = 0; r2 < 4; ++r2) oc[r2] = fminf(fmaxf(oc[r2], -100.f), 100.f);
#endif
        u32x2 w; w.x = cvtpk(oc[0], oc[1]); w.y = cvtpk(oc[2], oc[3]); *(u32x2*)(dst + 16 * et + 4 * g) = w; }
}
__device__ __forceinline__ void item_kmean(const Params& P, int it, int lane) {
    unsigned char* ws = P.ws; const bf16_t* proj = (const bf16_t*)(ws + WS_PROJ);
    const int blk = it & 31, h = (it >> 5) & 7, b = it >> 8;
    const int rg = lane >> 3, dch = lane & 7;
    const bf16_t* src = proj + ((size_t)b * SEQ + blk * 256 + rg) * INP + B_OFF + 512 + h * 64 + dch * 8;
    u32x4 v[32];
#pragma unroll
    for (int i = 0; i < 32; ++i) v[i] = *(const u32x4*)(src + (size_t)(8 * i) * INP);
    __builtin_amdgcn_sched_barrier(0);
    float sm[8];
#pragma unroll
    for (int e = 0; e < 8; ++e) sm[e] = 0.f;
#pragma unroll
    for (int i = 0; i < 32; ++i)
#pragma unroll
        for (int w = 0; w < 4; ++w) { sm[2 * w] += bflo(v[i][w]); sm[2 * w + 1] += bfhi(v[i][w]); }
#pragma unroll
    for (int e = 0; e < 8; ++e) { sm[e] += __shfl_xor(sm[e], 8); sm[e] += __shfl_xor(sm[e], 16); sm[e] += __shfl_xor(sm[e], 32); }
    if (rg == 0) { float* dst = (float*)(ws + WS_KMEAN) + (size_t)it * 64 + dch * 8;
        *(f32x4*)dst = (f32x4){sm[0], sm[1], sm[2], sm[3]} * (1.f / 256.f); *(f32x4*)(dst + 4) = (f32x4){sm[4], sm[5], sm[6], sm[7]} * (1.f / 256.f); }
}
__device__ __forceinline__ void item_combineA4(const Params& P, int row0, int rstride, int lane) {
    unsigned char* ws = P.ws;
    float a0[4][3], a1[4][3], a2[4][3]; u32x2 w[4][3];
#pragma unroll
    for (int k = 0; k < 4; ++k) { const int rowu = row0 + k * rstride; const int row = rowu < MROWS ? rowu : MROWS - 1; const float* lse = (const float*)(ws + WS_LSE) + (size_t)row * 12; const bf16_t* O = (const bf16_t*)(ws + WS_O) + (size_t)row * 2048;
#pragma unroll
        for (int c = 0; c < 3; ++c) { const int col = 4 * (lane + 64 * c); const int hs = (col >> 6) & 3; a0[k][c] = lse[hs]; a1[k][c] = lse[4 + hs]; a2[k][c] = lse[8 + hs]; w[k][c] = *(const u32x2*)(O + col); } }
    __builtin_amdgcn_sched_barrier(0);
#pragma unroll
    for (int k = 0; k < 4; ++k) { const int row = row0 + k * rstride; if (row >= MROWS) break; bf16_t* O = (bf16_t*)(ws + WS_O) + (size_t)row * 2048;
#pragma unroll
        for (int c = 0; c < 3; ++c) { const int col = 4 * (lane + 64 * c); const int gi = col >> 8;
            const float mx = fmaxf(a0[k][c], fmaxf(a1[k][c], a2[k][c]));
            const float e0 = __expf(a0[k][c] - mx), e1 = __expf(a1[k][c] - mx), e2 = __expf(a2[k][c] - mx); const float al = (gi == 0 ? e0 : (gi == 1 ? e1 : e2)) / (e0 + e1 + e2);
            u32x2 r; r.x = cvtpk(bflo(w[k][c].x) * al, bfhi(w[k][c].x) * al); r.y = cvtpk(bflo(w[k][c].y) * al, bfhi(w[k][c].y) * al); *(u32x2*)(O + col) = r; } }
}

__device__ __forceinline__ void phase_conv(const Params& P, int layer, int tid) {
    unsigned char* ws = P.ws; const bf16_t* U = (const bf16_t*)(ws + WS_U); bf16_t* ACT = (bf16_t*)(ws + WS_ACT);
    const float* cw = P.conv_w + (size_t)layer * 3 * UPW; const float* cb = P.conv_b + (size_t)layer * UPW;
    constexpr int NCH = DFF / 8, TB = 8, NTB = MROWS / TB;
    for (int it = blockIdx.x * NTHREADS + tid; it < NCH * NTB; it += gridDim.x * NTHREADS) {
        const int ch = it % NCH, tb = it / NCH; const int c = ch * 8; const int ua = 256 * (c >> 7) + (c & 127);
        const int row0 = tb * TB; const bool first = (row0 % SEQ) == 0;
        u32x4 pa[TB + 2], pg[TB + 2];
#pragma unroll
        for (int t = 0; t < TB + 2; ++t) { const int r = row0 - 2 + t; const size_t off = (size_t)(r < 0 ? 0 : r) * UPW + ua; pa[t] = *(const u32x4*)(U + off); pg[t] = *(const u32x4*)(U + off + 128); }
        f32x4 wa4[3][2], wg4[3][2], ba4[2], bg4[2];
#pragma unroll
        for (int j = 0; j < 3; ++j)
#pragma unroll
            for (int h = 0; h < 2; ++h) { wa4[j][h] = *(const f32x4*)(cw + (size_t)j * UPW + c + 4 * h); wg4[j][h] = *(const f32x4*)(cw + (size_t)j * UPW + DFF + c + 4 * h); }
#pragma unroll
        for (int h = 0; h < 2; ++h) { ba4[h] = *(const f32x4*)(cb + c + 4 * h); bg4[h] = *(const f32x4*)(cb + DFF + c + 4 * h); }
        __builtin_amdgcn_sched_barrier(0);
        if (first) { pa[0] = (u32x4){0, 0, 0, 0}; pa[1] = pa[0]; pg[0] = pa[0]; pg[1] = pa[0]; }
#pragma unroll
        for (int t = 0; t < TB; ++t) {
            float r[8];
#pragma unroll
            for (int e = 0; e < 8; ++e) { const int w_ = e >> 1; const int h = e >> 2, x = e & 3;
                const float a0 = (e & 1) ? bfhi(pa[t + 2][w_]) : bflo(pa[t + 2][w_]), a1 = (e & 1) ? bfhi(pa[t + 1][w_]) : bflo(pa[t + 1][w_]), a2 = (e & 1) ? bfhi(pa[t][w_]) : bflo(pa[t][w_]);
                const float g0 = (e & 1) ? bfhi(pg[t + 2][w_]) : bflo(pg[t + 2][w_]), g1 = (e & 1) ? bfhi(pg[t + 1][w_]) : bflo(pg[t + 1][w_]), g2 = (e & 1) ? bfhi(pg[t][w_]) : bflo(pg[t][w_]);
                const float ya = ba4[h][x] + wa4[0][h][x] * a0 + wa4[1][h][x] * a1 + wa4[2][h][x] * a2;
                const float yg = bg4[h][x] + wg4[0][h][x] * g0 + wg4[1][h][x] * g1 + wg4[2][h][x] * g2;
                r[e] = ya * yg / (1.f + __expf(-yg)); }
            u32x4 w; w.x = cvtpk(r[0], r[1]); w.y = cvtpk(r[2], r[3]); w.z = cvtpk(r[4], r[5]); w.w = cvtpk(r[6], r[7]);
            *(u32x4*)(ACT + (size_t)(row0 + t) * DFF + c) = w;
        }
    }
}

__device__ __forceinline__ void phase_convfix(const Params& P, int layer, int tid) {
    unsigned char* ws = P.ws; const bf16_t* UB = (const bf16_t*)(ws + WS_UB); bf16_t* ACT = (bf16_t*)(ws + WS_ACT);
    const float* cw = P.conv_w + (size_t)layer * 3 * UPW; const float* cb = P.conv_b + (size_t)layer * UPW;
    constexpr int NCH = DFF / 8, NS = MROWS / 64;
    for (int it = blockIdx.x * NTHREADS + tid; it < NCH * 2 * NS; it += gridDim.x * NTHREADS) {
        const int ch = it % NCH, lr = (it / NCH) & 1, sl = it / (2 * NCH); const int c = ch * 8; const int ua = 256 * (c >> 7) + (c & 127);
        const bool first = (sl % (SEQ / 64)) == 0;
        const int slp = sl > 0 ? sl - 1 : 0;
        const bf16_t* r0 = UB + ((size_t)sl * 4 + lr) * UPW + ua;
        const bf16_t* r1 = lr == 0 ? UB + ((size_t)slp * 4 + 3) * UPW + ua : UB + ((size_t)sl * 4 + 0) * UPW + ua;
        const bf16_t* r2 = lr == 0 ? UB + ((size_t)slp * 4 + 2) * UPW + ua : UB + ((size_t)slp * 4 + 3) * UPW + ua;
        u32x4 a0 = *(const u32x4*)r0, g0 = *(const u32x4*)(r0 + 128), a1 = *(const u32x4*)r1, g1 = *(const u32x4*)(r1 + 128), a2 = *(const u32x4*)r2, g2 = *(const u32x4*)(r2 + 128);
        const u32x4 z = {0, 0, 0, 0};
        if (first && lr == 0) { a1 = z; g1 = z; }
        if (first) { a2 = z; g2 = z; }
        f32x4 wa[3][2], wg[3][2], ba[2], bg[2];
#pragma unroll
        for (int h = 0; h < 2; ++h) { ba[h] = *(const f32x4*)(cb + c + 4 * h); bg[h] = *(const f32x4*)(cb + DFF + c + 4 * h);
#pragma unroll
            for (int j = 0; j < 3; ++j) { wa[j][h] = *(const f32x4*)(cw + (size_t)j * UPW + c + 4 * h); wg[j][h] = *(const f32x4*)(cw + (size_t)j * UPW + DFF + c + 4 * h); } }
        float r[8];
#pragma unroll
        for (int e = 0; e < 8; ++e) { const int w_ = e >> 1, h = e >> 2, x = e & 3;
            const float x0 = (e & 1) ? bfhi(a0[w_]) : bflo(a0[w_]), x1 = (e & 1) ? bfhi(a1[w_]) : bflo(a1[w_]), x2 = (e & 1) ? bfhi(a2[w_]) : bflo(a2[w_]);
            const float y0 = (e & 1) ? bfhi(g0[w_]) : bflo(g0[w_]), y1 = (e & 1) ? bfhi(g1[w_]) : bflo(g1[w_]), y2 = (e & 1) ? bfhi(g2[w_]) : bflo(g2[w_]);
            const float ya = ba[h][x] + wa[0][h][x] * x0 + wa[1][h][x] * x1 + wa[2][h][x] * x2;
            const float yg = bg[h][x] + wg[0][h][x] * y0 + wg[1][h][x] * y1 + wg[2][h][x] * y2;
            r[e] = ya * yg / (1.f + __expf(-yg)); }
        u32x4 w; w.x = cvtpk(r[0], r[1]); w.y = cvtpk(r[2], r[3]); w.z = cvtpk(r[4], r[5]); w.w = cvtpk(r[6], r[7]);
        *(u32x4*)(ACT + (size_t)(sl * 64 + lr) * DFF + c) = w;
    }
}

#define XB_TMO      128
#define XB_XCNT(j)  (256  + 64 * (j))
#define XB_XSUB(j)  (1280 + 64 * (j))
#define XB_XGEN(j)  (2304 + 64 * (j))
#define XB_TOP      3328
#define XB_TOPGEN   3392
#define XCD_BAR_WORDS 3456
#define XB_SPIN_CAP (1u << 27)

__device__ __forceinline__ unsigned xb_ld(unsigned* p)              { return __hip_atomic_load(p, __ATOMIC_RELAXED, __HIP_MEMORY_SCOPE_AGENT); }
__device__ __forceinline__ unsigned xb_add(unsigned* p, unsigned v) { return __hip_atomic_fetch_add(p, v, __ATOMIC_RELAXED, __HIP_MEMORY_SCOPE_AGENT); }
__device__ __forceinline__ unsigned xb_xcc_id() { return (unsigned)__builtin_amdgcn_s_getreg((3 << 11) | 20) & 0xFu; }
#define XB_SPIN(cond, bar) do { unsigned _sp = 0; while (cond) { __builtin_amdgcn_s_sleep(1); \
    if ((++_sp & 255u) == 0u) { if (xb_ld(&(bar)[XB_TMO])) break; if (_sp > XB_SPIN_CAP) { atomicAdd(&(bar)[XB_TMO], 1u); break; } } } } while (0)

struct XcdBarrier {
    unsigned* bar; unsigned x;
    volatile LAS unsigned* st;
};

__device__ __forceinline__ XcdBarrier xcd_barrier_post(unsigned* bar, volatile LAS unsigned* st) {
    XcdBarrier b; b.bar = bar; b.x = xb_xcc_id(); b.st = st;
    if (threadIdx.x == 0) (void)xb_add(&bar[XB_XCNT(b.x)], 1u);
    return b;
}
__device__ __forceinline__ void xcd_barrier_complete(unsigned* bar, unsigned x, unsigned& nloc, unsigned& nx) {
    const unsigned G = gridDim.x * gridDim.y * gridDim.z;
    unsigned sum, cnt, mine, sp = 0u;
    for (;;) {
        sum = 0u; cnt = 0u; mine = 0u;
#pragma unroll
        for (unsigned j = 0; j < 16; ++j) { const unsigned c = xb_ld(&bar[XB_XCNT(j)]); sum += c; cnt += (c > 0u) ? 1u : 0u; mine = (j == x) ? c : mine; }
        if (sum == G) break;
        __builtin_amdgcn_s_sleep(1);
        if ((++sp & 255u) == 0u) { if (xb_ld(&bar[XB_TMO])) break; if (sp > XB_SPIN_CAP) { atomicAdd(&bar[XB_TMO], 1u); break; } }
    }
    nloc = mine > 0u ? mine : 1u; nx = cnt > 0u ? cnt : 1u;
}

__device__ __forceinline__ void xcd_barrier(const XcdBarrier& b) {
    asm volatile("s_waitcnt vmcnt(0)" ::: "memory");
    __syncthreads();
    if (threadIdx.x == 0) {
        unsigned* bar = b.bar;
        __builtin_amdgcn_s_waitcnt(0);
        unsigned nloc = b.st[0], nx = b.st[1];
        if (nloc == 0u) { xcd_barrier_complete(bar, b.x, nloc, nx); b.st[0] = nloc; b.st[1] = nx; }
        const unsigned old = xb_add(&bar[XB_XSUB(b.x)], 1u);
        const unsigned gen = old / nloc;
        if (old + 1u == (gen + 1u) * nloc) {
            __builtin_amdgcn_fence(__ATOMIC_RELEASE, "agent");
            asm volatile("s_waitcnt vmcnt(0)" ::: "memory");
            const unsigned og = xb_add(&bar[XB_TOP], 1u);
            const unsigned tg = og / nx;
            if (og + 1u == (tg + 1u) * nx) xb_add(&bar[XB_TOPGEN], 1u);
            else XB_SPIN(xb_ld(&bar[XB_TOPGEN]) == tg, bar);
            __builtin_amdgcn_fence(__ATOMIC_ACQUIRE, "agent");
            xb_add(&bar[XB_XGEN(b.x)], 1u);
            asm volatile("s_waitcnt vmcnt(0)" ::: "memory");
        } else {
            XB_SPIN(xb_ld(&bar[XB_XGEN(b.x)]) == gen, bar);
            __builtin_amdgcn_fence(__ATOMIC_ACQUIRE, "agent");
            asm volatile("s_waitcnt vmcnt(0)" ::: "memory");
        }
    }
    __syncthreads();
}

constexpr int BG_ITEMS = 16, BG_UNITS_LAYER = (I_LAYER + BG_ITEMS - 1) / BG_ITEMS, BG_TOTAL = (DEPTH - 1) * BG_UNITS_LAYER;
__device__ __forceinline__ void bg_unit(const Params& P, LAS unsigned char* lds, int u, int wave) {
    const int l = 1 + u / BG_UNITS_LAYER, r0 = (u % BG_UNITS_LAYER) * BG_ITEMS + wave * (BG_ITEMS / NWAVES);
    LAS float* scr = (LAS float*)(lds + wave * 16384); const int ln = lane_id_opaque();
    for (int k = 0; k < BG_ITEMS / NWAVES; ++k) { const int r = r0 + k; if (r < I_LAYER) p0_layer_item(P, scr, l, r, ln); }
}
__device__ __forceinline__ void bg_fill(const Params& P, LAS unsigned char* lds, unsigned* ctl, int bar_idx, int must_upto, int tid, int wave) {
    unsigned* done = ctl + 2560 + 16 * bar_idx; unsigned* nxt = ctl + 64 * 39;
    LAS int* slot = (LAS int*)(lds + L_MISC) + 3;
    const unsigned thresh = (gridDim.x * 13u) / 16u;
    __syncthreads();
    if (tid == 0) atomicAdd(done, 1u);
    for (;;) {
        if (tid == 0) { int u = -1; const unsigned cur = __hip_atomic_load(nxt, __ATOMIC_RELAXED, __HIP_MEMORY_SCOPE_AGENT);
            bool want = cur < (unsigned)must_upto;
            if (!want && cur < (unsigned)BG_TOTAL) want = __hip_atomic_load(done, __ATOMIC_RELAXED, __HIP_MEMORY_SCOPE_AGENT) < thresh;
            if (want) { u = (int)atomicAdd(nxt, 1u); if (u >= BG_TOTAL) u = -1; }
            *slot = u; }
        __syncthreads();
        const int u = *slot;
        __syncthreads();
        if (u < 0) break;
        bg_unit(P, lds, u, wave);
    }
}

__global__ void __launch_bounds__(NTHREADS) fwd_megakernel(Params P) {
    extern __shared__ __attribute__((aligned(16))) unsigned char lds_raw[];
    LAS unsigned char* lds = (LAS unsigned char*)lds_raw;
    int wave0 = __builtin_amdgcn_readfirstlane((int)threadIdx.x >> 6);
    unsigned char* ws0 = P.ws;
    volatile LAS unsigned* bst = (volatile LAS unsigned*)(lds + LDS_BYTES - 64);
    if (threadIdx.x < 2) bst[threadIdx.x] = 0u;
    __syncthreads();
    (void)xcd_barrier_post((unsigned*)(P.ws + WS_CTL) + 4096, bst);
#define GRID_BAR() do { XcdBarrier b_; b_.bar = (unsigned*)(ws0 + WS_CTL) + 4096; b_.x = xb_xcc_id(); b_.st = (volatile LAS unsigned*)(lds + LDS_BYTES - 64); xcd_barrier(b_); } while (0)
    { const int wave = wave0, lane = lane_id_opaque(), tid = wave * 64 + lane;

#ifndef SKIP_P0
    p0_prologue(P, lds, tid, lane, wave);
#ifdef DUP_P0
    p0_prologue(P, lds, tid, lane, wave);
#endif
#endif
    }
    GRID_BAR();

#pragma unroll 1
    for (int layer = 0; layer < DEPTH; ++layer) {
        asm volatile("" : "+s"(wave0), "+s"(ws0));
        const int wave = wave0, lane = lane_id_opaque(), tid = wave * 64 + lane;
        const int G = gridDim.x, gw = blockIdx.x * NWAVES + wave, NGW = G * NWAVES;
        unsigned char* ws = ws0;
        unsigned* ctl = (unsigned*)(ws + WS_CTL);
#ifdef PROBE_ZERO_O
        for (size_t i = (size_t)blockIdx.x * NTHREADS + tid; i < (size_t)MROWS * 2048 / 8; i += (size_t)G * NTHREADS) ((u32x4*)(ws + WS_O))[i] = (u32x4){0u, 0u, 0u, 0u};
#endif
        { pg8::Gemm gm{(const pg8::bf16_t*)(ws + WS_XB), (const pg8::bf16_t*)(ws + WS_WIN + layer * SZ_WIN), MROWS, INP, DM};
          pg8::StaticOrder S; S.init(MROWS, INP, G, (int)blockIdx.x);
          pg8::EpiScaleBf16 E{(pg8::bf16_t*)(ws + WS_PROJ), INP, (const float*)(ws + WS_SSP)};
          pg8::gemm_phase<pg8::EpiScaleBf16, pg8::StaticOrder, true, true>(lds, gm, S, E, wave); }
#ifdef BGFILL
        bg_fill(P, lds, ctl, layer * 10 + 0, BG_UNITS_LAYER * (layer + 0), tid, wave);
#endif
        GRID_BAR();
#ifndef SKIP_CMP
        for (int it = wave * G + (int)blockIdx.x; it < 384 + 512; it += NGW) { if (it < 384) item_compress(P, layer, it, lane); else item_kmean(P, it - 384, lane); }
#ifdef DUP_CMP
        for (int it = wave * G + (int)blockIdx.x; it < 384 + 512; it += NGW) { if (it < 384) item_compress(P, layer, it, lane); else item_kmean(P, it - 384, lane); }
#endif
#endif
#ifndef SKIP_MIXA
#ifdef DUP_P2A
        for (int rep_ = 0; rep_ < 2; ++rep_)
        for (;;) { const int u = next_unit(ctl + 64 * (layer * 2 + 0 + 8 * rep_), lds, tid); if (u >= 1536) break; const int ln_ = lane_id_opaque(); unit_mixA(P, lds, u, wave * 64 + ln_, ln_, wave); }
#else
        for (;;) { const int u = next_unit(ctl + 64 * (layer * 2 + 0), lds, tid); if (u >= 1536) break; const int ln_ = lane_id_opaque(); unit_mixA(P, lds, u, wave * 64 + ln_, ln_, wave); }
#endif
#endif
        GRID_BAR();
        for (int r = gw; r < MROWS; r += 4 * NGW) item_combineA4(P, r, NGW, lane);
#ifdef DUP_P2B
        for (int rep_ = 0; rep_ < 2; ++rep_)
        for (;;) { const int u = next_unit(ctl + 64 * (layer * 2 + 1 + 8 * rep_), lds, tid); if (u >= 384 + 1024) break;
#ifdef DUP_NSA_ONLY
            if (rep_ == 1 && u >= 384) continue;
#endif
#else
#ifdef TAILFILL_P2B
        const int n_units_b = 384 + 1024 + ((layer + 1 < DEPTH) ? N_CONV_UNITS : 0);
#else
        const int n_units_b = 384 + 1024;
#endif
        for (;;) { const int u = next_unit(ctl + 64 * (layer * 2 + 1), lds, tid); if (u >= n_units_b) break;
            if (u >= 384 + 1024) {
                LAS float* scr = (LAS float*)(lds + wave * 16384); const int ln_ = lane_id_opaque();
                for (int k = 0; k < CONV_UNIT_ITEMS / NWAVES; ++k) { const int r = (u - 384 - 1024) * CONV_UNIT_ITEMS + wave * (CONV_UNIT_ITEMS / NWAVES) + k; if (r < I_LAYER) p0_layer_item(P, scr, layer + 1, r, ln_); }
                continue; }
#endif
            if (u < 384) {
#ifndef SKIP_NSA
                { const int ln_ = lane_id_opaque(); unit_nsa(P, lds, (u % 6) / 3, (u % 6) % 3, 63 - u / 6, wave * 64 + ln_, ln_, wave); }
#endif
            } else { const int v = u - 384;
#ifndef SKIP_MOBA
                { const int ln_ = lane_id_opaque(); unit_moba(P, lds, (v % 16) / 8, (v % 16) % 8, 63 - v / 16, wave * 64 + ln_, ln_, wave); }
#endif
            } }
        GRID_BAR();
        { pg8::Gemm gm{(const pg8::bf16_t*)(ws + WS_O), (const pg8::bf16_t*)(ws + WS_WOUT + layer * SZ_WOUT), MROWS, DM, DM};
          pg8::StaticOrder S; S.init(MROWS, DM, G, (int)blockIdx.x);
          pg8::EpiResid E{(pg8::bf16_t*)(ws + WS_XB), (float*)(ws + WS_SSP)};
          pg8::gemm_phase<pg8::EpiResid, pg8::StaticOrder, true, true>(lds, gm, S, E, wave); }
        GRID_BAR();
#ifdef FUSE_CONV
        { pg8::Gemm gm{(const pg8::bf16_t*)(ws + WS_XB), (const pg8::bf16_t*)(ws + WS_WUP + layer * SZ_WUP), MROWS, UPW, DM};
          pg8::StaticOrder S; S.init(MROWS, UPW, G, (int)blockIdx.x);
          pg8::EpiConvGate E{(pg8::bf16_t*)(ws + WS_ACT), (pg8::bf16_t*)(ws + WS_UB), (const float*)(ws + WS_SSP), P.conv_w + (size_t)layer * 3 * UPW, P.conv_b + (size_t)layer * UPW, DFF};
          pg8::gemm_phase<pg8::EpiConvGate, pg8::StaticOrder, true, true>(lds, gm, S, E, wave); }
#ifdef BGFILL
        bg_fill(P, lds, ctl, layer * 10 + 4, BG_UNITS_LAYER * (layer + 0), tid, wave);
#endif
        GRID_BAR();
        phase_convfix(P, layer, tid);
        GRID_BAR();
#else
        { pg8::Gemm gm{(const pg8::bf16_t*)(ws + WS_XB), (const pg8::bf16_t*)(ws + WS_WUP + layer * SZ_WUP), MROWS, UPW, DM};
          pg8::StaticOrder S; S.init(MROWS, UPW, G, (int)blockIdx.x);
          pg8::EpiScaleBf16 E{(pg8::bf16_t*)(ws + WS_U), UPW, (const float*)(ws + WS_SSP)};
#ifdef DUP_G3
          pg8::gemm_phase<pg8::EpiScaleBf16, pg8::StaticOrder, true, true>(lds, gm, S, E, wave);
#endif
          pg8::gemm_phase<pg8::EpiScaleBf16, pg8::StaticOrder, true, true>(lds, gm, S, E, wave); }
        GRID_BAR();
#ifndef SKIP_CONV
        phase_conv(P, layer, tid);
#ifdef DUP_CONV
        phase_conv(P, layer, tid);
#endif
#endif
        GRID_BAR();
#endif
        { pg8::Gemm gm{(const pg8::bf16_t*)(ws + WS_ACT), (const pg8::bf16_t*)(ws + WS_WDN + layer * SZ_WDN), MROWS, DM, DFF};
          pg8::StaticOrder S; S.init(MROWS, DM, G, (int)blockIdx.x);
          pg8::EpiResid E{(pg8::bf16_t*)(ws + WS_XB), (float*)(ws + WS_SSP)};
          pg8::gemm_phase<pg8::EpiResid, pg8::StaticOrder, true, true>(lds, gm, S, E, wave); }
#ifdef BGFILL
        bg_fill(P, lds, ctl, layer * 10 + 8, BG_UNITS_LAYER * (layer + 1), tid, wave);
#endif
        GRID_BAR();
    }
    const int wave = wave0, lane = lane_id_opaque();
    const int G = gridDim.x, gw = blockIdx.x * NWAVES + wave, NGW = G * NWAVES;
    unsigned char* ws = ws0; (void)G;
    for (int mrow = gw; mrow < MROWS; mrow += NGW) {
        const u32x2* xr = (const u32x2*)((const bf16_t*)(ws + WS_XB) + (size_t)mrow * DM) + lane; const f32x4* gr = (const f32x4*)P.norm_final + lane;
        f32x4 v[8]; float s = 0.f;
#pragma unroll
        for (int j = 0; j < 8; ++j) { const u32x2 w = xr[64 * j]; v[j] = (f32x4){bflo(w.x), bfhi(w.x), bflo(w.y), bfhi(w.y)}; s += (v[j][0] * v[j][0] + v[j][1] * v[j][1]) + (v[j][2] * v[j][2] + v[j][3] * v[j][3]); }
#pragma unroll
        for (int o = 1; o < 64; o <<= 1) s += __shfl_xor(s, o);
        const float rs = 1.0f / sqrtf(s * (1.0f / DM) + 1e-6f);
        f32x4* orow = (f32x4*)(P.out + (size_t)mrow * DM) + lane;
#pragma unroll
        for (int j = 0; j < 8; ++j) orow[64 * j] = v[j] * rs * gr[64 * j];
    }
}

extern "C" void kernel_launch(void* const* d_in, const int* in_sizes, int n_in, void* d_out, int out_size, void* d_ws, size_t ws_size, hipStream_t stream) {
    static int grid = 0;
    if (grid == 0) {
        if (n_in != 14 || ws_size < WS_END) { fprintf(stderr, "kernel_launch: unexpected n_in %d or workspace %zu < %zu\n", n_in, ws_size, (size_t)WS_END); grid = -1; return; }
        int dev = 0, cus = 0, per_cu = 0;
        hipGetDevice(&dev); hipDeviceGetAttribute(&cus, hipDeviceAttributeMultiprocessorCount, dev);
        if (hipFuncSetAttribute((const void*)fwd_megakernel, hipFuncAttributeMaxDynamicSharedMemorySize, LDS_BYTES) != hipSuccess) { fprintf(stderr, "kernel_launch: hipFuncSetAttribute failed\n"); grid = -1; return; }
        if (hipOccupancyMaxActiveBlocksPerMultiprocessor(&per_cu, (const void*)fwd_megakernel, NTHREADS, LDS_BYTES) != hipSuccess || per_cu < 1) { fprintf(stderr, "kernel_launch: occupancy query says %d\n", per_cu); per_cu = 1; }
        (void)hipGetLastError();
        grid = cus * 1;
    }
    if (grid < 0) return;
    hipMemsetAsync((char*)d_ws + WS_CTL, 0, 32768, stream);
    Params p{};
    p.x = (const float*)d_in[0]; p.rel = (const float*)d_in[1]; p.w_in = (const float*)d_in[2]; p.w_out = (const float*)d_in[3]; p.cmp_w1 = (const float*)d_in[4]; p.cmp_w2 = (const float*)d_in[5];
    p.cmp_pe = (const float*)d_in[6]; p.norm_attn = (const float*)d_in[7]; p.norm_mlp = (const float*)d_in[8]; p.w_up = (const float*)d_in[9]; p.conv_w = (const float*)d_in[10]; p.conv_b = (const float*)d_in[11];
    p.w_down = (const float*)d_in[12]; p.norm_final = (const float*)d_in[13]; p.out = (float*)d_out; p.ws = (unsigned char*)d_ws;
    void* args[] = {&p};
    hipError_t e = hipLaunchCooperativeKernel((const void*)fwd_megakernel, dim3(grid), dim3(NTHREADS), args, LDS_BYTES, stream);
    if (e != hipSuccess) fprintf(stderr, "kernel_launch: cooperative launch failed: %s (grid %d)\n", hipGetErrorString(e), grid);
}
```
